# Optimizing an MI355X kernel written in HIP

```python
import math
import jax, jax.numpy as jnp
from jax import lax
import numpy as np

D_MODEL = 1024
BATCH = 1
SEQ = 16384
DEPTH = 4
DEC_BATCH = 8
DEC_SEQ = 16
PAST_LEN = 1024

CHUNK = 64
N_META = 16
N_MIXERS = 2
N_FOX = (DEPTH + 1) // 2
N_RET = DEPTH // 2
EPS = 1e-6

FOX_HEADS = 16
FOX_HEAD_DIM = 64
FOX_WIDTH = FOX_HEADS * FOX_HEAD_DIM
FOX_QBLOCK = 128
FOX_IN = 4 * FOX_WIDTH + FOX_HEADS

RET_HEADS = 4
RET_QK_DIM = 256
RET_V_DIM = 512
RET_QK_WIDTH = RET_HEADS * RET_QK_DIM
RET_V_WIDTH = RET_HEADS * RET_V_DIM
RET_IN = 2 * RET_QK_WIDTH + 2 * RET_V_WIDTH
ROPE_BASE = 10000.0

PEER_HEADS = 8
PEER_NKEYS = 128
PEER_EXPERTS = PEER_NKEYS * PEER_NKEYS
PEER_QDIM = 256
PEER_HALF = PEER_QDIM // 2
PEER_TOPK = 16
PEER_BLOCK = 128

kernel_name = 'fox_retention_peer_stream'


def _rmsnorm(x, g):
    xf = x.astype(jnp.float32)
    y = xf * lax.rsqrt(jnp.mean(xf * xf, axis=-1, keepdims=True) + EPS)
    return (y * g.astype(jnp.float32)).astype(x.dtype)


def _rotary(x, pos):
    half = x.shape[-1] // 2
    inv = ROPE_BASE ** (-jnp.arange(half, dtype=jnp.float32) / half)
    ang = pos.astype(jnp.float32)[:, None] * inv[None, :]
    cos = jnp.cos(ang)[:, None, :]
    sin = jnp.sin(ang)[:, None, :]
    xf = x.astype(jnp.float32)
    x1, x2 = xf[..., :half], xf[..., half:]
    return jnp.concatenate([x1 * cos - x2 * sin, x1 * sin + x2 * cos], axis=-1).astype(x.dtype)


def _ret_log_decay():
    return jnp.log(1.0 - 2.0 ** (-5.0 - jnp.arange(RET_HEADS, dtype=jnp.float32)))


def _fox_project(h, w_in, b_f, g_q, g_k):
    b, l, _ = h.shape
    z = h @ w_in
    shp = (b, l, FOX_HEADS, FOX_HEAD_DIM)
    q = _rmsnorm(z[..., :FOX_WIDTH].reshape(shp), g_q)
    k = _rmsnorm(z[..., FOX_WIDTH:2 * FOX_WIDTH].reshape(shp), g_k)
    v = z[..., 2 * FOX_WIDTH:3 * FOX_WIDTH].reshape(shp)
    og = z[..., 3 * FOX_WIDTH:4 * FOX_WIDTH]
    lf = jax.nn.log_sigmoid((z[..., 4 * FOX_WIDTH:] + b_f).astype(jnp.float32))
    return q, k, v, og, lf


def _fox_attend_prompt(q, k, v, lf):
    b, l, h, dh = q.shape
    c = jnp.cumsum(lf, axis=1)
    c_t = c.transpose(0, 2, 1)
    nb = -(-l // FOX_QBLOCK)
    pad = nb * FOX_QBLOCK - l
    qb = jnp.pad(q, ((0, 0), (0, pad), (0, 0), (0, 0))).reshape(b, nb, FOX_QBLOCK, h, dh).transpose(1, 0, 2, 3, 4)
    cb = jnp.pad(c, ((0, 0), (0, pad), (0, 0))).reshape(b, nb, FOX_QBLOCK, h).transpose(1, 0, 2, 3)
    kpos = jnp.arange(l)
    scale = dh ** -0.5

    def block(args):
        q_blk, c_blk, bi = args
        qpos = bi * FOX_QBLOCK + jnp.arange(FOX_QBLOCK)
        s = jnp.einsum('bqhd,bkhd->bhqk', q_blk, k).astype(jnp.float32) * scale
        s = s + (c_blk.transpose(0, 2, 1)[..., :, None] - c_t[:, :, None, :])
        s = jnp.where(kpos[None, :] <= qpos[:, None], s, -jnp.inf)
        p = jax.nn.softmax(s, axis=-1)
        return jnp.einsum('bhqk,bkhd->bqhd', p.astype(v.dtype), v)

    o = lax.map(block, (qb, cb, jnp.arange(nb)))
    return o.transpose(1, 0, 2, 3, 4).reshape(b, nb * FOX_QBLOCK, h, dh)[:, :l]


def _fox_attend_sample(q, k_new, v_new, lf_new, k_cache, v_cache, lf_cache):
    p_len = k_cache.shape[1]
    n = q.shape[1]
    k = jnp.concatenate([k_cache, k_new], axis=1)
    v = jnp.concatenate([v_cache, v_new], axis=1)
    c = jnp.cumsum(jnp.concatenate([lf_cache.astype(jnp.float32), lf_new], axis=1), axis=1)
    c_t = c.transpose(0, 2, 1)
    s = jnp.einsum('bqhd,bkhd->bhqk', q, k).astype(jnp.float32) * (q.shape[-1] ** -0.5)
    s = s + (c_t[:, :, p_len:, None] - c_t[:, :, None, :])
    mask = jnp.arange(p_len + n)[None, :] <= (p_len + jnp.arange(n))[:, None]
    s = jnp.where(mask, s, -jnp.inf)
    p = jax.nn.softmax(s, axis=-1)
    return jnp.einsum('bhqk,bkhd->bqhd', p.astype(v.dtype), v)


def _fox_output(o, og, w_out):
    b, l = o.shape[:2]
    y = o.reshape(b, l, FOX_WIDTH) * jax.nn.sigmoid(og.astype(jnp.float32)).astype(o.dtype)
    return y @ w_out


def _ret_project(h, w_in, pos):
    b, l, _ = h.shape
    z = h @ w_in
    q = _rotary(z[..., :RET_QK_WIDTH].reshape(b, l, RET_HEADS, RET_QK_DIM), pos) * (RET_QK_DIM ** -0.5)
    k = _rotary(z[..., RET_QK_WIDTH:2 * RET_QK_WIDTH].reshape(b, l, RET_HEADS, RET_QK_DIM), pos)
    v = z[..., 2 * RET_QK_WIDTH:2 * RET_QK_WIDTH + RET_V_WIDTH].reshape(b, l, RET_HEADS, RET_V_DIM)
    g = z[..., 2 * RET_QK_WIDTH + RET_V_WIDTH:]
    return q, k, v, g


def _retention_prompt(q, k, v):
    b, l, h, _ = q.shape
    lead = (-l) % CHUNK
    nc = (l + lead) // CHUNK
    padf = lambda a: jnp.pad(a.astype(jnp.float32), ((0, 0), (lead, 0), (0, 0), (0, 0)))
    qc = padf(q).reshape(b, nc, CHUNK, h, RET_QK_DIM)
    kc = padf(k).reshape(b, nc, CHUNK, h, RET_QK_DIM)
    vc = padf(v).reshape(b, nc, CHUNK, h, RET_V_DIM)
    logg = _ret_log_decay()
    idx = jnp.arange(CHUNK, dtype=jnp.float32)
    dmat = jnp.exp(logg[:, None, None] * jnp.abs(idx[:, None] - idx[None, :]))
    s = jnp.einsum('bnihd,bnjhd->bnhij', qc, kc) * dmat
    o_intra = jnp.einsum('bnhij,bnjhe->bnihe', s, vc)
    q_dec = jnp.exp(logg[None, :] * (idx[:, None] + 1.0))
    k_dec = jnp.exp(logg[None, :] * (CHUNK - 1.0 - idx[:, None]))
    c_dec = jnp.exp(logg * CHUNK)

    def step(state, inp):
        qn, kn, vn = inp
        o = jnp.einsum('bihd,bhde->bihe', qn, state) * q_dec[None, :, :, None]
        state = state * c_dec[None, :, None, None] + jnp.einsum('bjhd,jh,bjhe->bhde', kn, k_dec, vn)
        return state, o

    s0 = jnp.zeros((b, h, RET_QK_DIM, RET_V_DIM), jnp.float32)
    s_fin, o_inter = lax.scan(step, s0, (qc.transpose(1, 0, 2, 3, 4), kc.transpose(1, 0, 2, 3, 4), vc.transpose(1, 0, 2, 3, 4)))
    o = o_intra + o_inter.transpose(1, 0, 2, 3, 4)
    return o.reshape(b, nc * CHUNK, h, RET_V_DIM)[:, lead:], s_fin


def _retention_sample(q, k, v, state):
    n = q.shape[1]
    qf, kf, vf = q.astype(jnp.float32), k.astype(jnp.float32), v.astype(jnp.float32)
    st = state.astype(jnp.float32)
    logg = _ret_log_decay()
    idx = jnp.arange(n, dtype=jnp.float32)
    dmat = jnp.exp(logg[:, None, None] * jnp.abs(idx[:, None] - idx[None, :]))
    s = jnp.einsum('bihd,bjhd->bhij', qf, kf) * dmat
    o = jnp.einsum('bhij,bjhe->bihe', s, vf)
    o = o + jnp.einsum('bihd,bhde->bihe', qf, st) * jnp.exp(logg[None, :] * (idx[:, None] + 1.0))[None, :, :, None]
    k_dec = jnp.exp(logg[None, :] * (n - 1.0 - idx[:, None]))
    new_state = st * jnp.exp(logg * n)[None, :, None, None] + jnp.einsum('bjhd,jh,bjhe->bhde', kf, k_dec, vf)
    return o, new_state


def _ret_output(o, g, gn, w_out):
    b, l = o.shape[:2]
    of = o.astype(jnp.float32)
    mu = jnp.mean(of, axis=-1, keepdims=True)
    var = jnp.mean(jnp.square(of - mu), axis=-1, keepdims=True)
    y = ((of - mu) * lax.rsqrt(var + EPS)).reshape(b, l, RET_V_WIDTH) * gn.astype(jnp.float32)
    y = jax.nn.silu(g.astype(jnp.float32)) * y
    return y.astype(g.dtype) @ w_out


def _peer(h, w_q, subkeys, u_tab, v_tab):
    t, d = h.shape
    nb = -(-t // PEER_BLOCK)
    hb = jnp.pad(h, ((0, nb * PEER_BLOCK - t), (0, 0))).reshape(nb, PEER_BLOCK, d)

    def block(xb):
        qh = (xb @ w_q).reshape(PEER_BLOCK, PEER_HEADS, 2, PEER_HALF)
        s = jnp.einsum('thpc,hpkc->thpk', qh, subkeys).astype(jnp.float32)
        sv, si = lax.top_k(s, PEER_TOPK)
        cand = (sv[:, :, 0, :, None] + sv[:, :, 1, None, :]).reshape(PEER_BLOCK, PEER_HEADS, PEER_TOPK * PEER_TOPK)
        cid = (si[:, :, 0, :, None] * PEER_NKEYS + si[:, :, 1, None, :]).reshape(PEER_BLOCK, PEER_HEADS, PEER_TOPK * PEER_TOPK)
        fv, fi = lax.top_k(cand, PEER_TOPK)
        eid = jnp.take_along_axis(cid, fi, axis=-1)
        gate = jax.nn.softmax(fv, axis=-1)
        a = jax.nn.gelu(jnp.einsum('thkd,td->thk', u_tab[eid], xb).astype(jnp.float32), approximate=False)
        w = (gate * a).astype(xb.dtype)
        return jnp.einsum('thk,thkd->td', w, v_tab[eid])

    return lax.map(block, hb).reshape(nb * PEER_BLOCK, d)[:t]


def setup_inputs(seed: int = 0) -> dict:
    key = jax.random.key(seed)
    ks = jax.random.split(key, 24)
    f32 = jnp.float32
    nrm = lambda k, shape, scale: scale * jax.random.normal(k, shape, f32)
    return {
        'x_prompt': nrm(ks[0], (BATCH, SEQ, D_MODEL), 1.0),
        'x_sample': nrm(ks[1], (DEC_BATCH, DEC_SEQ, D_MODEL), 1.0),
        'cache_fox_k': nrm(ks[2], (N_FOX, DEC_BATCH, PAST_LEN, FOX_HEADS, FOX_HEAD_DIM), 1.0),
        'cache_fox_v': nrm(ks[3], (N_FOX, DEC_BATCH, PAST_LEN, FOX_HEADS, FOX_HEAD_DIM), 1.0),
        'cache_fox_lf': jax.nn.log_sigmoid(3.0 + nrm(ks[4], (N_FOX, DEC_BATCH, PAST_LEN, FOX_HEADS), 1.5)),
        'state_ret': nrm(ks[5], (N_RET, DEC_BATCH, RET_HEADS, RET_QK_DIM, RET_V_DIM), 0.5),
        'meta_tokens': nrm(ks[6], (N_META, D_MODEL), 1.0),
        'norm_mix': 1.0 + nrm(ks[7], (DEPTH, D_MODEL), 0.02),
        'norm_ffn': 1.0 + nrm(ks[8], (DEPTH, D_MODEL), 0.02),
        'fox_w_in': nrm(ks[9], (N_FOX, D_MODEL, FOX_IN), D_MODEL ** -0.5),
        'fox_b_f': jax.random.uniform(ks[10], (N_FOX, FOX_HEADS), f32, 1.0, 6.0),
        'fox_q_norm': 1.0 + nrm(ks[11], (N_FOX, FOX_HEAD_DIM), 0.02),
        'fox_k_norm': 1.0 + nrm(ks[12], (N_FOX, FOX_HEAD_DIM), 0.02),
        'fox_w_out': nrm(ks[13], (N_FOX, FOX_WIDTH, D_MODEL), 0.5 * FOX_WIDTH ** -0.5),
        'ret_w_in': nrm(ks[14], (N_RET, D_MODEL, RET_IN), D_MODEL ** -0.5),
        'ret_gn': 1.0 + nrm(ks[15], (N_RET, RET_V_WIDTH), 0.02),
        'ret_w_out': nrm(ks[16], (N_RET, RET_V_WIDTH, D_MODEL), 0.5 * RET_V_WIDTH ** -0.5),
        'peer_w_q': nrm(ks[17], (DEPTH, D_MODEL, PEER_HEADS * PEER_QDIM), D_MODEL ** -0.5),
        'peer_subkeys': nrm(ks[18], (DEPTH, PEER_HEADS, 2, PEER_NKEYS, PEER_HALF), PEER_HALF ** -0.5),
        'peer_u': nrm(ks[19], (DEPTH, PEER_EXPERTS, D_MODEL), D_MODEL ** -0.5),
        'peer_v': nrm(ks[20], (DEPTH, PEER_EXPERTS, D_MODEL), 0.1),
    }


def reference(x_prompt, x_sample, cache_fox_k, cache_fox_v, cache_fox_lf, state_ret,
              meta_tokens, norm_mix, norm_ffn, fox_w_in, fox_b_f, fox_q_norm, fox_k_norm, fox_w_out,
              ret_w_in, ret_gn, ret_w_out, peer_w_q, peer_subkeys, peer_u, peer_v):
    b, s_len, d = x_prompt.shape
    bd, n, _ = x_sample.shape
    p_len = cache_fox_k.shape[2]
    l = N_META + s_len
    xp = jnp.concatenate([jnp.broadcast_to(meta_tokens[None].astype(x_prompt.dtype), (b, N_META, d)), x_prompt], axis=1)
    xs = x_sample
    pos_p = jnp.arange(l) - N_META
    pos_s = p_len + jnp.arange(n)
    kp_l, vp_l, lfp_l, ks_l, vs_l, lfs_l, srp_l, srs_l = [], [], [], [], [], [], [], []
    for layer in range(DEPTH):
        j = layer // N_MIXERS
        hp = _rmsnorm(xp, norm_mix[layer])
        hs = _rmsnorm(xs, norm_mix[layer])
        if layer % N_MIXERS == 0:
            qp, kp, vp, gp, lfp = _fox_project(hp, fox_w_in[j], fox_b_f[j], fox_q_norm[j], fox_k_norm[j])
            qs, kss, vss, gs, lfs = _fox_project(hs, fox_w_in[j], fox_b_f[j], fox_q_norm[j], fox_k_norm[j])
            op = _fox_attend_prompt(qp, kp, vp, lfp)
            osm = _fox_attend_sample(qs, kss, vss, lfs, cache_fox_k[j], cache_fox_v[j], cache_fox_lf[j])
            xp = xp + _fox_output(op, gp, fox_w_out[j])
            xs = xs + _fox_output(osm, gs, fox_w_out[j])
            kp_l.append(kp)
            vp_l.append(vp)
            lfp_l.append(lfp.astype(x_prompt.dtype))
            ks_l.append(kss)
            vs_l.append(vss)
            lfs_l.append(lfs.astype(cache_fox_lf.dtype))
        else:
            qp, kp, vp, gp = _ret_project(hp, ret_w_in[j], pos_p)
            qs, kss, vss, gs = _ret_project(hs, ret_w_in[j], pos_s)
            op, st_p = _retention_prompt(qp, kp, vp)
            osm, st_s = _retention_sample(qs, kss, vss, state_ret[j])
            xp = xp + _ret_output(op, gp, ret_gn[j], ret_w_out[j])
            xs = xs + _ret_output(osm, gs, ret_gn[j], ret_w_out[j])
            srp_l.append(st_p.astype(x_prompt.dtype))
            srs_l.append(st_s.astype(state_ret.dtype))
        xp = xp + _peer(_rmsnorm(xp, norm_ffn[layer]).reshape(b * l, d), peer_w_q[layer], peer_subkeys[layer], peer_u[layer], peer_v[layer]).reshape(b, l, d)
        xs = xs + _peer(_rmsnorm(xs, norm_ffn[layer]).reshape(bd * n, d), peer_w_q[layer], peer_subkeys[layer], peer_u[layer], peer_v[layer]).reshape(bd, n, d)
    y_prompt = xp[:, N_META:]
    y_sample = xs
    new_fox_k_prompt = jnp.stack(kp_l)
    new_fox_v_prompt = jnp.stack(vp_l)
    new_fox_lf_prompt = jnp.stack(lfp_l)
    new_state_ret_prompt = jnp.stack(srp_l)
    new_fox_k_sample = jnp.stack(ks_l)
    new_fox_v_sample = jnp.stack(vs_l)
    new_fox_lf_sample = jnp.stack(lfs_l)
    new_state_ret_sample = jnp.stack(srs_l)
    return (y_prompt, y_sample, new_fox_k_prompt, new_fox_v_prompt, new_fox_lf_prompt, new_state_ret_prompt,
            new_fox_k_sample, new_fox_v_sample, new_fox_lf_sample, new_state_ret_sample)
```

```cpp
#include <hip/hip_runtime.h>
#include <hip/hip_cooperative_groups.h>
#include <stdint.h>
#include <math.h>
#include <stdio.h>
#include <string.h>
namespace cg = cooperative_groups;

typedef unsigned short u16;
typedef __attribute__((ext_vector_type(8))) short bf16x8;
typedef __attribute__((ext_vector_type(4))) float f32x4;
typedef __attribute__((ext_vector_type(2))) float f32x2;
typedef __attribute__((ext_vector_type(4))) unsigned int u32x4;
typedef __attribute__((ext_vector_type(2))) unsigned int u32x2;
#define DEV __device__ __forceinline__

#ifndef ONE_LAUNCH
#define ONE_LAUNCH 1
#endif

constexpr int DM = 1024;
constexpr int NMETA = 16;
constexpr int LP = 16400;
constexpr int NSMP = 128;
constexpr int TTOK = LP + NSMP;
constexpr int TPAD = 16640;
constexpr int MTILES = 130;
constexpr int LEAD = 48;
constexpr int TP2 = 16704;
constexpr int NCH = 257;
constexpr int PAST = 1024;
constexpr int NEXP = 16384;
constexpr float EPS = 1e-6f;

constexpr size_t O_YP = 0;
constexpr size_t O_YS = O_YP + (size_t)16384 * 1024;
constexpr size_t O_FKP = O_YS + (size_t)128 * 1024;
constexpr size_t O_FVP = O_FKP + (size_t)2 * LP * 1024;
constexpr size_t O_FLP = O_FVP + (size_t)2 * LP * 1024;
constexpr size_t O_SRP = O_FLP + (size_t)2 * LP * 16;
constexpr size_t O_FKS = O_SRP + (size_t)2 * 4 * 256 * 512;
constexpr size_t O_FVS = O_FKS + (size_t)2 * 128 * 1024;
constexpr size_t O_FLS = O_FVS + (size_t)2 * 128 * 1024;
constexpr size_t O_SRS = O_FLS + (size_t)2 * 128 * 16;

struct Params {
  const float *x_prompt, *x_sample, *cache_k, *cache_v, *cache_lf, *state_ret, *meta, *norm_mix, *norm_ffn;
  const float *fox_w_in, *fox_b_f, *fox_qn, *fox_kn, *fox_w_out, *ret_w_in, *ret_gn, *ret_w_out;
  const float *peer_wq, *peer_sk, *peer_u, *peer_v;
  float* out;
  float* X; u16* H;
  u16 *WfinT, *WfoutT, *WrinT, *WroutT, *WpqT, *SKb, *Ub, *Vb;
  float *SV; int* SI;
  float *LFC, *LFR, *TT;
  u16 *Qf, *Kf, *VtF, *OGf, *AO;
  u16 *Qr, *Kr, *KrT, *VrT, *Gr, *ST;
  float rope_rev[128];
};

DEV u16 f2bf(float f) {
  uint32_t u = __float_as_uint(f);
  u += 0x7fffu + ((u >> 16) & 1u);
  return (u16)(u >> 16);
}
DEV float bf2f(u16 h) { return __uint_as_float(((uint32_t)h) << 16); }
DEV uint32_t pack2(float a, float b) { return (uint32_t)f2bf(a) | ((uint32_t)f2bf(b) << 16); }
DEV float bflo(uint32_t u) { return __uint_as_float(u << 16); }
DEV float bfhi(uint32_t u) { return __uint_as_float(u & 0xffff0000u); }

union V8 { bf16x8 v; uint32_t u[4]; u32x2 d[2]; u32x4 q; };

DEV f32x4 mfma(bf16x8 a, bf16x8 b, f32x4 c) { return __builtin_amdgcn_mfma_f32_16x16x32_bf16(a, b, c, 0, 0, 0); }

template <int CTRL> DEV float dppf(float v) {
  return __int_as_float(__builtin_amdgcn_update_dpp(0, __float_as_int(v), CTRL, 0xf, 0xf, false));
}
template <int CTRL> DEV uint32_t dppu(uint32_t v) {
  return (uint32_t)__builtin_amdgcn_update_dpp(0, (int)v, CTRL, 0xf, 0xf, false);
}
DEV float row16_sum(float v) {
  v += dppf<0xB1>(v); v += dppf<0x4E>(v); v += dppf<0x141>(v); v += dppf<0x140>(v);
  return v;
}
DEV uint32_t row16_maxu(uint32_t v) {
  v = max(v, dppu<0xB1>(v)); v = max(v, dppu<0x4E>(v)); v = max(v, dppu<0x141>(v)); v = max(v, dppu<0x140>(v));
  return v;
}
DEV float rdlane(float v, int l) { float r = __int_as_float(__builtin_amdgcn_readlane(__float_as_int(v), l)); asm volatile("" : "+v"(r)); return r; }
DEV float wave_sum(float v) {
  v = row16_sum(v);
  return rdlane(v, 0) + rdlane(v, 16) + rdlane(v, 32) + rdlane(v, 48);
}
DEV float wave_max(float v) {
  v = fmaxf(v, dppf<0xB1>(v)); v = fmaxf(v, dppf<0x4E>(v)); v = fmaxf(v, dppf<0x141>(v)); v = fmaxf(v, dppf<0x140>(v));
  return fmaxf(fmaxf(rdlane(v, 0), rdlane(v, 16)), fmaxf(rdlane(v, 32), rdlane(v, 48)));
}
DEV uint32_t wave_maxu(uint32_t v) {
  v = row16_maxu(v);
  uint32_t a = (uint32_t)__builtin_amdgcn_readlane((int)v, 0), b = (uint32_t)__builtin_amdgcn_readlane((int)v, 16);
  uint32_t c = (uint32_t)__builtin_amdgcn_readlane((int)v, 32), d = (uint32_t)__builtin_amdgcn_readlane((int)v, 48);
  return max(max(a, b), max(c, d));
}
DEV uint32_t f2key(float f) { uint32_t u = __float_as_uint(f); return (u & 0x80000000u) ? ~u : (u | 0x80000000u); }
DEV float key2f(uint32_t k) { uint32_t u = (k & 0x80000000u) ? (k & 0x7fffffffu) : ~k; return __uint_as_float(u); }

DEV float sigmoidf_(float x) { return 1.f / (1.f + __expf(-x)); }
DEV float logsigmoid_(float x) { return fminf(x, 0.f) - log1pf(expf(-fabsf(x))); }
DEV float gelu_(float x) { return 0.5f * x * (1.f + erff(x * 0.70710678118654752f)); }
DEV float ret_l2g(int h) { return log2f(1.f - exp2f(-5.f - (float)h)); }
DEV int otid() { int t = threadIdx.x; asm volatile("" : "+v"(t)); return t; }
DEV int perm_dorig(int dp) { return ((dp >> 4) & 1) * 128 + (dp >> 5) * 16 + (dp & 15); }

DEV void norm_rows(const Params& p, const float* gain, bool from_input) {
  int tid_ = otid();
  int lane = tid_ & 63;
  int gw = (blockIdx.x * blockDim.x + tid_) >> 6, nw = (gridDim.x * blockDim.x) >> 6;
  for (int t = gw; t < TPAD; t += nw) {
    const float* src;
    if (from_input) {
      if (t < NMETA) src = p.meta + (size_t)t * DM;
      else if (t < LP) src = p.x_prompt + (size_t)(t - NMETA) * DM;
      else if (t < TTOK) src = p.x_sample + (size_t)(t - LP) * DM;
      else src = nullptr;
    } else src = p.X + (size_t)t * DM;
    f32x4 v[4];
    float ss = 0.f;
#pragma unroll
    for (int c = 0; c < 4; ++c) {
      if (src) v[c] = *(const f32x4*)(src + c * 256 + lane * 4); else v[c] = f32x4{0.f, 0.f, 0.f, 0.f};
      ss += v[c].x * v[c].x + v[c].y * v[c].y + v[c].z * v[c].z + v[c].w * v[c].w;
    }
    ss = wave_sum(ss);
    float rstd = rsqrtf(ss * (1.f / DM) + EPS);
#pragma unroll
    for (int c = 0; c < 4; ++c) {
      if (from_input) *(f32x4*)(p.X + (size_t)t * DM + c * 256 + lane * 4) = v[c];
      f32x4 g = *(const f32x4*)(gain + c * 256 + lane * 4);
      u32x2 o;
      o.x = pack2(v[c].x * rstd * g.x, v[c].y * rstd * g.y);
      o.y = pack2(v[c].z * rstd * g.z, v[c].w * rstd * g.w);
      *(u32x2*)(p.H + (size_t)t * DM + c * 256 + lane * 4) = o;
    }
  }
}

DEV void convert_bf16(const float* src, u16* dst, size_t n4) {
  size_t i = (size_t)blockIdx.x * blockDim.x + otid(), st = (size_t)gridDim.x * blockDim.x;
  for (; i < n4; i += st) {
    f32x4 v = ((const f32x4*)src)[i];
    u32x2 o; o.x = pack2(v.x, v.y); o.y = pack2(v.z, v.w);
    ((u32x2*)dst)[i] = o;
  }
}

DEV void xpose(const float* W, int K, int N, int Npad, u16* Wt, bool permq, char* smem) {
  u16* tile = (u16*)smem;
  int tid = otid();
  int ntn = Npad / 64, ntk = K / 64;
  for (int it = blockIdx.x; it < ntn * ntk; it += gridDim.x) {
    int n0 = (it / ntk) * 64, k0 = (it % ntk) * 64;
    int c = tid & 63, r0 = tid >> 6;
    int np = n0 + c;
    int src = np;
    if (permq && np < 2048) src = (np & ~255) + perm_dorig(np & 255);
    __syncthreads();
#pragma unroll
    for (int i = 0; i < 16; ++i) {
      int k = r0 + 4 * i;
      float v = (np < N) ? W[(size_t)(k0 + k) * N + src] : 0.f;
      tile[c * 72 + k] = f2bf(v);
    }
    __syncthreads();
    int nl = tid >> 2, kq = (tid & 3) * 16;
    u32x4 a = *(const u32x4*)(tile + nl * 72 + kq);
    u32x4 b = *(const u32x4*)(tile + nl * 72 + kq + 8);
    *(u32x4*)(Wt + (size_t)(n0 + nl) * K + k0 + kq) = a;
    *(u32x4*)(Wt + (size_t)(n0 + nl) * K + k0 + kq + 8) = b;
  }
}

DEV void conv_tables(const Params& p, int layer) {
  convert_bf16(p.peer_u + (size_t)layer * NEXP * DM, p.Ub, (size_t)NEXP * DM / 4);
  convert_bf16(p.peer_v + (size_t)layer * NEXP * DM, p.Vb, (size_t)NEXP * DM / 4);
}

DEV void ph_prep(const Params& p, char* smem) {
  norm_rows(p, p.norm_mix, true);
  convert_bf16(p.peer_sk, p.SKb, (size_t)4 * 8 * 2 * 128 * 128 / 4);
  for (int j = 0; j < 2; ++j) {
    xpose(p.fox_w_in + (size_t)j * 1024 * 4112, 1024, 4112, 4224, p.WfinT + (size_t)j * 4224 * 1024, false, smem);
    xpose(p.fox_w_out + (size_t)j * 1024 * 1024, 1024, 1024, 1024, p.WfoutT + (size_t)j * 1024 * 1024, false, smem);
    xpose(p.ret_w_in + (size_t)j * 1024 * 6144, 1024, 6144, 6144, p.WrinT + (size_t)j * 6144 * 1024, true, smem);
    xpose(p.ret_w_out + (size_t)j * 2048 * 1024, 2048, 1024, 1024, p.WroutT + (size_t)j * 1024 * 2048, false, smem);
  }
  for (int l = 0; l < 4; ++l)
    xpose(p.peer_wq + (size_t)l * 1024 * 2048, 1024, 2048, 2048, p.WpqT + (size_t)l * 2048 * 1024, false, smem);
}

constexpr int LDK = 72;
DEV void gemm_tile(const u16* __restrict__ A, int lda, const u16* __restrict__ Bt, int ldb, int K,
                          int m0, int n0, char* smem, f32x4 (&acc)[4][4]) {
  u16* sA = (u16*)smem;
  u16* sB = sA + 128 * LDK;
  int tid = otid(), lane = tid & 63, wid = tid >> 6;
  int wr = wid >> 1, wc = wid & 1, fr = lane & 15, fq = lane >> 4;
#pragma unroll
  for (int m = 0; m < 4; ++m)
#pragma unroll
    for (int n = 0; n < 4; ++n) acc[m][n] = f32x4{0.f, 0.f, 0.f, 0.f};
  u32x4 ra[4], rb[4];
  const u16* Ap = A + (size_t)(m0 + (tid >> 3)) * lda + (tid & 7) * 8;
  const u16* Bp = Bt + (size_t)(n0 + (tid >> 3)) * ldb + (tid & 7) * 8;
#pragma unroll
  for (int i = 0; i < 4; ++i) {
    ra[i] = *(const u32x4*)(Ap + (size_t)(32 * i) * lda);
    rb[i] = *(const u32x4*)(Bp + (size_t)(32 * i) * ldb);
  }
  for (int k0 = 0; k0 < K; k0 += 64) {
    __syncthreads();
#pragma unroll
    for (int i = 0; i < 4; ++i) {
      *(u32x4*)(sA + ((tid >> 3) + 32 * i) * LDK + (tid & 7) * 8) = ra[i];
      *(u32x4*)(sB + ((tid >> 3) + 32 * i) * LDK + (tid & 7) * 8) = rb[i];
    }
    __syncthreads();
    if (k0 + 64 < K) {
#pragma unroll
      for (int i = 0; i < 4; ++i) {
        ra[i] = *(const u32x4*)(Ap + (size_t)(32 * i) * lda + k0 + 64);
        rb[i] = *(const u32x4*)(Bp + (size_t)(32 * i) * ldb + k0 + 64);
      }
    }
#pragma unroll
    for (int ks = 0; ks < 2; ++ks) {
      bf16x8 af[4], bfv[4];
#pragma unroll
      for (int m = 0; m < 4; ++m) af[m] = *(const bf16x8*)(sA + (wr * 64 + m * 16 + fr) * LDK + ks * 32 + fq * 8);
#pragma unroll
      for (int n = 0; n < 4; ++n) bfv[n] = *(const bf16x8*)(sB + (wc * 64 + n * 16 + fr) * LDK + ks * 32 + fq * 8);
#pragma unroll
      for (int m = 0; m < 4; ++m)
#pragma unroll
        for (int n = 0; n < 4; ++n) acc[m][n] = mfma(af[m], bfv[n], acc[m][n]);
    }
  }
}

DEV void ph_f1(const Params& p, int jf, char* smem) {
  const u16* Wt = p.WfinT + (size_t)jf * 4224 * 1024;
  int tid = otid(), lane = tid & 63, wid = tid >> 6;
  int wr = wid >> 1, wc = wid & 1, fr = lane & 15, fq = lane >> 4;
  const int NT = 33;
  for (int it = blockIdx.x; it < MTILES * NT; it += gridDim.x) {
    int mt = it / NT, nt = it % NT;
    int m0 = mt * 128;
    f32x4 acc[4][4];
    gemm_tile(p.H, DM, Wt, DM, DM, m0, nt * 128, smem, acc);
    int type = nt >> 3;
    if (type <= 1) {
      int hh = (nt & 7) * 2 + wc;
      const float* gn = (type == 0 ? p.fox_qn : p.fox_kn) + jf * 64;
      float g[4];
#pragma unroll
      for (int n = 0; n < 4; ++n) g[n] = gn[n * 16 + fr] * (type == 0 ? 0.125f : 1.f);
#pragma unroll
      for (int m = 0; m < 4; ++m)
#pragma unroll
        for (int j = 0; j < 4; ++j) {
          float ss = 0.f;
#pragma unroll
          for (int n = 0; n < 4; ++n) ss += acc[m][n][j] * acc[m][n][j];
          ss = row16_sum(ss);
          float rstd = rsqrtf(ss * (1.f / 64.f) + EPS);
          int row = m0 + wr * 64 + m * 16 + fq * 4 + j;
#pragma unroll
          for (int n = 0; n < 4; ++n) {
            float v = acc[m][n][j] * rstd * g[n];
            int col = hh * 64 + n * 16 + fr;
            if (type == 0) p.Qf[(size_t)row * DM + col] = f2bf(v);
            else {
              p.Kf[(size_t)row * DM + col] = f2bf(v);
              if (row < LP) p.out[O_FKP + ((size_t)jf * LP + row) * 1024 + col] = v;
              else if (row < TTOK) p.out[O_FKS + ((size_t)jf * 128 + (row - LP)) * 1024 + col] = v;
            }
          }
        }
    } else if (type == 2) {
      int hh = (nt & 7) * 2 + wc;
#pragma unroll
      for (int m = 0; m < 4; ++m) {
        int rb = m0 + wr * 64 + m * 16 + fq * 4;
#pragma unroll
        for (int n = 0; n < 4; ++n) {
          int d = n * 16 + fr;
          u32x2 o; o.x = pack2(acc[m][n][0], acc[m][n][1]); o.y = pack2(acc[m][n][2], acc[m][n][3]);
          *(u32x2*)(p.VtF + (size_t)(hh * 64 + d) * TPAD + rb) = o;
#pragma unroll
          for (int j = 0; j < 4; ++j) {
            int row = rb + j; int col = hh * 64 + d;
            if (row < LP) p.out[O_FVP + ((size_t)jf * LP + row) * 1024 + col] = acc[m][n][j];
            else if (row < TTOK) p.out[O_FVS + ((size_t)jf * 128 + (row - LP)) * 1024 + col] = acc[m][n][j];
          }
        }
      }
    } else if (type == 3) {
#pragma unroll
      for (int m = 0; m < 4; ++m)
#pragma unroll
        for (int n = 0; n < 4; ++n)
#pragma unroll
          for (int j = 0; j < 4; ++j) {
            int row = m0 + wr * 64 + m * 16 + fq * 4 + j;
            int col = (nt - 24) * 128 + wc * 64 + n * 16 + fr;
            p.OGf[(size_t)row * DM + col] = f2bf(acc[m][n][j]);
          }
    } else {
      float* lfs = (float*)smem;
      __syncthreads();
      if (wc == 0) {
        float bf = p.fox_b_f[jf * 16 + fr];
#pragma unroll
        for (int m = 0; m < 4; ++m)
#pragma unroll
          for (int j = 0; j < 4; ++j) {
            int rl = wr * 64 + m * 16 + fq * 4 + j;
            int row = m0 + rl;
            float lf = logsigmoid_(acc[m][0][j] + bf);
            lfs[rl * 16 + fr] = lf;
            p.LFR[(size_t)row * 16 + fr] = lf;
            if (row < LP) p.out[O_FLP + ((size_t)jf * LP + row) * 16 + fr] = lf;
            else if (row < TTOK) p.out[O_FLS + ((size_t)jf * 128 + (row - LP)) * 16 + fr] = lf;
          }
      }
      __syncthreads();
      if (tid < 16) {
        float run = 0.f;
        for (int r = 0; r < 128; ++r) {
          run += lfs[r * 16 + tid];
          p.LFC[(size_t)(m0 + r) * 16 + tid] = run;
        }
        p.TT[mt * 16 + tid] = run;
      }
    }
  }
}

DEV void f2_prompt(const Params& p, int qt, int h, char* smem) {
  u16* Ks = (u16*)smem;
  u16* Vs = Ks + 2 * 64 * LDK;
  float* cs = (float*)(Vs + 2 * 64 * LDK);
  float* off = cs + 128;
  float* tmp = off + 132;
  int tid = otid(), lane = tid & 63, wid = tid >> 6, fr = lane & 15, fq = lane >> 4;
  __syncthreads();
  if (tid < MTILES) tmp[tid] = p.TT[tid * 16 + h];
  __syncthreads();
  if (tid < MTILES) { float s = 0.f; for (int m = 0; m < tid; ++m) s += tmp[m]; off[tid] = s; }
  __syncthreads();
  int q0 = qt * 128 + wid * 32;
  bf16x8 qf[2][2];
  float cq[2];
#pragma unroll
  for (int qi = 0; qi < 2; ++qi) {
    int q = q0 + qi * 16 + fr;
#pragma unroll
    for (int ks = 0; ks < 2; ++ks) qf[qi][ks] = *(const bf16x8*)(p.Qf + (size_t)q * DM + h * 64 + ks * 32 + fq * 8);
    cq[qi] = p.LFC[(size_t)q * 16 + h] + off[q >> 7];
  }
  f32x4 o[4][2];
  float mrow[2], lrow[2];
#pragma unroll
  for (int qi = 0; qi < 2; ++qi) {
    mrow[qi] = -INFINITY; lrow[qi] = 0.f;
#pragma unroll
    for (int dt = 0; dt < 4; ++dt) o[dt][qi] = f32x4{0.f, 0.f, 0.f, 0.f};
  }
  int nkt = 2 * (qt + 1);
  u32x4 rk[2], rv[2]; float rc = 0.f;
  const int lrow_ = tid >> 3, lcol = (tid & 7) * 8;
#define GL(kt_) { int key0_ = (kt_) * 64; \
    _Pragma("unroll") for (int i = 0; i < 2; ++i) { int r = lrow_ + 32 * i; \
      rk[i] = *(const u32x4*)(p.Kf + (size_t)(key0_ + r) * DM + h * 64 + lcol); \
      rv[i] = *(const u32x4*)(p.VtF + (size_t)(h * 64 + r) * TPAD + key0_ + lcol); } \
    if (tid < 64) rc = p.LFC[(size_t)(key0_ + tid) * 16 + h] + off[(key0_ + tid) >> 7]; }
  GL(0);
  for (int kt = 0; kt < nkt; ++kt) {
    int buf = kt & 1;
    u16* Kb = Ks + buf * 64 * LDK; u16* Vb = Vs + buf * 64 * LDK; float* cb = cs + buf * 64;
#pragma unroll
    for (int i = 0; i < 2; ++i) {
      int r = lrow_ + 32 * i;
      *(u32x4*)(Kb + r * LDK + lcol) = rk[i];
      *(u32x4*)(Vb + r * LDK + lcol) = rv[i];
    }
    if (tid < 64) cb[tid] = rc;
    __syncthreads();
    if (kt + 1 < nkt) GL(kt + 1);
    int key0 = kt * 64;
    if (key0 <= q0 + 31) {
      f32x4 s[4][2];
#pragma unroll
      for (int kk = 0; kk < 4; ++kk) {
#pragma unroll
        for (int qi = 0; qi < 2; ++qi) s[kk][qi] = f32x4{0.f, 0.f, 0.f, 0.f};
#pragma unroll
        for (int ks = 0; ks < 2; ++ks) {
          bf16x8 a = *(const bf16x8*)(Kb + (kk * 16 + fr) * LDK + ks * 32 + fq * 8);
#pragma unroll
          for (int qi = 0; qi < 2; ++qi) s[kk][qi] = mfma(a, qf[qi][ks], s[kk][qi]);
        }
      }
      bool diag = (key0 + 63 > q0);
      f32x4 ck[4];
#pragma unroll
      for (int kk = 0; kk < 4; ++kk) ck[kk] = *(const f32x4*)(cb + kk * 16 + fq * 4);
      bf16x8 pf[2][2];
#pragma unroll
      for (int qi = 0; qi < 2; ++qi) {
        int q = q0 + qi * 16 + fr;
        float mloc = -INFINITY;
#pragma unroll
        for (int kk = 0; kk < 4; ++kk)
#pragma unroll
          for (int j = 0; j < 4; ++j) {
            float v = s[kk][qi][j] + (cq[qi] - ck[kk][j]);
            if (diag && (key0 + kk * 16 + fq * 4 + j > q)) v = -INFINITY;
            s[kk][qi][j] = v;
            mloc = fmaxf(mloc, v);
          }
        mloc = fmaxf(mloc, __shfl_xor(mloc, 16));
        mloc = fmaxf(mloc, __shfl_xor(mloc, 32));
        float mnew = fmaxf(mrow[qi], mloc);
        float alpha = __expf(mrow[qi] - mnew);
        mrow[qi] = mnew;
        float ls = 0.f;
#pragma unroll
        for (int kk = 0; kk < 4; ++kk)
#pragma unroll
          for (int j = 0; j < 4; ++j) {
            float e = __expf(s[kk][qi][j] - mnew);
            s[kk][qi][j] = e; ls += e;
          }
        lrow[qi] = lrow[qi] * alpha + ls;
#pragma unroll
        for (int dt = 0; dt < 4; ++dt) o[dt][qi] = o[dt][qi] * alpha;
#pragma unroll
        for (int pp = 0; pp < 2; ++pp) {
          V8 t;
          t.u[0] = pack2(s[2 * pp][qi][0], s[2 * pp][qi][1]); t.u[1] = pack2(s[2 * pp][qi][2], s[2 * pp][qi][3]);
          t.u[2] = pack2(s[2 * pp + 1][qi][0], s[2 * pp + 1][qi][1]); t.u[3] = pack2(s[2 * pp + 1][qi][2], s[2 * pp + 1][qi][3]);
          pf[qi][pp] = t.v;
        }
      }
#pragma unroll
      for (int dt = 0; dt < 4; ++dt)
#pragma unroll
        for (int pp = 0; pp < 2; ++pp) {
          V8 a;
          a.d[0] = *(const u32x2*)(Vb + (dt * 16 + fr) * LDK + (2 * pp) * 16 + fq * 4);
          a.d[1] = *(const u32x2*)(Vb + (dt * 16 + fr) * LDK + (2 * pp + 1) * 16 + fq * 4);
#pragma unroll
          for (int qi = 0; qi < 2; ++qi) o[dt][qi] = mfma(a.v, pf[qi][pp], o[dt][qi]);
        }
    }
  }
#pragma unroll
  for (int qi = 0; qi < 2; ++qi) {
    float l = lrow[qi];
    l += __shfl_xor(l, 16); l += __shfl_xor(l, 32);
    float inv = 1.f / l;
    int q = q0 + qi * 16 + fr;
    if (q < LP) {
#pragma unroll
      for (int dt = 0; dt < 4; ++dt) {
        int d = dt * 16 + fq * 4;
        u32x2 og = *(const u32x2*)(p.OGf + (size_t)q * DM + h * 64 + d);
        u32x2 r;
        r.x = pack2(o[dt][qi][0] * inv * sigmoidf_(bflo(og.x)), o[dt][qi][1] * inv * sigmoidf_(bfhi(og.x)));
        r.y = pack2(o[dt][qi][2] * inv * sigmoidf_(bflo(og.y)), o[dt][qi][3] * inv * sigmoidf_(bfhi(og.y)));
        *(u32x2*)(p.AO + (size_t)q * DM + h * 64 + d) = r;
      }
    }
  }
}

DEV void f2_sample(const Params& p, int jf, int b, int h, int qh, char* smem) {
  constexpr int NK = PAST + 16;
  float* S = (float*)smem;
  float* qs = S + 8 * NK;
  float* cc = qs + 8 * 64;
  float* part = cc + NK;
  float* invl = part + 256;
  int tid = otid(), lane = tid & 63, wid = tid >> 6;
  __syncthreads();
  for (int e = tid; e < 512; e += 256) {
    int i = e >> 6, d = e & 63;
    qs[e] = bf2f(p.Qf[(size_t)(LP + b * 16 + qh * 8 + i) * DM + h * 64 + d]);
  }
  float lv[5]; float run = 0.f;
#pragma unroll
  for (int u = 0; u < 5; ++u) {
    int j = tid * 5 + u;
    float v = 0.f;
    if (j < PAST) v = p.cache_lf[(((size_t)jf * 8 + b) * PAST + j) * 16 + h];
    else if (j < NK) v = p.LFR[(size_t)(LP + b * 16 + (j - PAST)) * 16 + h];
    run += v; lv[u] = run;
  }
  part[tid] = run;
  __syncthreads();
  float base = 0.f;
  for (int m = 0; m < tid; ++m) base += part[m];
#pragma unroll
  for (int u = 0; u < 5; ++u) { int j = tid * 5 + u; if (j < NK) cc[j] = base + lv[u]; }
  __syncthreads();
  for (int j = tid; j < NK; j += 256) {
    const float* kp;
    if (j < PAST) kp = p.cache_k + ((((size_t)jf * 8 + b) * PAST + j) * 16 + h) * 64;
    else kp = p.out + O_FKS + (((size_t)jf * 128 + b * 16 + (j - PAST)) * 16 + h) * 64;
    f32x4 kv[16];
#pragma unroll
    for (int c = 0; c < 16; ++c) kv[c] = ((const f32x4*)kp)[c];
    float cj = cc[j];
#pragma unroll
    for (int i = 0; i < 8; ++i) {
      float a = 0.f;
#pragma unroll
      for (int c = 0; c < 16; ++c) {
        f32x4 qv = *(const f32x4*)(qs + i * 64 + c * 4);
        a += qv.x * kv[c].x + qv.y * kv[c].y + qv.z * kv[c].z + qv.w * kv[c].w;
      }
      int qi = qh * 8 + i;
      a += cc[PAST + qi] - cj;
      if (j > PAST + qi) a = -INFINITY;
      S[i * NK + j] = a;
    }
  }
  __syncthreads();
  for (int i = wid * 2; i < wid * 2 + 2; ++i) {
    float m = -INFINITY;
    for (int j = lane; j < NK; j += 64) m = fmaxf(m, S[i * NK + j]);
    m = wave_max(m);
    float l = 0.f;
    for (int j = lane; j < NK; j += 64) { float e = __expf(S[i * NK + j] - m); S[i * NK + j] = e; l += e; }
    l = wave_sum(l);
    if (lane == 0) invl[i] = 1.f / l;
  }
  __syncthreads();
  {
    int i = tid >> 5, dq = tid & 31;
    float o0 = 0.f, o1 = 0.f;
    const float* vb = p.cache_v + ((((size_t)jf * 8 + b) * PAST) * 16 + h) * 64 + dq * 2;
#pragma unroll 8
    for (int j = 0; j < PAST; ++j) {
      f32x2 v = *(const f32x2*)(vb + (size_t)j * 1024);
      float pj = S[i * NK + j];
      o0 += pj * v.x; o1 += pj * v.y;
    }
    const float* vn = p.out + O_FVS + (((size_t)jf * 128 + b * 16) * 16 + h) * 64 + dq * 2;
#pragma unroll
    for (int j = 0; j < 16; ++j) {
      f32x2 v = *(const f32x2*)(vn + (size_t)j * 1024);
      float pj = S[i * NK + PAST + j];
      o0 += pj * v.x; o1 += pj * v.y;
    }
    int row = LP + b * 16 + qh * 8 + i;
    float il = invl[i];
    uint32_t og = *(const uint32_t*)(p.OGf + (size_t)row * DM + h * 64 + dq * 2);
    *(uint32_t*)(p.AO + (size_t)row * DM + h * 64 + dq * 2) = pack2(o0 * il * sigmoidf_(bflo(og)), o1 * il * sigmoidf_(bfhi(og)));
  }
}

DEV void ph_f2(const Params& p, int jf, char* smem) {
  const int NP = 129 * 16, NI = NP + 256;
  int G = gridDim.x;
  {
    int gt = blockIdx.x * blockDim.x + otid(), gs = gridDim.x * blockDim.x;
    for (int i = gt; i < (TPAD - TTOK) * DM / 2; i += gs) ((uint32_t*)(p.AO + (size_t)TTOK * DM))[i] = 0u;
  }
  for (int r = 0;; ++r) {
    int pos = (r & 1) ? (G - 1 - (int)blockIdx.x) : (int)blockIdx.x;
    int idx = r * G + pos;
    if (r * G >= NI) break;
    if (idx >= NI) continue;
    if (idx < NP) f2_prompt(p, 128 - idx / 16, idx % 16, smem);
    else { int s = idx - NP; f2_sample(p, jf, s >> 5, (s >> 1) & 15, s & 1, smem); }
  }
}

DEV void ph_outproj(const Params& p, const u16* A, int K, const u16* Wt, char* smem) {
  int tid = otid(), lane = tid & 63, wid = tid >> 6;
  int wr = wid >> 1, wc = wid & 1, fr = lane & 15, fq = lane >> 4;
  for (int it = blockIdx.x; it < MTILES * 8; it += gridDim.x) {
    int mt = it / 8, nt = it % 8;
    f32x4 acc[4][4];
    gemm_tile(A, K, Wt, K, K, mt * 128, nt * 128, smem, acc);
#pragma unroll
    for (int m = 0; m < 4; ++m)
#pragma unroll
      for (int n = 0; n < 4; ++n)
#pragma unroll
        for (int j = 0; j < 4; ++j) {
          int row = mt * 128 + wr * 64 + m * 16 + fq * 4 + j;
          int col = nt * 128 + wc * 64 + n * 16 + fr;
          p.X[(size_t)row * DM + col] += acc[m][n][j];
        }
  }
}

DEV void ph_r1(const Params& p, int jr, char* smem) {
  const u16* Wt = p.WrinT + (size_t)jr * 6144 * 1024;
  int tid = otid(), lane = tid & 63, wid = tid >> 6;
  int wr = wid >> 1, wc = wid & 1, fr = lane & 15, fq = lane >> 4;
  {
    int gt = blockIdx.x * blockDim.x + tid, gs = gridDim.x * blockDim.x;
    for (int i = gt; i < LEAD * DM; i += gs) { p.Qr[i] = 0; p.Kr[i] = 0; }
    for (int i = gt; i < 1024 * LEAD; i += gs) p.KrT[(size_t)(i / LEAD) * TP2 + (i % LEAD)] = 0;
    for (int i = gt; i < 2048 * LEAD; i += gs) p.VrT[(size_t)(i / LEAD) * TP2 + (i % LEAD)] = 0;
  }
  const int NT = 48;
  for (int it = blockIdx.x; it < MTILES * NT; it += gridDim.x) {
    int mt = it / NT, nt = it % NT;
    int m0 = mt * 128;
    f32x4 acc[4][4];
    gemm_tile(p.H, DM, Wt, DM, DM, m0, nt * 128, smem, acc);
    if (nt < 16) {
      bool isq = nt < 8;
      int hh = (nt & 7) >> 1, half = nt & 1;
      float l2g = ret_l2g(hh);
      u16* dst = isq ? p.Qr : p.Kr;
#pragma unroll
      for (int pr = 0; pr < 2; ++pr) {
        int g = half * 4 + wc * 2 + pr;
        int fi = g * 16 + fr;
        float rr = p.rope_rev[fi];
        int dp1 = g * 32 + fr, dp2 = dp1 + 16;
#pragma unroll
        for (int m = 0; m < 4; ++m) {
          int rb = m0 + wr * 64 + m * 16 + fq * 4;
          float o1[4], o2[4];
#pragma unroll
          for (int j = 0; j < 4; ++j) {
            int row = rb + j;
            int pos = (row < LP) ? (row - NMETA) : ((row < TTOK) ? (PAST + ((row - LP) & 15)) : 0);
            float rev = (float)pos * rr;
            rev -= floorf(rev);
            float sn = __builtin_amdgcn_sinf(rev), cs = __builtin_amdgcn_cosf(rev);
            float x1 = acc[m][2 * pr][j], x2 = acc[m][2 * pr + 1][j];
            float a = x1 * cs - x2 * sn, bb = x1 * sn + x2 * cs;
            if (isq) { a *= 0.0625f; bb *= 0.0625f; }
            o1[j] = a; o2[j] = bb;
            dst[(size_t)(row + LEAD) * DM + hh * 256 + dp1] = f2bf(a);
            dst[(size_t)(row + LEAD) * DM + hh * 256 + dp2] = f2bf(bb);
          }
          if (!isq) {
            float dc[4];
#pragma unroll
            for (int j = 0; j < 4; ++j) dc[j] = exp2f(l2g * (float)(63 - ((rb + j + LEAD) & 63)));
            u32x2 t1, t2;
            t1.x = pack2(o1[0] * dc[0], o1[1] * dc[1]); t1.y = pack2(o1[2] * dc[2], o1[3] * dc[3]);
            t2.x = pack2(o2[0] * dc[0], o2[1] * dc[1]); t2.y = pack2(o2[2] * dc[2], o2[3] * dc[3]);
            *(u32x2*)(p.KrT + (size_t)(hh * 256 + dp1) * TP2 + rb + LEAD) = t1;
            *(u32x2*)(p.KrT + (size_t)(hh * 256 + dp2) * TP2 + rb + LEAD) = t2;
          }
        }
      }
    } else if (nt < 32) {
      int hh = (nt - 16) >> 2;
#pragma unroll
      for (int m = 0; m < 4; ++m) {
        int rb = m0 + wr * 64 + m * 16 + fq * 4;
#pragma unroll
        for (int n = 0; n < 4; ++n) {
          int e = ((nt - 16) & 3) * 128 + wc * 64 + n * 16 + fr;
          u32x2 o; o.x = pack2(acc[m][n][0], acc[m][n][1]); o.y = pack2(acc[m][n][2], acc[m][n][3]);
          *(u32x2*)(p.VrT + (size_t)(hh * 512 + e) * TP2 + rb + LEAD) = o;
        }
      }
    } else {
#pragma unroll
      for (int m = 0; m < 4; ++m)
#pragma unroll
        for (int n = 0; n < 4; ++n)
#pragma unroll
          for (int j = 0; j < 4; ++j) {
            int row = m0 + wr * 64 + m * 16 + fq * 4 + j;
            int col = (nt - 32) * 128 + wc * 64 + n * 16 + fr;
            p.Gr[(size_t)row * 2048 + col] = f2bf(acc[m][n][j]);
          }
    }
  }
}

DEV void ph_r2(const Params& p, int jr) {
  int tid = otid(), lane = tid & 63, wid = tid >> 6, fr = lane & 15, fq = lane >> 4;
  for (int it = blockIdx.x; it < 64; it += gridDim.x) {
    int h = it >> 4, sl = it & 15;
    float dec64 = exp2f(ret_l2g(h) * 64.f);
    f32x4 st[4][2];
#pragma unroll
    for (int r = 0; r < 4; ++r)
#pragma unroll
      for (int c = 0; c < 2; ++c) st[r][c] = f32x4{0.f, 0.f, 0.f, 0.f};
    const u16* kbase = p.KrT + (size_t)(h * 256 + wid * 64 + fr) * TP2 + fq * 8;
    const u16* vbase = p.VrT + (size_t)(h * 512 + sl * 32 + fr) * TP2 + fq * 8;
    bf16x8 ac[8], bc[4], an[8], bn[4];
#pragma unroll
    for (int r = 0; r < 4; ++r)
#pragma unroll
      for (int ks = 0; ks < 2; ++ks) ac[r * 2 + ks] = *(const bf16x8*)(kbase + (size_t)(r * 16) * TP2 + ks * 32);
#pragma unroll
    for (int c = 0; c < 2; ++c)
#pragma unroll
      for (int ks = 0; ks < 2; ++ks) bc[c * 2 + ks] = *(const bf16x8*)(vbase + (size_t)(c * 16) * TP2 + ks * 32);
#pragma unroll 1
    for (int n = 0; n < NCH; ++n) {
      if (n + 1 < NCH) {
#pragma unroll
        for (int r = 0; r < 4; ++r)
#pragma unroll
          for (int ks = 0; ks < 2; ++ks) an[r * 2 + ks] = *(const bf16x8*)(kbase + (size_t)(r * 16) * TP2 + (n + 1) * 64 + ks * 32);
#pragma unroll
        for (int c = 0; c < 2; ++c)
#pragma unroll
          for (int ks = 0; ks < 2; ++ks) bn[c * 2 + ks] = *(const bf16x8*)(vbase + (size_t)(c * 16) * TP2 + (n + 1) * 64 + ks * 32);
      }
      if (n >= 1) {
#pragma unroll
        for (int c = 0; c < 2; ++c) {
          u16* sp = p.ST + ((size_t)(n * 4 + h) * 512 + sl * 32 + c * 16 + fr) * 256 + wid * 64 + fq * 4;
#pragma unroll
          for (int r = 0; r < 4; ++r) {
            u32x2 o; o.x = pack2(st[r][c][0], st[r][c][1]); o.y = pack2(st[r][c][2], st[r][c][3]);
            *(u32x2*)(sp + r * 16) = o;
          }
        }
      }
#pragma unroll
      for (int r = 0; r < 4; ++r)
#pragma unroll
        for (int c = 0; c < 2; ++c) {
          f32x4 t = st[r][c] * dec64;
#pragma unroll
          for (int ks = 0; ks < 2; ++ks) t = mfma(ac[r * 2 + ks], bc[c * 2 + ks], t);
          st[r][c] = t;
        }
#pragma unroll
      for (int i = 0; i < 8; ++i) ac[i] = an[i];
#pragma unroll
      for (int i = 0; i < 4; ++i) bc[i] = bn[i];
    }
#pragma unroll
    for (int r = 0; r < 4; ++r)
#pragma unroll
      for (int c = 0; c < 2; ++c)
#pragma unroll
        for (int j = 0; j < 4; ++j) {
          int dorig = perm_dorig(wid * 64 + r * 16 + fq * 4 + j);
          p.out[O_SRP + ((size_t)(jr * 4 + h) * 256 + dorig) * 512 + sl * 32 + c * 16 + fr] = st[r][c][j];
        }
  }
}

DEV void r3_prompt(const Params& p, int jr, int n, int h, char* smem) {
  u32x4* Sf = (u32x4*)smem;
  float* red = (float*)(smem + 8192);
  int tid = otid(), lane = tid & 63, w = tid >> 6, fr = lane & 15, fq = lane >> 4;
  int p0 = n * 64;
  float l2g = ret_l2g(h);
  f32x4 acc[8][4];
#pragma unroll
  for (int a = 0; a < 8; ++a)
#pragma unroll
    for (int b = 0; b < 4; ++b) acc[a][b] = f32x4{0.f, 0.f, 0.f, 0.f};
  const u16* qb = p.Qr + (size_t)(p0 + fr) * DM + h * 256 + fq * 8;
  if (n >= 1) {
    const u16* sb = p.ST + ((size_t)(n * 4 + h) * 512 + w * 128 + fr) * 256 + fq * 8;
#pragma unroll 1
    for (int ks = 0; ks < 8; ++ks) {
      bf16x8 bq[4];
#pragma unroll
      for (int it = 0; it < 4; ++it) bq[it] = *(const bf16x8*)(qb + (size_t)(it * 16) * DM + ks * 32);
#pragma unroll
      for (int dvt = 0; dvt < 8; ++dvt) {
        bf16x8 a = *(const bf16x8*)(sb + (size_t)(dvt * 16) * 256 + ks * 32);
#pragma unroll
        for (int it = 0; it < 4; ++it) acc[dvt][it] = mfma(a, bq[it], acc[dvt][it]);
      }
    }
#pragma unroll
    for (int it = 0; it < 4; ++it) {
      float qd = exp2f(l2g * (float)(it * 16 + fr + 1));
#pragma unroll
      for (int dvt = 0; dvt < 8; ++dvt) acc[dvt][it] = acc[dvt][it] * qd;
    }
  }
  {
    f32x4 s[4];
#pragma unroll
    for (int jt = 0; jt < 4; ++jt) s[jt] = f32x4{0.f, 0.f, 0.f, 0.f};
    const u16* kb = p.Kr + (size_t)(p0 + fr) * DM + h * 256 + fq * 8;
#pragma unroll 1
    for (int ks = 0; ks < 8; ++ks) {
      bf16x8 b = *(const bf16x8*)(qb + (size_t)(w * 16) * DM + ks * 32);
#pragma unroll
      for (int jt = 0; jt < 4; ++jt) {
        bf16x8 a = *(const bf16x8*)(kb + (size_t)(jt * 16) * DM + ks * 32);
        s[jt] = mfma(a, b, s[jt]);
      }
    }
    int i = w * 16 + fr;
#pragma unroll
    for (int jt = 0; jt < 4; ++jt)
#pragma unroll
      for (int jj = 0; jj < 4; ++jj) {
        int j = jt * 16 + fq * 4 + jj;
        int dd = i > j ? i - j : j - i;
        s[jt][jj] *= exp2f(l2g * (float)dd);
      }
    __syncthreads();
#pragma unroll
    for (int pp = 0; pp < 2; ++pp) {
      u32x4 t;
      t.x = pack2(s[2 * pp][0], s[2 * pp][1]); t.y = pack2(s[2 * pp][2], s[2 * pp][3]);
      t.z = pack2(s[2 * pp + 1][0], s[2 * pp + 1][1]); t.w = pack2(s[2 * pp + 1][2], s[2 * pp + 1][3]);
      Sf[(w * 2 + pp) * 64 + lane] = t;
    }
    __syncthreads();
  }
  {
    const u16* vb = p.VrT + (size_t)(h * 512 + w * 128 + fr) * TP2 + p0 + fq * 4;
#pragma unroll
    for (int pp = 0; pp < 2; ++pp) {
      V8 bs[4];
#pragma unroll
      for (int it = 0; it < 4; ++it) bs[it].q = Sf[(it * 2 + pp) * 64 + lane];
#pragma unroll
      for (int dvt = 0; dvt < 8; ++dvt) {
        V8 a;
        a.d[0] = *(const u32x2*)(vb + (size_t)(dvt * 16) * TP2 + (2 * pp) * 16);
        a.d[1] = *(const u32x2*)(vb + (size_t)(dvt * 16) * TP2 + (2 * pp + 1) * 16);
#pragma unroll
        for (int it = 0; it < 4; ++it) acc[dvt][it] = mfma(a.v, bs[it].v, acc[dvt][it]);
      }
    }
  }
  float mean[4], rstd[4];
  {
    float s1[4];
#pragma unroll
    for (int it = 0; it < 4; ++it) {
      float s = 0.f;
#pragma unroll
      for (int dvt = 0; dvt < 8; ++dvt) s += acc[dvt][it][0] + acc[dvt][it][1] + acc[dvt][it][2] + acc[dvt][it][3];
      s += __shfl_xor(s, 16); s += __shfl_xor(s, 32);
      s1[it] = s;
    }
    __syncthreads();
    if (fq == 0) {
#pragma unroll
      for (int it = 0; it < 4; ++it) red[w * 64 + it * 16 + fr] = s1[it];
    }
    __syncthreads();
#pragma unroll
    for (int it = 0; it < 4; ++it) {
      int i = it * 16 + fr;
      mean[it] = (red[i] + red[64 + i] + red[128 + i] + red[192 + i]) * (1.f / 512.f);
    }
#pragma unroll
    for (int it = 0; it < 4; ++it) {
      float s = 0.f;
#pragma unroll
      for (int dvt = 0; dvt < 8; ++dvt)
#pragma unroll
        for (int j = 0; j < 4; ++j) { float d = acc[dvt][it][j] - mean[it]; s += d * d; }
      s += __shfl_xor(s, 16); s += __shfl_xor(s, 32);
      s1[it] = s;
    }
    __syncthreads();
    if (fq == 0) {
#pragma unroll
      for (int it = 0; it < 4; ++it) red[w * 64 + it * 16 + fr] = s1[it];
    }
    __syncthreads();
#pragma unroll
    for (int it = 0; it < 4; ++it) {
      int i = it * 16 + fr;
      float var = (red[i] + red[64 + i] + red[128 + i] + red[192 + i]) * (1.f / 512.f);
      rstd[it] = rsqrtf(var + EPS);
    }
  }
#pragma unroll
  for (int it = 0; it < 4; ++it) {
    int t = p0 + it * 16 + fr - LEAD;
    if (t >= 0 && t < LP) {
#pragma unroll
      for (int dvt = 0; dvt < 8; ++dvt) {
        int e0 = h * 512 + w * 128 + dvt * 16 + fq * 4;
        u16* gp = p.Gr + (size_t)t * 2048 + e0;
        u32x2 g = *(const u32x2*)gp;
        f32x4 gn = *(const f32x4*)(p.ret_gn + jr * 2048 + e0);
        float g0 = bflo(g.x), g1 = bfhi(g.x), g2 = bflo(g.y), g3 = bfhi(g.y);
        float y0 = (acc[dvt][it][0] - mean[it]) * rstd[it] * gn.x * (g0 * sigmoidf_(g0));
        float y1 = (acc[dvt][it][1] - mean[it]) * rstd[it] * gn.y * (g1 * sigmoidf_(g1));
        float y2 = (acc[dvt][it][2] - mean[it]) * rstd[it] * gn.z * (g2 * sigmoidf_(g2));
        float y3 = (acc[dvt][it][3] - mean[it]) * rstd[it] * gn.w * (g3 * sigmoidf_(g3));
        u32x2 o; o.x = pack2(y0, y1); o.y = pack2(y2, y3);
        *(u32x2*)gp = o;
      }
    }
  }
}

DEV void r3_sample(const Params& p, int jr, int b, int h, char* smem) {
  float* obuf = (float*)smem;
  u16* qs = (u16*)(smem + 32768);
  u16* ks = qs + 16 * 256;
  float* sm = (float*)(smem + 49152);
  float* red = sm + 256;
  float* stat = red + 64;
  int tid = otid(), lane = tid & 63, wid = tid >> 6;
  float l2g = ret_l2g(h);
  int prow = LP + LEAD + b * 16;
  __syncthreads();
  for (int e = tid; e < 16 * 256; e += 256) {
    int i = e >> 8, d = e & 255;
    qs[e] = p.Qr[(size_t)(prow + i) * DM + h * 256 + d];
    ks[e] = p.Kr[(size_t)(prow + i) * DM + h * 256 + d];
  }
  __syncthreads();
  {
    int i = tid >> 4, j = tid & 15;
    float a = 0.f;
#pragma unroll 8
    for (int d = 0; d < 256; ++d) a += bf2f(qs[i * 256 + d]) * bf2f(ks[j * 256 + d]);
    int dd = i > j ? i - j : j - i;
    sm[tid] = a * exp2f(l2g * (float)dd);
  }
  __syncthreads();
  for (int e = tid; e < 16 * 256; e += 256) ks[e] = f2bf(bf2f(ks[e]) * exp2f(l2g * (float)(15 - (e >> 8))));
  __syncthreads();
  float dec16 = exp2f(l2g * 16.f);
  const float* stin = p.state_ret + ((size_t)(jr * 8 + b) * 4 + h) * 256 * 512;
  float* stout = p.out + O_SRS + ((size_t)(jr * 8 + b) * 4 + h) * 256 * 512;
#pragma unroll 1
  for (int c = 0; c < 2; ++c) {
    int e = tid + c * 256;
    float v[16], o[16];
    const u16* vp = p.VrT + (size_t)(h * 512 + e) * TP2 + prow;
    u32x4 a = *(const u32x4*)vp, bq = *(const u32x4*)(vp + 8);
    v[0] = bflo(a.x); v[1] = bfhi(a.x); v[2] = bflo(a.y); v[3] = bfhi(a.y);
    v[4] = bflo(a.z); v[5] = bfhi(a.z); v[6] = bflo(a.w); v[7] = bfhi(a.w);
    v[8] = bflo(bq.x); v[9] = bfhi(bq.x); v[10] = bflo(bq.y); v[11] = bfhi(bq.y);
    v[12] = bflo(bq.z); v[13] = bfhi(bq.z); v[14] = bflo(bq.w); v[15] = bfhi(bq.w);
#pragma unroll
    for (int i = 0; i < 16; ++i) o[i] = 0.f;
#pragma unroll 2
    for (int dp = 0; dp < 256; ++dp) {
      int dorig = perm_dorig(dp);
      float s0 = stin[(size_t)dorig * 512 + e];
      float n0 = s0 * dec16;
#pragma unroll
      for (int i = 0; i < 16; ++i) {
        o[i] += bf2f(qs[i * 256 + dp]) * s0;
        n0 += bf2f(ks[i * 256 + dp]) * v[i];
      }
      stout[(size_t)dorig * 512 + e] = n0;
    }
#pragma unroll
    for (int i = 0; i < 16; ++i) obuf[i * 512 + e] = o[i] * exp2f(l2g * (float)(i + 1));
#pragma unroll 1
    for (int i = 0; i < 16; ++i) {
      float a0 = obuf[i * 512 + e];
#pragma unroll
      for (int j = 0; j < 16; ++j) a0 += sm[i * 16 + j] * v[j];
      obuf[i * 512 + e] = a0;
    }
  }
  __syncthreads();
  for (int i = 0; i < 16; ++i) {
    float s = wave_sum(obuf[i * 512 + tid] + obuf[i * 512 + 256 + tid]);
    if (lane == 0) red[wid * 16 + i] = s;
  }
  __syncthreads();
  if (tid < 16) stat[tid] = (red[tid] + red[16 + tid] + red[32 + tid] + red[48 + tid]) * (1.f / 512.f);
  __syncthreads();
  for (int i = 0; i < 16; ++i) {
    float mu = stat[i];
    float d0 = obuf[i * 512 + tid] - mu, d1 = obuf[i * 512 + 256 + tid] - mu;
    float s = wave_sum(d0 * d0 + d1 * d1);
    if (lane == 0) red[wid * 16 + i] = s;
  }
  __syncthreads();
  if (tid < 16) stat[16 + tid] = rsqrtf((red[tid] + red[16 + tid] + red[32 + tid] + red[48 + tid]) * (1.f / 512.f) + EPS);
  __syncthreads();
  for (int c = 0; c < 2; ++c) {
    int e = tid + c * 256;
    float gn = p.ret_gn[jr * 2048 + h * 512 + e];
    for (int i = 0; i < 16; ++i) {
      int t = LP + b * 16 + i;
      float g = bf2f(p.Gr[(size_t)t * 2048 + h * 512 + e]);
      float y = (obuf[i * 512 + e] - stat[i]) * stat[16 + i] * gn * (g * sigmoidf_(g));
      p.Gr[(size_t)t * 2048 + h * 512 + e] = f2bf(y);
    }
  }
}

DEV void ph_r3(const Params& p, int jr, char* smem) {
  const int NP = NCH * 4, NI = NP + 32;
  for (int it = blockIdx.x; it < NI; it += gridDim.x) {
    if (it < 32) r3_sample(p, jr, it >> 2, it & 3, smem);
    else { int q = it - 32; r3_prompt(p, jr, q >> 2, q & 3, smem); }
  }
}

DEV void ph_p2(const Params& p, int layer, char* smem) {
  const u16* Wt = p.WpqT + (size_t)layer * 2048 * 1024;
  u16* Qs = (u16*)smem;
  constexpr int LQ = 136;
  int tid = otid(), lane = tid & 63, wid = tid >> 6;
  int wr = wid >> 1, wc = wid & 1, fr = lane & 15, fq = lane >> 4;
  for (int it = blockIdx.x; it < MTILES * 16; it += gridDim.x) {
    int mt = it / 16, hp = it % 16;
    int m0 = mt * 128;
    f32x4 acc[4][4];
    gemm_tile(p.H, DM, Wt, DM, DM, m0, hp * 128, smem, acc);
    __syncthreads();
#pragma unroll
    for (int m = 0; m < 4; ++m)
#pragma unroll
      for (int n = 0; n < 4; ++n)
#pragma unroll
        for (int j = 0; j < 4; ++j)
          Qs[(wr * 64 + m * 16 + fq * 4 + j) * LQ + wc * 64 + n * 16 + fr] = f2bf(acc[m][n][j]);
    __syncthreads();
    f32x4 sc[2][8];
#pragma unroll
    for (int rt = 0; rt < 2; ++rt)
#pragma unroll
      for (int ct = 0; ct < 8; ++ct) sc[rt][ct] = f32x4{0.f, 0.f, 0.f, 0.f};
    const u16* skb = p.SKb + ((size_t)(layer * 16 + hp) * 128 + fr) * 128 + fq * 8;
#pragma unroll
    for (int ks = 0; ks < 4; ++ks) {
      bf16x8 a[2];
#pragma unroll
      for (int rt = 0; rt < 2; ++rt) a[rt] = *(const bf16x8*)(Qs + (wid * 32 + rt * 16 + fr) * LQ + ks * 32 + fq * 8);
#pragma unroll
      for (int ct = 0; ct < 8; ++ct) {
        bf16x8 b = *(const bf16x8*)(skb + (size_t)(ct * 16) * 128 + ks * 32);
#pragma unroll
        for (int rt = 0; rt < 2; ++rt) sc[rt][ct] = mfma(a[rt], b, sc[rt][ct]);
      }
    }
#pragma unroll
    for (int rt = 0; rt < 2; ++rt)
#pragma unroll
      for (int j = 0; j < 4; ++j) {
        uint32_t key[8];
#pragma unroll
        for (int ct = 0; ct < 8; ++ct) key[ct] = (f2key(sc[rt][ct][j]) & ~127u) | (uint32_t)(127 - (ct * 16 + fr));
        uint32_t mine = 0;
#pragma unroll 1
        for (int r = 0; r < 16; ++r) {
          uint32_t best = key[0];
#pragma unroll
          for (int ct = 1; ct < 8; ++ct) best = max(best, key[ct]);
          best = row16_maxu(best);
#pragma unroll
          for (int ct = 0; ct < 8; ++ct) key[ct] = (key[ct] == best) ? 0u : key[ct];
          if (fr == r) mine = best;
        }
        int row = m0 + wid * 32 + rt * 16 + fq * 4 + j;
        p.SV[((size_t)row * 16 + hp) * 16 + fr] = key2f(mine & ~127u);
        p.SI[((size_t)row * 16 + hp) * 16 + fr] = 127 - (int)(mine & 127u);
      }
  }
}

DEV void ph_p3(const Params& p, int layer, char* smem) {
  int tid = otid(), lane = tid & 63, wid = tid >> 6;
  int* eidL = (int*)smem + wid * 256;
  float* gateL = (float*)(eidL + 128);
  int ca = 0, cb = 0; bool cvalid = false;
  {
    int cnt = 0;
    for (int a = 0; a < 16; ++a) {
      int nb = 16 / (a + 1);
      if (lane >= cnt && lane < cnt + nb) { ca = a; cb = lane - cnt; cvalid = true; }
      cnt += nb;
    }
  }
  const u16* Ub = p.Ub;
  const u16* Vb = p.Vb;
  int gw = (blockIdx.x * blockDim.x + tid) >> 6, nw = (gridDim.x * blockDim.x) >> 6;
  for (int t = gw; t < TTOK; t += nw) {
    const float* svp = p.SV + (size_t)t * 256;
    const int* sip = p.SI + (size_t)t * 256;
    for (int h = 0; h < 8; ++h) {
      float cand = cvalid ? (svp[h * 32 + ca] + svp[h * 32 + 16 + cb]) : 0.f;
      uint32_t key = cvalid ? ((f2key(cand) & ~63u) | (uint32_t)(63 - lane)) : 0u;
      uint32_t mine = 0;
#pragma unroll 1
      for (int r = 0; r < 16; ++r) {
        uint32_t best = wave_maxu(key);
        key = (key == best) ? 0u : key;
        if (lane == r) mine = best;
      }
      int src = 63 - (int)(mine & 63u);
      int wa = __shfl(ca, src), wb = __shfl(cb, src);
      float fv = key2f(mine & ~63u);
      float f0 = rdlane(fv, 0);
      float e = (lane < 16) ? __expf(fv - f0) : 0.f;
      float ssum = row16_sum(e);
      if (lane < 16) {
        int eid = sip[h * 32 + wa] * 128 + sip[h * 32 + 16 + wb];
        eidL[h * 16 + lane] = eid;
        gateL[h * 16 + lane] = e / ssum;
      }
    }
    u32x4 ha = *(const u32x4*)(p.H + (size_t)t * DM + lane * 8);
    u32x4 hb = *(const u32x4*)(p.H + (size_t)t * DM + 512 + lane * 8);
    float hf[16];
    hf[0] = bflo(ha.x); hf[1] = bfhi(ha.x); hf[2] = bflo(ha.y); hf[3] = bfhi(ha.y);
    hf[4] = bflo(ha.z); hf[5] = bfhi(ha.z); hf[6] = bflo(ha.w); hf[7] = bfhi(ha.w);
    hf[8] = bflo(hb.x); hf[9] = bfhi(hb.x); hf[10] = bflo(hb.y); hf[11] = bfhi(hb.y);
    hf[12] = bflo(hb.z); hf[13] = bfhi(hb.z); hf[14] = bflo(hb.w); hf[15] = bfhi(hb.w);
    float w0 = 0.f, w1 = 0.f;
#pragma unroll 1
    for (int k0 = 0; k0 < 128; k0 += 8) {
      u32x4 ua[8], ub[8];
#pragma unroll
      for (int u = 0; u < 8; ++u) {
        int eid = __builtin_amdgcn_readfirstlane(eidL[k0 + u]);
        const u16* up = Ub + (size_t)eid * DM;
        ua[u] = *(const u32x4*)(up + lane * 8);
        ub[u] = *(const u32x4*)(up + 512 + lane * 8);
      }
#pragma unroll
      for (int u = 0; u < 8; ++u) {
        float d = hf[0] * bflo(ua[u].x) + hf[1] * bfhi(ua[u].x) + hf[2] * bflo(ua[u].y) + hf[3] * bfhi(ua[u].y)
                + hf[4] * bflo(ua[u].z) + hf[5] * bfhi(ua[u].z) + hf[6] * bflo(ua[u].w) + hf[7] * bfhi(ua[u].w)
                + hf[8] * bflo(ub[u].x) + hf[9] * bfhi(ub[u].x) + hf[10] * bflo(ub[u].y) + hf[11] * bfhi(ub[u].y)
                + hf[12] * bflo(ub[u].z) + hf[13] * bfhi(ub[u].z) + hf[14] * bflo(ub[u].w) + hf[15] * bfhi(ub[u].w);
        d = wave_sum(d);
        int k = k0 + u;
        if (lane == (k & 63)) { if (k < 64) w0 = d; else w1 = d; }
      }
    }
    w0 = gateL[lane] * gelu_(w0);
    w1 = gateL[64 + lane] * gelu_(w1);
    float oacc[16];
#pragma unroll
    for (int i = 0; i < 16; ++i) oacc[i] = 0.f;
#pragma unroll 1
    for (int half = 0; half < 2; ++half) {
      float wsel = half ? w1 : w0;
#pragma unroll 1
      for (int kk = 0; kk < 64; kk += 8) {
        u32x4 va[8], vb[8];
#pragma unroll
        for (int u = 0; u < 8; ++u) {
          int eid = __builtin_amdgcn_readfirstlane(eidL[half * 64 + kk + u]);
          const u16* vp = Vb + (size_t)eid * DM;
          va[u] = *(const u32x4*)(vp + lane * 8);
          vb[u] = *(const u32x4*)(vp + 512 + lane * 8);
        }
#pragma unroll
        for (int u = 0; u < 8; ++u) {
          float wk = rdlane(wsel, kk + u);
          oacc[0] += wk * bflo(va[u].x); oacc[1] += wk * bfhi(va[u].x); oacc[2] += wk * bflo(va[u].y); oacc[3] += wk * bfhi(va[u].y);
          oacc[4] += wk * bflo(va[u].z); oacc[5] += wk * bfhi(va[u].z); oacc[6] += wk * bflo(va[u].w); oacc[7] += wk * bfhi(va[u].w);
          oacc[8] += wk * bflo(vb[u].x); oacc[9] += wk * bfhi(vb[u].x); oacc[10] += wk * bflo(vb[u].y); oacc[11] += wk * bfhi(vb[u].y);
          oacc[12] += wk * bflo(vb[u].z); oacc[13] += wk * bfhi(vb[u].z); oacc[14] += wk * bflo(vb[u].w); oacc[15] += wk * bfhi(vb[u].w);
        }
      }
    }
    float* xr = p.X + (size_t)t * DM;
    f32x4 x0 = *(const f32x4*)(xr + lane * 8), x1 = *(const f32x4*)(xr + lane * 8 + 4);
    f32x4 x2 = *(const f32x4*)(xr + 512 + lane * 8), x3 = *(const f32x4*)(xr + 512 + lane * 8 + 4);
    x0.x += oacc[0]; x0.y += oacc[1]; x0.z += oacc[2]; x0.w += oacc[3];
    x1.x += oacc[4]; x1.y += oacc[5]; x1.z += oacc[6]; x1.w += oacc[7];
    x2.x += oacc[8]; x2.y += oacc[9]; x2.z += oacc[10]; x2.w += oacc[11];
    x3.x += oacc[12]; x3.y += oacc[13]; x3.z += oacc[14]; x3.w += oacc[15];
    if (layer < 3) {
      *(f32x4*)(xr + lane * 8) = x0; *(f32x4*)(xr + lane * 8 + 4) = x1;
      *(f32x4*)(xr + 512 + lane * 8) = x2; *(f32x4*)(xr + 512 + lane * 8 + 4) = x3;
      float ss = x0.x * x0.x + x0.y * x0.y + x0.z * x0.z + x0.w * x0.w + x1.x * x1.x + x1.y * x1.y + x1.z * x1.z + x1.w * x1.w
               + x2.x * x2.x + x2.y * x2.y + x2.z * x2.z + x2.w * x2.w + x3.x * x3.x + x3.y * x3.y + x3.z * x3.z + x3.w * x3.w;
      ss = wave_sum(ss);
      float rstd = rsqrtf(ss * (1.f / DM) + EPS);
      const float* g = p.norm_mix + (size_t)(layer + 1) * DM;
      f32x4 g0 = *(const f32x4*)(g + lane * 8), g1 = *(const f32x4*)(g + lane * 8 + 4);
      f32x4 g2 = *(const f32x4*)(g + 512 + lane * 8), g3 = *(const f32x4*)(g + 512 + lane * 8 + 4);
      u32x4 o0, o1;
      o0.x = pack2(x0.x * rstd * g0.x, x0.y * rstd * g0.y); o0.y = pack2(x0.z * rstd * g0.z, x0.w * rstd * g0.w);
      o0.z = pack2(x1.x * rstd * g1.x, x1.y * rstd * g1.y); o0.w = pack2(x1.z * rstd * g1.z, x1.w * rstd * g1.w);
      o1.x = pack2(x2.x * rstd * g2.x, x2.y * rstd * g2.y); o1.y = pack2(x2.z * rstd * g2.z, x2.w * rstd * g2.w);
      o1.z = pack2(x3.x * rstd * g3.x, x3.y * rstd * g3.y); o1.w = pack2(x3.z * rstd * g3.z, x3.w * rstd * g3.w);
      *(u32x4*)(p.H + (size_t)t * DM + lane * 8) = o0;
      *(u32x4*)(p.H + (size_t)t * DM + 512 + lane * 8) = o1;
    } else {
      float* yo = nullptr;
      if (t >= NMETA && t < LP) yo = p.out + O_YP + (size_t)(t - NMETA) * DM;
      else if (t >= LP) yo = p.out + O_YS + (size_t)(t - LP) * DM;
      if (yo) {
        *(f32x4*)(yo + lane * 8) = x0; *(f32x4*)(yo + lane * 8 + 4) = x1;
        *(f32x4*)(yo + 512 + lane * 8) = x2; *(f32x4*)(yo + 512 + lane * 8 + 4) = x3;
      }
    }
  }
}

constexpr int NPHASE = 27;
#ifndef DBG_PHASES
#define DBG_PHASES NPHASE
#endif
#ifndef DBG_SCALES
#define DBG_SCALES {1,1,1,1,1,1,1,1,1,1,1,1,1,1,1,1,1,1,1,1}
#endif
#ifndef DBG_POST
#define DBG_POST 0
#endif
DEV void post_scale(const Params& p) {
  const float sc[20] = DBG_SCALES;
  const size_t offs[11] = {O_YP, O_YS, O_FKP, O_FVP, O_FLP, O_SRP, O_FKS, O_FVS, O_FLS, O_SRS, O_SRS + (size_t)2 * 8 * 4 * 256 * 512};
  size_t i0 = (size_t)blockIdx.x * blockDim.x + otid(), st = (size_t)gridDim.x * blockDim.x;
#pragma unroll
  for (int k = 0; k < 20; ++k) {
    float f = sc[k];
    if (f == 1.f) continue;
    size_t a = offs[k >> 1], b = offs[(k >> 1) + 1], mid = a + (b - a) / 2;
    size_t lo = (k & 1) ? mid : a, hi = (k & 1) ? b : mid;
    for (size_t i = lo + i0; i < hi; i += st) p.out[i] *= f;
  }
}
DEV void dump_x(const Params& p) {
  size_t i = (size_t)blockIdx.x * blockDim.x + otid(), st = (size_t)gridDim.x * blockDim.x;
  for (; i < (size_t)(TTOK - NMETA) * DM; i += st) p.out[i] = p.X[(size_t)NMETA * DM + i];
}
__global__ void __launch_bounds__(256, 2) mega(Params p, int ph0, int ph1) {
  __shared__ __attribute__((aligned(16))) char smem[53248];
  for (int ph = ph0; ph < ph1; ++ph) {
    if (ph > ph0) cg::this_grid().sync();
    if (ph == 0) { ph_prep(p, smem); continue; }
    if (ph == 100) { dump_x(p); continue; }
    if (ph == 101) { post_scale(p); continue; }
    int q = ph - 1, layer, idx;
    if (q < 6) { layer = 0; idx = q; } else if (q < 13) { layer = 1; idx = q - 6; }
    else if (q < 19) { layer = 2; idx = q - 13; } else { layer = 3; idx = q - 19; }
    int j = layer >> 1;
    bool fox = (layer & 1) == 0;
    if (fox) {
      if (idx == 0) ph_f1(p, j, smem);
      else if (idx == 1) ph_f2(p, j, smem);
      else if (idx == 2) ph_outproj(p, p.AO, 1024, p.WfoutT + (size_t)j * 1024 * 1024, smem);
      else if (idx == 3) { norm_rows(p, p.norm_ffn + (size_t)layer * DM, false); conv_tables(p, layer); }
      else if (idx == 4) ph_p2(p, layer, smem);
      else ph_p3(p, layer, smem);
    } else {
      if (idx == 0) ph_r1(p, j, smem);
      else if (idx == 1) ph_r2(p, j);
      else if (idx == 2) ph_r3(p, j, smem);
      else if (idx == 3) ph_outproj(p, p.Gr, 2048, p.WroutT + (size_t)j * 1024 * 2048, smem);
      else if (idx == 4) { norm_rows(p, p.norm_ffn + (size_t)layer * DM, false); conv_tables(p, layer); }
      else if (idx == 5) ph_p2(p, layer, smem);
      else ph_p3(p, layer, smem);
    }
  }
}

extern "C" void kernel_launch(void* const* d_in, const int* in_sizes, int n_in, void* d_out, int out_size,
                              void* d_ws, size_t ws_size, hipStream_t stream) {
  static int grid_blocks = 0;
  if (!grid_blocks) {
    int dev = 0, cus = 0, per_cu = 0;
    hipGetDevice(&dev);
    hipDeviceGetAttribute(&cus, hipDeviceAttributeMultiprocessorCount, dev);
    hipOccupancyMaxActiveBlocksPerMultiprocessor(&per_cu, mega, 256, 0);
    if (per_cu > 2) per_cu = 2;
    if (per_cu < 1) per_cu = 1;
    grid_blocks = cus * per_cu;
  }
  Params p;
  memset(&p, 0, sizeof(p));
  const float* const* in = (const float* const*)d_in;
  p.x_prompt = in[0]; p.x_sample = in[1]; p.cache_k = in[2]; p.cache_v = in[3]; p.cache_lf = in[4]; p.state_ret = in[5];
  p.meta = in[6]; p.norm_mix = in[7]; p.norm_ffn = in[8]; p.fox_w_in = in[9]; p.fox_b_f = in[10]; p.fox_qn = in[11];
  p.fox_kn = in[12]; p.fox_w_out = in[13]; p.ret_w_in = in[14]; p.ret_gn = in[15]; p.ret_w_out = in[16];
  p.peer_wq = in[17]; p.peer_sk = in[18]; p.peer_u = in[19]; p.peer_v = in[20];
  p.out = (float*)d_out;
  char* w = (char*)d_ws;
  size_t off = 0;
  auto take = [&](size_t bytes) { char* r = w + off; off += (bytes + 255) & ~(size_t)255; return r; };
  p.X = (float*)take((size_t)TPAD * DM * 4);
  p.H = (u16*)take((size_t)TPAD * DM * 2);
  p.WfinT = (u16*)take((size_t)2 * 4224 * 1024 * 2);
  p.WfoutT = (u16*)take((size_t)2 * 1024 * 1024 * 2);
  p.WrinT = (u16*)take((size_t)2 * 6144 * 1024 * 2);
  p.WroutT = (u16*)take((size_t)2 * 1024 * 2048 * 2);
  p.WpqT = (u16*)take((size_t)4 * 2048 * 1024 * 2);
  p.SKb = (u16*)take((size_t)4 * 8 * 2 * 128 * 128 * 2);
  p.Ub = (u16*)take((size_t)NEXP * DM * 2);
  p.Vb = (u16*)take((size_t)NEXP * DM * 2);
  p.SV = (float*)take((size_t)TPAD * 256 * 4);
  p.SI = (int*)take((size_t)TPAD * 256 * 4);
  p.LFC = (float*)take((size_t)TPAD * 16 * 4);
  p.LFR = (float*)take((size_t)TPAD * 16 * 4);
  p.TT = (float*)take((size_t)MTILES * 16 * 4);
  size_t region = off;
  p.Qf = (u16*)take((size_t)TPAD * DM * 2);
  p.Kf = (u16*)take((size_t)TPAD * DM * 2);
  p.VtF = (u16*)take((size_t)1024 * TPAD * 2);
  p.OGf = (u16*)take((size_t)TPAD * DM * 2);
  p.AO = (u16*)take((size_t)TPAD * DM * 2);
  off = region;
  p.Qr = (u16*)take((size_t)TP2 * DM * 2);
  p.Kr = (u16*)take((size_t)TP2 * DM * 2);
  p.KrT = (u16*)take((size_t)1024 * TP2 * 2);
  p.VrT = (u16*)take((size_t)2048 * TP2 * 2);
  p.Gr = (u16*)take((size_t)TPAD * 2048 * 2);
  p.ST = (u16*)take((size_t)NCH * 4 * 512 * 256 * 2);
  if (off > ws_size) { fprintf(stderr, "workspace too small: need %zu have %zu\n", off, ws_size); return; }
  for (int i = 0; i < 128; ++i) p.rope_rev[i] = (float)(pow(10000.0, -(double)i / 128.0) / (2.0 * M_PI));
#if ONE_LAUNCH
  int ph0 = 0, ph1 = NPHASE;
  void* args[] = {&p, &ph0, &ph1};
  hipError_t e = hipLaunchCooperativeKernel((void*)mega, dim3(grid_blocks), dim3(256), args, 0, stream);
  if (e != hipSuccess) fprintf(stderr, "cooperative launch failed: %s (grid %d)\n", hipGetErrorString(e), grid_blocks);
#else
  for (int ph = 0; ph < DBG_PHASES; ++ph) mega<<<grid_blocks, 256, 0, stream>>>(p, ph, ph + 1);
  if (DBG_PHASES < NPHASE) mega<<<grid_blocks, 256, 0, stream>>>(p, 100, 101);
  if (DBG_POST) mega<<<grid_blocks, 256, 0, stream>>>(p, 101, 102);
#endif
}
```

```cpp
#include <hip/hip_runtime.h>
#include <hip/hip_cooperative_groups.h>
#include <stdint.h>
#include <math.h>
#include <stdio.h>
#include <string.h>
namespace cg = cooperative_groups;

typedef unsigned short u16;
typedef __attribute__((ext_vector_type(8))) short bf16x8;
typedef __attribute__((ext_vector_type(4))) float f32x4;
typedef __attribute__((ext_vector_type(2))) float f32x2;
typedef __attribute__((ext_vector_type(4))) unsigned int u32x4;
typedef __attribute__((ext_vector_type(2))) unsigned int u32x2;
#define DEV __device__ __forceinline__

#ifndef ONE_LAUNCH
#define ONE_LAUNCH 1
#endif

constexpr int DM = 1024;
constexpr int NMETA = 16;
constexpr int LP = 16400;
constexpr int NSMP = 128;
constexpr int TTOK = LP + NSMP;
constexpr int TPAD = 16640;
constexpr int MTILES = 130;
constexpr int LEAD = 48;
constexpr int TP2 = 16704;
constexpr int NCH = 257;
constexpr int PAST = 1024;
constexpr int NEXP = 16384;
constexpr float EPS = 1e-6f;

constexpr size_t O_YP = 0;
constexpr size_t O_YS = O_YP + (size_t)16384 * 1024;
constexpr size_t O_FKP = O_YS + (size_t)128 * 1024;
constexpr size_t O_FVP = O_FKP + (size_t)2 * LP * 1024;
constexpr size_t O_FLP = O_FVP + (size_t)2 * LP * 1024;
constexpr size_t O_SRP = O_FLP + (size_t)2 * LP * 16;
constexpr size_t O_FKS = O_SRP + (size_t)2 * 4 * 256 * 512;
constexpr size_t O_FVS = O_FKS + (size_t)2 * 128 * 1024;
constexpr size_t O_FLS = O_FVS + (size_t)2 * 128 * 1024;
constexpr size_t O_SRS = O_FLS + (size_t)2 * 128 * 16;

struct Params {
  const float *x_prompt, *x_sample, *cache_k, *cache_v, *cache_lf, *state_ret, *meta, *norm_mix, *norm_ffn;
  const float *fox_w_in, *fox_b_f, *fox_qn, *fox_kn, *fox_w_out, *ret_w_in, *ret_gn, *ret_w_out;
  const float *peer_wq, *peer_sk, *peer_u, *peer_v;
  float* out;
  float* X; u16* H;
  u16 *WfinT, *WfoutT, *WrinT, *WroutT, *WpqT, *SKb, *Ub, *Vb;
  float *SV; int* SI;
  float *LFC, *LFR, *TT;
  u16 *Qf, *Kf, *VtF, *OGf, *AO;
  u16 *Qr, *Kr, *KrT, *VrT, *Gr, *ST;
  float rope_rev[128];
};

DEV u16 f2bf(float f) {
  uint32_t u = __float_as_uint(f);
  u += 0x7fffu + ((u >> 16) & 1u);
  return (u16)(u >> 16);
}
DEV float bf2f(u16 h) { return __uint_as_float(((uint32_t)h) << 16); }
DEV uint32_t pack2(float a, float b) { return (uint32_t)f2bf(a) | ((uint32_t)f2bf(b) << 16); }
DEV float bflo(uint32_t u) { return __uint_as_float(u << 16); }
DEV float bfhi(uint32_t u) { return __uint_as_float(u & 0xffff0000u); }

union V8 { bf16x8 v; uint32_t u[4]; u32x2 d[2]; u32x4 q; };

DEV f32x4 mfma(bf16x8 a, bf16x8 b, f32x4 c) { return __builtin_amdgcn_mfma_f32_16x16x32_bf16(a, b, c, 0, 0, 0); }

template <int CTRL> DEV float dppf(float v) {
  return __int_as_float(__builtin_amdgcn_update_dpp(0, __float_as_int(v), CTRL, 0xf, 0xf, false));
}
template <int CTRL> DEV uint32_t dppu(uint32_t v) {
  return (uint32_t)__builtin_amdgcn_update_dpp(0, (int)v, CTRL, 0xf, 0xf, false);
}
DEV float row16_sum(float v) {
  v += dppf<0xB1>(v); v += dppf<0x4E>(v); v += dppf<0x141>(v); v += dppf<0x140>(v);
  return v;
}
DEV uint32_t row16_maxu(uint32_t v) {
  v = max(v, dppu<0xB1>(v)); v = max(v, dppu<0x4E>(v)); v = max(v, dppu<0x141>(v)); v = max(v, dppu<0x140>(v));
  return v;
}
DEV float rdlane(float v, int l) { float r = __int_as_float(__builtin_amdgcn_readlane(__float_as_int(v), l)); asm volatile("" : "+v"(r)); return r; }
DEV float wave_sum(float v) {
  v = row16_sum(v);
  return rdlane(v, 0) + rdlane(v, 16) + rdlane(v, 32) + rdlane(v, 48);
}
DEV float wave_max(float v) {
  v = fmaxf(v, dppf<0xB1>(v)); v = fmaxf(v, dppf<0x4E>(v)); v = fmaxf(v, dppf<0x141>(v)); v = fmaxf(v, dppf<0x140>(v));
  return fmaxf(fmaxf(rdlane(v, 0), rdlane(v, 16)), fmaxf(rdlane(v, 32), rdlane(v, 48)));
}
DEV uint32_t wave_maxu(uint32_t v) {
  v = row16_maxu(v);
  uint32_t a = (uint32_t)__builtin_amdgcn_readlane((int)v, 0), b = (uint32_t)__builtin_amdgcn_readlane((int)v, 16);
  uint32_t c = (uint32_t)__builtin_amdgcn_readlane((int)v, 32), d = (uint32_t)__builtin_amdgcn_readlane((int)v, 48);
  return max(max(a, b), max(c, d));
}
DEV uint32_t f2key(float f) { uint32_t u = __float_as_uint(f); return (u & 0x80000000u) ? ~u : (u | 0x80000000u); }
DEV float key2f(uint32_t k) { uint32_t u = (k & 0x80000000u) ? (k & 0x7fffffffu) : ~k; return __uint_as_float(u); }

DEV float sigmoidf_(float x) { return 1.f / (1.f + __expf(-x)); }
DEV float logsigmoid_(float x) { return fminf(x, 0.f) - log1pf(expf(-fabsf(x))); }
DEV float gelu_(float x) { return 0.5f * x * (1.f + erff(x * 0.70710678118654752f)); }
DEV float ret_l2g(int h) { return log2f(1.f - exp2f(-5.f - (float)h)); }
DEV int otid() { int t = threadIdx.x; asm volatile("" : "+v"(t)); return t; }
DEV int perm_dorig(int dp) { return ((dp >> 4) & 1) * 128 + (dp >> 5) * 16 + (dp & 15); }

DEV void norm_rows(const Params& p, const float* gain, bool from_input) {
  int tid_ = otid();
  int lane = tid_ & 63;
  int gw = (blockIdx.x * blockDim.x + tid_) >> 6, nw = (gridDim.x * blockDim.x) >> 6;
  for (int t = gw; t < TPAD; t += nw) {
    const float* src;
    if (from_input) {
      if (t < NMETA) src = p.meta + (size_t)t * DM;
      else if (t < LP) src = p.x_prompt + (size_t)(t - NMETA) * DM;
      else if (t < TTOK) src = p.x_sample + (size_t)(t - LP) * DM;
      else src = nullptr;
    } else src = p.X + (size_t)t * DM;
    f32x4 v[4];
    float ss = 0.f;
#pragma unroll
    for (int c = 0; c < 4; ++c) {
      if (src) v[c] = *(const f32x4*)(src + c * 256 + lane * 4); else v[c] = f32x4{0.f, 0.f, 0.f, 0.f};
      ss += v[c].x * v[c].x + v[c].y * v[c].y + v[c].z * v[c].z + v[c].w * v[c].w;
    }
    ss = wave_sum(ss);
    float rstd = rsqrtf(ss * (1.f / DM) + EPS);
#pragma unroll
    for (int c = 0; c < 4; ++c) {
      if (from_input) *(f32x4*)(p.X + (size_t)t * DM + c * 256 + lane * 4) = v[c];
      f32x4 g = *(const f32x4*)(gain + c * 256 + lane * 4);
      u32x2 o;
      o.x = pack2(v[c].x * rstd * g.x, v[c].y * rstd * g.y);
      o.y = pack2(v[c].z * rstd * g.z, v[c].w * rstd * g.w);
      *(u32x2*)(p.H + (size_t)t * DM + c * 256 + lane * 4) = o;
    }
  }
}

DEV void convert_bf16(const float* src, u16* dst, size_t n4) {
  size_t i = (size_t)blockIdx.x * blockDim.x + otid(), st = (size_t)gridDim.x * blockDim.x;
  for (; i < n4; i += st) {
    f32x4 v = ((const f32x4*)src)[i];
    u32x2 o; o.x = pack2(v.x, v.y); o.y = pack2(v.z, v.w);
    ((u32x2*)dst)[i] = o;
  }
}

DEV void xpose(const float* W, int K, int N, int Npad, u16* Wt, bool permq, char* smem) {
  u16* tile = (u16*)smem;
  int tid = otid();
  int ntn = Npad / 64, ntk = K / 64;
  for (int it = blockIdx.x; it < ntn * ntk; it += gridDim.x) {
    int n0 = (it / ntk) * 64, k0 = (it % ntk) * 64;
    int c = tid & 63, r0 = tid >> 6;
    int np = n0 + c;
    int src = np;
    if (permq && np < 2048) src = (np & ~255) + perm_dorig(np & 255);
    __syncthreads();
#pragma unroll
    for (int i = 0; i < 16; ++i) {
      int k = r0 + 4 * i;
      float v = (np < N) ? W[(size_t)(k0 + k) * N + src] : 0.f;
      tile[c * 72 + k] = f2bf(v);
    }
    __syncthreads();
    int nl = tid >> 2, kq = (tid & 3) * 16;
    u32x4 a = *(const u32x4*)(tile + nl * 72 + kq);
    u32x4 b = *(const u32x4*)(tile + nl * 72 + kq + 8);
    *(u32x4*)(Wt + (size_t)(n0 + nl) * K + k0 + kq) = a;
    *(u32x4*)(Wt + (size_t)(n0 + nl) * K + k0 + kq + 8) = b;
  }
}

typedef __attribute__((ext_vector_type(2))) float v2f_t;
constexpr float U_SCALE = 64.f, V_SCALE = 16.f;
DEV void convert_fp8(const float* src, uint32_t* dst, size_t n4, float scale) {
  size_t i = (size_t)blockIdx.x * blockDim.x + otid(), st = (size_t)gridDim.x * blockDim.x;
  for (; i < n4; i += st) {
    f32x4 v = ((const f32x4*)src)[i];
    int w = __builtin_amdgcn_cvt_pk_fp8_f32(v.x * scale, v.y * scale, 0, false);
    w = __builtin_amdgcn_cvt_pk_fp8_f32(v.z * scale, v.w * scale, w, true);
    dst[i] = (uint32_t)w;
  }
}
DEV void conv_tables(const Params& p, int layer) {
  convert_fp8(p.peer_u + (size_t)layer * NEXP * DM, (uint32_t*)p.Ub, (size_t)NEXP * DM / 4, U_SCALE);
  convert_fp8(p.peer_v + (size_t)layer * NEXP * DM, (uint32_t*)p.Vb, (size_t)NEXP * DM / 4, V_SCALE);
}

DEV void ph_prep(const Params& p, char* smem) {
  norm_rows(p, p.norm_mix, true);
  convert_bf16(p.peer_sk, p.SKb, (size_t)4 * 8 * 2 * 128 * 128 / 4);
  for (int j = 0; j < 2; ++j) {
    xpose(p.fox_w_in + (size_t)j * 1024 * 4112, 1024, 4112, 4224, p.WfinT + (size_t)j * 4224 * 1024, false, smem);
    xpose(p.fox_w_out + (size_t)j * 1024 * 1024, 1024, 1024, 1024, p.WfoutT + (size_t)j * 1024 * 1024, false, smem);
    xpose(p.ret_w_in + (size_t)j * 1024 * 6144, 1024, 6144, 6144, p.WrinT + (size_t)j * 6144 * 1024, true, smem);
    xpose(p.ret_w_out + (size_t)j * 2048 * 1024, 2048, 1024, 1024, p.WroutT + (size_t)j * 1024 * 2048, false, smem);
  }
  for (int l = 0; l < 4; ++l)
    xpose(p.peer_wq + (size_t)l * 1024 * 2048, 1024, 2048, 2048, p.WpqT + (size_t)l * 2048 * 1024, false, smem);
}

constexpr int LDK = 72;
DEV void gemm_tile(const u16* __restrict__ A, int lda, const u16* __restrict__ Bt, int ldb, int K,
                          int m0, int n0, char* smem, f32x4 (&acc)[4][4]) {
  u16* sA = (u16*)smem;
  u16* sB = sA + 128 * LDK;
  int tid = otid(), lane = tid & 63, wid = tid >> 6;
  int wr = wid >> 1, wc = wid & 1, fr = lane & 15, fq = lane >> 4;
#pragma unroll
  for (int m = 0; m < 4; ++m)
#pragma unroll
    for (int n = 0; n < 4; ++n) acc[m][n] = f32x4{0.f, 0.f, 0.f, 0.f};
  u32x4 ra[4], rb[4];
  const u16* Ap = A + (size_t)(m0 + (tid >> 3)) * lda + (tid & 7) * 8;
  const u16* Bp = Bt + (size_t)(n0 + (tid >> 3)) * ldb + (tid & 7) * 8;
#pragma unroll
  for (int i = 0; i < 4; ++i) {
    ra[i] = *(const u32x4*)(Ap + (size_t)(32 * i) * lda);
    rb[i] = *(const u32x4*)(Bp + (size_t)(32 * i) * ldb);
  }
  for (int k0 = 0; k0 < K; k0 += 64) {
    __syncthreads();
#pragma unroll
    for (int i = 0; i < 4; ++i) {
      *(u32x4*)(sA + ((tid >> 3) + 32 * i) * LDK + (tid & 7) * 8) = ra[i];
      *(u32x4*)(sB + ((tid >> 3) + 32 * i) * LDK + (tid & 7) * 8) = rb[i];
    }
    __syncthreads();
    if (k0 + 64 < K) {
#pragma unroll
      for (int i = 0; i < 4; ++i) {
        ra[i] = *(const u32x4*)(Ap + (size_t)(32 * i) * lda + k0 + 64);
        rb[i] = *(const u32x4*)(Bp + (size_t)(32 * i) * ldb + k0 + 64);
      }
    }
#pragma unroll
    for (int ks = 0; ks < 2; ++ks) {
      bf16x8 af[4], bfv[4];
#pragma unroll
      for (int m = 0; m < 4; ++m) af[m] = *(const bf16x8*)(sA + (wr * 64 + m * 16 + fr) * LDK + ks * 32 + fq * 8);
#pragma unroll
      for (int n = 0; n < 4; ++n) bfv[n] = *(const bf16x8*)(sB + (wc * 64 + n * 16 + fr) * LDK + ks * 32 + fq * 8);
#pragma unroll
      for (int m = 0; m < 4; ++m)
#pragma unroll
        for (int n = 0; n < 4; ++n) acc[m][n] = mfma(af[m], bfv[n], acc[m][n]);
    }
  }
}

DEV void ph_f1(const Params& p, int jf, char* smem) {
  const u16* Wt = p.WfinT + (size_t)jf * 4224 * 1024;
  int tid = otid(), lane = tid & 63, wid = tid >> 6;
  int wr = wid >> 1, wc = wid & 1, fr = lane & 15, fq = lane >> 4;
  const int NT = 33;
  for (int it = blockIdx.x; it < MTILES * NT; it += gridDim.x) {
    int mt = it / NT, nt = it % NT;
    int m0 = mt * 128;
    f32x4 acc[4][4];
    gemm_tile(p.H, DM, Wt, DM, DM, m0, nt * 128, smem, acc);
    int type = nt >> 3;
    if (type <= 1) {
      int hh = (nt & 7) * 2 + wc;
      const float* gn = (type == 0 ? p.fox_qn : p.fox_kn) + jf * 64;
      float g[4];
#pragma unroll
      for (int n = 0; n < 4; ++n) g[n] = gn[n * 16 + fr] * (type == 0 ? 0.125f : 1.f);
#pragma unroll
      for (int m = 0; m < 4; ++m)
#pragma unroll
        for (int j = 0; j < 4; ++j) {
          float ss = 0.f;
#pragma unroll
          for (int n = 0; n < 4; ++n) ss += acc[m][n][j] * acc[m][n][j];
          ss = row16_sum(ss);
          float rstd = rsqrtf(ss * (1.f / 64.f) + EPS);
          int row = m0 + wr * 64 + m * 16 + fq * 4 + j;
#pragma unroll
          for (int n = 0; n < 4; ++n) {
            float v = acc[m][n][j] * rstd * g[n];
            int col = hh * 64 + n * 16 + fr;
            if (type == 0) p.Qf[(size_t)row * DM + col] = f2bf(v);
            else {
              p.Kf[(size_t)row * DM + col] = f2bf(v);
              if (row < LP) p.out[O_FKP + ((size_t)jf * LP + row) * 1024 + col] = v;
              else if (row < TTOK) p.out[O_FKS + ((size_t)jf * 128 + (row - LP)) * 1024 + col] = v;
            }
          }
        }
    } else if (type == 2) {
      int hh = (nt & 7) * 2 + wc;
#pragma unroll
      for (int m = 0; m < 4; ++m) {
        int rb = m0 + wr * 64 + m * 16 + fq * 4;
#pragma unroll
        for (int n = 0; n < 4; ++n) {
          int d = n * 16 + fr;
          u32x2 o; o.x = pack2(acc[m][n][0], acc[m][n][1]); o.y = pack2(acc[m][n][2], acc[m][n][3]);
          *(u32x2*)(p.VtF + (size_t)(hh * 64 + d) * TPAD + rb) = o;
#pragma unroll
          for (int j = 0; j < 4; ++j) {
            int row = rb + j; int col = hh * 64 + d;
            if (row < LP) p.out[O_FVP + ((size_t)jf * LP + row) * 1024 + col] = acc[m][n][j];
            else if (row < TTOK) p.out[O_FVS + ((size_t)jf * 128 + (row - LP)) * 1024 + col] = acc[m][n][j];
          }
        }
      }
    } else if (type == 3) {
#pragma unroll
      for (int m = 0; m < 4; ++m)
#pragma unroll
        for (int n = 0; n < 4; ++n)
#pragma unroll
          for (int j = 0; j < 4; ++j) {
            int row = m0 + wr * 64 + m * 16 + fq * 4 + j;
            int col = (nt - 24) * 128 + wc * 64 + n * 16 + fr;
            p.OGf[(size_t)row * DM + col] = f2bf(acc[m][n][j]);
          }
    } else {
      float* lfs = (float*)smem;
      __syncthreads();
      if (wc == 0) {
        float bf = p.fox_b_f[jf * 16 + fr];
#pragma unroll
        for (int m = 0; m < 4; ++m)
#pragma unroll
          for (int j = 0; j < 4; ++j) {
            int rl = wr * 64 + m * 16 + fq * 4 + j;
            int row = m0 + rl;
            float lf = logsigmoid_(acc[m][0][j] + bf);
            lfs[rl * 16 + fr] = lf;
            p.LFR[(size_t)row * 16 + fr] = lf;
            if (row < LP) p.out[O_FLP + ((size_t)jf * LP + row) * 16 + fr] = lf;
            else if (row < TTOK) p.out[O_FLS + ((size_t)jf * 128 + (row - LP)) * 16 + fr] = lf;
          }
      }
      __syncthreads();
      if (tid < 16) {
        float run = 0.f;
        for (int r = 0; r < 128; ++r) {
          run += lfs[r * 16 + tid];
          p.LFC[(size_t)(m0 + r) * 16 + tid] = run;
        }
        p.TT[mt * 16 + tid] = run;
      }
    }
  }
}

DEV void f2_prompt(const Params& p, int qt, int h, char* smem) {
  u16* Ks = (u16*)smem;
  u16* Vs = Ks + 2 * 64 * LDK;
  float* cs = (float*)(Vs + 2 * 64 * LDK);
  float* off = cs + 128;
  float* tmp = off + 132;
  int tid = otid(), lane = tid & 63, wid = tid >> 6, fr = lane & 15, fq = lane >> 4;
  __syncthreads();
  if (tid < MTILES) tmp[tid] = p.TT[tid * 16 + h];
  __syncthreads();
  if (tid < MTILES) { float s = 0.f; for (int m = 0; m < tid; ++m) s += tmp[m]; off[tid] = s; }
  __syncthreads();
  int q0 = qt * 128 + wid * 32;
  bf16x8 qf[2][2];
  float cq[2];
#pragma unroll
  for (int qi = 0; qi < 2; ++qi) {
    int q = q0 + qi * 16 + fr;
#pragma unroll
    for (int ks = 0; ks < 2; ++ks) qf[qi][ks] = *(const bf16x8*)(p.Qf + (size_t)q * DM + h * 64 + ks * 32 + fq * 8);
    cq[qi] = p.LFC[(size_t)q * 16 + h] + off[q >> 7];
  }
  f32x4 o[4][2];
  float mrow[2], lrow[2];
#pragma unroll
  for (int qi = 0; qi < 2; ++qi) {
    mrow[qi] = -INFINITY; lrow[qi] = 0.f;
#pragma unroll
    for (int dt = 0; dt < 4; ++dt) o[dt][qi] = f32x4{0.f, 0.f, 0.f, 0.f};
  }
  int nkt = 2 * (qt + 1);
  u32x4 rk[2], rv[2]; float rc = 0.f;
  const int lrow_ = tid >> 3, lcol = (tid & 7) * 8;
#define GL(kt_) { int key0_ = (kt_) * 64; \
    _Pragma("unroll") for (int i = 0; i < 2; ++i) { int r = lrow_ + 32 * i; \
      rk[i] = *(const u32x4*)(p.Kf + (size_t)(key0_ + r) * DM + h * 64 + lcol); \
      rv[i] = *(const u32x4*)(p.VtF + (size_t)(h * 64 + r) * TPAD + key0_ + lcol); } \
    if (tid < 64) rc = p.LFC[(size_t)(key0_ + tid) * 16 + h] + off[(key0_ + tid) >> 7]; }
  GL(0);
  for (int kt = 0; kt < nkt; ++kt) {
    int buf = kt & 1;
    u16* Kb = Ks + buf * 64 * LDK; u16* Vb = Vs + buf * 64 * LDK; float* cb = cs + buf * 64;
#pragma unroll
    for (int i = 0; i < 2; ++i) {
      int r = lrow_ + 32 * i;
      *(u32x4*)(Kb + r * LDK + lcol) = rk[i];
      *(u32x4*)(Vb + r * LDK + lcol) = rv[i];
    }
    if (tid < 64) cb[tid] = rc;
    __syncthreads();
    if (kt + 1 < nkt) GL(kt + 1);
    int key0 = kt * 64;
    if (key0 <= q0 + 31) {
      f32x4 s[4][2];
#pragma unroll
      for (int kk = 0; kk < 4; ++kk) {
#pragma unroll
        for (int qi = 0; qi < 2; ++qi) s[kk][qi] = f32x4{0.f, 0.f, 0.f, 0.f};
#pragma unroll
        for (int ks = 0; ks < 2; ++ks) {
          bf16x8 a = *(const bf16x8*)(Kb + (kk * 16 + fr) * LDK + ks * 32 + fq * 8);
#pragma unroll
          for (int qi = 0; qi < 2; ++qi) s[kk][qi] = mfma(a, qf[qi][ks], s[kk][qi]);
        }
      }
      bool diag = (key0 + 63 > q0);
      f32x4 ck[4];
#pragma unroll
      for (int kk = 0; kk < 4; ++kk) ck[kk] = *(const f32x4*)(cb + kk * 16 + fq * 4);
      bf16x8 pf[2][2];
#pragma unroll
      for (int qi = 0; qi < 2; ++qi) {
        int q = q0 + qi * 16 + fr;
        float mloc = -INFINITY;
#pragma unroll
        for (int kk = 0; kk < 4; ++kk)
#pragma unroll
          for (int j = 0; j < 4; ++j) {
            float v = s[kk][qi][j] + (cq[qi] - ck[kk][j]);
            if (diag && (key0 + kk * 16 + fq * 4 + j > q)) v = -INFINITY;
            s[kk][qi][j] = v;
            mloc = fmaxf(mloc, v);
          }
        mloc = fmaxf(mloc, __shfl_xor(mloc, 16));
        mloc = fmaxf(mloc, __shfl_xor(mloc, 32));
        float mnew = fmaxf(mrow[qi], mloc);
        float alpha = __expf(mrow[qi] - mnew);
        mrow[qi] = mnew;
        float ls = 0.f;
#pragma unroll
        for (int kk = 0; kk < 4; ++kk)
#pragma unroll
          for (int j = 0; j < 4; ++j) {
            float e = __expf(s[kk][qi][j] - mnew);
            s[kk][qi][j] = e; ls += e;
          }
        lrow[qi] = lrow[qi] * alpha + ls;
#pragma unroll
        for (int dt = 0; dt < 4; ++dt) o[dt][qi] = o[dt][qi] * alpha;
#pragma unroll
        for (int pp = 0; pp < 2; ++pp) {
          V8 t;
          t.u[0] = pack2(s[2 * pp][qi][0], s[2 * pp][qi][1]); t.u[1] = pack2(s[2 * pp][qi][2], s[2 * pp][qi][3]);
          t.u[2] = pack2(s[2 * pp + 1][qi][0], s[2 * pp + 1][qi][1]); t.u[3] = pack2(s[2 * pp + 1][qi][2], s[2 * pp + 1][qi][3]);
          pf[qi][pp] = t.v;
        }
      }
#pragma unroll
      for (int dt = 0; dt < 4; ++dt)
#pragma unroll
        for (int pp = 0; pp < 2; ++pp) {
          V8 a;
          a.d[0] = *(const u32x2*)(Vb + (dt * 16 + fr) * LDK + (2 * pp) * 16 + fq * 4);
          a.d[1] = *(const u32x2*)(Vb + (dt * 16 + fr) * LDK + (2 * pp + 1) * 16 + fq * 4);
#pragma unroll
          for (int qi = 0; qi < 2; ++qi) o[dt][qi] = mfma(a.v, pf[qi][pp], o[dt][qi]);
        }
    }
  }
#pragma unroll
  for (int qi = 0; qi < 2; ++qi) {
    float l = lrow[qi];
    l += __shfl_xor(l, 16); l += __shfl_xor(l, 32);
    float inv = 1.f / l;
    int q = q0 + qi * 16 + fr;
    if (q < LP) {
#pragma unroll
      for (int dt = 0; dt < 4; ++dt) {
        int d = dt * 16 + fq * 4;
        u32x2 og = *(const u32x2*)(p.OGf + (size_t)q * DM + h * 64 + d);
        u32x2 r;
        r.x = pack2(o[dt][qi][0] * inv * sigmoidf_(bflo(og.x)), o[dt][qi][1] * inv * sigmoidf_(bfhi(og.x)));
        r.y = pack2(o[dt][qi][2] * inv * sigmoidf_(bflo(og.y)), o[dt][qi][3] * inv * sigmoidf_(bfhi(og.y)));
        *(u32x2*)(p.AO + (size_t)q * DM + h * 64 + d) = r;
      }
    }
  }
}

DEV void f2_sample(const Params& p, int jf, int b, int h, int qh, char* smem) {
  constexpr int NK = PAST + 16;
  float* S = (float*)smem;
  float* qs = S + 8 * NK;
  float* cc = qs + 8 * 64;
  float* part = cc + NK;
  float* invl = part + 256;
  int tid = otid(), lane = tid & 63, wid = tid >> 6;
  __syncthreads();
  for (int e = tid; e < 512; e += 256) {
    int i = e >> 6, d = e & 63;
    qs[e] = bf2f(p.Qf[(size_t)(LP + b * 16 + qh * 8 + i) * DM + h * 64 + d]);
  }
  float lv[5]; float run = 0.f;
#pragma unroll
  for (int u = 0; u < 5; ++u) {
    int j = tid * 5 + u;
    float v = 0.f;
    if (j < PAST) v = p.cache_lf[(((size_t)jf * 8 + b) * PAST + j) * 16 + h];
    else if (j < NK) v = p.LFR[(size_t)(LP + b * 16 + (j - PAST)) * 16 + h];
    run += v; lv[u] = run;
  }
  part[tid] = run;
  __syncthreads();
  float base = 0.f;
  for (int m = 0; m < tid; ++m) base += part[m];
#pragma unroll
  for (int u = 0; u < 5; ++u) { int j = tid * 5 + u; if (j < NK) cc[j] = base + lv[u]; }
  __syncthreads();
  for (int j = tid; j < NK; j += 256) {
    const float* kp;
    if (j < PAST) kp = p.cache_k + ((((size_t)jf * 8 + b) * PAST + j) * 16 + h) * 64;
    else kp = p.out + O_FKS + (((size_t)jf * 128 + b * 16 + (j - PAST)) * 16 + h) * 64;
    f32x4 kv[16];
#pragma unroll
    for (int c = 0; c < 16; ++c) kv[c] = ((const f32x4*)kp)[c];
    float cj = cc[j];
#pragma unroll
    for (int i = 0; i < 8; ++i) {
      float a = 0.f;
#pragma unroll
      for (int c = 0; c < 16; ++c) {
        f32x4 qv = *(const f32x4*)(qs + i * 64 + c * 4);
        a += qv.x * kv[c].x + qv.y * kv[c].y + qv.z * kv[c].z + qv.w * kv[c].w;
      }
      int qi = qh * 8 + i;
      a += cc[PAST + qi] - cj;
      if (j > PAST + qi) a = -INFINITY;
      S[i * NK + j] = a;
    }
  }
  __syncthreads();
  for (int i = wid * 2; i < wid * 2 + 2; ++i) {
    float m = -INFINITY;
    for (int j = lane; j < NK; j += 64) m = fmaxf(m, S[i * NK + j]);
    m = wave_max(m);
    float l = 0.f;
    for (int j = lane; j < NK; j += 64) { float e = __expf(S[i * NK + j] - m); S[i * NK + j] = e; l += e; }
    l = wave_sum(l);
    if (lane == 0) invl[i] = 1.f / l;
  }
  __syncthreads();
  {
    int i = tid >> 5, dq = tid & 31;
    float o0 = 0.f, o1 = 0.f;
    const float* vb = p.cache_v + ((((size_t)jf * 8 + b) * PAST) * 16 + h) * 64 + dq * 2;
#pragma unroll 8
    for (int j = 0; j < PAST; ++j) {
      f32x2 v = *(const f32x2*)(vb + (size_t)j * 1024);
      float pj = S[i * NK + j];
      o0 += pj * v.x; o1 += pj * v.y;
    }
    const float* vn = p.out + O_FVS + (((size_t)jf * 128 + b * 16) * 16 + h) * 64 + dq * 2;
#pragma unroll
    for (int j = 0; j < 16; ++j) {
      f32x2 v = *(const f32x2*)(vn + (size_t)j * 1024);
      float pj = S[i * NK + PAST + j];
      o0 += pj * v.x; o1 += pj * v.y;
    }
    int row = LP + b * 16 + qh * 8 + i;
    float il = invl[i];
    uint32_t og = *(const uint32_t*)(p.OGf + (size_t)row * DM + h * 64 + dq * 2);
    *(uint32_t*)(p.AO + (size_t)row * DM + h * 64 + dq * 2) = pack2(o0 * il * sigmoidf_(bflo(og)), o1 * il * sigmoidf_(bfhi(og)));
  }
}

DEV void ph_f2(const Params& p, int jf, char* smem) {
  const int NP = 129 * 16, NI = NP + 256;
  int G = gridDim.x;
  {
    int gt = blockIdx.x * blockDim.x + otid(), gs = gridDim.x * blockDim.x;
    for (int i = gt; i < (TPAD - TTOK) * DM / 2; i += gs) ((uint32_t*)(p.AO + (size_t)TTOK * DM))[i] = 0u;
  }
  for (int r = 0;; ++r) {
    int pos = (r & 1) ? (G - 1 - (int)blockIdx.x) : (int)blockIdx.x;
    int idx = r * G + pos;
    if (r * G >= NI) break;
    if (idx >= NI) continue;
    if (idx < NP) f2_prompt(p, 128 - idx / 16, idx % 16, smem);
    else { int s = idx - NP; f2_sample(p, jf, s >> 5, (s >> 1) & 15, s & 1, smem); }
  }
}

DEV void ph_outproj(const Params& p, const u16* A, int K, const u16* Wt, char* smem) {
  int tid = otid(), lane = tid & 63, wid = tid >> 6;
  int wr = wid >> 1, wc = wid & 1, fr = lane & 15, fq = lane >> 4;
  for (int it = blockIdx.x; it < MTILES * 8; it += gridDim.x) {
    int mt = it / 8, nt = it % 8;
    f32x4 acc[4][4];
    gemm_tile(A, K, Wt, K, K, mt * 128, nt * 128, smem, acc);
#pragma unroll
    for (int m = 0; m < 4; ++m)
#pragma unroll
      for (int n = 0; n < 4; ++n)
#pragma unroll
        for (int j = 0; j < 4; ++j) {
          int row = mt * 128 + wr * 64 + m * 16 + fq * 4 + j;
          int col = nt * 128 + wc * 64 + n * 16 + fr;
          p.X[(size_t)row * DM + col] += acc[m][n][j];
        }
  }
}

DEV void ph_r1(const Params& p, int jr, char* smem) {
  const u16* Wt = p.WrinT + (size_t)jr * 6144 * 1024;
  int tid = otid(), lane = tid & 63, wid = tid >> 6;
  int wr = wid >> 1, wc = wid & 1, fr = lane & 15, fq = lane >> 4;
  {
    int gt = blockIdx.x * blockDim.x + tid, gs = gridDim.x * blockDim.x;
    for (int i = gt; i < LEAD * DM; i += gs) { p.Qr[i] = 0; p.Kr[i] = 0; }
    for (int i = gt; i < 1024 * LEAD; i += gs) p.KrT[(size_t)(i / LEAD) * TP2 + (i % LEAD)] = 0;
    for (int i = gt; i < 2048 * LEAD; i += gs) p.VrT[(size_t)(i / LEAD) * TP2 + (i % LEAD)] = 0;
  }
  const int NT = 48;
  for (int it = blockIdx.x; it < MTILES * NT; it += gridDim.x) {
    int mt = it / NT, nt = it % NT;
    int m0 = mt * 128;
    f32x4 acc[4][4];
    gemm_tile(p.H, DM, Wt, DM, DM, m0, nt * 128, smem, acc);
    if (nt < 16) {
      bool isq = nt < 8;
      int hh = (nt & 7) >> 1, half = nt & 1;
      float l2g = ret_l2g(hh);
      u16* dst = isq ? p.Qr : p.Kr;
#pragma unroll
      for (int pr = 0; pr < 2; ++pr) {
        int g = half * 4 + wc * 2 + pr;
        int fi = g * 16 + fr;
        float rr = p.rope_rev[fi];
        int dp1 = g * 32 + fr, dp2 = dp1 + 16;
#pragma unroll
        for (int m = 0; m < 4; ++m) {
          int rb = m0 + wr * 64 + m * 16 + fq * 4;
          float o1[4], o2[4];
#pragma unroll
          for (int j = 0; j < 4; ++j) {
            int row = rb + j;
            int pos = (row < LP) ? (row - NMETA) : ((row < TTOK) ? (PAST + ((row - LP) & 15)) : 0);
            float rev = (float)pos * rr;
            rev -= floorf(rev);
            float sn = __builtin_amdgcn_sinf(rev), cs = __builtin_amdgcn_cosf(rev);
            float x1 = acc[m][2 * pr][j], x2 = acc[m][2 * pr + 1][j];
            float a = x1 * cs - x2 * sn, bb = x1 * sn + x2 * cs;
            if (isq) { a *= 0.0625f; bb *= 0.0625f; }
            o1[j] = a; o2[j] = bb;
            dst[(size_t)(row + LEAD) * DM + hh * 256 + dp1] = f2bf(a);
            dst[(size_t)(row + LEAD) * DM + hh * 256 + dp2] = f2bf(bb);
          }
          if (!isq) {
            float dc[4];
#pragma unroll
            for (int j = 0; j < 4; ++j) dc[j] = exp2f(l2g * (float)(63 - ((rb + j + LEAD) & 63)));
            u32x2 t1, t2;
            t1.x = pack2(o1[0] * dc[0], o1[1] * dc[1]); t1.y = pack2(o1[2] * dc[2], o1[3] * dc[3]);
            t2.x = pack2(o2[0] * dc[0], o2[1] * dc[1]); t2.y = pack2(o2[2] * dc[2], o2[3] * dc[3]);
            *(u32x2*)(p.KrT + (size_t)(hh * 256 + dp1) * TP2 + rb + LEAD) = t1;
            *(u32x2*)(p.KrT + (size_t)(hh * 256 + dp2) * TP2 + rb + LEAD) = t2;
          }
        }
      }
    } else if (nt < 32) {
      int hh = (nt - 16) >> 2;
#pragma unroll
      for (int m = 0; m < 4; ++m) {
        int rb = m0 + wr * 64 + m * 16 + fq * 4;
#pragma unroll
        for (int n = 0; n < 4; ++n) {
          int e = ((nt - 16) & 3) * 128 + wc * 64 + n * 16 + fr;
          u32x2 o; o.x = pack2(acc[m][n][0], acc[m][n][1]); o.y = pack2(acc[m][n][2], acc[m][n][3]);
          *(u32x2*)(p.VrT + (size_t)(hh * 512 + e) * TP2 + rb + LEAD) = o;
        }
      }
    } else {
#pragma unroll
      for (int m = 0; m < 4; ++m)
#pragma unroll
        for (int n = 0; n < 4; ++n)
#pragma unroll
          for (int j = 0; j < 4; ++j) {
            int row = m0 + wr * 64 + m * 16 + fq * 4 + j;
            int col = (nt - 32) * 128 + wc * 64 + n * 16 + fr;
            p.Gr[(size_t)row * 2048 + col] = f2bf(acc[m][n][j]);
          }
    }
  }
}

DEV void ph_r2(const Params& p, int jr) {
  int tid = otid(), lane = tid & 63, wid = tid >> 6, fr = lane & 15, fq = lane >> 4;
  for (int it = blockIdx.x; it < 64; it += gridDim.x) {
    int h = it >> 4, sl = it & 15;
    float dec64 = exp2f(ret_l2g(h) * 64.f);
    f32x4 st[4][2];
#pragma unroll
    for (int r = 0; r < 4; ++r)
#pragma unroll
      for (int c = 0; c < 2; ++c) st[r][c] = f32x4{0.f, 0.f, 0.f, 0.f};
    const u16* kbase = p.KrT + (size_t)(h * 256 + wid * 64 + fr) * TP2 + fq * 8;
    const u16* vbase = p.VrT + (size_t)(h * 512 + sl * 32 + fr) * TP2 + fq * 8;
    bf16x8 ac[8], bc[4], an[8], bn[4];
#pragma unroll
    for (int r = 0; r < 4; ++r)
#pragma unroll
      for (int ks = 0; ks < 2; ++ks) ac[r * 2 + ks] = *(const bf16x8*)(kbase + (size_t)(r * 16) * TP2 + ks * 32);
#pragma unroll
    for (int c = 0; c < 2; ++c)
#pragma unroll
      for (int ks = 0; ks < 2; ++ks) bc[c * 2 + ks] = *(const bf16x8*)(vbase + (size_t)(c * 16) * TP2 + ks * 32);
#pragma unroll 1
    for (int n = 0; n < NCH; ++n) {
      if (n + 1 < NCH) {
#pragma unroll
        for (int r = 0; r < 4; ++r)
#pragma unroll
          for (int ks = 0; ks < 2; ++ks) an[r * 2 + ks] = *(const bf16x8*)(kbase + (size_t)(r * 16) * TP2 + (n + 1) * 64 + ks * 32);
#pragma unroll
        for (int c = 0; c < 2; ++c)
#pragma unroll
          for (int ks = 0; ks < 2; ++ks) bn[c * 2 + ks] = *(const bf16x8*)(vbase + (size_t)(c * 16) * TP2 + (n + 1) * 64 + ks * 32);
      }
      if (n >= 1) {
#pragma unroll
        for (int c = 0; c < 2; ++c) {
          u16* sp = p.ST + ((size_t)(n * 4 + h) * 512 + sl * 32 + c * 16 + fr) * 256 + wid * 64 + fq * 4;
#pragma unroll
          for (int r = 0; r < 4; ++r) {
            u32x2 o; o.x = pack2(st[r][c][0], st[r][c][1]); o.y = pack2(st[r][c][2], st[r][c][3]);
            *(u32x2*)(sp + r * 16) = o;
          }
        }
      }
#pragma unroll
      for (int r = 0; r < 4; ++r)
#pragma unroll
        for (int c = 0; c < 2; ++c) {
          f32x4 t = st[r][c] * dec64;
#pragma unroll
          for (int ks = 0; ks < 2; ++ks) t = mfma(ac[r * 2 + ks], bc[c * 2 + ks], t);
          st[r][c] = t;
        }
#pragma unroll
      for (int i = 0; i < 8; ++i) ac[i] = an[i];
#pragma unroll
      for (int i = 0; i < 4; ++i) bc[i] = bn[i];
    }
#pragma unroll
    for (int r = 0; r < 4; ++r)
#pragma unroll
      for (int c = 0; c < 2; ++c)
#pragma unroll
        for (int j = 0; j < 4; ++j) {
          int dorig = perm_dorig(wid * 64 + r * 16 + fq * 4 + j);
          p.out[O_SRP + ((size_t)(jr * 4 + h) * 256 + dorig) * 512 + sl * 32 + c * 16 + fr] = st[r][c][j];
        }
  }
}

DEV void r3_prompt(const Params& p, int jr, int n, int h, char* smem) {
  u32x4* Sf = (u32x4*)smem;
  float* red = (float*)(smem + 8192);
  int tid = otid(), lane = tid & 63, w = tid >> 6, fr = lane & 15, fq = lane >> 4;
  int p0 = n * 64;
  float l2g = ret_l2g(h);
  f32x4 acc[8][4];
#pragma unroll
  for (int a = 0; a < 8; ++a)
#pragma unroll
    for (int b = 0; b < 4; ++b) acc[a][b] = f32x4{0.f, 0.f, 0.f, 0.f};
  const u16* qb = p.Qr + (size_t)(p0 + fr) * DM + h * 256 + fq * 8;
  if (n >= 1) {
    const u16* sb = p.ST + ((size_t)(n * 4 + h) * 512 + w * 128 + fr) * 256 + fq * 8;
#pragma unroll 1
    for (int ks = 0; ks < 8; ++ks) {
      bf16x8 bq[4];
#pragma unroll
      for (int it = 0; it < 4; ++it) bq[it] = *(const bf16x8*)(qb + (size_t)(it * 16) * DM + ks * 32);
#pragma unroll
      for (int dvt = 0; dvt < 8; ++dvt) {
        bf16x8 a = *(const bf16x8*)(sb + (size_t)(dvt * 16) * 256 + ks * 32);
#pragma unroll
        for (int it = 0; it < 4; ++it) acc[dvt][it] = mfma(a, bq[it], acc[dvt][it]);
      }
    }
#pragma unroll
    for (int it = 0; it < 4; ++it) {
      float qd = exp2f(l2g * (float)(it * 16 + fr + 1));
#pragma unroll
      for (int dvt = 0; dvt < 8; ++dvt) acc[dvt][it] = acc[dvt][it] * qd;
    }
  }
  {
    f32x4 s[4];
#pragma unroll
    for (int jt = 0; jt < 4; ++jt) s[jt] = f32x4{0.f, 0.f, 0.f, 0.f};
    const u16* kb = p.Kr + (size_t)(p0 + fr) * DM + h * 256 + fq * 8;
#pragma unroll 1
    for (int ks = 0; ks < 8; ++ks) {
      bf16x8 b = *(const bf16x8*)(qb + (size_t)(w * 16) * DM + ks * 32);
#pragma unroll
      for (int jt = 0; jt < 4; ++jt) {
        bf16x8 a = *(const bf16x8*)(kb + (size_t)(jt * 16) * DM + ks * 32);
        s[jt] = mfma(a, b, s[jt]);
      }
    }
    int i = w * 16 + fr;
#pragma unroll
    for (int jt = 0; jt < 4; ++jt)
#pragma unroll
      for (int jj = 0; jj < 4; ++jj) {
        int j = jt * 16 + fq * 4 + jj;
        int dd = i > j ? i - j : j - i;
        s[jt][jj] *= exp2f(l2g * (float)dd);
      }
    __syncthreads();
#pragma unroll
    for (int pp = 0; pp < 2; ++pp) {
      u32x4 t;
      t.x = pack2(s[2 * pp][0], s[2 * pp][1]); t.y = pack2(s[2 * pp][2], s[2 * pp][3]);
      t.z = pack2(s[2 * pp + 1][0], s[2 * pp + 1][1]); t.w = pack2(s[2 * pp + 1][2], s[2 * pp + 1][3]);
      Sf[(w * 2 + pp) * 64 + lane] = t;
    }
    __syncthreads();
  }
  {
    const u16* vb = p.VrT + (size_t)(h * 512 + w * 128 + fr) * TP2 + p0 + fq * 4;
#pragma unroll
    for (int pp = 0; pp < 2; ++pp) {
      V8 bs[4];
#pragma unroll
      for (int it = 0; it < 4; ++it) bs[it].q = Sf[(it * 2 + pp) * 64 + lane];
#pragma unroll
      for (int dvt = 0; dvt < 8; ++dvt) {
        V8 a;
        a.d[0] = *(const u32x2*)(vb + (size_t)(dvt * 16) * TP2 + (2 * pp) * 16);
        a.d[1] = *(const u32x2*)(vb + (size_t)(dvt * 16) * TP2 + (2 * pp + 1) * 16);
#pragma unroll
        for (int it = 0; it < 4; ++it) acc[dvt][it] = mfma(a.v, bs[it].v, acc[dvt][it]);
      }
    }
  }
  float mean[4], rstd[4];
  {
    float s1[4];
#pragma unroll
    for (int it = 0; it < 4; ++it) {
      float s = 0.f;
#pragma unroll
      for (int dvt = 0; dvt < 8; ++dvt) s += acc[dvt][it][0] + acc[dvt][it][1] + acc[dvt][it][2] + acc[dvt][it][3];
      s += __shfl_xor(s, 16); s += __shfl_xor(s, 32);
      s1[it] = s;
    }
    __syncthreads();
    if (fq == 0) {
#pragma unroll
      for (int it = 0; it < 4; ++it) red[w * 64 + it * 16 + fr] = s1[it];
    }
    __syncthreads();
#pragma unroll
    for (int it = 0; it < 4; ++it) {
      int i = it * 16 + fr;
      mean[it] = (red[i] + red[64 + i] + red[128 + i] + red[192 + i]) * (1.f / 512.f);
    }
#pragma unroll
    for (int it = 0; it < 4; ++it) {
      float s = 0.f;
#pragma unroll
      for (int dvt = 0; dvt < 8; ++dvt)
#pragma unroll
        for (int j = 0; j < 4; ++j) { float d = acc[dvt][it][j] - mean[it]; s += d * d; }
      s += __shfl_xor(s, 16); s += __shfl_xor(s, 32);
      s1[it] = s;
    }
    __syncthreads();
    if (fq == 0) {
#pragma unroll
      for (int it = 0; it < 4; ++it) red[w * 64 + it * 16 + fr] = s1[it];
    }
    __syncthreads();
#pragma unroll
    for (int it = 0; it < 4; ++it) {
      int i = it * 16 + fr;
      float var = (red[i] + red[64 + i] + red[128 + i] + red[192 + i]) * (1.f / 512.f);
      rstd[it] = rsqrtf(var + EPS);
    }
  }
#pragma unroll
  for (int it = 0; it < 4; ++it) {
    int t = p0 + it * 16 + fr - LEAD;
    if (t >= 0 && t < LP) {
#pragma unroll
      for (int dvt = 0; dvt < 8; ++dvt) {
        int e0 = h * 512 + w * 128 + dvt * 16 + fq * 4;
        u16* gp = p.Gr + (size_t)t * 2048 + e0;
        u32x2 g = *(const u32x2*)gp;
        f32x4 gn = *(const f32x4*)(p.ret_gn + jr * 2048 + e0);
        float g0 = bflo(g.x), g1 = bfhi(g.x), g2 = bflo(g.y), g3 = bfhi(g.y);
        float y0 = (acc[dvt][it][0] - mean[it]) * rstd[it] * gn.x * (g0 * sigmoidf_(g0));
        float y1 = (acc[dvt][it][1] - mean[it]) * rstd[it] * gn.y * (g1 * sigmoidf_(g1));
        float y2 = (acc[dvt][it][2] - mean[it]) * rstd[it] * gn.z * (g2 * sigmoidf_(g2));
        float y3 = (acc[dvt][it][3] - mean[it]) * rstd[it] * gn.w * (g3 * sigmoidf_(g3));
        u32x2 o; o.x = pack2(y0, y1); o.y = pack2(y2, y3);
        *(u32x2*)gp = o;
      }
    }
  }
}

DEV void r3_sample(const Params& p, int jr, int b, int h, char* smem) {
  float* obuf = (float*)smem;
  u16* qs = (u16*)(smem + 32768);
  u16* ks = qs + 16 * 256;
  float* sm = (float*)(smem + 49152);
  float* red = sm + 256;
  float* stat = red + 64;
  int tid = otid(), lane = tid & 63, wid = tid >> 6;
  float l2g = ret_l2g(h);
  int prow = LP + LEAD + b * 16;
  __syncthreads();
  for (int e = tid; e < 16 * 256; e += 256) {
    int i = e >> 8, d = e & 255;
    qs[e] = p.Qr[(size_t)(prow + i) * DM + h * 256 + d];
    ks[e] = p.Kr[(size_t)(prow + i) * DM + h * 256 + d];
  }
  __syncthreads();
  {
    int i = tid >> 4, j = tid & 15;
    float a = 0.f;
#pragma unroll 8
    for (int d = 0; d < 256; ++d) a += bf2f(qs[i * 256 + d]) * bf2f(ks[j * 256 + d]);
    int dd = i > j ? i - j : j - i;
    sm[tid] = a * exp2f(l2g * (float)dd);
  }
  __syncthreads();
  for (int e = tid; e < 16 * 256; e += 256) ks[e] = f2bf(bf2f(ks[e]) * exp2f(l2g * (float)(15 - (e >> 8))));
  __syncthreads();
  float dec16 = exp2f(l2g * 16.f);
  const float* stin = p.state_ret + ((size_t)(jr * 8 + b) * 4 + h) * 256 * 512;
  float* stout = p.out + O_SRS + ((size_t)(jr * 8 + b) * 4 + h) * 256 * 512;
#pragma unroll 1
  for (int c = 0; c < 2; ++c) {
    int e = tid + c * 256;
    float v[16], o[16];
    const u16* vp = p.VrT + (size_t)(h * 512 + e) * TP2 + prow;
    u32x4 a = *(const u32x4*)vp, bq = *(const u32x4*)(vp + 8);
    v[0] = bflo(a.x); v[1] = bfhi(a.x); v[2] = bflo(a.y); v[3] = bfhi(a.y);
    v[4] = bflo(a.z); v[5] = bfhi(a.z); v[6] = bflo(a.w); v[7] = bfhi(a.w);
    v[8] = bflo(bq.x); v[9] = bfhi(bq.x); v[10] = bflo(bq.y); v[11] = bfhi(bq.y);
    v[12] = bflo(bq.z); v[13] = bfhi(bq.z); v[14] = bflo(bq.w); v[15] = bfhi(bq.w);
#pragma unroll
    for (int i = 0; i < 16; ++i) o[i] = 0.f;
#pragma unroll 2
    for (int dp = 0; dp < 256; ++dp) {
      int dorig = perm_dorig(dp);
      float s0 = stin[(size_t)dorig * 512 + e];
      float n0 = s0 * dec16;
#pragma unroll
      for (int i = 0; i < 16; ++i) {
        o[i] += bf2f(qs[i * 256 + dp]) * s0;
        n0 += bf2f(ks[i * 256 + dp]) * v[i];
      }
      stout[(size_t)dorig * 512 + e] = n0;
    }
#pragma unroll
    for (int i = 0; i < 16; ++i) obuf[i * 512 + e] = o[i] * exp2f(l2g * (float)(i + 1));
#pragma unroll 1
    for (int i = 0; i < 16; ++i) {
      float a0 = obuf[i * 512 + e];
#pragma unroll
      for (int j = 0; j < 16; ++j) a0 += sm[i * 16 + j] * v[j];
      obuf[i * 512 + e] = a0;
    }
  }
  __syncthreads();
  for (int i = 0; i < 16; ++i) {
    float s = wave_sum(obuf[i * 512 + tid] + obuf[i * 512 + 256 + tid]);
    if (lane == 0) red[wid * 16 + i] = s;
  }
  __syncthreads();
  if (tid < 16) stat[tid] = (red[tid] + red[16 + tid] + red[32 + tid] + red[48 + tid]) * (1.f / 512.f);
  __syncthreads();
  for (int i = 0; i < 16; ++i) {
    float mu = stat[i];
    float d0 = obuf[i * 512 + tid] - mu, d1 = obuf[i * 512 + 256 + tid] - mu;
    float s = wave_sum(d0 * d0 + d1 * d1);
    if (lane == 0) red[wid * 16 + i] = s;
  }
  __syncthreads();
  if (tid < 16) stat[16 + tid] = rsqrtf((red[tid] + red[16 + tid] + red[32 + tid] + red[48 + tid]) * (1.f / 512.f) + EPS);
  __syncthreads();
  for (int c = 0; c < 2; ++c) {
    int e = tid + c * 256;
    float gn = p.ret_gn[jr * 2048 + h * 512 + e];
    for (int i = 0; i < 16; ++i) {
      int t = LP + b * 16 + i;
      float g = bf2f(p.Gr[(size_t)t * 2048 + h * 512 + e]);
      float y = (obuf[i * 512 + e] - stat[i]) * stat[16 + i] * gn * (g * sigmoidf_(g));
      p.Gr[(size_t)t * 2048 + h * 512 + e] = f2bf(y);
    }
  }
}

DEV void ph_r3(const Params& p, int jr, char* smem) {
  const int NP = NCH * 4, NI = NP + 32;
  for (int it = blockIdx.x; it < NI; it += gridDim.x) {
    if (it < 32) r3_sample(p, jr, it >> 2, it & 3, smem);
    else { int q = it - 32; r3_prompt(p, jr, q >> 2, q & 3, smem); }
  }
}

DEV void ph_p2(const Params& p, int layer, char* smem) {
  const u16* Wt = p.WpqT + (size_t)layer * 2048 * 1024;
  u16* Qs = (u16*)smem;
  constexpr int LQ = 136;
  int tid = otid(), lane = tid & 63, wid = tid >> 6;
  int wr = wid >> 1, wc = wid & 1, fr = lane & 15, fq = lane >> 4;
  for (int it = blockIdx.x; it < MTILES * 16; it += gridDim.x) {
    int mt = it / 16, hp = it % 16;
    int m0 = mt * 128;
    f32x4 acc[4][4];
    gemm_tile(p.H, DM, Wt, DM, DM, m0, hp * 128, smem, acc);
    __syncthreads();
#pragma unroll
    for (int m = 0; m < 4; ++m)
#pragma unroll
      for (int n = 0; n < 4; ++n)
#pragma unroll
        for (int j = 0; j < 4; ++j)
          Qs[(wr * 64 + m * 16 + fq * 4 + j) * LQ + wc * 64 + n * 16 + fr] = f2bf(acc[m][n][j]);
    __syncthreads();
    f32x4 sc[2][8];
#pragma unroll
    for (int rt = 0; rt < 2; ++rt)
#pragma unroll
      for (int ct = 0; ct < 8; ++ct) sc[rt][ct] = f32x4{0.f, 0.f, 0.f, 0.f};
    const u16* skb = p.SKb + ((size_t)(layer * 16 + hp) * 128 + fr) * 128 + fq * 8;
#pragma unroll
    for (int ks = 0; ks < 4; ++ks) {
      bf16x8 a[2];
#pragma unroll
      for (int rt = 0; rt < 2; ++rt) a[rt] = *(const bf16x8*)(Qs + (wid * 32 + rt * 16 + fr) * LQ + ks * 32 + fq * 8);
#pragma unroll
      for (int ct = 0; ct < 8; ++ct) {
        bf16x8 b = *(const bf16x8*)(skb + (size_t)(ct * 16) * 128 + ks * 32);
#pragma unroll
        for (int rt = 0; rt < 2; ++rt) sc[rt][ct] = mfma(a[rt], b, sc[rt][ct]);
      }
    }
#pragma unroll
    for (int rt = 0; rt < 2; ++rt)
#pragma unroll
      for (int j = 0; j < 4; ++j) {
        uint32_t key[8];
#pragma unroll
        for (int ct = 0; ct < 8; ++ct) key[ct] = (f2key(sc[rt][ct][j]) & ~127u) | (uint32_t)(127 - (ct * 16 + fr));
        uint32_t mine = 0;
#pragma unroll 1
        for (int r = 0; r < 16; ++r) {
          uint32_t best = key[0];
#pragma unroll
          for (int ct = 1; ct < 8; ++ct) best = max(best, key[ct]);
          best = row16_maxu(best);
#pragma unroll
          for (int ct = 0; ct < 8; ++ct) key[ct] = (key[ct] == best) ? 0u : key[ct];
          if (fr == r) mine = best;
        }
        int row = m0 + wid * 32 + rt * 16 + fq * 4 + j;
        p.SV[((size_t)row * 16 + hp) * 16 + fr] = key2f(mine & ~127u);
        p.SI[((size_t)row * 16 + hp) * 16 + fr] = 127 - (int)(mine & 127u);
      }
  }
}

DEV void ph_p3(const Params& p, int layer, char* smem) {
  int tid = otid(), lane = tid & 63, wid = tid >> 6;
  int* eidL = (int*)smem + wid * 256;
  float* gateL = (float*)(eidL + 128);
  int ca = 0, cb = 0; bool cvalid = false;
  {
    int cnt = 0;
    for (int a = 0; a < 16; ++a) {
      int nb = 16 / (a + 1);
      if (lane >= cnt && lane < cnt + nb) { ca = a; cb = lane - cnt; cvalid = true; }
      cnt += nb;
    }
  }
  int gw = (blockIdx.x * blockDim.x + tid) >> 6, nw = (gridDim.x * blockDim.x) >> 6;
  for (int t = gw; t < TTOK; t += nw) {
    const float* svp = p.SV + (size_t)t * 256;
    const int* sip = p.SI + (size_t)t * 256;
    for (int h = 0; h < 8; ++h) {
      float cand = cvalid ? (svp[h * 32 + ca] + svp[h * 32 + 16 + cb]) : 0.f;
      uint32_t key = cvalid ? ((f2key(cand) & ~63u) | (uint32_t)(63 - lane)) : 0u;
      uint32_t mine = 0;
#pragma unroll 1
      for (int r = 0; r < 16; ++r) {
        uint32_t best = wave_maxu(key);
        key = (key == best) ? 0u : key;
        if (lane == r) mine = best;
      }
      int src = 63 - (int)(mine & 63u);
      int wa = __shfl(ca, src), wb = __shfl(cb, src);
      float fv = key2f(mine & ~63u);
      float f0 = rdlane(fv, 0);
      float e = (lane < 16) ? __expf(fv - f0) : 0.f;
      float ssum = row16_sum(e);
      if (lane < 16) {
        int eid = sip[h * 32 + wa] * 128 + sip[h * 32 + 16 + wb];
        eidL[h * 16 + lane] = eid;
        gateL[h * 16 + lane] = e / ssum;
      }
    }
    float hf[16];
    {
      u32x4 ha = *(const u32x4*)(p.H + (size_t)t * DM + lane * 16);
      u32x4 hb = *(const u32x4*)(p.H + (size_t)t * DM + lane * 16 + 8);
      hf[0] = bflo(ha.x); hf[1] = bfhi(ha.x); hf[2] = bflo(ha.y); hf[3] = bfhi(ha.y);
      hf[4] = bflo(ha.z); hf[5] = bfhi(ha.z); hf[6] = bflo(ha.w); hf[7] = bfhi(ha.w);
      hf[8] = bflo(hb.x); hf[9] = bfhi(hb.x); hf[10] = bflo(hb.y); hf[11] = bfhi(hb.y);
      hf[12] = bflo(hb.z); hf[13] = bfhi(hb.z); hf[14] = bflo(hb.w); hf[15] = bfhi(hb.w);
    }
    const unsigned char* U8 = (const unsigned char*)p.Ub + lane * 16;
    const unsigned char* V8p = (const unsigned char*)p.Vb + lane * 16;
#define P3_LOAD(buf, tab, base) _Pragma("unroll") for (int u = 0; u < 8; ++u) { \
      int eid_ = __builtin_amdgcn_readfirstlane(eidL[(base) + u]); \
      buf[u] = *(const u32x4*)((tab) + (size_t)eid_ * DM); }
#define P3_CVT(f, q) { v2f_t c_; \
      c_ = __builtin_amdgcn_cvt_pk_f32_fp8((int)(q).x, false); f[0] = c_.x; f[1] = c_.y; \
      c_ = __builtin_amdgcn_cvt_pk_f32_fp8((int)(q).x, true);  f[2] = c_.x; f[3] = c_.y; \
      c_ = __builtin_amdgcn_cvt_pk_f32_fp8((int)(q).y, false); f[4] = c_.x; f[5] = c_.y; \
      c_ = __builtin_amdgcn_cvt_pk_f32_fp8((int)(q).y, true);  f[6] = c_.x; f[7] = c_.y; \
      c_ = __builtin_amdgcn_cvt_pk_f32_fp8((int)(q).z, false); f[8] = c_.x; f[9] = c_.y; \
      c_ = __builtin_amdgcn_cvt_pk_f32_fp8((int)(q).z, true);  f[10] = c_.x; f[11] = c_.y; \
      c_ = __builtin_amdgcn_cvt_pk_f32_fp8((int)(q).w, false); f[12] = c_.x; f[13] = c_.y; \
      c_ = __builtin_amdgcn_cvt_pk_f32_fp8((int)(q).w, true);  f[14] = c_.x; f[15] = c_.y; }
#define P3_DOT(buf, base) _Pragma("unroll") for (int u = 0; u < 8; ++u) { \
      float f_[16]; P3_CVT(f_, buf[u]); float d_ = 0.f; \
      _Pragma("unroll") for (int i = 0; i < 16; ++i) d_ += hf[i] * f_[i]; \
      d_ = wave_sum(d_) * (1.f / U_SCALE); \
      int k_ = (base) + u; \
      if (lane == (k_ & 63)) { if (k_ < 64) w0 = d_; else w1 = d_; } }
#define P3_AXPY(buf, base) { float ws_ = ((base) < 64) ? w0 : w1; \
      _Pragma("unroll") for (int u = 0; u < 8; ++u) { \
        float f_[16]; P3_CVT(f_, buf[u]); float wk_ = rdlane(ws_, ((base) + u) & 63); \
        _Pragma("unroll") for (int i = 0; i < 16; ++i) oacc[i] += wk_ * f_[i]; } }
    float w0 = 0.f, w1 = 0.f;
    {
      u32x4 A[8], B[8];
      P3_LOAD(A, U8, 0)
#pragma unroll 1
      for (int kb = 0; kb < 128; kb += 16) {
        P3_LOAD(B, U8, kb + 8)
        P3_DOT(A, kb)
        if (kb + 16 < 128) { P3_LOAD(A, U8, kb + 16) }
        P3_DOT(B, kb + 8)
      }
    }
    w0 = gateL[lane] * gelu_(w0);
    w1 = gateL[64 + lane] * gelu_(w1);
    float oacc[16];
#pragma unroll
    for (int i = 0; i < 16; ++i) oacc[i] = 0.f;
    {
      u32x4 A[8], B[8];
      P3_LOAD(A, V8p, 0)
#pragma unroll 1
      for (int kb = 0; kb < 128; kb += 16) {
        P3_LOAD(B, V8p, kb + 8)
        P3_AXPY(A, kb)
        if (kb + 16 < 128) { P3_LOAD(A, V8p, kb + 16) }
        P3_AXPY(B, kb + 8)
      }
    }
    float* xr = p.X + (size_t)t * DM + lane * 16;
    f32x4 xv[4];
#pragma unroll
    for (int c = 0; c < 4; ++c) {
      xv[c] = *(const f32x4*)(xr + c * 4);
      xv[c].x += oacc[c * 4 + 0] * (1.f / V_SCALE); xv[c].y += oacc[c * 4 + 1] * (1.f / V_SCALE);
      xv[c].z += oacc[c * 4 + 2] * (1.f / V_SCALE); xv[c].w += oacc[c * 4 + 3] * (1.f / V_SCALE);
    }
    if (layer < 3) {
      float ss = 0.f;
#pragma unroll
      for (int c = 0; c < 4; ++c) {
        *(f32x4*)(xr + c * 4) = xv[c];
        ss += xv[c].x * xv[c].x + xv[c].y * xv[c].y + xv[c].z * xv[c].z + xv[c].w * xv[c].w;
      }
      ss = wave_sum(ss);
      float rstd = rsqrtf(ss * (1.f / DM) + EPS);
      const float* g = p.norm_mix + (size_t)(layer + 1) * DM + lane * 16;
      u32x4 o0, o1;
      f32x4 g0 = *(const f32x4*)(g), g1 = *(const f32x4*)(g + 4), g2 = *(const f32x4*)(g + 8), g3 = *(const f32x4*)(g + 12);
      o0.x = pack2(xv[0].x * rstd * g0.x, xv[0].y * rstd * g0.y); o0.y = pack2(xv[0].z * rstd * g0.z, xv[0].w * rstd * g0.w);
      o0.z = pack2(xv[1].x * rstd * g1.x, xv[1].y * rstd * g1.y); o0.w = pack2(xv[1].z * rstd * g1.z, xv[1].w * rstd * g1.w);
      o1.x = pack2(xv[2].x * rstd * g2.x, xv[2].y * rstd * g2.y); o1.y = pack2(xv[2].z * rstd * g2.z, xv[2].w * rstd * g2.w);
      o1.z = pack2(xv[3].x * rstd * g3.x, xv[3].y * rstd * g3.y); o1.w = pack2(xv[3].z * rstd * g3.z, xv[3].w * rstd * g3.w);
      *(u32x4*)(p.H + (size_t)t * DM + lane * 16) = o0;
      *(u32x4*)(p.H + (size_t)t * DM + lane * 16 + 8) = o1;
    } else {
      float* yo = nullptr;
      if (t >= NMETA && t < LP) yo = p.out + O_YP + (size_t)(t - NMETA) * DM + lane * 16;
      else if (t >= LP) yo = p.out + O_YS + (size_t)(t - LP) * DM + lane * 16;
      if (yo) {
#pragma unroll
        for (int c = 0; c < 4; ++c) *(f32x4*)(yo + c * 4) = xv[c];
      }
    }
  }
}

constexpr int NPHASE = 27;
#ifndef DBG_PHASES
#define DBG_PHASES NPHASE
#endif
#ifndef DBG_SCALES
#define DBG_SCALES {1,1,1,1,1,1,1,1,1,1,1,1,1,1,1,1,1,1,1,1}
#endif
#ifndef DBG_POST
#define DBG_POST 0
#endif
DEV void post_scale(const Params& p) {
  const float sc[20] = DBG_SCALES;
  const size_t offs[11] = {O_YP, O_YS, O_FKP, O_FVP, O_FLP, O_SRP, O_FKS, O_FVS, O_FLS, O_SRS, O_SRS + (size_t)2 * 8 * 4 * 256 * 512};
  size_t i0 = (size_t)blockIdx.x * blockDim.x + otid(), st = (size_t)gridDim.x * blockDim.x;
#pragma unroll
  for (int k = 0; k < 20; ++k) {
    float f = sc[k];
    if (f == 1.f) continue;
    size_t a = offs[k >> 1], b = offs[(k >> 1) + 1], mid = a + (b - a) / 2;
    size_t lo = (k & 1) ? mid : a, hi = (k & 1) ? b : mid;
    for (size_t i = lo + i0; i < hi; i += st) p.out[i] *= f;
  }
}
DEV void dump_x(const Params& p) {
  size_t i = (size_t)blockIdx.x * blockDim.x + otid(), st = (size_t)gridDim.x * blockDim.x;
  for (; i < (size_t)(TTOK - NMETA) * DM; i += st) p.out[i] = p.X[(size_t)NMETA * DM + i];
}
__global__ void __launch_bounds__(256, 2) mega(Params p, int ph0, int ph1) {
  __shared__ __attribute__((aligned(16))) char smem[53248];
#ifndef DUP_FOX
#define DUP_FOX 0
#endif
#ifndef DUP_RET
#define DUP_RET 0
#endif
  for (int ph2 = ph0 * 2; ph2 < ph1 * 2; ++ph2) {
    int ph = ph2 >> 1;
    if (ph2 & 1) {
      bool dup = false;
      if (ph >= 1 && ph < NPHASE) {
        int q = ph - 1, layer, idx;
        if (q < 6) { layer = 0; idx = q; } else if (q < 13) { layer = 1; idx = q - 6; }
        else if (q < 19) { layer = 2; idx = q - 13; } else { layer = 3; idx = q - 19; }
        dup = ((layer & 1) == 0) ? ((DUP_FOX >> idx) & 1) : ((DUP_RET >> idx) & 1);
      }
      if (!dup) continue;
    }
    if (ph2 > ph0 * 2) cg::this_grid().sync();
    if (ph == 0) { ph_prep(p, smem); continue; }
    if (ph == 100) { dump_x(p); continue; }
    if (ph == 101) { post_scale(p); continue; }
    int q = ph - 1, layer, idx;
    if (q < 6) { layer = 0; idx = q; } else if (q < 13) { layer = 1; idx = q - 6; }
    else if (q < 19) { layer = 2; idx = q - 13; } else { layer = 3; idx = q - 19; }
    int j = layer >> 1;
    bool fox = (layer & 1) == 0;
    if (fox) {
      if (idx == 0) ph_f1(p, j, smem);
      else if (idx == 1) ph_f2(p, j, smem);
      else if (idx == 2) ph_outproj(p, p.AO, 1024, p.WfoutT + (size_t)j * 1024 * 1024, smem);
      else if (idx == 3) { norm_rows(p, p.norm_ffn + (size_t)layer * DM, false); conv_tables(p, layer); }
      else if (idx == 4) ph_p2(p, layer, smem);
      else ph_p3(p, layer, smem);
    } else {
      if (idx == 0) ph_r1(p, j, smem);
      else if (idx == 1) ph_r2(p, j);
      else if (idx == 2) ph_r3(p, j, smem);
      else if (idx == 3) ph_outproj(p, p.Gr, 2048, p.WroutT + (size_t)j * 1024 * 2048, smem);
      else if (idx == 4) { norm_rows(p, p.norm_ffn + (size_t)layer * DM, false); conv_tables(p, layer); }
      else if (idx == 5) ph_p2(p, layer, smem);
      else ph_p3(p, layer, smem);
    }
  }
}

extern "C" void kernel_launch(void* const* d_in, const int* in_sizes, int n_in, void* d_out, int out_size,
                              void* d_ws, size_t ws_size, hipStream_t stream) {
  static int grid_blocks = 0;
  if (!grid_blocks) {
    int dev = 0, cus = 0, per_cu = 0;
    hipGetDevice(&dev);
    hipDeviceGetAttribute(&cus, hipDeviceAttributeMultiprocessorCount, dev);
    hipOccupancyMaxActiveBlocksPerMultiprocessor(&per_cu, mega, 256, 0);
    if (per_cu > 2) per_cu = 2;
    if (per_cu < 1) per_cu = 1;
    grid_blocks = cus * per_cu;
  }
  Params p;
  memset(&p, 0, sizeof(p));
  const float* const* in = (const float* const*)d_in;
  p.x_prompt = in[0]; p.x_sample = in[1]; p.cache_k = in[2]; p.cache_v = in[3]; p.cache_lf = in[4]; p.state_ret = in[5];
  p.meta = in[6]; p.norm_mix = in[7]; p.norm_ffn = in[8]; p.fox_w_in = in[9]; p.fox_b_f = in[10]; p.fox_qn = in[11];
  p.fox_kn = in[12]; p.fox_w_out = in[13]; p.ret_w_in = in[14]; p.ret_gn = in[15]; p.ret_w_out = in[16];
  p.peer_wq = in[17]; p.peer_sk = in[18]; p.peer_u = in[19]; p.peer_v = in[20];
  p.out = (float*)d_out;
  char* w = (char*)d_ws;
  size_t off = 0;
  auto take = [&](size_t bytes) { char* r = w + off; off += (bytes + 255) & ~(size_t)255; return r; };
  p.X = (float*)take((size_t)TPAD * DM * 4);
  p.H = (u16*)take((size_t)TPAD * DM * 2);
  p.WfinT = (u16*)take((size_t)2 * 4224 * 1024 * 2);
  p.WfoutT = (u16*)take((size_t)2 * 1024 * 1024 * 2);
  p.WrinT = (u16*)take((size_t)2 * 6144 * 1024 * 2);
  p.WroutT = (u16*)take((size_t)2 * 1024 * 2048 * 2);
  p.WpqT = (u16*)take((size_t)4 * 2048 * 1024 * 2);
  p.SKb = (u16*)take((size_t)4 * 8 * 2 * 128 * 128 * 2);
  p.Ub = (u16*)take((size_t)NEXP * DM * 2);
  p.Vb = (u16*)take((size_t)NEXP * DM * 2);
  p.SV = (float*)take((size_t)TPAD * 256 * 4);
  p.SI = (int*)take((size_t)TPAD * 256 * 4);
  p.LFC = (float*)take((size_t)TPAD * 16 * 4);
  p.LFR = (float*)take((size_t)TPAD * 16 * 4);
  p.TT = (float*)take((size_t)MTILES * 16 * 4);
  size_t region = off;
  p.Qf = (u16*)take((size_t)TPAD * DM * 2);
  p.Kf = (u16*)take((size_t)TPAD * DM * 2);
  p.VtF = (u16*)take((size_t)1024 * TPAD * 2);
  p.OGf = (u16*)take((size_t)TPAD * DM * 2);
  p.AO = (u16*)take((size_t)TPAD * DM * 2);
  off = region;
  p.Qr = (u16*)take((size_t)TP2 * DM * 2);
  p.Kr = (u16*)take((size_t)TP2 * DM * 2);
  p.KrT = (u16*)take((size_t)1024 * TP2 * 2);
  p.VrT = (u16*)take((size_t)2048 * TP2 * 2);
  p.Gr = (u16*)take((size_t)TPAD * 2048 * 2);
  p.ST = (u16*)take((size_t)NCH * 4 * 512 * 256 * 2);
  if (off > ws_size) { fprintf(stderr, "workspace too small: need %zu have %zu\n", off, ws_size); return; }
  for (int i = 0; i < 128; ++i) p.rope_rev[i] = (float)(pow(10000.0, -(double)i / 128.0) / (2.0 * M_PI));
#if ONE_LAUNCH
  int ph0 = 0, ph1 = NPHASE;
  void* args[] = {&p, &ph0, &ph1};
  hipError_t e = hipLaunchCooperativeKernel((void*)mega, dim3(grid_blocks), dim3(256), args, 0, stream);
  if (e != hipSuccess) fprintf(stderr, "cooperative launch failed: %s (grid %d)\n", hipGetErrorString(e), grid_blocks);
#else
  for (int ph = 0; ph < DBG_PHASES; ++ph) mega<<<grid_blocks, 256, 0, stream>>>(p, ph, ph + 1);
  if (DBG_PHASES < NPHASE) mega<<<grid_blocks, 256, 0, stream>>>(p, 100, 101);
  if (DBG_POST) mega<<<grid_blocks, 256, 0, stream>>>(p, 101, 102);
#endif
}
```

```cpp
#include <hip/hip_runtime.h>
#include <hip/hip_cooperative_groups.h>
#include <stdint.h>
#include <math.h>
#include <stdio.h>
#include <string.h>
namespace cg = cooperative_groups;

typedef unsigned short u16;
typedef __attribute__((ext_vector_type(8))) short bf16x8;
typedef __attribute__((ext_vector_type(4))) float f32x4;
typedef __attribute__((ext_vector_type(2))) float f32x2;
typedef __attribute__((ext_vector_type(4))) unsigned int u32x4;
typedef __attribute__((ext_vector_type(2))) unsigned int u32x2;
#define DEV __device__ __forceinline__

#ifndef ONE_LAUNCH
#define ONE_LAUNCH 1
#endif

constexpr int DM = 1024;
constexpr int NMETA = 16;
constexpr int LP = 16400;
constexpr int NSMP = 128;
constexpr int TTOK = LP + NSMP;
constexpr int TPAD = 16640;
constexpr int MTILES = 130;
constexpr int LEAD = 48;
constexpr int TP2 = 16704;
constexpr int NCH = 257;
constexpr int PAST = 1024;
constexpr int NEXP = 16384;
constexpr float EPS = 1e-6f;

constexpr size_t O_YP = 0;
constexpr size_t O_YS = O_YP + (size_t)16384 * 1024;
constexpr size_t O_FKP = O_YS + (size_t)128 * 1024;
constexpr size_t O_FVP = O_FKP + (size_t)2 * LP * 1024;
constexpr size_t O_FLP = O_FVP + (size_t)2 * LP * 1024;
constexpr size_t O_SRP = O_FLP + (size_t)2 * LP * 16;
constexpr size_t O_FKS = O_SRP + (size_t)2 * 4 * 256 * 512;
constexpr size_t O_FVS = O_FKS + (size_t)2 * 128 * 1024;
constexpr size_t O_FLS = O_FVS + (size_t)2 * 128 * 1024;
constexpr size_t O_SRS = O_FLS + (size_t)2 * 128 * 16;

struct Params {
  const float *x_prompt, *x_sample, *cache_k, *cache_v, *cache_lf, *state_ret, *meta, *norm_mix, *norm_ffn;
  const float *fox_w_in, *fox_b_f, *fox_qn, *fox_kn, *fox_w_out, *ret_w_in, *ret_gn, *ret_w_out;
  const float *peer_wq, *peer_sk, *peer_u, *peer_v;
  float* out;
  float* X; u16* H;
  u16 *WfinT, *WfoutT, *WrinT, *WroutT, *WpqT, *SKb, *Ub, *Vb;
  float *SV; int* SI;
  float *LFC, *LFR, *TT;
  u16 *Qf, *Kf, *VtF, *OGf, *AO;
  u16 *Qr, *Kr, *KrT, *VrT, *Gr, *ST;
  float rope_rev[128];
};

DEV u16 f2bf(float f) {
  uint32_t u = __float_as_uint(f);
  u += 0x7fffu + ((u >> 16) & 1u);
  return (u16)(u >> 16);
}
DEV float bf2f(u16 h) { return __uint_as_float(((uint32_t)h) << 16); }
DEV uint32_t pack2(float a, float b) { return (uint32_t)f2bf(a) | ((uint32_t)f2bf(b) << 16); }
DEV float bflo(uint32_t u) { return __uint_as_float(u << 16); }
DEV float bfhi(uint32_t u) { return __uint_as_float(u & 0xffff0000u); }

union V8 { bf16x8 v; uint32_t u[4]; u32x2 d[2]; u32x4 q; };

DEV f32x4 mfma(bf16x8 a, bf16x8 b, f32x4 c) { return __builtin_amdgcn_mfma_f32_16x16x32_bf16(a, b, c, 0, 0, 0); }

template <int CTRL> DEV float dppf(float v) {
  return __int_as_float(__builtin_amdgcn_update_dpp(0, __float_as_int(v), CTRL, 0xf, 0xf, false));
}
template <int CTRL> DEV uint32_t dppu(uint32_t v) {
  return (uint32_t)__builtin_amdgcn_update_dpp(0, (int)v, CTRL, 0xf, 0xf, false);
}
DEV float row16_sum(float v) {
  v += dppf<0xB1>(v); v += dppf<0x4E>(v); v += dppf<0x141>(v); v += dppf<0x140>(v);
  return v;
}
DEV uint32_t row16_maxu(uint32_t v) {
  v = max(v, dppu<0xB1>(v)); v = max(v, dppu<0x4E>(v)); v = max(v, dppu<0x141>(v)); v = max(v, dppu<0x140>(v));
  return v;
}
DEV float rdlane(float v, int l) { float r = __int_as_float(__builtin_amdgcn_readlane(__float_as_int(v), l)); asm volatile("" : "+v"(r)); return r; }
DEV float wave_sum(float v) {
  v = row16_sum(v);
  return rdlane(v, 0) + rdlane(v, 16) + rdlane(v, 32) + rdlane(v, 48);
}
DEV float wave_max(float v) {
  v = fmaxf(v, dppf<0xB1>(v)); v = fmaxf(v, dppf<0x4E>(v)); v = fmaxf(v, dppf<0x141>(v)); v = fmaxf(v, dppf<0x140>(v));
  return fmaxf(fmaxf(rdlane(v, 0), rdlane(v, 16)), fmaxf(rdlane(v, 32), rdlane(v, 48)));
}
DEV uint32_t wave_maxu(uint32_t v) {
  v = row16_maxu(v);
  uint32_t a = (uint32_t)__builtin_amdgcn_readlane((int)v, 0), b = (uint32_t)__builtin_amdgcn_readlane((int)v, 16);
  uint32_t c = (uint32_t)__builtin_amdgcn_readlane((int)v, 32), d = (uint32_t)__builtin_amdgcn_readlane((int)v, 48);
  return max(max(a, b), max(c, d));
}
DEV uint32_t f2key(float f) { uint32_t u = __float_as_uint(f); return (u & 0x80000000u) ? ~u : (u | 0x80000000u); }
DEV float key2f(uint32_t k) { uint32_t u = (k & 0x80000000u) ? (k & 0x7fffffffu) : ~k; return __uint_as_float(u); }

DEV float sigmoidf_(float x) { return 1.f / (1.f + __expf(-x)); }
DEV float logsigmoid_(float x) { return fminf(x, 0.f) - log1pf(expf(-fabsf(x))); }
DEV float gelu_(float x) { return 0.5f * x * (1.f + erff(x * 0.70710678118654752f)); }
DEV float ret_l2g(int h) { return log2f(1.f - exp2f(-5.f - (float)h)); }
DEV int otid() { int t = threadIdx.x; asm volatile("" : "+v"(t)); return t; }
DEV size_t tix(int rows, int h, int row, int pp) { return ((size_t)(h * 261 + (pp >> 6)) * rows + row) * 64 + (pp & 63); }
DEV int perm_dorig(int dp) { return ((dp >> 4) & 1) * 128 + (dp >> 5) * 16 + (dp & 15); }

DEV void norm_rows(const Params& p, const float* gain, bool from_input) {
  int tid_ = otid();
  int lane = tid_ & 63;
  int gw = (blockIdx.x * blockDim.x + tid_) >> 6, nw = (gridDim.x * blockDim.x) >> 6;
  for (int t = gw; t < TPAD; t += nw) {
    const float* src;
    if (from_input) {
      if (t < NMETA) src = p.meta + (size_t)t * DM;
      else if (t < LP) src = p.x_prompt + (size_t)(t - NMETA) * DM;
      else if (t < TTOK) src = p.x_sample + (size_t)(t - LP) * DM;
      else src = nullptr;
    } else src = p.X + (size_t)t * DM;
    f32x4 v[4];
    float ss = 0.f;
#pragma unroll
    for (int c = 0; c < 4; ++c) {
      if (src) v[c] = *(const f32x4*)(src + c * 256 + lane * 4); else v[c] = f32x4{0.f, 0.f, 0.f, 0.f};
      ss += v[c].x * v[c].x + v[c].y * v[c].y + v[c].z * v[c].z + v[c].w * v[c].w;
    }
    ss = wave_sum(ss);
    float rstd = rsqrtf(ss * (1.f / DM) + EPS);
#pragma unroll
    for (int c = 0; c < 4; ++c) {
      if (from_input) *(f32x4*)(p.X + (size_t)t * DM + c * 256 + lane * 4) = v[c];
      f32x4 g = *(const f32x4*)(gain + c * 256 + lane * 4);
      u32x2 o;
      o.x = pack2(v[c].x * rstd * g.x, v[c].y * rstd * g.y);
      o.y = pack2(v[c].z * rstd * g.z, v[c].w * rstd * g.w);
      *(u32x2*)(p.H + (size_t)t * DM + c * 256 + lane * 4) = o;
    }
  }
}

DEV void convert_bf16(const float* src, u16* dst, size_t n4) {
  size_t i = (size_t)blockIdx.x * blockDim.x + otid(), st = (size_t)gridDim.x * blockDim.x;
  for (; i < n4; i += st) {
    f32x4 v = ((const f32x4*)src)[i];
    u32x2 o; o.x = pack2(v.x, v.y); o.y = pack2(v.z, v.w);
    ((u32x2*)dst)[i] = o;
  }
}

DEV void xpose(const float* W, int K, int N, int Npad, u16* Wt, bool permq, char* smem) {
  u16* tile = (u16*)smem;
  int tid = otid();
  int ntn = Npad / 64, ntk = K / 64;
  for (int it = blockIdx.x; it < ntn * ntk; it += gridDim.x) {
    int n0 = (it / ntk) * 64, k0 = (it % ntk) * 64;
    int c = tid & 63, r0 = tid >> 6;
    int np = n0 + c;
    int src = np;
    if (permq && np < 2048) src = (np & ~255) + perm_dorig(np & 255);
    __syncthreads();
#pragma unroll
    for (int i = 0; i < 16; ++i) {
      int k = r0 + 4 * i;
      float v = (np < N) ? W[(size_t)(k0 + k) * N + src] : 0.f;
      tile[c * 72 + k] = f2bf(v);
    }
    __syncthreads();
    int nl = tid >> 2, kq = (tid & 3) * 16;
    u32x4 a = *(const u32x4*)(tile + nl * 72 + kq);
    u32x4 b = *(const u32x4*)(tile + nl * 72 + kq + 8);
    *(u32x4*)(Wt + (size_t)(n0 + nl) * K + k0 + kq) = a;
    *(u32x4*)(Wt + (size_t)(n0 + nl) * K + k0 + kq + 8) = b;
  }
}

typedef __attribute__((ext_vector_type(2))) float v2f_t;
constexpr float U_SCALE = 64.f, V_SCALE = 16.f;
DEV void convert_fp8(const float* src, uint32_t* dst, size_t n4, float scale) {
  size_t i = (size_t)blockIdx.x * blockDim.x + otid(), st = (size_t)gridDim.x * blockDim.x;
  for (; i < n4; i += st) {
    f32x4 v = ((const f32x4*)src)[i];
    int w = __builtin_amdgcn_cvt_pk_fp8_f32(v.x * scale, v.y * scale, 0, false);
    w = __builtin_amdgcn_cvt_pk_fp8_f32(v.z * scale, v.w * scale, w, true);
    dst[i] = (uint32_t)w;
  }
}
DEV void conv_tables(const Params& p, int layer) {
  convert_fp8(p.peer_u + (size_t)layer * NEXP * DM, (uint32_t*)p.Ub, (size_t)NEXP * DM / 4, U_SCALE);
  convert_fp8(p.peer_v + (size_t)layer * NEXP * DM, (uint32_t*)p.Vb, (size_t)NEXP * DM / 4, V_SCALE);
}

DEV void ph_prep(const Params& p, char* smem) {
  norm_rows(p, p.norm_mix, true);
  convert_bf16(p.peer_sk, p.SKb, (size_t)4 * 8 * 2 * 128 * 128 / 4);
  for (int j = 0; j < 2; ++j) {
    xpose(p.fox_w_in + (size_t)j * 1024 * 4112, 1024, 4112, 4224, p.WfinT + (size_t)j * 4224 * 1024, false, smem);
    xpose(p.fox_w_out + (size_t)j * 1024 * 1024, 1024, 1024, 1024, p.WfoutT + (size_t)j * 1024 * 1024, false, smem);
    xpose(p.ret_w_in + (size_t)j * 1024 * 6144, 1024, 6144, 6144, p.WrinT + (size_t)j * 6144 * 1024, true, smem);
    xpose(p.ret_w_out + (size_t)j * 2048 * 1024, 2048, 1024, 1024, p.WroutT + (size_t)j * 1024 * 2048, false, smem);
  }
  for (int l = 0; l < 4; ++l)
    xpose(p.peer_wq + (size_t)l * 1024 * 2048, 1024, 2048, 2048, p.WpqT + (size_t)l * 2048 * 1024, false, smem);
}

DEV void tile_mn(int it, int NT, int& mt, int& nt) {
  const int GM = 8;
  int g = it / (GM * NT), r = it - g * (GM * NT);
  int gm = min(GM, MTILES - g * GM);
  nt = r / gm; mt = g * GM + (r - nt * gm);
}

constexpr int LDK = 72;
template <bool SWAP>
DEV void gemm_tile(const u16* __restrict__ A, int lda, const u16* __restrict__ Bt, int ldb, int K,
                          int m0, int n0, char* smem, f32x4 (&acc)[4][4]) {
  u16* sA = (u16*)smem;
  u16* sB = sA + 128 * LDK;
  int tid = otid(), lane = tid & 63, wid = tid >> 6;
  int wr = wid >> 1, wc = wid & 1, fr = lane & 15, fq = lane >> 4;
#pragma unroll
  for (int m = 0; m < 4; ++m)
#pragma unroll
    for (int n = 0; n < 4; ++n) acc[m][n] = f32x4{0.f, 0.f, 0.f, 0.f};
  u32x4 ra[4], rb[4];
  const u16* Ap = A + (size_t)(m0 + (tid >> 3)) * lda + (tid & 7) * 8;
  const u16* Bp = Bt + (size_t)(n0 + (tid >> 3)) * ldb + (tid & 7) * 8;
#pragma unroll
  for (int i = 0; i < 4; ++i) {
    ra[i] = *(const u32x4*)(Ap + (size_t)(32 * i) * lda);
    rb[i] = *(const u32x4*)(Bp + (size_t)(32 * i) * ldb);
  }
  for (int k0 = 0; k0 < K; k0 += 64) {
    __syncthreads();
#pragma unroll
    for (int i = 0; i < 4; ++i) {
      *(u32x4*)(sA + ((tid >> 3) + 32 * i) * LDK + (tid & 7) * 8) = ra[i];
      *(u32x4*)(sB + ((tid >> 3) + 32 * i) * LDK + (tid & 7) * 8) = rb[i];
    }
    __syncthreads();
    if (k0 + 64 < K) {
#pragma unroll
      for (int i = 0; i < 4; ++i) {
        ra[i] = *(const u32x4*)(Ap + (size_t)(32 * i) * lda + k0 + 64);
        rb[i] = *(const u32x4*)(Bp + (size_t)(32 * i) * ldb + k0 + 64);
      }
    }
#pragma unroll
    for (int ks = 0; ks < 2; ++ks) {
      bf16x8 af[4], bfv[4];
#pragma unroll
      for (int m = 0; m < 4; ++m) af[m] = *(const bf16x8*)(sA + (wr * 64 + m * 16 + fr) * LDK + ks * 32 + fq * 8);
#pragma unroll
      for (int n = 0; n < 4; ++n) bfv[n] = *(const bf16x8*)(sB + (wc * 64 + n * 16 + fr) * LDK + ks * 32 + fq * 8);
#pragma unroll
      for (int m = 0; m < 4; ++m)
#pragma unroll
        for (int n = 0; n < 4; ++n) acc[m][n] = SWAP ? mfma(bfv[n], af[m], acc[m][n]) : mfma(af[m], bfv[n], acc[m][n]);
    }
  }
}

DEV void ph_f1(const Params& p, int jf, char* smem) {
  const u16* Wt = p.WfinT + (size_t)jf * 4224 * 1024;
  int tid = otid(), lane = tid & 63, wid = tid >> 6;
  int wr = wid >> 1, wc = wid & 1, fr = lane & 15, fq = lane >> 4;
  const int NT = 33;
  for (int it = blockIdx.x; it < MTILES * NT; it += gridDim.x) {
    int mt, nt; tile_mn(it, NT, mt, nt);
    int m0 = mt * 128;
    f32x4 acc[4][4];
    int type = nt >> 3;
    if (type == 2 || type == 4) gemm_tile<false>(p.H, DM, Wt, DM, DM, m0, nt * 128, smem, acc);
    else gemm_tile<true>(p.H, DM, Wt, DM, DM, m0, nt * 128, smem, acc);
    if (type <= 1) {
      int hh = (nt & 7) * 2 + wc;
      const float* gn = (type == 0 ? p.fox_qn : p.fox_kn) + jf * 64;
      const float gs = (type == 0) ? 0.125f * 1.44269504089f : 1.f;
      f32x4 g[4];
#pragma unroll
      for (int n = 0; n < 4; ++n) g[n] = *(const f32x4*)(gn + n * 16 + fq * 4) * gs;
#pragma unroll
      for (int m = 0; m < 4; ++m) {
        float ss = 0.f;
#pragma unroll
        for (int n = 0; n < 4; ++n)
#pragma unroll
          for (int j = 0; j < 4; ++j) ss += acc[m][n][j] * acc[m][n][j];
        ss += __shfl_xor(ss, 16); ss += __shfl_xor(ss, 32);
        float rstd = rsqrtf(ss * (1.f / 64.f) + EPS);
        int row = m0 + wr * 64 + m * 16 + fr;
#pragma unroll
        for (int n = 0; n < 4; ++n) {
          f32x4 v = acc[m][n] * rstd * g[n];
          int col = hh * 64 + n * 16 + fq * 4;
          u32x2 o; o.x = pack2(v.x, v.y); o.y = pack2(v.z, v.w);
          if (type == 0) *(u32x2*)(p.Qf + (size_t)row * DM + col) = o;
          else {
            *(u32x2*)(p.Kf + (size_t)row * DM + col) = o;
            if (row < LP) *(f32x4*)(p.out + O_FKP + ((size_t)jf * LP + row) * 1024 + col) = v;
            else if (row < TTOK) *(f32x4*)(p.out + O_FKS + ((size_t)jf * 128 + (row - LP)) * 1024 + col) = v;
          }
        }
      }
    } else if (type == 2) {
      int hh = (nt & 7) * 2 + wc;
#pragma unroll
      for (int m = 0; m < 4; ++m) {
        int rb = m0 + wr * 64 + m * 16 + fq * 4;
#pragma unroll
        for (int n = 0; n < 4; ++n) {
          int d = n * 16 + fr;
          u32x2 o; o.x = pack2(acc[m][n][0], acc[m][n][1]); o.y = pack2(acc[m][n][2], acc[m][n][3]);
          *(u32x2*)(p.VtF + (size_t)(hh * 64 + d) * TPAD + rb) = o;
#pragma unroll
          for (int j = 0; j < 4; ++j) {
            int row = rb + j; int col = hh * 64 + d;
            if (row < LP) p.out[O_FVP + ((size_t)jf * LP + row) * 1024 + col] = acc[m][n][j];
            else if (row < TTOK) p.out[O_FVS + ((size_t)jf * 128 + (row - LP)) * 1024 + col] = acc[m][n][j];
          }
        }
      }
    } else if (type == 3) {
#pragma unroll
      for (int m = 0; m < 4; ++m)
#pragma unroll
        for (int n = 0; n < 4; ++n) {
          int row = m0 + wr * 64 + m * 16 + fr;
          int col = (nt - 24) * 128 + wc * 64 + n * 16 + fq * 4;
          u32x2 o; o.x = pack2(acc[m][n][0], acc[m][n][1]); o.y = pack2(acc[m][n][2], acc[m][n][3]);
          *(u32x2*)(p.OGf + (size_t)row * DM + col) = o;
        }
    } else {
      float* lfs = (float*)smem;
      __syncthreads();
      if (wc == 0) {
        float bf = p.fox_b_f[jf * 16 + fr];
#pragma unroll
        for (int m = 0; m < 4; ++m)
#pragma unroll
          for (int j = 0; j < 4; ++j) {
            int rl = wr * 64 + m * 16 + fq * 4 + j;
            int row = m0 + rl;
            float lf = logsigmoid_(acc[m][0][j] + bf);
            lfs[rl * 16 + fr] = lf;
            p.LFR[(size_t)row * 16 + fr] = lf;
            if (row < LP) p.out[O_FLP + ((size_t)jf * LP + row) * 16 + fr] = lf;
            else if (row < TTOK) p.out[O_FLS + ((size_t)jf * 128 + (row - LP)) * 16 + fr] = lf;
          }
      }
      __syncthreads();
      if (tid < 16) {
        float run = 0.f;
        for (int r = 0; r < 128; ++r) {
          run += lfs[r * 16 + tid];
          p.LFC[(size_t)(m0 + r) * 16 + tid] = run;
        }
        p.TT[mt * 16 + tid] = run;
      }
    }
  }
}

DEV void f2_prompt(const Params& p, int qt, int h, char* smem) {
  u16* Ks = (u16*)smem;
  u16* Vs = Ks + 2 * 64 * LDK;
  float* cs = (float*)(Vs + 2 * 64 * LDK);
  float* off = cs + 128;
  float* tmp = off + 132;
  int tid = otid(), lane = tid & 63, wid = tid >> 6, fr = lane & 15, fq = lane >> 4;
  __syncthreads();
  if (tid < MTILES) tmp[tid] = p.TT[tid * 16 + h];
  __syncthreads();
  if (tid < MTILES) { float s = 0.f; for (int m = 0; m < tid; ++m) s += tmp[m]; off[tid] = s; }
  __syncthreads();
  int q0 = qt * 256 + wid * 64;
  bf16x8 qf[4][2];
  float cq[4], lrow[4];
  f32x4 o[4][4];
#pragma unroll
  for (int qi = 0; qi < 4; ++qi) {
    int q = q0 + qi * 16 + fr;
#pragma unroll
    for (int ks = 0; ks < 2; ++ks) qf[qi][ks] = *(const bf16x8*)(p.Qf + (size_t)q * DM + h * 64 + ks * 32 + fq * 8);
    cq[qi] = (p.LFC[(size_t)q * 16 + h] + off[q >> 7] - 12.f) * 1.44269504089f;
    lrow[qi] = 0.f;
#pragma unroll
    for (int dt = 0; dt < 4; ++dt) o[dt][qi] = f32x4{0.f, 0.f, 0.f, 0.f};
  }
  int nkt = 4 * (qt + 1);
  if (nkt > (LP + 63) / 64) nkt = (LP + 63) / 64;
  bool wave_valid = q0 < LP;
  u32x4 rk[2], rv[2]; float rc = 0.f;
  const int lrow_ = tid >> 2, lcol = (tid & 3) * 16;
  const u16* kfb = p.Kf + h * 64;
  const u16* vtb = p.VtF + (size_t)h * 64 * TPAD;
  const float* lcb = p.LFC + h;
  const unsigned kvo0 = (unsigned)(lrow_ * DM + lcol), kvo1 = kvo0 + 32u * DM;
  const unsigned vvo0 = (unsigned)(lrow_ * TPAD + lcol), vvo1 = vvo0 + 32u * TPAD;
#define GL(kt_) { int key0_ = (kt_) * 64; \
    const u16* kp_ = p.Kf + (size_t)(key0_ + lrow_) * DM + h * 64 + lcol; \
    const u16* vp_ = p.VtF + (size_t)(h * 64 + lrow_) * TPAD + key0_ + lcol; \
    rk[0] = *(const u32x4*)(kp_); rk[1] = *(const u32x4*)(kp_ + 8); \
    rv[0] = *(const u32x4*)(vp_); rv[1] = *(const u32x4*)(vp_ + 8); \
    if (tid < 64) rc = (p.LFC[(size_t)(key0_ + tid) * 16 + h] + off[(key0_ + tid) >> 7]) * 1.44269504089f; }
  GL(0);
  for (int kt = 0; kt < nkt; ++kt) {
    int buf = kt & 1;
    u16* Kb = Ks + buf * 64 * LDK; u16* Vb = Vs + buf * 64 * LDK; float* cb = cs + buf * 64;
#pragma unroll
    for (int i = 0; i < 2; ++i) {
      *(u32x4*)(Kb + lrow_ * LDK + lcol + 8 * i) = rk[i];
      *(u32x4*)(Vb + lrow_ * LDK + lcol + 8 * i) = rv[i];
    }
    if (tid < 64) cb[tid] = rc;
    __syncthreads();
    if (kt + 1 < nkt) GL(kt + 1);
    int key0 = kt * 64;
    if (wave_valid && key0 <= q0 + 63) {
      bool diag = (key0 + 63 > q0);
#pragma unroll
      for (int pp = 0; pp < 2; ++pp) {
        V8 pfu[4];
#pragma unroll
        for (int kl = 0; kl < 2; ++kl) {
          f32x4 s1[4];
#pragma unroll
          for (int qi = 0; qi < 4; ++qi) s1[qi] = f32x4{0.f, 0.f, 0.f, 0.f};
#pragma unroll
          for (int ks = 0; ks < 2; ++ks) {
            bf16x8 a = *(const bf16x8*)(Kb + ((2 * pp + kl) * 16 + fr) * LDK + ks * 32 + fq * 8);
#pragma unroll
            for (int qi = 0; qi < 4; ++qi) s1[qi] = mfma(a, qf[qi][ks], s1[qi]);
          }
          f32x4 ck = *(const f32x4*)(cb + (2 * pp + kl) * 16 + fq * 4);
#pragma unroll
          for (int qi = 0; qi < 4; ++qi) {
            int q = q0 + qi * 16 + fr;
            float e[4];
#pragma unroll
            for (int j = 0; j < 4; ++j) {
              float v = s1[qi][j] + (cq[qi] - ck[j]);
              if (diag && (key0 + (2 * pp + kl) * 16 + fq * 4 + j > q)) v = -INFINITY;
              e[j] = __builtin_amdgcn_exp2f(v);
            }
            lrow[qi] += (e[0] + e[1]) + (e[2] + e[3]);
            pfu[qi].u[kl * 2 + 0] = pack2(e[0], e[1]);
            pfu[qi].u[kl * 2 + 1] = pack2(e[2], e[3]);
          }
        }
        bf16x8 pf[4];
#pragma unroll
        for (int qi = 0; qi < 4; ++qi) pf[qi] = pfu[qi].v;
#pragma unroll
        for (int dt = 0; dt < 4; ++dt) {
          V8 a;
          a.d[0] = *(const u32x2*)(Vb + (dt * 16 + fr) * LDK + (2 * pp) * 16 + fq * 4);
          a.d[1] = *(const u32x2*)(Vb + (dt * 16 + fr) * LDK + (2 * pp + 1) * 16 + fq * 4);
#pragma unroll
          for (int qi = 0; qi < 4; ++qi) o[dt][qi] = mfma(a.v, pf[qi], o[dt][qi]);
        }
      }
    }
  }
  int q0e = q0;
  asm volatile("" : "+v"(q0e));
#pragma unroll
  for (int qi = 0; qi < 4; ++qi) {
    float l = lrow[qi];
    l += __shfl_xor(l, 16); l += __shfl_xor(l, 32);
    float inv = 1.f / l;
    int q = q0e + qi * 16 + fr;
    if (q < LP) {
#pragma unroll
      for (int dt = 0; dt < 4; ++dt) {
        int d = dt * 16 + fq * 4;
        u32x2 og = *(const u32x2*)(p.OGf + (size_t)q * DM + h * 64 + d);
        u32x2 r;
        r.x = pack2(o[dt][qi][0] * inv * sigmoidf_(bflo(og.x)), o[dt][qi][1] * inv * sigmoidf_(bfhi(og.x)));
        r.y = pack2(o[dt][qi][2] * inv * sigmoidf_(bflo(og.y)), o[dt][qi][3] * inv * sigmoidf_(bfhi(og.y)));
        *(u32x2*)(p.AO + (size_t)q * DM + h * 64 + d) = r;
      }
    }
  }
}

DEV void f2_sample(const Params& p, int jf, int b, int h, int qh, char* smem) {
  constexpr int NK = PAST + 16;
  float* S = (float*)smem;
  float* qs = S + 8 * NK;
  float* cc = qs + 8 * 64;
  float* part = cc + NK;
  float* invl = part + 256;
  int tid = otid(), lane = tid & 63, wid = tid >> 6;
  __syncthreads();
  for (int e = tid; e < 512; e += 256) {
    int i = e >> 6, d = e & 63;
    qs[e] = bf2f(p.Qf[(size_t)(LP + b * 16 + qh * 8 + i) * DM + h * 64 + d]);
  }
  float lv[5]; float run = 0.f;
#pragma unroll
  for (int u = 0; u < 5; ++u) {
    int j = tid * 5 + u;
    float v = 0.f;
    if (j < PAST) v = p.cache_lf[(((size_t)jf * 8 + b) * PAST + j) * 16 + h];
    else if (j < NK) v = p.LFR[(size_t)(LP + b * 16 + (j - PAST)) * 16 + h];
    run += v; lv[u] = run;
  }
  part[tid] = run;
  __syncthreads();
  float base = 0.f;
  for (int m = 0; m < tid; ++m) base += part[m];
#pragma unroll
  for (int u = 0; u < 5; ++u) { int j = tid * 5 + u; if (j < NK) cc[j] = base + lv[u]; }
  __syncthreads();
  for (int j = tid; j < NK; j += 256) {
    const float* kp;
    if (j < PAST) kp = p.cache_k + ((((size_t)jf * 8 + b) * PAST + j) * 16 + h) * 64;
    else kp = p.out + O_FKS + (((size_t)jf * 128 + b * 16 + (j - PAST)) * 16 + h) * 64;
    f32x4 kv[16];
#pragma unroll
    for (int c = 0; c < 16; ++c) kv[c] = ((const f32x4*)kp)[c];
    float cj = cc[j];
#pragma unroll
    for (int i = 0; i < 8; ++i) {
      float a = 0.f;
#pragma unroll
      for (int c = 0; c < 16; ++c) {
        f32x4 qv = *(const f32x4*)(qs + i * 64 + c * 4);
        a += qv.x * kv[c].x + qv.y * kv[c].y + qv.z * kv[c].z + qv.w * kv[c].w;
      }
      int qi = qh * 8 + i;
      a = a * 0.69314718056f + (cc[PAST + qi] - cj);
      if (j > PAST + qi) a = -INFINITY;
      S[i * NK + j] = a;
    }
  }
  __syncthreads();
  for (int i = wid * 2; i < wid * 2 + 2; ++i) {
    float m = -INFINITY;
    for (int j = lane; j < NK; j += 64) m = fmaxf(m, S[i * NK + j]);
    m = wave_max(m);
    float l = 0.f;
    for (int j = lane; j < NK; j += 64) { float e = __expf(S[i * NK + j] - m); S[i * NK + j] = e; l += e; }
    l = wave_sum(l);
    if (lane == 0) invl[i] = 1.f / l;
  }
  __syncthreads();
  {
    int i = tid >> 5, dq = tid & 31;
    float o0 = 0.f, o1 = 0.f;
    const float* vb = p.cache_v + ((((size_t)jf * 8 + b) * PAST) * 16 + h) * 64 + dq * 2;
#pragma unroll 8
    for (int j = 0; j < PAST; ++j) {
      f32x2 v = *(const f32x2*)(vb + (size_t)j * 1024);
      float pj = S[i * NK + j];
      o0 += pj * v.x; o1 += pj * v.y;
    }
    const float* vn = p.out + O_FVS + (((size_t)jf * 128 + b * 16) * 16 + h) * 64 + dq * 2;
#pragma unroll
    for (int j = 0; j < 16; ++j) {
      f32x2 v = *(const f32x2*)(vn + (size_t)j * 1024);
      float pj = S[i * NK + PAST + j];
      o0 += pj * v.x; o1 += pj * v.y;
    }
    int row = LP + b * 16 + qh * 8 + i;
    float il = invl[i];
    uint32_t og = *(const uint32_t*)(p.OGf + (size_t)row * DM + h * 64 + dq * 2);
    *(uint32_t*)(p.AO + (size_t)row * DM + h * 64 + dq * 2) = pack2(o0 * il * sigmoidf_(bflo(og)), o1 * il * sigmoidf_(bfhi(og)));
  }
}

DEV void ph_f2(const Params& p, int jf, char* smem) {
  const int NP = 65 * 16, NI = NP + 256;
  int G = gridDim.x;
  {
    int gt = blockIdx.x * blockDim.x + otid(), gs = gridDim.x * blockDim.x;
    for (int i = gt; i < (TPAD - TTOK) * DM / 2; i += gs) ((uint32_t*)(p.AO + (size_t)TTOK * DM))[i] = 0u;
  }
  for (int r = 0;; ++r) {
    int pos = (r & 1) ? (G - 1 - (int)blockIdx.x) : (int)blockIdx.x;
    int idx = r * G + pos;
    if (r * G >= NI) break;
    if (idx >= NI) continue;
    if (idx < NP) f2_prompt(p, 64 - idx / 16, idx % 16, smem);
    else { int s = idx - NP; f2_sample(p, jf, s >> 5, (s >> 1) & 15, s & 1, smem); }
  }
}

DEV void ph_outproj(const Params& p, const u16* A, int K, const u16* Wt, char* smem) {
  int tid = otid(), lane = tid & 63, wid = tid >> 6;
  int wr = wid >> 1, wc = wid & 1, fr = lane & 15, fq = lane >> 4;
  for (int it = blockIdx.x; it < MTILES * 8; it += gridDim.x) {
    int mt, nt; tile_mn(it, 8, mt, nt);
    f32x4 acc[4][4];
    gemm_tile<true>(A, K, Wt, K, K, mt * 128, nt * 128, smem, acc);
#pragma unroll
    for (int m = 0; m < 4; ++m)
#pragma unroll
      for (int n = 0; n < 4; ++n) {
        int row = mt * 128 + wr * 64 + m * 16 + fr;
        int col = nt * 128 + wc * 64 + n * 16 + fq * 4;
        f32x4* xp = (f32x4*)(p.X + (size_t)row * DM + col);
        *xp = *xp + acc[m][n];
      }
  }
}

DEV void ph_r1(const Params& p, int jr, char* smem) {
  const u16* Wt = p.WrinT + (size_t)jr * 6144 * 1024;
  int tid = otid(), lane = tid & 63, wid = tid >> 6;
  int wr = wid >> 1, wc = wid & 1, fr = lane & 15, fq = lane >> 4;
  {
    int gt = blockIdx.x * blockDim.x + tid, gs = gridDim.x * blockDim.x;
    for (int i = gt; i < LEAD * DM; i += gs) { p.Qr[i] = 0; p.Kr[i] = 0; }
    for (int i = gt; i < 1024 * LEAD; i += gs) p.KrT[tix(256, (i / LEAD) >> 8, (i / LEAD) & 255, i % LEAD)] = 0;
    for (int i = gt; i < 2048 * LEAD; i += gs) p.VrT[tix(512, (i / LEAD) >> 9, (i / LEAD) & 511, i % LEAD)] = 0;
  }
  const int NT = 48;
  for (int it = blockIdx.x; it < MTILES * NT; it += gridDim.x) {
    int mt, nt; tile_mn(it, NT, mt, nt);
    int m0 = mt * 128;
    f32x4 acc[4][4];
    if (nt >= 8 && nt < 32) gemm_tile<false>(p.H, DM, Wt, DM, DM, m0, nt * 128, smem, acc);
    else gemm_tile<true>(p.H, DM, Wt, DM, DM, m0, nt * 128, smem, acc);
    if (nt < 8) {
      int hh = nt >> 1, half = nt & 1;
#pragma unroll
      for (int pr = 0; pr < 2; ++pr) {
        int g = half * 4 + wc * 2 + pr;
        f32x4 rr = *(const f32x4*)(p.rope_rev + g * 16 + fq * 4);
#pragma unroll
        for (int m = 0; m < 4; ++m) {
          int row = m0 + wr * 64 + m * 16 + fr;
          int pos = (row < LP) ? (row - NMETA) : ((row < TTOK) ? (PAST + ((row - LP) & 15)) : 0);
          float o1[4], o2[4];
#pragma unroll
          for (int j = 0; j < 4; ++j) {
            float rev = (float)pos * rr[j];
            rev -= floorf(rev);
            float sn = __builtin_amdgcn_sinf(rev), cs = __builtin_amdgcn_cosf(rev);
            float x1 = acc[m][2 * pr][j], x2 = acc[m][2 * pr + 1][j];
            o1[j] = (x1 * cs - x2 * sn) * 0.0625f; o2[j] = (x1 * sn + x2 * cs) * 0.0625f;
          }
          u32x2 t1, t2;
          t1.x = pack2(o1[0], o1[1]); t1.y = pack2(o1[2], o1[3]);
          t2.x = pack2(o2[0], o2[1]); t2.y = pack2(o2[2], o2[3]);
          u16* dq = p.Qr + (size_t)(row + LEAD) * DM + hh * 256 + g * 32 + fq * 4;
          *(u32x2*)dq = t1;
          *(u32x2*)(dq + 16) = t2;
        }
      }
    } else if (nt < 16) {
      bool isq = false;
      int hh = (nt & 7) >> 1, half = nt & 1;
      float l2g = ret_l2g(hh);
      u16* dst = isq ? p.Qr : p.Kr;
#pragma unroll
      for (int pr = 0; pr < 2; ++pr) {
        int g = half * 4 + wc * 2 + pr;
        int fi = g * 16 + fr;
        float rr = p.rope_rev[fi];
        int dp1 = g * 32 + fr, dp2 = dp1 + 16;
#pragma unroll
        for (int m = 0; m < 4; ++m) {
          int rb = m0 + wr * 64 + m * 16 + fq * 4;
          float o1[4], o2[4];
#pragma unroll
          for (int j = 0; j < 4; ++j) {
            int row = rb + j;
            int pos = (row < LP) ? (row - NMETA) : ((row < TTOK) ? (PAST + ((row - LP) & 15)) : 0);
            float rev = (float)pos * rr;
            rev -= floorf(rev);
            float sn = __builtin_amdgcn_sinf(rev), cs = __builtin_amdgcn_cosf(rev);
            float x1 = acc[m][2 * pr][j], x2 = acc[m][2 * pr + 1][j];
            float a = x1 * cs - x2 * sn, bb = x1 * sn + x2 * cs;
            if (isq) { a *= 0.0625f; bb *= 0.0625f; }
            o1[j] = a; o2[j] = bb;
            dst[(size_t)(row + LEAD) * DM + hh * 256 + dp1] = f2bf(a);
            dst[(size_t)(row + LEAD) * DM + hh * 256 + dp2] = f2bf(bb);
          }
          if (!isq) {
            float dc[4];
#pragma unroll
            for (int j = 0; j < 4; ++j) dc[j] = exp2f(l2g * (float)(63 - ((rb + j + LEAD) & 63)));
            u32x2 t1, t2;
            t1.x = pack2(o1[0] * dc[0], o1[1] * dc[1]); t1.y = pack2(o1[2] * dc[2], o1[3] * dc[3]);
            t2.x = pack2(o2[0] * dc[0], o2[1] * dc[1]); t2.y = pack2(o2[2] * dc[2], o2[3] * dc[3]);
            *(u32x2*)(p.KrT + tix(256, hh, dp1, rb + LEAD)) = t1;
            *(u32x2*)(p.KrT + tix(256, hh, dp2, rb + LEAD)) = t2;
          }
        }
      }
    } else if (nt < 32) {
      int hh = (nt - 16) >> 2;
#pragma unroll
      for (int m = 0; m < 4; ++m) {
        int rb = m0 + wr * 64 + m * 16 + fq * 4;
#pragma unroll
        for (int n = 0; n < 4; ++n) {
          int e = ((nt - 16) & 3) * 128 + wc * 64 + n * 16 + fr;
          u32x2 o; o.x = pack2(acc[m][n][0], acc[m][n][1]); o.y = pack2(acc[m][n][2], acc[m][n][3]);
          *(u32x2*)(p.VrT + tix(512, hh, e, rb + LEAD)) = o;
        }
      }
    } else {
#pragma unroll
      for (int m = 0; m < 4; ++m)
#pragma unroll
        for (int n = 0; n < 4; ++n) {
          int row = m0 + wr * 64 + m * 16 + fr;
          int col = (nt - 32) * 128 + wc * 64 + n * 16 + fq * 4;
          u32x2 o; o.x = pack2(acc[m][n][0], acc[m][n][1]); o.y = pack2(acc[m][n][2], acc[m][n][3]);
          *(u32x2*)(p.Gr + (size_t)row * 2048 + col) = o;
        }
    }
  }
}

DEV void ph_r2(const Params& p, int jr) {
  int tid = otid(), lane = tid & 63, wid = tid >> 6, fr = lane & 15, fq = lane >> 4;
  for (int it = blockIdx.x; it < 64; it += gridDim.x) {
    int h = it >> 4, sl = it & 15;
    float dec64 = exp2f(ret_l2g(h) * 64.f);
    f32x4 st[4][2];
#pragma unroll
    for (int r = 0; r < 4; ++r)
#pragma unroll
      for (int c = 0; c < 2; ++c) st[r][c] = f32x4{0.f, 0.f, 0.f, 0.f};
    const u16* kbase = p.KrT + tix(256, h, wid * 64 + fr, 0) + fq * 8;
    const u16* vbase = p.VrT + tix(512, h, sl * 32 + fr, 0) + fq * 8;
    bf16x8 A0[8], B0[4], A1[8], B1[4], A2[8], B2[4];
#define R2_LOAD(A, B, n_) { \
    _Pragma("unroll") for (int r = 0; r < 4; ++r) _Pragma("unroll") for (int ks = 0; ks < 2; ++ks) \
      A[r * 2 + ks] = *(const bf16x8*)(kbase + (size_t)(n_) * (256 * 64) + r * 16 * 64 + ks * 32); \
    _Pragma("unroll") for (int c = 0; c < 2; ++c) _Pragma("unroll") for (int ks = 0; ks < 2; ++ks) \
      B[c * 2 + ks] = *(const bf16x8*)(vbase + (size_t)(n_) * (512 * 64) + c * 16 * 64 + ks * 32); }
#define R2_STEP(A, B, n_) { \
    { \
      _Pragma("unroll") for (int c = 0; c < 2; ++c) { \
        u16* sp = p.ST + (((size_t)((n_) * 4 + h) * 16 + wid * 4) * 512 + sl * 32 + c * 16 + fr) * 16 + fq * 4; \
        _Pragma("unroll") for (int r = 0; r < 4; ++r) { \
          u32x2 o; o.x = pack2(st[r][c][0], st[r][c][1]); o.y = pack2(st[r][c][2], st[r][c][3]); \
          *(u32x2*)(sp + r * (512 * 16)) = o; } } } \
    _Pragma("unroll") for (int r = 0; r < 4; ++r) _Pragma("unroll") for (int c = 0; c < 2; ++c) { \
      f32x4 t = st[r][c] * dec64; \
      _Pragma("unroll") for (int ks = 0; ks < 2; ++ks) t = mfma(A[r * 2 + ks], B[c * 2 + ks], t); \
      st[r][c] = t; } }
    R2_LOAD(A0, B0, 0) R2_LOAD(A1, B1, 1) R2_LOAD(A2, B2, 2)
#pragma unroll 1
    for (int n = 0; n < 255; n += 3) {
      R2_STEP(A0, B0, n)
      R2_LOAD(A0, B0, min(n + 3, NCH - 1))
      R2_STEP(A1, B1, n + 1)
      R2_LOAD(A1, B1, min(n + 4, NCH - 1))
      R2_STEP(A2, B2, n + 2)
      R2_LOAD(A2, B2, min(n + 5, NCH - 1))
    }
    R2_STEP(A0, B0, 255)
    R2_STEP(A1, B1, 256)
    int fre = fr, fqe = fq;
    asm volatile("" : "+v"(fre), "+v"(fqe));
#pragma unroll
    for (int r = 0; r < 4; ++r)
#pragma unroll
      for (int c = 0; c < 2; ++c)
#pragma unroll
        for (int j = 0; j < 4; ++j) {
          int dorig = perm_dorig(wid * 64 + r * 16 + fqe * 4 + j);
          p.out[O_SRP + ((size_t)(jr * 4 + h) * 256 + dorig) * 512 + sl * 32 + c * 16 + fre] = st[r][c][j];
        }
  }
}

DEV void r3_prompt(const Params& p, int jr, int n, int h, char* smem) {
  u32x4* Sf = (u32x4*)smem;
  float* red = (float*)(smem + 8192);
  int tid = otid(), lane = tid & 63, w = tid >> 6, fr = lane & 15, fq = lane >> 4;
  int p0 = n * 64;
  float l2g = ret_l2g(h);
  f32x4 acc[8][4];
#pragma unroll
  for (int a = 0; a < 8; ++a)
#pragma unroll
    for (int b = 0; b < 4; ++b) acc[a][b] = f32x4{0.f, 0.f, 0.f, 0.f};
  const u16* qb = p.Qr + (size_t)(p0 + fr) * DM + h * 256 + fq * 8;
  if (n >= 1) {
    const u16* sb = p.ST + (((size_t)(n * 4 + h) * 16 + (fq >> 1)) * 512 + w * 128 + fr) * 16 + (fq & 1) * 8;
#pragma unroll 1
    for (int ks = 0; ks < 8; ++ks) {
      bf16x8 bq[4];
#pragma unroll
      for (int it = 0; it < 4; ++it) bq[it] = *(const bf16x8*)(qb + (size_t)(it * 16) * DM + ks * 32);
#pragma unroll
      for (int dvt = 0; dvt < 8; ++dvt) {
        bf16x8 a = *(const bf16x8*)(sb + (size_t)(ks * 2) * (512 * 16) + dvt * 16 * 16);
#pragma unroll
        for (int it = 0; it < 4; ++it) acc[dvt][it] = mfma(a, bq[it], acc[dvt][it]);
      }
    }
#pragma unroll
    for (int it = 0; it < 4; ++it) {
      float qd = exp2f(l2g * (float)(it * 16 + fr + 1));
#pragma unroll
      for (int dvt = 0; dvt < 8; ++dvt) acc[dvt][it] = acc[dvt][it] * qd;
    }
  }
  {
    f32x4 s[4];
#pragma unroll
    for (int jt = 0; jt < 4; ++jt) s[jt] = f32x4{0.f, 0.f, 0.f, 0.f};
    const u16* kb = p.Kr + (size_t)(p0 + fr) * DM + h * 256 + fq * 8;
#pragma unroll 1
    for (int ks = 0; ks < 8; ++ks) {
      bf16x8 b = *(const bf16x8*)(qb + (size_t)(w * 16) * DM + ks * 32);
#pragma unroll
      for (int jt = 0; jt < 4; ++jt) {
        bf16x8 a = *(const bf16x8*)(kb + (size_t)(jt * 16) * DM + ks * 32);
        s[jt] = mfma(a, b, s[jt]);
      }
    }
    int i = w * 16 + fr;
#pragma unroll
    for (int jt = 0; jt < 4; ++jt)
#pragma unroll
      for (int jj = 0; jj < 4; ++jj) {
        int j = jt * 16 + fq * 4 + jj;
        int dd = i > j ? i - j : j - i;
        s[jt][jj] *= exp2f(l2g * (float)dd);
      }
    __syncthreads();
#pragma unroll
    for (int pp = 0; pp < 2; ++pp) {
      u32x4 t;
      t.x = pack2(s[2 * pp][0], s[2 * pp][1]); t.y = pack2(s[2 * pp][2], s[2 * pp][3]);
      t.z = pack2(s[2 * pp + 1][0], s[2 * pp + 1][1]); t.w = pack2(s[2 * pp + 1][2], s[2 * pp + 1][3]);
      Sf[(w * 2 + pp) * 64 + lane] = t;
    }
    __syncthreads();
  }
  {
    const u16* vb = p.VrT + tix(512, h, w * 128 + fr, p0) + fq * 4;
#pragma unroll
    for (int pp = 0; pp < 2; ++pp) {
      V8 bs[4];
#pragma unroll
      for (int it = 0; it < 4; ++it) bs[it].q = Sf[(it * 2 + pp) * 64 + lane];
#pragma unroll
      for (int dvt = 0; dvt < 8; ++dvt) {
        V8 a;
        a.d[0] = *(const u32x2*)(vb + dvt * 16 * 64 + (2 * pp) * 16);
        a.d[1] = *(const u32x2*)(vb + dvt * 16 * 64 + (2 * pp + 1) * 16);
#pragma unroll
        for (int it = 0; it < 4; ++it) acc[dvt][it] = mfma(a.v, bs[it].v, acc[dvt][it]);
      }
    }
  }
  float mean[4], rstd[4];
  {
    float s1[4];
#pragma unroll
    for (int it = 0; it < 4; ++it) {
      float s = 0.f;
#pragma unroll
      for (int dvt = 0; dvt < 8; ++dvt) s += acc[dvt][it][0] + acc[dvt][it][1] + acc[dvt][it][2] + acc[dvt][it][3];
      s += __shfl_xor(s, 16); s += __shfl_xor(s, 32);
      s1[it] = s;
    }
    __syncthreads();
    if (fq == 0) {
#pragma unroll
      for (int it = 0; it < 4; ++it) red[w * 64 + it * 16 + fr] = s1[it];
    }
    __syncthreads();
#pragma unroll
    for (int it = 0; it < 4; ++it) {
      int i = it * 16 + fr;
      mean[it] = (red[i] + red[64 + i] + red[128 + i] + red[192 + i]) * (1.f / 512.f);
    }
#pragma unroll
    for (int it = 0; it < 4; ++it) {
      float s = 0.f;
#pragma unroll
      for (int dvt = 0; dvt < 8; ++dvt)
#pragma unroll
        for (int j = 0; j < 4; ++j) { float d = acc[dvt][it][j] - mean[it]; s += d * d; }
      s += __shfl_xor(s, 16); s += __shfl_xor(s, 32);
      s1[it] = s;
    }
    __syncthreads();
    if (fq == 0) {
#pragma unroll
      for (int it = 0; it < 4; ++it) red[w * 64 + it * 16 + fr] = s1[it];
    }
    __syncthreads();
#pragma unroll
    for (int it = 0; it < 4; ++it) {
      int i = it * 16 + fr;
      float var = (red[i] + red[64 + i] + red[128 + i] + red[192 + i]) * (1.f / 512.f);
      rstd[it] = rsqrtf(var + EPS);
    }
  }
#pragma unroll
  for (int it = 0; it < 4; ++it) {
    int t = p0 + it * 16 + fr - LEAD;
    if (t >= 0 && t < LP) {
#pragma unroll
      for (int dvt = 0; dvt < 8; ++dvt) {
        int e0 = h * 512 + w * 128 + dvt * 16 + fq * 4;
        u16* gp = p.Gr + (size_t)t * 2048 + e0;
        u32x2 g = *(const u32x2*)gp;
        f32x4 gn = *(const f32x4*)(p.ret_gn + jr * 2048 + e0);
        float g0 = bflo(g.x), g1 = bfhi(g.x), g2 = bflo(g.y), g3 = bfhi(g.y);
        float y0 = (acc[dvt][it][0] - mean[it]) * rstd[it] * gn.x * (g0 * sigmoidf_(g0));
        float y1 = (acc[dvt][it][1] - mean[it]) * rstd[it] * gn.y * (g1 * sigmoidf_(g1));
        float y2 = (acc[dvt][it][2] - mean[it]) * rstd[it] * gn.z * (g2 * sigmoidf_(g2));
        float y3 = (acc[dvt][it][3] - mean[it]) * rstd[it] * gn.w * (g3 * sigmoidf_(g3));
        u32x2 o; o.x = pack2(y0, y1); o.y = pack2(y2, y3);
        *(u32x2*)gp = o;
      }
    }
  }
}

DEV void r3_sample(const Params& p, int jr, int b, int h, char* smem) {
  float* obuf = (float*)smem;
  u16* qs = (u16*)(smem + 32768);
  u16* ks = qs + 16 * 256;
  float* sm = (float*)(smem + 49152);
  float* red = sm + 256;
  float* stat = red + 64;
  int tid = otid(), lane = tid & 63, wid = tid >> 6;
  float l2g = ret_l2g(h);
  int prow = LP + LEAD + b * 16;
  __syncthreads();
  for (int e = tid; e < 16 * 256; e += 256) {
    int i = e >> 8, d = e & 255;
    qs[e] = p.Qr[(size_t)(prow + i) * DM + h * 256 + d];
    ks[e] = p.Kr[(size_t)(prow + i) * DM + h * 256 + d];
  }
  __syncthreads();
  {
    int i = tid >> 4, j = tid & 15;
    float a = 0.f;
#pragma unroll 8
    for (int d = 0; d < 256; ++d) a += bf2f(qs[i * 256 + d]) * bf2f(ks[j * 256 + d]);
    int dd = i > j ? i - j : j - i;
    sm[tid] = a * exp2f(l2g * (float)dd);
  }
  __syncthreads();
  for (int e = tid; e < 16 * 256; e += 256) ks[e] = f2bf(bf2f(ks[e]) * exp2f(l2g * (float)(15 - (e >> 8))));
  __syncthreads();
  float dec16 = exp2f(l2g * 16.f);
  const float* stin = p.state_ret + ((size_t)(jr * 8 + b) * 4 + h) * 256 * 512;
  float* stout = p.out + O_SRS + ((size_t)(jr * 8 + b) * 4 + h) * 256 * 512;
#pragma unroll 1
  for (int c = 0; c < 2; ++c) {
    int e = tid + c * 256;
    float v[16], o[16];
    const u16* vp = p.VrT + tix(512, h, e, prow);
    u32x4 a = *(const u32x4*)vp, bq = *(const u32x4*)(vp + 8);
    v[0] = bflo(a.x); v[1] = bfhi(a.x); v[2] = bflo(a.y); v[3] = bfhi(a.y);
    v[4] = bflo(a.z); v[5] = bfhi(a.z); v[6] = bflo(a.w); v[7] = bfhi(a.w);
    v[8] = bflo(bq.x); v[9] = bfhi(bq.x); v[10] = bflo(bq.y); v[11] = bfhi(bq.y);
    v[12] = bflo(bq.z); v[13] = bfhi(bq.z); v[14] = bflo(bq.w); v[15] = bfhi(bq.w);
#pragma unroll
    for (int i = 0; i < 16; ++i) o[i] = 0.f;
#pragma unroll 2
    for (int dp = 0; dp < 256; ++dp) {
      int dorig = perm_dorig(dp);
      float s0 = stin[(size_t)dorig * 512 + e];
      float n0 = s0 * dec16;
#pragma unroll
      for (int i = 0; i < 16; ++i) {
        o[i] += bf2f(qs[i * 256 + dp]) * s0;
        n0 += bf2f(ks[i * 256 + dp]) * v[i];
      }
      stout[(size_t)dorig * 512 + e] = n0;
    }
#pragma unroll
    for (int i = 0; i < 16; ++i) obuf[i * 512 + e] = o[i] * exp2f(l2g * (float)(i + 1));
#pragma unroll 1
    for (int i = 0; i < 16; ++i) {
      float a0 = obuf[i * 512 + e];
#pragma unroll
      for (int j = 0; j < 16; ++j) a0 += sm[i * 16 + j] * v[j];
      obuf[i * 512 + e] = a0;
    }
  }
  __syncthreads();
  for (int i = 0; i < 16; ++i) {
    float s = wave_sum(obuf[i * 512 + tid] + obuf[i * 512 + 256 + tid]);
    if (lane == 0) red[wid * 16 + i] = s;
  }
  __syncthreads();
  if (tid < 16) stat[tid] = (red[tid] + red[16 + tid] + red[32 + tid] + red[48 + tid]) * (1.f / 512.f);
  __syncthreads();
  for (int i = 0; i < 16; ++i) {
    float mu = stat[i];
    float d0 = obuf[i * 512 + tid] - mu, d1 = obuf[i * 512 + 256 + tid] - mu;
    float s = wave_sum(d0 * d0 + d1 * d1);
    if (lane == 0) red[wid * 16 + i] = s;
  }
  __syncthreads();
  if (tid < 16) stat[16 + tid] = rsqrtf((red[tid] + red[16 + tid] + red[32 + tid] + red[48 + tid]) * (1.f / 512.f) + EPS);
  __syncthreads();
  for (int c = 0; c < 2; ++c) {
    int e = tid + c * 256;
    float gn = p.ret_gn[jr * 2048 + h * 512 + e];
    for (int i = 0; i < 16; ++i) {
      int t = LP + b * 16 + i;
      float g = bf2f(p.Gr[(size_t)t * 2048 + h * 512 + e]);
      float y = (obuf[i * 512 + e] - stat[i]) * stat[16 + i] * gn * (g * sigmoidf_(g));
      p.Gr[(size_t)t * 2048 + h * 512 + e] = f2bf(y);
    }
  }
}

DEV void ph_r3(const Params& p, int jr, char* smem) {
  const int NP = NCH * 4, NI = NP + 32;
  for (int it = blockIdx.x; it < NI; it += gridDim.x) {
    if (it < 32) r3_sample(p, jr, it >> 2, it & 3, smem);
    else { int q = it - 32; r3_prompt(p, jr, q >> 2, q & 3, smem); }
  }
}

DEV void ph_p2(const Params& p, int layer, char* smem) {
  const u16* Wt = p.WpqT + (size_t)layer * 2048 * 1024;
  u16* Qs = (u16*)smem;
  constexpr int LQ = 136;
  int tid = otid(), lane = tid & 63, wid = tid >> 6;
  int wr = wid >> 1, wc = wid & 1, fr = lane & 15, fq = lane >> 4;
  for (int it = blockIdx.x; it < MTILES * 16; it += gridDim.x) {
    int mt, hp; tile_mn(it, 16, mt, hp);
    int m0 = mt * 128;
    f32x4 acc[4][4];
    gemm_tile<true>(p.H, DM, Wt, DM, DM, m0, hp * 128, smem, acc);
    __syncthreads();
#pragma unroll
    for (int m = 0; m < 4; ++m)
#pragma unroll
      for (int n = 0; n < 4; ++n) {
        u32x2 o; o.x = pack2(acc[m][n][0], acc[m][n][1]); o.y = pack2(acc[m][n][2], acc[m][n][3]);
        *(u32x2*)(Qs + (wr * 64 + m * 16 + fr) * LQ + wc * 64 + n * 16 + fq * 4) = o;
      }
    __syncthreads();
    f32x4 sc[2][8];
#pragma unroll
    for (int rt = 0; rt < 2; ++rt)
#pragma unroll
      for (int ct = 0; ct < 8; ++ct) sc[rt][ct] = f32x4{0.f, 0.f, 0.f, 0.f};
    const u16* skb = p.SKb + ((size_t)(layer * 16 + hp) * 128 + fr) * 128 + fq * 8;
#pragma unroll
    for (int ks = 0; ks < 4; ++ks) {
      bf16x8 a[2];
#pragma unroll
      for (int rt = 0; rt < 2; ++rt) a[rt] = *(const bf16x8*)(Qs + (wid * 32 + rt * 16 + fr) * LQ + ks * 32 + fq * 8);
#pragma unroll
      for (int ct = 0; ct < 8; ++ct) {
        bf16x8 b = *(const bf16x8*)(skb + (size_t)(ct * 16) * 128 + ks * 32);
#pragma unroll
        for (int rt = 0; rt < 2; ++rt) sc[rt][ct] = mfma(a[rt], b, sc[rt][ct]);
      }
    }
#pragma unroll
    for (int rt = 0; rt < 2; ++rt)
#pragma unroll
      for (int j = 0; j < 4; ++j) {
        uint32_t key[8];
#pragma unroll
        for (int ct = 0; ct < 8; ++ct) key[ct] = (f2key(sc[rt][ct][j]) & ~127u) | (uint32_t)(127 - (ct * 16 + fr));
        uint32_t mine = 0;
#pragma unroll 1
        for (int r = 0; r < 16; ++r) {
          uint32_t best = key[0];
#pragma unroll
          for (int ct = 1; ct < 8; ++ct) best = max(best, key[ct]);
          best = row16_maxu(best);
#pragma unroll
          for (int ct = 0; ct < 8; ++ct) key[ct] = (key[ct] == best) ? 0u : key[ct];
          if (fr == r) mine = best;
        }
        int row = m0 + wid * 32 + rt * 16 + fq * 4 + j;
        p.SV[((size_t)row * 16 + hp) * 16 + fr] = key2f(mine & ~127u);
        p.SI[((size_t)row * 16 + hp) * 16 + fr] = 127 - (int)(mine & 127u);
      }
  }
}

DEV void ph_p3(const Params& p, int layer, char* smem) {
  int tid = otid(), lane = tid & 63, wid = tid >> 6;
  int* eidL = (int*)smem + wid * 256;
  float* gateL = (float*)(eidL + 128);
  int ca = 0, cb = 0; bool cvalid = false;
  {
    int cnt = 0;
    for (int a = 0; a < 16; ++a) {
      int nb = 16 / (a + 1);
      if (lane >= cnt && lane < cnt + nb) { ca = a; cb = lane - cnt; cvalid = true; }
      cnt += nb;
    }
  }
  int gw = (blockIdx.x * blockDim.x + tid) >> 6, nw = (gridDim.x * blockDim.x) >> 6;
  for (int t = gw; t < TTOK; t += nw) {
    const float* svp = p.SV + (size_t)t * 256;
    const int* sip = p.SI + (size_t)t * 256;
    for (int h = 0; h < 8; ++h) {
      float cand = cvalid ? (svp[h * 32 + ca] + svp[h * 32 + 16 + cb]) : 0.f;
      uint32_t key = cvalid ? ((f2key(cand) & ~63u) | (uint32_t)(63 - lane)) : 0u;
      uint32_t mine = 0;
#pragma unroll 1
      for (int r = 0; r < 16; ++r) {
        uint32_t best = wave_maxu(key);
        key = (key == best) ? 0u : key;
        if (lane == r) mine = best;
      }
      int src = 63 - (int)(mine & 63u);
      int wa = __shfl(ca, src), wb = __shfl(cb, src);
      float fv = key2f(mine & ~63u);
      float f0 = rdlane(fv, 0);
      float e = (lane < 16) ? __expf(fv - f0) : 0.f;
      float ssum = row16_sum(e);
      if (lane < 16) {
        int eid = sip[h * 32 + wa] * 128 + sip[h * 32 + 16 + wb];
        eidL[h * 16 + lane] = eid;
        gateL[h * 16 + lane] = e / ssum;
      }
    }
    float hf[16];
    {
      u32x4 ha = *(const u32x4*)(p.H + (size_t)t * DM + lane * 16);
      u32x4 hb = *(const u32x4*)(p.H + (size_t)t * DM + lane * 16 + 8);
      hf[0] = bflo(ha.x); hf[1] = bfhi(ha.x); hf[2] = bflo(ha.y); hf[3] = bfhi(ha.y);
      hf[4] = bflo(ha.z); hf[5] = bfhi(ha.z); hf[6] = bflo(ha.w); hf[7] = bfhi(ha.w);
      hf[8] = bflo(hb.x); hf[9] = bfhi(hb.x); hf[10] = bflo(hb.y); hf[11] = bfhi(hb.y);
      hf[12] = bflo(hb.z); hf[13] = bfhi(hb.z); hf[14] = bflo(hb.w); hf[15] = bfhi(hb.w);
    }
    const unsigned char* U8 = (const unsigned char*)p.Ub + lane * 16;
    const unsigned char* V8p = (const unsigned char*)p.Vb + lane * 16;
#define P3_LOAD(buf, tab, base) _Pragma("unroll") for (int u = 0; u < 8; ++u) { \
      int eid_ = __builtin_amdgcn_readfirstlane(eidL[(base) + u]); \
      buf[u] = *(const u32x4*)((tab) + (size_t)eid_ * DM); }
#define P3_CVT(f, q) { v2f_t c_; \
      c_ = __builtin_amdgcn_cvt_pk_f32_fp8((int)(q).x, false); f[0] = c_.x; f[1] = c_.y; \
      c_ = __builtin_amdgcn_cvt_pk_f32_fp8((int)(q).x, true);  f[2] = c_.x; f[3] = c_.y; \
      c_ = __builtin_amdgcn_cvt_pk_f32_fp8((int)(q).y, false); f[4] = c_.x; f[5] = c_.y; \
      c_ = __builtin_amdgcn_cvt_pk_f32_fp8((int)(q).y, true);  f[6] = c_.x; f[7] = c_.y; \
      c_ = __builtin_amdgcn_cvt_pk_f32_fp8((int)(q).z, false); f[8] = c_.x; f[9] = c_.y; \
      c_ = __builtin_amdgcn_cvt_pk_f32_fp8((int)(q).z, true);  f[10] = c_.x; f[11] = c_.y; \
      c_ = __builtin_amdgcn_cvt_pk_f32_fp8((int)(q).w, false); f[12] = c_.x; f[13] = c_.y; \
      c_ = __builtin_amdgcn_cvt_pk_f32_fp8((int)(q).w, true);  f[14] = c_.x; f[15] = c_.y; }
#define P3_DOT(buf, base) _Pragma("unroll") for (int u = 0; u < 8; ++u) { \
      float f_[16]; P3_CVT(f_, buf[u]); float d_ = 0.f; \
      _Pragma("unroll") for (int i = 0; i < 16; ++i) d_ += hf[i] * f_[i]; \
      d_ = wave_sum(d_) * (1.f / U_SCALE); \
      int k_ = (base) + u; \
      if (lane == (k_ & 63)) { if (k_ < 64) w0 = d_; else w1 = d_; } }
#define P3_AXPY(buf, base) { float ws_ = ((base) < 64) ? w0 : w1; \
      _Pragma("unroll") for (int u = 0; u < 8; ++u) { \
        float f_[16]; P3_CVT(f_, buf[u]); float wk_ = rdlane(ws_, ((base) + u) & 63); \
        _Pragma("unroll") for (int i = 0; i < 16; ++i) oacc[i] += wk_ * f_[i]; } }
    float w0 = 0.f, w1 = 0.f;
    {
      u32x4 A[8], B[8];
      P3_LOAD(A, U8, 0)
#pragma unroll 1
      for (int kb = 0; kb < 128; kb += 16) {
        P3_LOAD(B, U8, kb + 8)
        P3_DOT(A, kb)
        if (kb + 16 < 128) { P3_LOAD(A, U8, kb + 16) }
        P3_DOT(B, kb + 8)
      }
    }
    w0 = gateL[lane] * gelu_(w0);
    w1 = gateL[64 + lane] * gelu_(w1);
    float oacc[16];
#pragma unroll
    for (int i = 0; i < 16; ++i) oacc[i] = 0.f;
    {
      u32x4 A[8], B[8];
      P3_LOAD(A, V8p, 0)
#pragma unroll 1
      for (int kb = 0; kb < 128; kb += 16) {
        P3_LOAD(B, V8p, kb + 8)
        P3_AXPY(A, kb)
        if (kb + 16 < 128) { P3_LOAD(A, V8p, kb + 16) }
        P3_AXPY(B, kb + 8)
      }
    }
    float* xr = p.X + (size_t)t * DM + lane * 16;
    f32x4 xv[4];
#pragma unroll
    for (int c = 0; c < 4; ++c) {
      xv[c] = *(const f32x4*)(xr + c * 4);
      xv[c].x += oacc[c * 4 + 0] * (1.f / V_SCALE); xv[c].y += oacc[c * 4 + 1] * (1.f / V_SCALE);
      xv[c].z += oacc[c * 4 + 2] * (1.f / V_SCALE); xv[c].w += oacc[c * 4 + 3] * (1.f / V_SCALE);
    }
    if (layer < 3) {
      float ss = 0.f;
#pragma unroll
      for (int c = 0; c < 4; ++c) {
        *(f32x4*)(xr + c * 4) = xv[c];
        ss += xv[c].x * xv[c].x + xv[c].y * xv[c].y + xv[c].z * xv[c].z + xv[c].w * xv[c].w;
      }
      ss = wave_sum(ss);
      float rstd = rsqrtf(ss * (1.f / DM) + EPS);
      const float* g = p.norm_mix + (size_t)(layer + 1) * DM + lane * 16;
      u32x4 o0, o1;
      f32x4 g0 = *(const f32x4*)(g), g1 = *(const f32x4*)(g + 4), g2 = *(const f32x4*)(g + 8), g3 = *(const f32x4*)(g + 12);
      o0.x = pack2(xv[0].x * rstd * g0.x, xv[0].y * rstd * g0.y); o0.y = pack2(xv[0].z * rstd * g0.z, xv[0].w * rstd * g0.w);
      o0.z = pack2(xv[1].x * rstd * g1.x, xv[1].y * rstd * g1.y); o0.w = pack2(xv[1].z * rstd * g1.z, xv[1].w * rstd * g1.w);
      o1.x = pack2(xv[2].x * rstd * g2.x, xv[2].y * rstd * g2.y); o1.y = pack2(xv[2].z * rstd * g2.z, xv[2].w * rstd * g2.w);
      o1.z = pack2(xv[3].x * rstd * g3.x, xv[3].y * rstd * g3.y); o1.w = pack2(xv[3].z * rstd * g3.z, xv[3].w * rstd * g3.w);
      *(u32x4*)(p.H + (size_t)t * DM + lane * 16) = o0;
      *(u32x4*)(p.H + (size_t)t * DM + lane * 16 + 8) = o1;
    } else {
      float* yo = nullptr;
      if (t >= NMETA && t < LP) yo = p.out + O_YP + (size_t)(t - NMETA) * DM + lane * 16;
      else if (t >= LP) yo = p.out + O_YS + (size_t)(t - LP) * DM + lane * 16;
      if (yo) {
#pragma unroll
        for (int c = 0; c < 4; ++c) *(f32x4*)(yo + c * 4) = xv[c];
      }
    }
  }
}

constexpr int NPHASE = 27;
#ifndef DBG_PHASES
#define DBG_PHASES NPHASE
#endif
#ifndef DBG_SCALES
#define DBG_SCALES {1,1,1,1,1,1,1,1,1,1,1,1,1,1,1,1,1,1,1,1}
#endif
#ifndef DBG_POST
#define DBG_POST 0
#endif
DEV void post_scale(const Params& p) {
  const float sc[20] = DBG_SCALES;
  const size_t offs[11] = {O_YP, O_YS, O_FKP, O_FVP, O_FLP, O_SRP, O_FKS, O_FVS, O_FLS, O_SRS, O_SRS + (size_t)2 * 8 * 4 * 256 * 512};
  size_t i0 = (size_t)blockIdx.x * blockDim.x + otid(), st = (size_t)gridDim.x * blockDim.x;
#pragma unroll
  for (int k = 0; k < 20; ++k) {
    float f = sc[k];
    if (f == 1.f) continue;
    size_t a = offs[k >> 1], b = offs[(k >> 1) + 1], mid = a + (b - a) / 2;
    size_t lo = (k & 1) ? mid : a, hi = (k & 1) ? b : mid;
    for (size_t i = lo + i0; i < hi; i += st) p.out[i] *= f;
  }
}
DEV void dump_x(const Params& p) {
  size_t i = (size_t)blockIdx.x * blockDim.x + otid(), st = (size_t)gridDim.x * blockDim.x;
  for (; i < (size_t)(TTOK - NMETA) * DM; i += st) p.out[i] = p.X[(size_t)NMETA * DM + i];
}
__global__ void __launch_bounds__(256, 2) mega(Params p, int ph0, int ph1) {
  __shared__ __attribute__((aligned(16))) char smem[53248];
#ifndef DUP_FOX
#define DUP_FOX 0
#endif
#ifndef DUP_RET
#define DUP_RET 0
#endif
  for (int ph2 = ph0 * 2; ph2 < ph1 * 2; ++ph2) {
    int ph = ph2 >> 1;
    if (ph2 & 1) {
      bool dup = false;
      if (ph >= 1 && ph < NPHASE) {
        int q = ph - 1, layer, idx;
        if (q < 6) { layer = 0; idx = q; } else if (q < 13) { layer = 1; idx = q - 6; }
        else if (q < 19) { layer = 2; idx = q - 13; } else { layer = 3; idx = q - 19; }
        dup = ((layer & 1) == 0) ? ((DUP_FOX >> idx) & 1) : ((DUP_RET >> idx) & 1);
      }
      if (!dup) continue;
    }
    if (ph2 > ph0 * 2) cg::this_grid().sync();
    if (ph == 0) { ph_prep(p, smem); continue; }
    if (ph == 100) { dump_x(p); continue; }
    if (ph == 101) { post_scale(p); continue; }
    int q = ph - 1, layer, idx;
    if (q < 6) { layer = 0; idx = q; } else if (q < 13) { layer = 1; idx = q - 6; }
    else if (q < 19) { layer = 2; idx = q - 13; } else { layer = 3; idx = q - 19; }
    int j = layer >> 1;
    bool fox = (layer & 1) == 0;
    if (fox) {
      if (idx == 0) ph_f1(p, j, smem);
      else if (idx == 1) ph_f2(p, j, smem);
      else if (idx == 2) ph_outproj(p, p.AO, 1024, p.WfoutT + (size_t)j * 1024 * 1024, smem);
      else if (idx == 3) { norm_rows(p, p.norm_ffn + (size_t)layer * DM, false); conv_tables(p, layer); }
      else if (idx == 4) ph_p2(p, layer, smem);
      else ph_p3(p, layer, smem);
    } else {
      if (idx == 0) ph_r1(p, j, smem);
      else if (idx == 1) { ph_r2(p, j); conv_tables(p, layer); }
      else if (idx == 2) ph_r3(p, j, smem);
      else if (idx == 3) ph_outproj(p, p.Gr, 2048, p.WroutT + (size_t)j * 1024 * 2048, smem);
      else if (idx == 4) norm_rows(p, p.norm_ffn + (size_t)layer * DM, false);
      else if (idx == 5) ph_p2(p, layer, smem);
      else ph_p3(p, layer, smem);
    }
  }
}

extern "C" void kernel_launch(void* const* d_in, const int* in_sizes, int n_in, void* d_out, int out_size,
                              void* d_ws, size_t ws_size, hipStream_t stream) {
  static int grid_blocks = 0;
  if (!grid_blocks) {
    int dev = 0, cus = 0, per_cu = 0;
    hipGetDevice(&dev);
    hipDeviceGetAttribute(&cus, hipDeviceAttributeMultiprocessorCount, dev);
    hipOccupancyMaxActiveBlocksPerMultiprocessor(&per_cu, mega, 256, 0);
    if (per_cu > 2) per_cu = 2;
    if (per_cu < 1) per_cu = 1;
    grid_blocks = cus * per_cu;
  }
  Params p;
  memset(&p, 0, sizeof(p));
  const float* const* in = (const float* const*)d_in;
  p.x_prompt = in[0]; p.x_sample = in[1]; p.cache_k = in[2]; p.cache_v = in[3]; p.cache_lf = in[4]; p.state_ret = in[5];
  p.meta = in[6]; p.norm_mix = in[7]; p.norm_ffn = in[8]; p.fox_w_in = in[9]; p.fox_b_f = in[10]; p.fox_qn = in[11];
  p.fox_kn = in[12]; p.fox_w_out = in[13]; p.ret_w_in = in[14]; p.ret_gn = in[15]; p.ret_w_out = in[16];
  p.peer_wq = in[17]; p.peer_sk = in[18]; p.peer_u = in[19]; p.peer_v = in[20];
  p.out = (float*)d_out;
  char* w = (char*)d_ws;
  size_t off = 0;
  auto take = [&](size_t bytes) { char* r = w + off; off += (bytes + 255) & ~(size_t)255; return r; };
  p.X = (float*)take((size_t)TPAD * DM * 4);
  p.H = (u16*)take((size_t)TPAD * DM * 2);
  p.WfinT = (u16*)take((size_t)2 * 4224 * 1024 * 2);
  p.WfoutT = (u16*)take((size_t)2 * 1024 * 1024 * 2);
  p.WrinT = (u16*)take((size_t)2 * 6144 * 1024 * 2);
  p.WroutT = (u16*)take((size_t)2 * 1024 * 2048 * 2);
  p.WpqT = (u16*)take((size_t)4 * 2048 * 1024 * 2);
  p.SKb = (u16*)take((size_t)4 * 8 * 2 * 128 * 128 * 2);
  p.Ub = (u16*)take((size_t)NEXP * DM * 2);
  p.Vb = (u16*)take((size_t)NEXP * DM * 2);
  p.SV = (float*)take((size_t)TPAD * 256 * 4);
  p.SI = (int*)take((size_t)TPAD * 256 * 4);
  p.LFC = (float*)take((size_t)TPAD * 16 * 4);
  p.LFR = (float*)take((size_t)TPAD * 16 * 4);
  p.TT = (float*)take((size_t)MTILES * 16 * 4);
  size_t region = off;
  p.Qf = (u16*)take((size_t)TPAD * DM * 2);
  p.Kf = (u16*)take((size_t)TPAD * DM * 2);
  p.VtF = (u16*)take((size_t)1024 * TPAD * 2);
  p.OGf = (u16*)take((size_t)TPAD * DM * 2);
  p.AO = (u16*)take((size_t)TPAD * DM * 2);
  off = region;
  p.Qr = (u16*)take((size_t)TP2 * DM * 2);
  p.Kr = (u16*)take((size_t)TP2 * DM * 2);
  p.KrT = (u16*)take((size_t)1024 * TP2 * 2);
  p.VrT = (u16*)take((size_t)2048 * TP2 * 2);
  p.Gr = (u16*)take((size_t)TPAD * 2048 * 2);
  p.ST = (u16*)take((size_t)NCH * 4 * 512 * 256 * 2);
  if (off > ws_size) { fprintf(stderr, "workspace too small: need %zu have %zu\n", off, ws_size); return; }
  for (int i = 0; i < 128; ++i) p.rope_rev[i] = (float)(pow(10000.0, -(double)i / 128.0) / (2.0 * M_PI));
#if ONE_LAUNCH
  int ph0 = 0, ph1 = NPHASE;
  void* args[] = {&p, &ph0, &ph1};
  hipError_t e = hipLaunchCooperativeKernel((void*)mega, dim3(grid_blocks), dim3(256), args, 0, stream);
  if (e != hipSuccess) fprintf(stderr, "cooperative launch failed: %s (grid %d)\n", hipGetErrorString(e), grid_blocks);
#else
  for (int ph = 0; ph < DBG_PHASES; ++ph) mega<<<grid_blocks, 256, 0, stream>>>(p, ph, ph + 1);
  if (DBG_PHASES < NPHASE) mega<<<grid_blocks, 256, 0, stream>>>(p, 100, 101);
  if (DBG_POST) mega<<<grid_blocks, 256, 0, stream>>>(p, 101, 102);
#endif
}
```

```cpp
#include <hip/hip_runtime.h>
#include <hip/hip_cooperative_groups.h>
#include <stdint.h>
#include <math.h>
#include <stdio.h>
#include <string.h>
namespace cg = cooperative_groups;

typedef unsigned short u16;
typedef __attribute__((ext_vector_type(8))) short bf16x8;
typedef __attribute__((ext_vector_type(4))) float f32x4;
typedef __attribute__((ext_vector_type(2))) float f32x2;
typedef __attribute__((ext_vector_type(4))) unsigned int u32x4;
typedef __attribute__((ext_vector_type(2))) unsigned int u32x2;
#define DEV __device__ __forceinline__

#ifndef ONE_LAUNCH
#define ONE_LAUNCH 1
#endif

constexpr int DM = 1024;
constexpr int NMETA = 16;
constexpr int LP = 16400;
constexpr int NSMP = 128;
constexpr int TTOK = LP + NSMP;
constexpr int TPAD = 16640;
constexpr int MTILES = 130;
constexpr int LEAD = 48;
constexpr int TP2 = 16704;
constexpr int NCH = 257;
constexpr int PAST = 1024;
constexpr int NEXP = 16384;
constexpr float EPS = 1e-6f;

constexpr size_t O_YP = 0;
constexpr size_t O_YS = O_YP + (size_t)16384 * 1024;
constexpr size_t O_FKP = O_YS + (size_t)128 * 1024;
constexpr size_t O_FVP = O_FKP + (size_t)2 * LP * 1024;
constexpr size_t O_FLP = O_FVP + (size_t)2 * LP * 1024;
constexpr size_t O_SRP = O_FLP + (size_t)2 * LP * 16;
constexpr size_t O_FKS = O_SRP + (size_t)2 * 4 * 256 * 512;
constexpr size_t O_FVS = O_FKS + (size_t)2 * 128 * 1024;
constexpr size_t O_FLS = O_FVS + (size_t)2 * 128 * 1024;
constexpr size_t O_SRS = O_FLS + (size_t)2 * 128 * 16;

struct Params {
  const float *x_prompt, *x_sample, *cache_k, *cache_v, *cache_lf, *state_ret, *meta, *norm_mix, *norm_ffn;
  const float *fox_w_in, *fox_b_f, *fox_qn, *fox_kn, *fox_w_out, *ret_w_in, *ret_gn, *ret_w_out;
  const float *peer_wq, *peer_sk, *peer_u, *peer_v;
  float* out;
  float* X; u16* H;
  u16 *WfinT, *WfoutT, *WrinT, *WroutT, *WpqT, *SKb, *Ub, *Vb;
  float *SV; int* SI;
  float *LFC, *LFR, *TT; unsigned long long* SSQ;
  u16 *Qf, *Kf, *VtF, *OGf, *AO;
  u16 *Qr, *Kr, *KrT, *VrT, *Gr, *ST;
  float rope_rev[128];
};

DEV u16 f2bf(float f) {
  uint32_t u = __float_as_uint(f);
  u += 0x7fffu + ((u >> 16) & 1u);
  return (u16)(u >> 16);
}
DEV float bf2f(u16 h) { return __uint_as_float(((uint32_t)h) << 16); }
DEV uint32_t pack2(float a, float b) { return (uint32_t)f2bf(a) | ((uint32_t)f2bf(b) << 16); }
DEV float bflo(uint32_t u) { return __uint_as_float(u << 16); }
DEV float bfhi(uint32_t u) { return __uint_as_float(u & 0xffff0000u); }

union V8 { bf16x8 v; uint32_t u[4]; u32x2 d[2]; u32x4 q; };

DEV f32x4 mfma(bf16x8 a, bf16x8 b, f32x4 c) { return __builtin_amdgcn_mfma_f32_16x16x32_bf16(a, b, c, 0, 0, 0); }

template <int CTRL> DEV float dppf(float v) {
  return __int_as_float(__builtin_amdgcn_update_dpp(0, __float_as_int(v), CTRL, 0xf, 0xf, false));
}
template <int CTRL> DEV uint32_t dppu(uint32_t v) {
  return (uint32_t)__builtin_amdgcn_update_dpp(0, (int)v, CTRL, 0xf, 0xf, false);
}
DEV float row16_sum(float v) {
  v += dppf<0xB1>(v); v += dppf<0x4E>(v); v += dppf<0x141>(v); v += dppf<0x140>(v);
  return v;
}
DEV uint32_t row16_maxu(uint32_t v) {
  v = max(v, dppu<0xB1>(v)); v = max(v, dppu<0x4E>(v)); v = max(v, dppu<0x141>(v)); v = max(v, dppu<0x140>(v));
  return v;
}
DEV float rdlane(float v, int l) { float r = __int_as_float(__builtin_amdgcn_readlane(__float_as_int(v), l)); asm volatile("" : "+v"(r)); return r; }
DEV float wave_sum(float v) {
  v = row16_sum(v);
  return rdlane(v, 0) + rdlane(v, 16) + rdlane(v, 32) + rdlane(v, 48);
}
DEV float wave_max(float v) {
  v = fmaxf(v, dppf<0xB1>(v)); v = fmaxf(v, dppf<0x4E>(v)); v = fmaxf(v, dppf<0x141>(v)); v = fmaxf(v, dppf<0x140>(v));
  return fmaxf(fmaxf(rdlane(v, 0), rdlane(v, 16)), fmaxf(rdlane(v, 32), rdlane(v, 48)));
}
DEV uint32_t wave_maxu(uint32_t v) {
  v = row16_maxu(v);
  uint32_t a = (uint32_t)__builtin_amdgcn_readlane((int)v, 0), b = (uint32_t)__builtin_amdgcn_readlane((int)v, 16);
  uint32_t c = (uint32_t)__builtin_amdgcn_readlane((int)v, 32), d = (uint32_t)__builtin_amdgcn_readlane((int)v, 48);
  return max(max(a, b), max(c, d));
}
DEV uint32_t f2key(float f) { uint32_t u = __float_as_uint(f); return (u & 0x80000000u) ? ~u : (u | 0x80000000u); }
DEV float key2f(uint32_t k) { uint32_t u = (k & 0x80000000u) ? (k & 0x7fffffffu) : ~k; return __uint_as_float(u); }

DEV float sigmoidf_(float x) { return 1.f / (1.f + __expf(-x)); }
DEV float logsigmoid_(float x) { return fminf(x, 0.f) - log1pf(expf(-fabsf(x))); }
DEV float gelu_(float x) { return 0.5f * x * (1.f + erff(x * 0.70710678118654752f)); }
DEV float ret_l2g(int h) { return log2f(1.f - exp2f(-5.f - (float)h)); }
DEV int otid() { int t = threadIdx.x; asm volatile("" : "+v"(t)); return t; }
DEV size_t tix(int rows, int h, int row, int pp) { return ((size_t)(h * 261 + (pp >> 6)) * rows + row) * 64 + (pp & 63); }
DEV int perm_dorig(int dp) { return ((dp >> 4) & 1) * 128 + (dp >> 5) * 16 + (dp & 15); }

DEV void norm_rows(const Params& p, const float* gain, bool from_input) {
  int tid_ = otid();
  int lane = tid_ & 63;
  int gw = (blockIdx.x * blockDim.x + tid_) >> 6, nw = (gridDim.x * blockDim.x) >> 6;
  for (int t = gw; t < TPAD; t += nw) {
    const float* src;
    if (from_input) {
      if (t < NMETA) src = p.meta + (size_t)t * DM;
      else if (t < LP) src = p.x_prompt + (size_t)(t - NMETA) * DM;
      else if (t < TTOK) src = p.x_sample + (size_t)(t - LP) * DM;
      else src = nullptr;
    } else src = p.X + (size_t)t * DM;
    f32x4 v[4];
    float ss = 0.f;
#pragma unroll
    for (int c = 0; c < 4; ++c) {
      if (src) v[c] = *(const f32x4*)(src + c * 256 + lane * 4); else v[c] = f32x4{0.f, 0.f, 0.f, 0.f};
      ss += v[c].x * v[c].x + v[c].y * v[c].y + v[c].z * v[c].z + v[c].w * v[c].w;
    }
    ss = wave_sum(ss);
    float rstd = rsqrtf(ss * (1.f / DM) + EPS);
#pragma unroll
    for (int c = 0; c < 4; ++c) {
      if (from_input) *(f32x4*)(p.X + (size_t)t * DM + c * 256 + lane * 4) = v[c];
      f32x4 g = *(const f32x4*)(gain + c * 256 + lane * 4);
      u32x2 o;
      o.x = pack2(v[c].x * rstd * g.x, v[c].y * rstd * g.y);
      o.y = pack2(v[c].z * rstd * g.z, v[c].w * rstd * g.w);
      *(u32x2*)(p.H + (size_t)t * DM + c * 256 + lane * 4) = o;
    }
  }
}

DEV void convert_bf16(const float* src, u16* dst, size_t n4) {
  size_t i = (size_t)blockIdx.x * blockDim.x + otid(), st = (size_t)gridDim.x * blockDim.x;
  for (; i < n4; i += st) {
    f32x4 v = ((const f32x4*)src)[i];
    u32x2 o; o.x = pack2(v.x, v.y); o.y = pack2(v.z, v.w);
    ((u32x2*)dst)[i] = o;
  }
}

DEV void xpose(const float* W, int K, int N, int Npad, u16* Wt, bool permq, char* smem) {
  u16* tile = (u16*)smem;
  int tid = otid();
  int ntn = Npad / 64, ntk = K / 64;
  for (int it = blockIdx.x; it < ntn * ntk; it += gridDim.x) {
    int n0 = (it / ntk) * 64, k0 = (it % ntk) * 64;
    int c = tid & 63, r0 = tid >> 6;
    int np = n0 + c;
    int src = np;
    if (permq && np < 2048) src = (np & ~255) + perm_dorig(np & 255);
    __syncthreads();
#pragma unroll
    for (int i = 0; i < 16; ++i) {
      int k = r0 + 4 * i;
      float v = (np < N) ? W[(size_t)(k0 + k) * N + src] : 0.f;
      tile[c * 72 + k] = f2bf(v);
    }
    __syncthreads();
    int nl = tid >> 2, kq = (tid & 3) * 16;
    u32x4 a = *(const u32x4*)(tile + nl * 72 + kq);
    u32x4 b = *(const u32x4*)(tile + nl * 72 + kq + 8);
    *(u32x4*)(Wt + (size_t)(n0 + nl) * K + k0 + kq) = a;
    *(u32x4*)(Wt + (size_t)(n0 + nl) * K + k0 + kq + 8) = b;
  }
}

typedef __attribute__((ext_vector_type(2))) float v2f_t;
constexpr float U_SCALE = 64.f, V_SCALE = 16.f;
DEV void convert_fp8(const float* src, uint32_t* dst, size_t n4, float scale) {
  size_t i = (size_t)blockIdx.x * blockDim.x + otid(), st = (size_t)gridDim.x * blockDim.x;
  for (; i < n4; i += st) {
    f32x4 v = ((const f32x4*)src)[i];
    int w = __builtin_amdgcn_cvt_pk_fp8_f32(v.x * scale, v.y * scale, 0, false);
    w = __builtin_amdgcn_cvt_pk_fp8_f32(v.z * scale, v.w * scale, w, true);
    dst[i] = (uint32_t)w;
  }
}
DEV void conv_tables(const Params& p, int layer) {
  convert_fp8(p.peer_u + (size_t)layer * NEXP * DM, (uint32_t*)p.Ub, (size_t)NEXP * DM / 4, U_SCALE);
  convert_fp8(p.peer_v + (size_t)layer * NEXP * DM, (uint32_t*)p.Vb, (size_t)NEXP * DM / 4, V_SCALE);
}

DEV void ph_prep(const Params& p, char* smem) {
  norm_rows(p, p.norm_mix, true);
  convert_bf16(p.peer_sk, p.SKb, (size_t)4 * 8 * 2 * 128 * 128 / 4);
  for (int j = 0; j < 2; ++j) {
    xpose(p.fox_w_in + (size_t)j * 1024 * 4112, 1024, 4112, 4224, p.WfinT + (size_t)j * 4224 * 1024, false, smem);
    xpose(p.fox_w_out + (size_t)j * 1024 * 1024, 1024, 1024, 1024, p.WfoutT + (size_t)j * 1024 * 1024, false, smem);
    xpose(p.ret_w_in + (size_t)j * 1024 * 6144, 1024, 6144, 6144, p.WrinT + (size_t)j * 6144 * 1024, true, smem);
    xpose(p.ret_w_out + (size_t)j * 2048 * 1024, 2048, 1024, 1024, p.WroutT + (size_t)j * 1024 * 2048, false, smem);
  }
  for (int l = 0; l < 4; ++l)
    xpose(p.peer_wq + (size_t)l * 1024 * 2048, 1024, 2048, 2048, p.WpqT + (size_t)l * 2048 * 1024, false, smem);
}

DEV void tile_mn(int it, int NT, int& mt, int& nt) {
  const int GM = 8;
  int g = it / (GM * NT), r = it - g * (GM * NT);
  int gm = min(GM, MTILES - g * GM);
  nt = r / gm; mt = g * GM + (r - nt * gm);
}

constexpr int LDK = 72;
template <bool SWAP>
DEV void gemm_tile(const u16* __restrict__ A, int lda, const u16* __restrict__ Bt, int ldb, int K,
                          int m0, int n0, char* smem, f32x4 (&acc)[4][4]) {
  u16* sA = (u16*)smem;
  u16* sB = sA + 128 * LDK;
  int tid = otid(), lane = tid & 63, wid = tid >> 6;
  int wr = wid >> 1, wc = wid & 1, fr = lane & 15, fq = lane >> 4;
#pragma unroll
  for (int m = 0; m < 4; ++m)
#pragma unroll
    for (int n = 0; n < 4; ++n) acc[m][n] = f32x4{0.f, 0.f, 0.f, 0.f};
  u32x4 ra[4], rb[4];
  const u16* Ap = A + (size_t)(m0 + (tid >> 3)) * lda + (tid & 7) * 8;
  const u16* Bp = Bt + (size_t)(n0 + (tid >> 3)) * ldb + (tid & 7) * 8;
#pragma unroll
  for (int i = 0; i < 4; ++i) {
    ra[i] = *(const u32x4*)(Ap + (size_t)(32 * i) * lda);
    rb[i] = *(const u32x4*)(Bp + (size_t)(32 * i) * ldb);
  }
  for (int k0 = 0; k0 < K; k0 += 64) {
    __syncthreads();
#pragma unroll
    for (int i = 0; i < 4; ++i) {
      *(u32x4*)(sA + ((tid >> 3) + 32 * i) * LDK + (tid & 7) * 8) = ra[i];
      *(u32x4*)(sB + ((tid >> 3) + 32 * i) * LDK + (tid & 7) * 8) = rb[i];
    }
    __syncthreads();
    if (k0 + 64 < K) {
#pragma unroll
      for (int i = 0; i < 4; ++i) {
        ra[i] = *(const u32x4*)(Ap + (size_t)(32 * i) * lda + k0 + 64);
        rb[i] = *(const u32x4*)(Bp + (size_t)(32 * i) * ldb + k0 + 64);
      }
    }
#pragma unroll
    for (int ks = 0; ks < 2; ++ks) {
      bf16x8 af[4], bfv[4];
#pragma unroll
      for (int m = 0; m < 4; ++m) af[m] = *(const bf16x8*)(sA + (wr * 64 + m * 16 + fr) * LDK + ks * 32 + fq * 8);
#pragma unroll
      for (int n = 0; n < 4; ++n) bfv[n] = *(const bf16x8*)(sB + (wc * 64 + n * 16 + fr) * LDK + ks * 32 + fq * 8);
#pragma unroll
      for (int m = 0; m < 4; ++m)
#pragma unroll
        for (int n = 0; n < 4; ++n) acc[m][n] = SWAP ? mfma(bfv[n], af[m], acc[m][n]) : mfma(af[m], bfv[n], acc[m][n]);
    }
  }
}

DEV void ph_f1(const Params& p, int jf, char* smem) {
  for (int i = blockIdx.x * blockDim.x + otid(); i < TPAD; i += gridDim.x * blockDim.x) p.SSQ[i] = 0ull;
  const u16* Wt = p.WfinT + (size_t)jf * 4224 * 1024;
  int tid = otid(), lane = tid & 63, wid = tid >> 6;
  int wr = wid >> 1, wc = wid & 1, fr = lane & 15, fq = lane >> 4;
  const int NT = 33;
  for (int it = blockIdx.x; it < MTILES * NT; it += gridDim.x) {
    int mt, nt; tile_mn(it, NT, mt, nt);
    int m0 = mt * 128;
    f32x4 acc[4][4];
    int type = nt >> 3;
    if (type == 2 || type == 4) gemm_tile<false>(p.H, DM, Wt, DM, DM, m0, nt * 128, smem, acc);
    else gemm_tile<true>(p.H, DM, Wt, DM, DM, m0, nt * 128, smem, acc);
    if (type <= 1) {
      int hh = (nt & 7) * 2 + wc;
      const float* gn = (type == 0 ? p.fox_qn : p.fox_kn) + jf * 64;
      const float gs = (type == 0) ? 0.125f * 1.44269504089f : 1.f;
      f32x4 g[4];
#pragma unroll
      for (int n = 0; n < 4; ++n) g[n] = *(const f32x4*)(gn + n * 16 + fq * 4) * gs;
#pragma unroll
      for (int m = 0; m < 4; ++m) {
        float ss = 0.f;
#pragma unroll
        for (int n = 0; n < 4; ++n)
#pragma unroll
          for (int j = 0; j < 4; ++j) ss += acc[m][n][j] * acc[m][n][j];
        ss += __shfl_xor(ss, 16); ss += __shfl_xor(ss, 32);
        float rstd = rsqrtf(ss * (1.f / 64.f) + EPS);
        int row = m0 + wr * 64 + m * 16 + fr;
#pragma unroll
        for (int n = 0; n < 4; ++n) {
          f32x4 v = acc[m][n] * rstd * g[n];
          int col = hh * 64 + n * 16 + fq * 4;
          u32x2 o; o.x = pack2(v.x, v.y); o.y = pack2(v.z, v.w);
          if (type == 0) *(u32x2*)(p.Qf + (size_t)row * DM + col) = o;
          else {
            *(u32x2*)(p.Kf + (size_t)row * DM + col) = o;
            if (row < LP) *(f32x4*)(p.out + O_FKP + ((size_t)jf * LP + row) * 1024 + col) = v;
            else if (row < TTOK) *(f32x4*)(p.out + O_FKS + ((size_t)jf * 128 + (row - LP)) * 1024 + col) = v;
          }
        }
      }
    } else if (type == 2) {
      int hh = (nt & 7) * 2 + wc;
#pragma unroll
      for (int m = 0; m < 4; ++m) {
        int rb = m0 + wr * 64 + m * 16 + fq * 4;
#pragma unroll
        for (int n = 0; n < 4; ++n) {
          int d = n * 16 + fr;
          u32x2 o; o.x = pack2(acc[m][n][0], acc[m][n][1]); o.y = pack2(acc[m][n][2], acc[m][n][3]);
          *(u32x2*)(p.VtF + (size_t)(hh * 64 + d) * TPAD + rb) = o;
#pragma unroll
          for (int j = 0; j < 4; ++j) {
            int row = rb + j; int col = hh * 64 + d;
            if (row < LP) p.out[O_FVP + ((size_t)jf * LP + row) * 1024 + col] = acc[m][n][j];
            else if (row < TTOK) p.out[O_FVS + ((size_t)jf * 128 + (row - LP)) * 1024 + col] = acc[m][n][j];
          }
        }
      }
    } else if (type == 3) {
#pragma unroll
      for (int m = 0; m < 4; ++m)
#pragma unroll
        for (int n = 0; n < 4; ++n) {
          int row = m0 + wr * 64 + m * 16 + fr;
          int col = (nt - 24) * 128 + wc * 64 + n * 16 + fq * 4;
          u32x2 o; o.x = pack2(acc[m][n][0], acc[m][n][1]); o.y = pack2(acc[m][n][2], acc[m][n][3]);
          *(u32x2*)(p.OGf + (size_t)row * DM + col) = o;
        }
    } else {
      float* lfs = (float*)smem;
      __syncthreads();
      if (wc == 0) {
        float bf = p.fox_b_f[jf * 16 + fr];
#pragma unroll
        for (int m = 0; m < 4; ++m)
#pragma unroll
          for (int j = 0; j < 4; ++j) {
            int rl = wr * 64 + m * 16 + fq * 4 + j;
            int row = m0 + rl;
            float lf = logsigmoid_(acc[m][0][j] + bf);
            lfs[rl * 16 + fr] = lf;
            p.LFR[(size_t)row * 16 + fr] = lf;
            if (row < LP) p.out[O_FLP + ((size_t)jf * LP + row) * 16 + fr] = lf;
            else if (row < TTOK) p.out[O_FLS + ((size_t)jf * 128 + (row - LP)) * 16 + fr] = lf;
          }
      }
      __syncthreads();
      if (tid < 16) {
        float run = 0.f;
        for (int r = 0; r < 128; ++r) {
          run += lfs[r * 16 + tid];
          p.LFC[(size_t)(m0 + r) * 16 + tid] = run;
        }
        p.TT[mt * 16 + tid] = run;
      }
    }
  }
}

DEV void f2_prompt(const Params& p, int qt, int h, char* smem) {
  u16* Ks = (u16*)smem;
  u16* Vs = Ks + 2 * 64 * LDK;
  float* cs = (float*)(Vs + 2 * 64 * LDK);
  float* off = cs + 128;
  float* tmp = off + 132;
  int tid = otid(), lane = tid & 63, wid = tid >> 6, fr = lane & 15, fq = lane >> 4;
  __syncthreads();
  if (tid < MTILES) tmp[tid] = p.TT[tid * 16 + h];
  __syncthreads();
  if (tid < MTILES) { float s = 0.f; for (int m = 0; m < tid; ++m) s += tmp[m]; off[tid] = s; }
  __syncthreads();
  int q0 = qt * 256 + wid * 64;
  bf16x8 qf[4][2];
  float cq[4], lrow[4];
  f32x4 o[4][4];
#pragma unroll
  for (int qi = 0; qi < 4; ++qi) {
    int q = q0 + qi * 16 + fr;
#pragma unroll
    for (int ks = 0; ks < 2; ++ks) qf[qi][ks] = *(const bf16x8*)(p.Qf + (size_t)q * DM + h * 64 + ks * 32 + fq * 8);
    cq[qi] = (p.LFC[(size_t)q * 16 + h] + off[q >> 7] - 12.f) * 1.44269504089f;
    lrow[qi] = 0.f;
#pragma unroll
    for (int dt = 0; dt < 4; ++dt) o[dt][qi] = f32x4{0.f, 0.f, 0.f, 0.f};
  }
  int nkt = 4 * (qt + 1);
  if (nkt > (LP + 63) / 64) nkt = (LP + 63) / 64;
  bool wave_valid = q0 < LP;
  u32x4 rk[2], rv[2]; float rc = 0.f;
  const int lrow_ = tid >> 2, lcol = (tid & 3) * 16;
  const u16* kfb = p.Kf + h * 64;
  const u16* vtb = p.VtF + (size_t)h * 64 * TPAD;
  const float* lcb = p.LFC + h;
  const unsigned kvo0 = (unsigned)(lrow_ * DM + lcol), kvo1 = kvo0 + 32u * DM;
  const unsigned vvo0 = (unsigned)(lrow_ * TPAD + lcol), vvo1 = vvo0 + 32u * TPAD;
#define GL(kt_) { int key0_ = (kt_) * 64; \
    const u16* kp_ = p.Kf + (size_t)(key0_ + lrow_) * DM + h * 64 + lcol; \
    const u16* vp_ = p.VtF + (size_t)(h * 64 + lrow_) * TPAD + key0_ + lcol; \
    rk[0] = *(const u32x4*)(kp_); rk[1] = *(const u32x4*)(kp_ + 8); \
    rv[0] = *(const u32x4*)(vp_); rv[1] = *(const u32x4*)(vp_ + 8); \
    if (tid < 64) rc = (p.LFC[(size_t)(key0_ + tid) * 16 + h] + off[(key0_ + tid) >> 7]) * 1.44269504089f; }
  GL(0);
  for (int kt = 0; kt < nkt; ++kt) {
    int buf = kt & 1;
    u16* Kb = Ks + buf * 64 * LDK; u16* Vb = Vs + buf * 64 * LDK; float* cb = cs + buf * 64;
#pragma unroll
    for (int i = 0; i < 2; ++i) {
      *(u32x4*)(Kb + lrow_ * LDK + lcol + 8 * i) = rk[i];
      *(u32x4*)(Vb + lrow_ * LDK + lcol + 8 * i) = rv[i];
    }
    if (tid < 64) cb[tid] = rc;
    __syncthreads();
    if (kt + 1 < nkt) GL(kt + 1);
    int key0 = kt * 64;
    if (wave_valid && key0 <= q0 + 63) {
      bool diag = (key0 + 63 > q0);
#pragma unroll
      for (int pp = 0; pp < 2; ++pp) {
        V8 pfu[4];
#pragma unroll
        for (int kl = 0; kl < 2; ++kl) {
          f32x4 s1[4];
#pragma unroll
          for (int qi = 0; qi < 4; ++qi) s1[qi] = f32x4{0.f, 0.f, 0.f, 0.f};
#pragma unroll
          for (int ks = 0; ks < 2; ++ks) {
            bf16x8 a = *(const bf16x8*)(Kb + ((2 * pp + kl) * 16 + fr) * LDK + ks * 32 + fq * 8);
#pragma unroll
            for (int qi = 0; qi < 4; ++qi) s1[qi] = mfma(a, qf[qi][ks], s1[qi]);
          }
          f32x4 ck = *(const f32x4*)(cb + (2 * pp + kl) * 16 + fq * 4);
#pragma unroll
          for (int qi = 0; qi < 4; ++qi) {
            int q = q0 + qi * 16 + fr;
            float e[4];
#pragma unroll
            for (int j = 0; j < 4; ++j) {
              float v = s1[qi][j] + (cq[qi] - ck[j]);
              if (diag && (key0 + (2 * pp + kl) * 16 + fq * 4 + j > q)) v = -INFINITY;
              e[j] = __builtin_amdgcn_exp2f(v);
            }
            lrow[qi] += (e[0] + e[1]) + (e[2] + e[3]);
            pfu[qi].u[kl * 2 + 0] = pack2(e[0], e[1]);
            pfu[qi].u[kl * 2 + 1] = pack2(e[2], e[3]);
          }
        }
        bf16x8 pf[4];
#pragma unroll
        for (int qi = 0; qi < 4; ++qi) pf[qi] = pfu[qi].v;
#pragma unroll
        for (int dt = 0; dt < 4; ++dt) {
          V8 a;
          a.d[0] = *(const u32x2*)(Vb + (dt * 16 + fr) * LDK + (2 * pp) * 16 + fq * 4);
          a.d[1] = *(const u32x2*)(Vb + (dt * 16 + fr) * LDK + (2 * pp + 1) * 16 + fq * 4);
#pragma unroll
          for (int qi = 0; qi < 4; ++qi) o[dt][qi] = mfma(a.v, pf[qi], o[dt][qi]);
        }
      }
    }
  }
  int q0e = q0;
  asm volatile("" : "+v"(q0e));
#pragma unroll
  for (int qi = 0; qi < 4; ++qi) {
    float l = lrow[qi];
    l += __shfl_xor(l, 16); l += __shfl_xor(l, 32);
    float inv = 1.f / l;
    int q = q0e + qi * 16 + fr;
    if (q < LP) {
#pragma unroll
      for (int dt = 0; dt < 4; ++dt) {
        int d = dt * 16 + fq * 4;
        u32x2 og = *(const u32x2*)(p.OGf + (size_t)q * DM + h * 64 + d);
        u32x2 r;
        r.x = pack2(o[dt][qi][0] * inv * sigmoidf_(bflo(og.x)), o[dt][qi][1] * inv * sigmoidf_(bfhi(og.x)));
        r.y = pack2(o[dt][qi][2] * inv * sigmoidf_(bflo(og.y)), o[dt][qi][3] * inv * sigmoidf_(bfhi(og.y)));
        *(u32x2*)(p.AO + (size_t)q * DM + h * 64 + d) = r;
      }
    }
  }
}

DEV void f2_sample(const Params& p, int jf, int b, int h, int qh, char* smem) {
  constexpr int NK = PAST + 16;
  float* S = (float*)smem;
  float* qs = S + 8 * NK;
  float* cc = qs + 8 * 64;
  float* part = cc + NK;
  float* invl = part + 256;
  int tid = otid(), lane = tid & 63, wid = tid >> 6;
  __syncthreads();
  for (int e = tid; e < 512; e += 256) {
    int i = e >> 6, d = e & 63;
    qs[e] = bf2f(p.Qf[(size_t)(LP + b * 16 + qh * 8 + i) * DM + h * 64 + d]);
  }
  float lv[5]; float run = 0.f;
#pragma unroll
  for (int u = 0; u < 5; ++u) {
    int j = tid * 5 + u;
    float v = 0.f;
    if (j < PAST) v = p.cache_lf[(((size_t)jf * 8 + b) * PAST + j) * 16 + h];
    else if (j < NK) v = p.LFR[(size_t)(LP + b * 16 + (j - PAST)) * 16 + h];
    run += v; lv[u] = run;
  }
  part[tid] = run;
  __syncthreads();
  float base = 0.f;
  for (int m = 0; m < tid; ++m) base += part[m];
#pragma unroll
  for (int u = 0; u < 5; ++u) { int j = tid * 5 + u; if (j < NK) cc[j] = base + lv[u]; }
  __syncthreads();
  for (int j = tid; j < NK; j += 256) {
    const float* kp;
    if (j < PAST) kp = p.cache_k + ((((size_t)jf * 8 + b) * PAST + j) * 16 + h) * 64;
    else kp = p.out + O_FKS + (((size_t)jf * 128 + b * 16 + (j - PAST)) * 16 + h) * 64;
    f32x4 kv[16];
#pragma unroll
    for (int c = 0; c < 16; ++c) kv[c] = ((const f32x4*)kp)[c];
    float cj = cc[j];
#pragma unroll
    for (int i = 0; i < 8; ++i) {
      float a = 0.f;
#pragma unroll
      for (int c = 0; c < 16; ++c) {
        f32x4 qv = *(const f32x4*)(qs + i * 64 + c * 4);
        a += qv.x * kv[c].x + qv.y * kv[c].y + qv.z * kv[c].z + qv.w * kv[c].w;
      }
      int qi = qh * 8 + i;
      a = a * 0.69314718056f + (cc[PAST + qi] - cj);
      if (j > PAST + qi) a = -INFINITY;
      S[i * NK + j] = a;
    }
  }
  __syncthreads();
  for (int i = wid * 2; i < wid * 2 + 2; ++i) {
    float m = -INFINITY;
    for (int j = lane; j < NK; j += 64) m = fmaxf(m, S[i * NK + j]);
    m = wave_max(m);
    float l = 0.f;
    for (int j = lane; j < NK; j += 64) { float e = __expf(S[i * NK + j] - m); S[i * NK + j] = e; l += e; }
    l = wave_sum(l);
    if (lane == 0) invl[i] = 1.f / l;
  }
  __syncthreads();
  {
    int i = tid >> 5, dq = tid & 31;
    float o0 = 0.f, o1 = 0.f;
    const float* vb = p.cache_v + ((((size_t)jf * 8 + b) * PAST) * 16 + h) * 64 + dq * 2;
#pragma unroll 8
    for (int j = 0; j < PAST; ++j) {
      f32x2 v = *(const f32x2*)(vb + (size_t)j * 1024);
      float pj = S[i * NK + j];
      o0 += pj * v.x; o1 += pj * v.y;
    }
    const float* vn = p.out + O_FVS + (((size_t)jf * 128 + b * 16) * 16 + h) * 64 + dq * 2;
#pragma unroll
    for (int j = 0; j < 16; ++j) {
      f32x2 v = *(const f32x2*)(vn + (size_t)j * 1024);
      float pj = S[i * NK + PAST + j];
      o0 += pj * v.x; o1 += pj * v.y;
    }
    int row = LP + b * 16 + qh * 8 + i;
    float il = invl[i];
    uint32_t og = *(const uint32_t*)(p.OGf + (size_t)row * DM + h * 64 + dq * 2);
    *(uint32_t*)(p.AO + (size_t)row * DM + h * 64 + dq * 2) = pack2(o0 * il * sigmoidf_(bflo(og)), o1 * il * sigmoidf_(bfhi(og)));
  }
}

DEV void ph_f2(const Params& p, int jf, char* smem) {
  const int NP = 65 * 16, NI = NP + 256;
  int G = gridDim.x;
  {
    int gt = blockIdx.x * blockDim.x + otid(), gs = gridDim.x * blockDim.x;
    for (int i = gt; i < (TPAD - TTOK) * DM / 2; i += gs) ((uint32_t*)(p.AO + (size_t)TTOK * DM))[i] = 0u;
  }
  for (int r = 0;; ++r) {
    int pos = (r & 1) ? (G - 1 - (int)blockIdx.x) : (int)blockIdx.x;
    int idx = r * G + pos;
    if (r * G >= NI) break;
    if (idx >= NI) continue;
    if (idx < NP) f2_prompt(p, 64 - idx / 16, idx % 16, smem);
    else { int s = idx - NP; f2_sample(p, jf, s >> 5, (s >> 1) & 15, s & 1, smem); }
  }
  conv_tables(p, jf * 2);
}

DEV void ph_outproj(const Params& p, const u16* A, int K, const u16* Wt, const float* gffn, char* smem) {
  int tid = otid(), lane = tid & 63, wid = tid >> 6;
  int wr = wid >> 1, wc = wid & 1, fr = lane & 15, fq = lane >> 4;
  for (int it = blockIdx.x; it < MTILES * 8; it += gridDim.x) {
    int mt, nt; tile_mn(it, 8, mt, nt);
    f32x4 acc[4][4];
    gemm_tile<true>(A, K, Wt, K, K, mt * 128, nt * 128, smem, acc);
#pragma unroll
    for (int m = 0; m < 4; ++m) {
      int row = mt * 128 + wr * 64 + m * 16 + fr;
      float ss = 0.f;
#pragma unroll
      for (int n = 0; n < 4; ++n) {
        int col = nt * 128 + wc * 64 + n * 16 + fq * 4;
        f32x4* xp = (f32x4*)(p.X + (size_t)row * DM + col);
        f32x4 xn = *xp + acc[m][n];
        *xp = xn;
        f32x4 g = *(const f32x4*)(gffn + col);
        u32x2 o; o.x = pack2(xn.x * g.x, xn.y * g.y); o.y = pack2(xn.z * g.z, xn.w * g.w);
        *(u32x2*)(p.H + (size_t)row * DM + col) = o;
        ss += xn.x * xn.x + xn.y * xn.y + xn.z * xn.z + xn.w * xn.w;
      }
      ss += __shfl_xor(ss, 16); ss += __shfl_xor(ss, 32);
      if (fq == 0) atomicAdd(p.SSQ + row, (unsigned long long)(ss * 1048576.f + 0.5f));
    }
  }
}

DEV void ph_r1(const Params& p, int jr, char* smem) {
  const u16* Wt = p.WrinT + (size_t)jr * 6144 * 1024;
  int tid = otid(), lane = tid & 63, wid = tid >> 6;
  int wr = wid >> 1, wc = wid & 1, fr = lane & 15, fq = lane >> 4;
  {
    int gt = blockIdx.x * blockDim.x + tid, gs = gridDim.x * blockDim.x;
    for (int i = gt; i < LEAD * DM; i += gs) { p.Qr[i] = 0; p.Kr[i] = 0; }
    for (int i = gt; i < TPAD; i += gs) p.SSQ[i] = 0ull;
    for (int i = gt; i < 1024 * LEAD; i += gs) p.KrT[tix(256, (i / LEAD) >> 8, (i / LEAD) & 255, i % LEAD)] = 0;
    for (int i = gt; i < 2048 * LEAD; i += gs) p.VrT[tix(512, (i / LEAD) >> 9, (i / LEAD) & 511, i % LEAD)] = 0;
  }
  const int NT = 48;
  for (int it = blockIdx.x; it < MTILES * NT; it += gridDim.x) {
    int mt, nt; tile_mn(it, NT, mt, nt);
    int m0 = mt * 128;
    f32x4 acc[4][4];
    if (nt >= 8 && nt < 32) gemm_tile<false>(p.H, DM, Wt, DM, DM, m0, nt * 128, smem, acc);
    else gemm_tile<true>(p.H, DM, Wt, DM, DM, m0, nt * 128, smem, acc);
    if (nt < 8) {
      int hh = nt >> 1, half = nt & 1;
#pragma unroll
      for (int pr = 0; pr < 2; ++pr) {
        int g = half * 4 + wc * 2 + pr;
        f32x4 rr = *(const f32x4*)(p.rope_rev + g * 16 + fq * 4);
#pragma unroll
        for (int m = 0; m < 4; ++m) {
          int row = m0 + wr * 64 + m * 16 + fr;
          int pos = (row < LP) ? (row - NMETA) : ((row < TTOK) ? (PAST + ((row - LP) & 15)) : 0);
          float o1[4], o2[4];
#pragma unroll
          for (int j = 0; j < 4; ++j) {
            float rev = (float)pos * rr[j];
            rev -= floorf(rev);
            float sn = __builtin_amdgcn_sinf(rev), cs = __builtin_amdgcn_cosf(rev);
            float x1 = acc[m][2 * pr][j], x2 = acc[m][2 * pr + 1][j];
            o1[j] = (x1 * cs - x2 * sn) * 0.0625f; o2[j] = (x1 * sn + x2 * cs) * 0.0625f;
          }
          u32x2 t1, t2;
          t1.x = pack2(o1[0], o1[1]); t1.y = pack2(o1[2], o1[3]);
          t2.x = pack2(o2[0], o2[1]); t2.y = pack2(o2[2], o2[3]);
          u16* dq = p.Qr + (size_t)(row + LEAD) * DM + hh * 256 + g * 32 + fq * 4;
          *(u32x2*)dq = t1;
          *(u32x2*)(dq + 16) = t2;
        }
      }
    } else if (nt < 16) {
      bool isq = false;
      int hh = (nt & 7) >> 1, half = nt & 1;
      float l2g = ret_l2g(hh);
      u16* dst = isq ? p.Qr : p.Kr;
#pragma unroll
      for (int pr = 0; pr < 2; ++pr) {
        int g = half * 4 + wc * 2 + pr;
        int fi = g * 16 + fr;
        float rr = p.rope_rev[fi];
        int dp1 = g * 32 + fr, dp2 = dp1 + 16;
#pragma unroll
        for (int m = 0; m < 4; ++m) {
          int rb = m0 + wr * 64 + m * 16 + fq * 4;
          float o1[4], o2[4];
#pragma unroll
          for (int j = 0; j < 4; ++j) {
            int row = rb + j;
            int pos = (row < LP) ? (row - NMETA) : ((row < TTOK) ? (PAST + ((row - LP) & 15)) : 0);
            float rev = (float)pos * rr;
            rev -= floorf(rev);
            float sn = __builtin_amdgcn_sinf(rev), cs = __builtin_amdgcn_cosf(rev);
            float x1 = acc[m][2 * pr][j], x2 = acc[m][2 * pr + 1][j];
            float a = x1 * cs - x2 * sn, bb = x1 * sn + x2 * cs;
            if (isq) { a *= 0.0625f; bb *= 0.0625f; }
            o1[j] = a; o2[j] = bb;
            dst[(size_t)(row + LEAD) * DM + hh * 256 + dp1] = f2bf(a);
            dst[(size_t)(row + LEAD) * DM + hh * 256 + dp2] = f2bf(bb);
          }
          if (!isq) {
            float dc[4];
#pragma unroll
            for (int j = 0; j < 4; ++j) dc[j] = exp2f(l2g * (float)(63 - ((rb + j + LEAD) & 63)));
            u32x2 t1, t2;
            t1.x = pack2(o1[0] * dc[0], o1[1] * dc[1]); t1.y = pack2(o1[2] * dc[2], o1[3] * dc[3]);
            t2.x = pack2(o2[0] * dc[0], o2[1] * dc[1]); t2.y = pack2(o2[2] * dc[2], o2[3] * dc[3]);
            *(u32x2*)(p.KrT + tix(256, hh, dp1, rb + LEAD)) = t1;
            *(u32x2*)(p.KrT + tix(256, hh, dp2, rb + LEAD)) = t2;
          }
        }
      }
    } else if (nt < 32) {
      int hh = (nt - 16) >> 2;
#pragma unroll
      for (int m = 0; m < 4; ++m) {
        int rb = m0 + wr * 64 + m * 16 + fq * 4;
#pragma unroll
        for (int n = 0; n < 4; ++n) {
          int e = ((nt - 16) & 3) * 128 + wc * 64 + n * 16 + fr;
          u32x2 o; o.x = pack2(acc[m][n][0], acc[m][n][1]); o.y = pack2(acc[m][n][2], acc[m][n][3]);
          *(u32x2*)(p.VrT + tix(512, hh, e, rb + LEAD)) = o;
        }
      }
    } else {
#pragma unroll
      for (int m = 0; m < 4; ++m)
#pragma unroll
        for (int n = 0; n < 4; ++n) {
          int row = m0 + wr * 64 + m * 16 + fr;
          int col = (nt - 32) * 128 + wc * 64 + n * 16 + fq * 4;
          u32x2 o; o.x = pack2(acc[m][n][0], acc[m][n][1]); o.y = pack2(acc[m][n][2], acc[m][n][3]);
          *(u32x2*)(p.Gr + (size_t)row * 2048 + col) = o;
        }
    }
  }
}

DEV void ph_r2(const Params& p, int jr) {
  int tid = otid(), lane = tid & 63, wid = tid >> 6, fr = lane & 15, fq = lane >> 4;
  for (int it = blockIdx.x; it < 64; it += gridDim.x) {
    int h = it >> 4, sl = it & 15;
    float dec64 = exp2f(ret_l2g(h) * 64.f);
    f32x4 st[4][2];
#pragma unroll
    for (int r = 0; r < 4; ++r)
#pragma unroll
      for (int c = 0; c < 2; ++c) st[r][c] = f32x4{0.f, 0.f, 0.f, 0.f};
    const u16* kbase = p.KrT + tix(256, h, wid * 64 + fr, 0) + fq * 8;
    const u16* vbase = p.VrT + tix(512, h, sl * 32 + fr, 0) + fq * 8;
    bf16x8 A0[8], B0[4], A1[8], B1[4], A2[8], B2[4];
#define R2_LOAD(A, B, n_) { \
    _Pragma("unroll") for (int r = 0; r < 4; ++r) _Pragma("unroll") for (int ks = 0; ks < 2; ++ks) \
      A[r * 2 + ks] = *(const bf16x8*)(kbase + (size_t)(n_) * (256 * 64) + r * 16 * 64 + ks * 32); \
    _Pragma("unroll") for (int c = 0; c < 2; ++c) _Pragma("unroll") for (int ks = 0; ks < 2; ++ks) \
      B[c * 2 + ks] = *(const bf16x8*)(vbase + (size_t)(n_) * (512 * 64) + c * 16 * 64 + ks * 32); }
#define R2_STEP(A, B, n_) { \
    { \
      _Pragma("unroll") for (int c = 0; c < 2; ++c) { \
        u16* sp = p.ST + (((size_t)((n_) * 4 + h) * 16 + wid * 4) * 512 + sl * 32 + c * 16 + fr) * 16 + fq * 4; \
        _Pragma("unroll") for (int r = 0; r < 4; ++r) { \
          u32x2 o; o.x = pack2(st[r][c][0], st[r][c][1]); o.y = pack2(st[r][c][2], st[r][c][3]); \
          *(u32x2*)(sp + r * (512 * 16)) = o; } } } \
    _Pragma("unroll") for (int r = 0; r < 4; ++r) _Pragma("unroll") for (int c = 0; c < 2; ++c) { \
      f32x4 t = st[r][c] * dec64; \
      _Pragma("unroll") for (int ks = 0; ks < 2; ++ks) t = mfma(A[r * 2 + ks], B[c * 2 + ks], t); \
      st[r][c] = t; } }
    R2_LOAD(A0, B0, 0) R2_LOAD(A1, B1, 1) R2_LOAD(A2, B2, 2)
#pragma unroll 1
    for (int n = 0; n < 255; n += 3) {
      R2_STEP(A0, B0, n)
      R2_LOAD(A0, B0, min(n + 3, NCH - 1))
      R2_STEP(A1, B1, n + 1)
      R2_LOAD(A1, B1, min(n + 4, NCH - 1))
      R2_STEP(A2, B2, n + 2)
      R2_LOAD(A2, B2, min(n + 5, NCH - 1))
    }
    R2_STEP(A0, B0, 255)
    R2_STEP(A1, B1, 256)
    int fre = fr, fqe = fq;
    asm volatile("" : "+v"(fre), "+v"(fqe));
#pragma unroll
    for (int r = 0; r < 4; ++r)
#pragma unroll
      for (int c = 0; c < 2; ++c)
#pragma unroll
        for (int j = 0; j < 4; ++j) {
          int dorig = perm_dorig(wid * 64 + r * 16 + fqe * 4 + j);
          p.out[O_SRP + ((size_t)(jr * 4 + h) * 256 + dorig) * 512 + sl * 32 + c * 16 + fre] = st[r][c][j];
        }
  }
}

DEV void r3_prompt(const Params& p, int jr, int n, int h, char* smem) {
  u32x4* Sf = (u32x4*)smem;
  float* red = (float*)(smem + 8192);
  int tid = otid(), lane = tid & 63, w = tid >> 6, fr = lane & 15, fq = lane >> 4;
  int p0 = n * 64;
  float l2g = ret_l2g(h);
  f32x4 acc[8][4];
#pragma unroll
  for (int a = 0; a < 8; ++a)
#pragma unroll
    for (int b = 0; b < 4; ++b) acc[a][b] = f32x4{0.f, 0.f, 0.f, 0.f};
  const u16* qb = p.Qr + (size_t)(p0 + fr) * DM + h * 256 + fq * 8;
  if (n >= 1) {
    const u16* sb = p.ST + (((size_t)(n * 4 + h) * 16 + (fq >> 1)) * 512 + w * 128 + fr) * 16 + (fq & 1) * 8;
#pragma unroll 1
    for (int ks = 0; ks < 8; ++ks) {
      bf16x8 bq[4];
#pragma unroll
      for (int it = 0; it < 4; ++it) bq[it] = *(const bf16x8*)(qb + (size_t)(it * 16) * DM + ks * 32);
#pragma unroll
      for (int dvt = 0; dvt < 8; ++dvt) {
        bf16x8 a = *(const bf16x8*)(sb + (size_t)(ks * 2) * (512 * 16) + dvt * 16 * 16);
#pragma unroll
        for (int it = 0; it < 4; ++it) acc[dvt][it] = mfma(a, bq[it], acc[dvt][it]);
      }
    }
#pragma unroll
    for (int it = 0; it < 4; ++it) {
      float qd = exp2f(l2g * (float)(it * 16 + fr + 1));
#pragma unroll
      for (int dvt = 0; dvt < 8; ++dvt) acc[dvt][it] = acc[dvt][it] * qd;
    }
  }
  {
    f32x4 s[4];
#pragma unroll
    for (int jt = 0; jt < 4; ++jt) s[jt] = f32x4{0.f, 0.f, 0.f, 0.f};
    const u16* kb = p.Kr + (size_t)(p0 + fr) * DM + h * 256 + fq * 8;
#pragma unroll 1
    for (int ks = 0; ks < 8; ++ks) {
      bf16x8 b = *(const bf16x8*)(qb + (size_t)(w * 16) * DM + ks * 32);
#pragma unroll
      for (int jt = 0; jt < 4; ++jt) {
        bf16x8 a = *(const bf16x8*)(kb + (size_t)(jt * 16) * DM + ks * 32);
        s[jt] = mfma(a, b, s[jt]);
      }
    }
    int i = w * 16 + fr;
#pragma unroll
    for (int jt = 0; jt < 4; ++jt)
#pragma unroll
      for (int jj = 0; jj < 4; ++jj) {
        int j = jt * 16 + fq * 4 + jj;
        int dd = i > j ? i - j : j - i;
        s[jt][jj] *= exp2f(l2g * (float)dd);
      }
    __syncthreads();
#pragma unroll
    for (int pp = 0; pp < 2; ++pp) {
      u32x4 t;
      t.x = pack2(s[2 * pp][0], s[2 * pp][1]); t.y = pack2(s[2 * pp][2], s[2 * pp][3]);
      t.z = pack2(s[2 * pp + 1][0], s[2 * pp + 1][1]); t.w = pack2(s[2 * pp + 1][2], s[2 * pp + 1][3]);
      Sf[(w * 2 + pp) * 64 + lane] = t;
    }
    __syncthreads();
  }
  {
    const u16* vb = p.VrT + tix(512, h, w * 128 + fr, p0) + fq * 4;
#pragma unroll
    for (int pp = 0; pp < 2; ++pp) {
      V8 bs[4];
#pragma unroll
      for (int it = 0; it < 4; ++it) bs[it].q = Sf[(it * 2 + pp) * 64 + lane];
#pragma unroll
      for (int dvt = 0; dvt < 8; ++dvt) {
        V8 a;
        a.d[0] = *(const u32x2*)(vb + dvt * 16 * 64 + (2 * pp) * 16);
        a.d[1] = *(const u32x2*)(vb + dvt * 16 * 64 + (2 * pp + 1) * 16);
#pragma unroll
        for (int it = 0; it < 4; ++it) acc[dvt][it] = mfma(a.v, bs[it].v, acc[dvt][it]);
      }
    }
  }
  float mean[4], rstd[4];
  {
    float s1[4];
#pragma unroll
    for (int it = 0; it < 4; ++it) {
      float s = 0.f;
#pragma unroll
      for (int dvt = 0; dvt < 8; ++dvt) s += acc[dvt][it][0] + acc[dvt][it][1] + acc[dvt][it][2] + acc[dvt][it][3];
      s += __shfl_xor(s, 16); s += __shfl_xor(s, 32);
      s1[it] = s;
    }
    __syncthreads();
    if (fq == 0) {
#pragma unroll
      for (int it = 0; it < 4; ++it) red[w * 64 + it * 16 + fr] = s1[it];
    }
    __syncthreads();
#pragma unroll
    for (int it = 0; it < 4; ++it) {
      int i = it * 16 + fr;
      mean[it] = (red[i] + red[64 + i] + red[128 + i] + red[192 + i]) * (1.f / 512.f);
    }
#pragma unroll
    for (int it = 0; it < 4; ++it) {
      float s = 0.f;
#pragma unroll
      for (int dvt = 0; dvt < 8; ++dvt)
#pragma unroll
        for (int j = 0; j < 4; ++j) { float d = acc[dvt][it][j] - mean[it]; s += d * d; }
      s += __shfl_xor(s, 16); s += __shfl_xor(s, 32);
      s1[it] = s;
    }
    __syncthreads();
    if (fq == 0) {
#pragma unroll
      for (int it = 0; it < 4; ++it) red[w * 64 + it * 16 + fr] = s1[it];
    }
    __syncthreads();
#pragma unroll
    for (int it = 0; it < 4; ++it) {
      int i = it * 16 + fr;
      float var = (red[i] + red[64 + i] + red[128 + i] + red[192 + i]) * (1.f / 512.f);
      rstd[it] = rsqrtf(var + EPS);
    }
  }
#pragma unroll
  for (int it = 0; it < 4; ++it) {
    int t = p0 + it * 16 + fr - LEAD;
    if (t >= 0 && t < LP) {
#pragma unroll
      for (int dvt = 0; dvt < 8; ++dvt) {
        int e0 = h * 512 + w * 128 + dvt * 16 + fq * 4;
        u16* gp = p.Gr + (size_t)t * 2048 + e0;
        u32x2 g = *(const u32x2*)gp;
        f32x4 gn = *(const f32x4*)(p.ret_gn + jr * 2048 + e0);
        float g0 = bflo(g.x), g1 = bfhi(g.x), g2 = bflo(g.y), g3 = bfhi(g.y);
        float y0 = (acc[dvt][it][0] - mean[it]) * rstd[it] * gn.x * (g0 * sigmoidf_(g0));
        float y1 = (acc[dvt][it][1] - mean[it]) * rstd[it] * gn.y * (g1 * sigmoidf_(g1));
        float y2 = (acc[dvt][it][2] - mean[it]) * rstd[it] * gn.z * (g2 * sigmoidf_(g2));
        float y3 = (acc[dvt][it][3] - mean[it]) * rstd[it] * gn.w * (g3 * sigmoidf_(g3));
        u32x2 o; o.x = pack2(y0, y1); o.y = pack2(y2, y3);
        *(u32x2*)gp = o;
      }
    }
  }
}

DEV void r3_sample(const Params& p, int jr, int b, int h, char* smem) {
  float* obuf = (float*)smem;
  u16* qs = (u16*)(smem + 32768);
  u16* ks = qs + 16 * 256;
  float* sm = (float*)(smem + 49152);
  float* red = sm + 256;
  float* stat = red + 64;
  int tid = otid(), lane = tid & 63, wid = tid >> 6;
  float l2g = ret_l2g(h);
  int prow = LP + LEAD + b * 16;
  __syncthreads();
  for (int e = tid; e < 16 * 256; e += 256) {
    int i = e >> 8, d = e & 255;
    qs[e] = p.Qr[(size_t)(prow + i) * DM + h * 256 + d];
    ks[e] = p.Kr[(size_t)(prow + i) * DM + h * 256 + d];
  }
  __syncthreads();
  {
    int i = tid >> 4, j = tid & 15;
    float a = 0.f;
#pragma unroll 8
    for (int d = 0; d < 256; ++d) a += bf2f(qs[i * 256 + d]) * bf2f(ks[j * 256 + d]);
    int dd = i > j ? i - j : j - i;
    sm[tid] = a * exp2f(l2g * (float)dd);
  }
  __syncthreads();
  for (int e = tid; e < 16 * 256; e += 256) ks[e] = f2bf(bf2f(ks[e]) * exp2f(l2g * (float)(15 - (e >> 8))));
  __syncthreads();
  float dec16 = exp2f(l2g * 16.f);
  const float* stin = p.state_ret + ((size_t)(jr * 8 + b) * 4 + h) * 256 * 512;
  float* stout = p.out + O_SRS + ((size_t)(jr * 8 + b) * 4 + h) * 256 * 512;
#pragma unroll 1
  for (int c = 0; c < 2; ++c) {
    int e = tid + c * 256;
    float v[16], o[16];
    const u16* vp = p.VrT + tix(512, h, e, prow);
    u32x4 a = *(const u32x4*)vp, bq = *(const u32x4*)(vp + 8);
    v[0] = bflo(a.x); v[1] = bfhi(a.x); v[2] = bflo(a.y); v[3] = bfhi(a.y);
    v[4] = bflo(a.z); v[5] = bfhi(a.z); v[6] = bflo(a.w); v[7] = bfhi(a.w);
    v[8] = bflo(bq.x); v[9] = bfhi(bq.x); v[10] = bflo(bq.y); v[11] = bfhi(bq.y);
    v[12] = bflo(bq.z); v[13] = bfhi(bq.z); v[14] = bflo(bq.w); v[15] = bfhi(bq.w);
#pragma unroll
    for (int i = 0; i < 16; ++i) o[i] = 0.f;
#pragma unroll 2
    for (int dp = 0; dp < 256; ++dp) {
      int dorig = perm_dorig(dp);
      float s0 = stin[(size_t)dorig * 512 + e];
      float n0 = s0 * dec16;
#pragma unroll
      for (int i = 0; i < 16; ++i) {
        o[i] += bf2f(qs[i * 256 + dp]) * s0;
        n0 += bf2f(ks[i * 256 + dp]) * v[i];
      }
      stout[(size_t)dorig * 512 + e] = n0;
    }
#pragma unroll
    for (int i = 0; i < 16; ++i) obuf[i * 512 + e] = o[i] * exp2f(l2g * (float)(i + 1));
#pragma unroll 1
    for (int i = 0; i < 16; ++i) {
      float a0 = obuf[i * 512 + e];
#pragma unroll
      for (int j = 0; j < 16; ++j) a0 += sm[i * 16 + j] * v[j];
      obuf[i * 512 + e] = a0;
    }
  }
  __syncthreads();
  for (int i = 0; i < 16; ++i) {
    float s = wave_sum(obuf[i * 512 + tid] + obuf[i * 512 + 256 + tid]);
    if (lane == 0) red[wid * 16 + i] = s;
  }
  __syncthreads();
  if (tid < 16) stat[tid] = (red[tid] + red[16 + tid] + red[32 + tid] + red[48 + tid]) * (1.f / 512.f);
  __syncthreads();
  for (int i = 0; i < 16; ++i) {
    float mu = stat[i];
    float d0 = obuf[i * 512 + tid] - mu, d1 = obuf[i * 512 + 256 + tid] - mu;
    float s = wave_sum(d0 * d0 + d1 * d1);
    if (lane == 0) red[wid * 16 + i] = s;
  }
  __syncthreads();
  if (tid < 16) stat[16 + tid] = rsqrtf((red[tid] + red[16 + tid] + red[32 + tid] + red[48 + tid]) * (1.f / 512.f) + EPS);
  __syncthreads();
  for (int c = 0; c < 2; ++c) {
    int e = tid + c * 256;
    float gn = p.ret_gn[jr * 2048 + h * 512 + e];
    for (int i = 0; i < 16; ++i) {
      int t = LP + b * 16 + i;
      float g = bf2f(p.Gr[(size_t)t * 2048 + h * 512 + e]);
      float y = (obuf[i * 512 + e] - stat[i]) * stat[16 + i] * gn * (g * sigmoidf_(g));
      p.Gr[(size_t)t * 2048 + h * 512 + e] = f2bf(y);
    }
  }
}

DEV void ph_r3(const Params& p, int jr, char* smem) {
  const int NP = NCH * 4, NI = NP + 32;
  for (int it = blockIdx.x; it < NI; it += gridDim.x) {
    if (it < 32) r3_sample(p, jr, it >> 2, it & 3, smem);
    else { int q = it - 32; r3_prompt(p, jr, q >> 2, q & 3, smem); }
  }
}

DEV void ph_p2(const Params& p, int layer, char* smem) {
  const u16* Wt = p.WpqT + (size_t)layer * 2048 * 1024;
  u16* Qs = (u16*)smem;
  constexpr int LQ = 136;
  int tid = otid(), lane = tid & 63, wid = tid >> 6;
  int wr = wid >> 1, wc = wid & 1, fr = lane & 15, fq = lane >> 4;
  for (int it = blockIdx.x; it < MTILES * 16; it += gridDim.x) {
    int mt, hp; tile_mn(it, 16, mt, hp);
    int m0 = mt * 128;
    f32x4 acc[4][4];
    gemm_tile<true>(p.H, DM, Wt, DM, DM, m0, hp * 128, smem, acc);
    __syncthreads();
#pragma unroll
    for (int m = 0; m < 4; ++m) {
      float rs = rsqrtf((float)p.SSQ[m0 + wr * 64 + m * 16 + fr] * (1.f / (1048576.f * DM)) + EPS);
#pragma unroll
      for (int n = 0; n < 4; ++n) {
        u32x2 o; o.x = pack2(acc[m][n][0] * rs, acc[m][n][1] * rs); o.y = pack2(acc[m][n][2] * rs, acc[m][n][3] * rs);
        *(u32x2*)(Qs + (wr * 64 + m * 16 + fr) * LQ + wc * 64 + n * 16 + fq * 4) = o;
      }
    }
    __syncthreads();
    f32x4 sc[2][8];
#pragma unroll
    for (int rt = 0; rt < 2; ++rt)
#pragma unroll
      for (int ct = 0; ct < 8; ++ct) sc[rt][ct] = f32x4{0.f, 0.f, 0.f, 0.f};
    const u16* skb = p.SKb + ((size_t)(layer * 16 + hp) * 128 + fr) * 128 + fq * 8;
#pragma unroll
    for (int ks = 0; ks < 4; ++ks) {
      bf16x8 a[2];
#pragma unroll
      for (int rt = 0; rt < 2; ++rt) a[rt] = *(const bf16x8*)(Qs + (wid * 32 + rt * 16 + fr) * LQ + ks * 32 + fq * 8);
#pragma unroll
      for (int ct = 0; ct < 8; ++ct) {
        bf16x8 b = *(const bf16x8*)(skb + (size_t)(ct * 16) * 128 + ks * 32);
#pragma unroll
        for (int rt = 0; rt < 2; ++rt) sc[rt][ct] = mfma(a[rt], b, sc[rt][ct]);
      }
    }
#pragma unroll
    for (int rt = 0; rt < 2; ++rt)
#pragma unroll
      for (int j = 0; j < 4; ++j) {
        uint32_t key[8];
#pragma unroll
        for (int ct = 0; ct < 8; ++ct) key[ct] = (f2key(sc[rt][ct][j]) & ~127u) | (uint32_t)(127 - (ct * 16 + fr));
        uint32_t mine = 0;
#pragma unroll 1
        for (int r = 0; r < 16; ++r) {
          uint32_t best = key[0];
#pragma unroll
          for (int ct = 1; ct < 8; ++ct) best = max(best, key[ct]);
          best = row16_maxu(best);
#pragma unroll
          for (int ct = 0; ct < 8; ++ct) key[ct] = (key[ct] == best) ? 0u : key[ct];
          if (fr == r) mine = best;
        }
        int row = m0 + wid * 32 + rt * 16 + fq * 4 + j;
        p.SV[((size_t)row * 16 + hp) * 16 + fr] = key2f(mine & ~127u);
        p.SI[((size_t)row * 16 + hp) * 16 + fr] = 127 - (int)(mine & 127u);
      }
  }
}

DEV void ph_p3(const Params& p, int layer, char* smem) {
  int tid = otid(), lane = tid & 63, wid = tid >> 6;
  int* eidL = (int*)smem + wid * 256;
  float* gateL = (float*)(eidL + 128);
  int ca = 0, cb = 0; bool cvalid = false;
  {
    int cnt = 0;
    for (int a = 0; a < 16; ++a) {
      int nb = 16 / (a + 1);
      if (lane >= cnt && lane < cnt + nb) { ca = a; cb = lane - cnt; cvalid = true; }
      cnt += nb;
    }
  }
  int gw = (blockIdx.x * blockDim.x + tid) >> 6, nw = (gridDim.x * blockDim.x) >> 6;
  for (int t = gw; t < TTOK; t += nw) {
    const float* svp = p.SV + (size_t)t * 256;
    const int* sip = p.SI + (size_t)t * 256;
    for (int h = 0; h < 8; ++h) {
      float cand = cvalid ? (svp[h * 32 + ca] + svp[h * 32 + 16 + cb]) : 0.f;
      uint32_t key = cvalid ? ((f2key(cand) & ~63u) | (uint32_t)(63 - lane)) : 0u;
      uint32_t mine = 0;
#pragma unroll 1
      for (int r = 0; r < 16; ++r) {
        uint32_t best = wave_maxu(key);
        key = (key == best) ? 0u : key;
        if (lane == r) mine = best;
      }
      int src = 63 - (int)(mine & 63u);
      int wa = __shfl(ca, src), wb = __shfl(cb, src);
      float fv = key2f(mine & ~63u);
      float f0 = rdlane(fv, 0);
      float e = (lane < 16) ? __expf(fv - f0) : 0.f;
      float ssum = row16_sum(e);
      if (lane < 16) {
        int eid = sip[h * 32 + wa] * 128 + sip[h * 32 + 16 + wb];
        eidL[h * 16 + lane] = eid;
        gateL[h * 16 + lane] = e / ssum;
      }
    }
    float hf[16];
    {
      u32x4 ha = *(const u32x4*)(p.H + (size_t)t * DM + lane * 16);
      u32x4 hb = *(const u32x4*)(p.H + (size_t)t * DM + lane * 16 + 8);
      hf[0] = bflo(ha.x); hf[1] = bfhi(ha.x); hf[2] = bflo(ha.y); hf[3] = bfhi(ha.y);
      hf[4] = bflo(ha.z); hf[5] = bfhi(ha.z); hf[6] = bflo(ha.w); hf[7] = bfhi(ha.w);
      hf[8] = bflo(hb.x); hf[9] = bfhi(hb.x); hf[10] = bflo(hb.y); hf[11] = bfhi(hb.y);
      hf[12] = bflo(hb.z); hf[13] = bfhi(hb.z); hf[14] = bflo(hb.w); hf[15] = bfhi(hb.w);
      float rs = rsqrtf((float)p.SSQ[t] * (1.f / (1048576.f * DM)) + EPS);
#pragma unroll
      for (int i = 0; i < 16; ++i) hf[i] *= rs;
    }
    const unsigned char* U8 = (const unsigned char*)p.Ub + lane * 16;
    const unsigned char* V8p = (const unsigned char*)p.Vb + lane * 16;
#define P3_LOAD(buf, tab, base) _Pragma("unroll") for (int u = 0; u < 8; ++u) { \
      int eid_ = __builtin_amdgcn_readfirstlane(eidL[(base) + u]); \
      buf[u] = *(const u32x4*)((tab) + (size_t)eid_ * DM); }
#define P3_CVT(f, q) { v2f_t c_; \
      c_ = __builtin_amdgcn_cvt_pk_f32_fp8((int)(q).x, false); f[0] = c_.x; f[1] = c_.y; \
      c_ = __builtin_amdgcn_cvt_pk_f32_fp8((int)(q).x, true);  f[2] = c_.x; f[3] = c_.y; \
      c_ = __builtin_amdgcn_cvt_pk_f32_fp8((int)(q).y, false); f[4] = c_.x; f[5] = c_.y; \
      c_ = __builtin_amdgcn_cvt_pk_f32_fp8((int)(q).y, true);  f[6] = c_.x; f[7] = c_.y; \
      c_ = __builtin_amdgcn_cvt_pk_f32_fp8((int)(q).z, false); f[8] = c_.x; f[9] = c_.y; \
      c_ = __builtin_amdgcn_cvt_pk_f32_fp8((int)(q).z, true);  f[10] = c_.x; f[11] = c_.y; \
      c_ = __builtin_amdgcn_cvt_pk_f32_fp8((int)(q).w, false); f[12] = c_.x; f[13] = c_.y; \
      c_ = __builtin_amdgcn_cvt_pk_f32_fp8((int)(q).w, true);  f[14] = c_.x; f[15] = c_.y; }
#define P3_DOT(buf, base) _Pragma("unroll") for (int u = 0; u < 8; ++u) { \
      float f_[16]; P3_CVT(f_, buf[u]); float d_ = 0.f; \
      _Pragma("unroll") for (int i = 0; i < 16; ++i) d_ += hf[i] * f_[i]; \
      d_ = wave_sum(d_) * (1.f / U_SCALE); \
      int k_ = (base) + u; \
      if (lane == (k_ & 63)) { if (k_ < 64) w0 = d_; else w1 = d_; } }
#define P3_AXPY(buf, base) { float ws_ = ((base) < 64) ? w0 : w1; \
      _Pragma("unroll") for (int u = 0; u < 8; ++u) { \
        float f_[16]; P3_CVT(f_, buf[u]); float wk_ = rdlane(ws_, ((base) + u) & 63); \
        _Pragma("unroll") for (int i = 0; i < 16; ++i) oacc[i] += wk_ * f_[i]; } }
    float w0 = 0.f, w1 = 0.f;
    {
      u32x4 A[8], B[8];
      P3_LOAD(A, U8, 0)
#pragma unroll 1
      for (int kb = 0; kb < 128; kb += 16) {
        P3_LOAD(B, U8, kb + 8)
        P3_DOT(A, kb)
        if (kb + 16 < 128) { P3_LOAD(A, U8, kb + 16) }
        P3_DOT(B, kb + 8)
      }
    }
    w0 = gateL[lane] * gelu_(w0);
    w1 = gateL[64 + lane] * gelu_(w1);
    float oacc[16];
#pragma unroll
    for (int i = 0; i < 16; ++i) oacc[i] = 0.f;
    {
      u32x4 A[8], B[8];
      P3_LOAD(A, V8p, 0)
#pragma unroll 1
      for (int kb = 0; kb < 128; kb += 16) {
        P3_LOAD(B, V8p, kb + 8)
        P3_AXPY(A, kb)
        if (kb + 16 < 128) { P3_LOAD(A, V8p, kb + 16) }
        P3_AXPY(B, kb + 8)
      }
    }
    float* xr = p.X + (size_t)t * DM + lane * 16;
    f32x4 xv[4];
#pragma unroll
    for (int c = 0; c < 4; ++c) {
      xv[c] = *(const f32x4*)(xr + c * 4);
      xv[c].x += oacc[c * 4 + 0] * (1.f / V_SCALE); xv[c].y += oacc[c * 4 + 1] * (1.f / V_SCALE);
      xv[c].z += oacc[c * 4 + 2] * (1.f / V_SCALE); xv[c].w += oacc[c * 4 + 3] * (1.f / V_SCALE);
    }
    if (layer < 3) {
      float ss = 0.f;
#pragma unroll
      for (int c = 0; c < 4; ++c) {
        *(f32x4*)(xr + c * 4) = xv[c];
        ss += xv[c].x * xv[c].x + xv[c].y * xv[c].y + xv[c].z * xv[c].z + xv[c].w * xv[c].w;
      }
      ss = wave_sum(ss);
      float rstd = rsqrtf(ss * (1.f / DM) + EPS);
      const float* g = p.norm_mix + (size_t)(layer + 1) * DM + lane * 16;
      u32x4 o0, o1;
      f32x4 g0 = *(const f32x4*)(g), g1 = *(const f32x4*)(g + 4), g2 = *(const f32x4*)(g + 8), g3 = *(const f32x4*)(g + 12);
      o0.x = pack2(xv[0].x * rstd * g0.x, xv[0].y * rstd * g0.y); o0.y = pack2(xv[0].z * rstd * g0.z, xv[0].w * rstd * g0.w);
      o0.z = pack2(xv[1].x * rstd * g1.x, xv[1].y * rstd * g1.y); o0.w = pack2(xv[1].z * rstd * g1.z, xv[1].w * rstd * g1.w);
      o1.x = pack2(xv[2].x * rstd * g2.x, xv[2].y * rstd * g2.y); o1.y = pack2(xv[2].z * rstd * g2.z, xv[2].w * rstd * g2.w);
      o1.z = pack2(xv[3].x * rstd * g3.x, xv[3].y * rstd * g3.y); o1.w = pack2(xv[3].z * rstd * g3.z, xv[3].w * rstd * g3.w);
      *(u32x4*)(p.H + (size_t)t * DM + lane * 16) = o0;
      *(u32x4*)(p.H + (size_t)t * DM + lane * 16 + 8) = o1;
    } else {
      float* yo = nullptr;
      if (t >= NMETA && t < LP) yo = p.out + O_YP + (size_t)(t - NMETA) * DM + lane * 16;
      else if (t >= LP) yo = p.out + O_YS + (size_t)(t - LP) * DM + lane * 16;
      if (yo) {
#pragma unroll
        for (int c = 0; c < 4; ++c) *(f32x4*)(yo + c * 4) = xv[c];
      }
    }
  }
}

constexpr int NPHASE = 23;
#ifndef DBG_PHASES
#define DBG_PHASES NPHASE
#endif
#ifndef DBG_SCALES
#define DBG_SCALES {1,1,1,1,1,1,1,1,1,1,1,1,1,1,1,1,1,1,1,1}
#endif
#ifndef DBG_POST
#define DBG_POST 0
#endif
DEV void post_scale(const Params& p) {
  const float sc[20] = DBG_SCALES;
  const size_t offs[11] = {O_YP, O_YS, O_FKP, O_FVP, O_FLP, O_SRP, O_FKS, O_FVS, O_FLS, O_SRS, O_SRS + (size_t)2 * 8 * 4 * 256 * 512};
  size_t i0 = (size_t)blockIdx.x * blockDim.x + otid(), st = (size_t)gridDim.x * blockDim.x;
#pragma unroll
  for (int k = 0; k < 20; ++k) {
    float f = sc[k];
    if (f == 1.f) continue;
    size_t a = offs[k >> 1], b = offs[(k >> 1) + 1], mid = a + (b - a) / 2;
    size_t lo = (k & 1) ? mid : a, hi = (k & 1) ? b : mid;
    for (size_t i = lo + i0; i < hi; i += st) p.out[i] *= f;
  }
}
DEV void dump_x(const Params& p) {
  size_t i = (size_t)blockIdx.x * blockDim.x + otid(), st = (size_t)gridDim.x * blockDim.x;
  for (; i < (size_t)(TTOK - NMETA) * DM; i += st) p.out[i] = p.X[(size_t)NMETA * DM + i];
}
__global__ void __launch_bounds__(256, 2) mega(Params p, int ph0, int ph1) {
  __shared__ __attribute__((aligned(16))) char smem[53248];
  for (int ph = ph0; ph < ph1; ++ph) {
    if (ph > ph0) cg::this_grid().sync();
    if (ph == 0) { ph_prep(p, smem); continue; }
    int q = ph - 1, layer, idx;
    if (q < 5) { layer = 0; idx = q; } else if (q < 11) { layer = 1; idx = q - 5; }
    else if (q < 16) { layer = 2; idx = q - 11; } else { layer = 3; idx = q - 16; }
    int j = layer >> 1;
    const float* gffn = p.norm_ffn + (size_t)layer * DM;
    if ((layer & 1) == 0) {
      if (idx == 0) ph_f1(p, j, smem);
      else if (idx == 1) ph_f2(p, j, smem);
      else if (idx == 2) ph_outproj(p, p.AO, 1024, p.WfoutT + (size_t)j * 1024 * 1024, gffn, smem);
      else if (idx == 3) ph_p2(p, layer, smem);
      else ph_p3(p, layer, smem);
    } else {
      if (idx == 0) ph_r1(p, j, smem);
      else if (idx == 1) { ph_r2(p, j); conv_tables(p, layer); }
      else if (idx == 2) ph_r3(p, j, smem);
      else if (idx == 3) ph_outproj(p, p.Gr, 2048, p.WroutT + (size_t)j * 1024 * 2048, gffn, smem);
      else if (idx == 4) ph_p2(p, layer, smem);
      else ph_p3(p, layer, smem);
    }
  }
}

extern "C" void kernel_launch(void* const* d_in, const int* in_sizes, int n_in, void* d_out, int out_size,
                              void* d_ws, size_t ws_size, hipStream_t stream) {
  static int grid_blocks = 0;
  if (!grid_blocks) {
    int dev = 0, cus = 0, per_cu = 0;
    hipGetDevice(&dev);
    hipDeviceGetAttribute(&cus, hipDeviceAttributeMultiprocessorCount, dev);
    hipOccupancyMaxActiveBlocksPerMultiprocessor(&per_cu, mega, 256, 0);
    if (per_cu > 2) per_cu = 2;
    if (per_cu < 1) per_cu = 1;
    grid_blocks = cus * per_cu;
  }
  Params p;
  memset(&p, 0, sizeof(p));
  const float* const* in = (const float* const*)d_in;
  p.x_prompt = in[0]; p.x_sample = in[1]; p.cache_k = in[2]; p.cache_v = in[3]; p.cache_lf = in[4]; p.state_ret = in[5];
  p.meta = in[6]; p.norm_mix = in[7]; p.norm_ffn = in[8]; p.fox_w_in = in[9]; p.fox_b_f = in[10]; p.fox_qn = in[11];
  p.fox_kn = in[12]; p.fox_w_out = in[13]; p.ret_w_in = in[14]; p.ret_gn = in[15]; p.ret_w_out = in[16];
  p.peer_wq = in[17]; p.peer_sk = in[18]; p.peer_u = in[19]; p.peer_v = in[20];
  p.out = (float*)d_out;
  char* w = (char*)d_ws;
  size_t off = 0;
  auto take = [&](size_t bytes) { char* r = w + off; off += (bytes + 255) & ~(size_t)255; return r; };
  p.X = (float*)take((size_t)TPAD * DM * 4);
  p.H = (u16*)take((size_t)TPAD * DM * 2);
  p.WfinT = (u16*)take((size_t)2 * 4224 * 1024 * 2);
  p.WfoutT = (u16*)take((size_t)2 * 1024 * 1024 * 2);
  p.WrinT = (u16*)take((size_t)2 * 6144 * 1024 * 2);
  p.WroutT = (u16*)take((size_t)2 * 1024 * 2048 * 2);
  p.WpqT = (u16*)take((size_t)4 * 2048 * 1024 * 2);
  p.SKb = (u16*)take((size_t)4 * 8 * 2 * 128 * 128 * 2);
  p.Ub = (u16*)take((size_t)NEXP * DM * 2);
  p.Vb = (u16*)take((size_t)NEXP * DM * 2);
  p.SV = (float*)take((size_t)TPAD * 256 * 4);
  p.SI = (int*)take((size_t)TPAD * 256 * 4);
  p.LFC = (float*)take((size_t)TPAD * 16 * 4);
  p.LFR = (float*)take((size_t)TPAD * 16 * 4);
  p.TT = (float*)take((size_t)MTILES * 16 * 4);
  p.SSQ = (unsigned long long*)take((size_t)TPAD * 8);
  size_t region = off;
  p.Qf = (u16*)take((size_t)TPAD * DM * 2);
  p.Kf = (u16*)take((size_t)TPAD * DM * 2);
  p.VtF = (u16*)take((size_t)1024 * TPAD * 2);
  p.OGf = (u16*)take((size_t)TPAD * DM * 2);
  p.AO = (u16*)take((size_t)TPAD * DM * 2);
  off = region;
  p.Qr = (u16*)take((size_t)TP2 * DM * 2);
  p.Kr = (u16*)take((size_t)TP2 * DM * 2);
  p.KrT = (u16*)take((size_t)1024 * TP2 * 2);
  p.VrT = (u16*)take((size_t)2048 * TP2 * 2);
  p.Gr = (u16*)take((size_t)TPAD * 2048 * 2);
  p.ST = (u16*)take((size_t)NCH * 4 * 512 * 256 * 2);
  if (off > ws_size) { fprintf(stderr, "workspace too small: need %zu have %zu\n", off, ws_size); return; }
  for (int i = 0; i < 128; ++i) p.rope_rev[i] = (float)(pow(10000.0, -(double)i / 128.0) / (2.0 * M_PI));
#if ONE_LAUNCH
  int ph0 = 0, ph1 = NPHASE;
  void* args[] = {&p, &ph0, &ph1};
  hipError_t e = hipLaunchCooperativeKernel((void*)mega, dim3(grid_blocks), dim3(256), args, 0, stream);
  if (e != hipSuccess) fprintf(stderr, "cooperative launch failed: %s (grid %d)\n", hipGetErrorString(e), grid_blocks);
#else
  for (int ph = 0; ph < NPHASE; ++ph) mega<<<grid_blocks, 256, 0, stream>>>(p, ph, ph + 1);
#endif
}
```

```cpp
#include <hip/hip_runtime.h>
#include <hip/hip_cooperative_groups.h>
#include <stdint.h>
#include <math.h>
#include <stdio.h>
#include <string.h>
namespace cg = cooperative_groups;

typedef unsigned short u16;
typedef __attribute__((ext_vector_type(8))) short bf16x8;
typedef __attribute__((ext_vector_type(4))) float f32x4;
typedef __attribute__((ext_vector_type(2))) float f32x2;
typedef __attribute__((ext_vector_type(4))) unsigned int u32x4;
typedef __attribute__((ext_vector_type(2))) unsigned int u32x2;
#define DEV __device__ __forceinline__

#ifndef ONE_LAUNCH
#define ONE_LAUNCH 1
#endif

constexpr int DM = 1024;
constexpr int NMETA = 16;
constexpr int LP = 16400;
constexpr int NSMP = 128;
constexpr int TTOK = LP + NSMP;
constexpr int TPAD = 16640;
constexpr int MTILES = 130;
constexpr int LEAD = 48;
constexpr int TP2 = 16704;
constexpr int NCH = 257;
constexpr int PAST = 1024;
constexpr int NEXP = 16384;
constexpr float EPS = 1e-6f;

constexpr size_t O_YP = 0;
constexpr size_t O_YS = O_YP + (size_t)16384 * 1024;
constexpr size_t O_FKP = O_YS + (size_t)128 * 1024;
constexpr size_t O_FVP = O_FKP + (size_t)2 * LP * 1024;
constexpr size_t O_FLP = O_FVP + (size_t)2 * LP * 1024;
constexpr size_t O_SRP = O_FLP + (size_t)2 * LP * 16;
constexpr size_t O_FKS = O_SRP + (size_t)2 * 4 * 256 * 512;
constexpr size_t O_FVS = O_FKS + (size_t)2 * 128 * 1024;
constexpr size_t O_FLS = O_FVS + (size_t)2 * 128 * 1024;
constexpr size_t O_SRS = O_FLS + (size_t)2 * 128 * 16;

struct Params {
  const float *x_prompt, *x_sample, *cache_k, *cache_v, *cache_lf, *state_ret, *meta, *norm_mix, *norm_ffn;
  const float *fox_w_in, *fox_b_f, *fox_qn, *fox_kn, *fox_w_out, *ret_w_in, *ret_gn, *ret_w_out;
  const float *peer_wq, *peer_sk, *peer_u, *peer_v;
  float* out;
  float* X; u16* H;
  u16 *WfinT, *WfoutT, *WrinT, *WroutT, *WpqT, *SKb, *Ub, *Vb;
  float *SV; int* SI;
  float *LFC, *LFR, *TT; unsigned long long* SSQ;
  u16 *Qf, *Kf, *VtF, *OGf, *AO;
  u16 *Qr, *Kr, *KrT, *VrT, *Gr, *ST;
  float rope_rev[128];
};

typedef __attribute__((ext_vector_type(2))) float f2cv_t;
typedef __attribute__((ext_vector_type(2))) __bf16 bf2cv_t;
DEV uint32_t pack2(float a, float b) { f2cv_t v = {a, b}; bf2cv_t r = __builtin_convertvector(v, bf2cv_t); return __builtin_bit_cast(uint32_t, r); }
DEV u16 f2bf(float f) { return (u16)(pack2(f, 0.f) & 0xffffu); }
DEV float bf2f(u16 h) { return __uint_as_float(((uint32_t)h) << 16); }
DEV float bflo(uint32_t u) { return __uint_as_float(u << 16); }
DEV float bfhi(uint32_t u) { return __uint_as_float(u & 0xffff0000u); }

union V8 { bf16x8 v; uint32_t u[4]; u32x2 d[2]; u32x4 q; };

DEV f32x4 mfma(bf16x8 a, bf16x8 b, f32x4 c) { return __builtin_amdgcn_mfma_f32_16x16x32_bf16(a, b, c, 0, 0, 0); }

template <int CTRL> DEV float dppf(float v) {
  return __int_as_float(__builtin_amdgcn_update_dpp(0, __float_as_int(v), CTRL, 0xf, 0xf, false));
}
template <int CTRL> DEV uint32_t dppu(uint32_t v) {
  return (uint32_t)__builtin_amdgcn_update_dpp(0, (int)v, CTRL, 0xf, 0xf, false);
}
DEV float row16_sum(float v) {
  v += dppf<0xB1>(v); v += dppf<0x4E>(v); v += dppf<0x141>(v); v += dppf<0x140>(v);
  return v;
}
DEV uint32_t row16_maxu(uint32_t v) {
  v = max(v, dppu<0xB1>(v)); v = max(v, dppu<0x4E>(v)); v = max(v, dppu<0x141>(v)); v = max(v, dppu<0x140>(v));
  return v;
}
DEV float rdlane(float v, int l) { float r = __int_as_float(__builtin_amdgcn_readlane(__float_as_int(v), l)); asm volatile("" : "+v"(r)); return r; }
DEV float wave_sum(float v) {
  v = row16_sum(v);
  return rdlane(v, 0) + rdlane(v, 16) + rdlane(v, 32) + rdlane(v, 48);
}
DEV float wave_max(float v) {
  v = fmaxf(v, dppf<0xB1>(v)); v = fmaxf(v, dppf<0x4E>(v)); v = fmaxf(v, dppf<0x141>(v)); v = fmaxf(v, dppf<0x140>(v));
  return fmaxf(fmaxf(rdlane(v, 0), rdlane(v, 16)), fmaxf(rdlane(v, 32), rdlane(v, 48)));
}
DEV uint32_t wave_maxu(uint32_t v) {
  v = row16_maxu(v);
  uint32_t a = (uint32_t)__builtin_amdgcn_readlane((int)v, 0), b = (uint32_t)__builtin_amdgcn_readlane((int)v, 16);
  uint32_t c = (uint32_t)__builtin_amdgcn_readlane((int)v, 32), d = (uint32_t)__builtin_amdgcn_readlane((int)v, 48);
  return max(max(a, b), max(c, d));
}
DEV uint32_t f2key(float f) { uint32_t u = __float_as_uint(f); return (u & 0x80000000u) ? ~u : (u | 0x80000000u); }
DEV float key2f(uint32_t k) { uint32_t u = (k & 0x80000000u) ? (k & 0x7fffffffu) : ~k; return __uint_as_float(u); }

DEV float sigmoidf_(float x) { return 1.f / (1.f + __expf(-x)); }
DEV float logsigmoid_(float x) { return fminf(x, 0.f) - log1pf(expf(-fabsf(x))); }
DEV float gelu_(float x) { return 0.5f * x * (1.f + erff(x * 0.70710678118654752f)); }
DEV float ret_l2g(int h) { return log2f(1.f - exp2f(-5.f - (float)h)); }
DEV int otid() { int t = threadIdx.x; asm volatile("" : "+v"(t)); return t; }
DEV size_t tix(int rows, int h, int row, int pp) { return ((size_t)(h * 261 + (pp >> 6)) * rows + row) * 64 + (pp & 63); }
DEV int perm_dorig(int dp) { return ((dp >> 4) & 1) * 128 + (dp >> 5) * 16 + (dp & 15); }

DEV void norm_rows(const Params& p, const float* gain, bool from_input) {
  int tid_ = otid();
  int lane = tid_ & 63;
  int gw = (blockIdx.x * blockDim.x + tid_) >> 6, nw = (gridDim.x * blockDim.x) >> 6;
  for (int t = gw; t < TPAD; t += nw) {
    const float* src;
    if (from_input) {
      if (t < NMETA) src = p.meta + (size_t)t * DM;
      else if (t < LP) src = p.x_prompt + (size_t)(t - NMETA) * DM;
      else if (t < TTOK) src = p.x_sample + (size_t)(t - LP) * DM;
      else src = nullptr;
    } else src = p.X + (size_t)t * DM;
    f32x4 v[4];
    float ss = 0.f;
#pragma unroll
    for (int c = 0; c < 4; ++c) {
      if (src) v[c] = *(const f32x4*)(src + c * 256 + lane * 4); else v[c] = f32x4{0.f, 0.f, 0.f, 0.f};
      ss += v[c].x * v[c].x + v[c].y * v[c].y + v[c].z * v[c].z + v[c].w * v[c].w;
    }
    ss = wave_sum(ss);
    float rstd = rsqrtf(ss * (1.f / DM) + EPS);
#pragma unroll
    for (int c = 0; c < 4; ++c) {
      if (from_input) *(f32x4*)(p.X + (size_t)t * DM + c * 256 + lane * 4) = v[c];
      f32x4 g = *(const f32x4*)(gain + c * 256 + lane * 4);
      u32x2 o;
      o.x = pack2(v[c].x * rstd * g.x, v[c].y * rstd * g.y);
      o.y = pack2(v[c].z * rstd * g.z, v[c].w * rstd * g.w);
      *(u32x2*)(p.H + (size_t)t * DM + c * 256 + lane * 4) = o;
    }
  }
}

DEV void convert_bf16(const float* src, u16* dst, size_t n4) {
  size_t i = (size_t)blockIdx.x * blockDim.x + otid(), st = (size_t)gridDim.x * blockDim.x;
  for (; i < n4; i += st) {
    f32x4 v = ((const f32x4*)src)[i];
    u32x2 o; o.x = pack2(v.x, v.y); o.y = pack2(v.z, v.w);
    ((u32x2*)dst)[i] = o;
  }
}

DEV void xpose(const float* W, int K, int N, int Npad, u16* Wt, bool permq, char* smem) {
  u16* tile = (u16*)smem;
  int tid = otid();
  int ntn = Npad / 64, ntk = K / 64;
  for (int it = blockIdx.x; it < ntn * ntk; it += gridDim.x) {
    int n0 = (it / ntk) * 64, k0 = (it % ntk) * 64;
    int c = tid & 63, r0 = tid >> 6;
    int np = n0 + c;
    int src = np;
    if (permq && np < 2048) src = (np & ~255) + perm_dorig(np & 255);
    __syncthreads();
#pragma unroll
    for (int i = 0; i < 16; ++i) {
      int k = r0 + 4 * i;
      float v = (np < N) ? W[(size_t)(k0 + k) * N + src] : 0.f;
      tile[c * 72 + k] = f2bf(v);
    }
    __syncthreads();
    int nl = tid >> 2, kq = (tid & 3) * 16;
    u32x4 a = *(const u32x4*)(tile + nl * 72 + kq);
    u32x4 b = *(const u32x4*)(tile + nl * 72 + kq + 8);
    *(u32x4*)(Wt + (size_t)(n0 + nl) * K + k0 + kq) = a;
    *(u32x4*)(Wt + (size_t)(n0 + nl) * K + k0 + kq + 8) = b;
  }
}

typedef __attribute__((ext_vector_type(2))) float v2f_t;
constexpr float U_SCALE = 64.f, V_SCALE = 16.f;
DEV void convert_fp8(const float* src, uint32_t* dst, size_t n4, float scale) {
  size_t i = (size_t)blockIdx.x * blockDim.x + otid(), st = (size_t)gridDim.x * blockDim.x;
  for (; i < n4; i += st) {
    f32x4 v = ((const f32x4*)src)[i];
    int w = __builtin_amdgcn_cvt_pk_fp8_f32(v.x * scale, v.y * scale, 0, false);
    w = __builtin_amdgcn_cvt_pk_fp8_f32(v.z * scale, v.w * scale, w, true);
    dst[i] = (uint32_t)w;
  }
}
DEV void conv_tables(const Params& p, int layer) {
  convert_fp8(p.peer_u + (size_t)layer * NEXP * DM, (uint32_t*)p.Ub, (size_t)NEXP * DM / 4, U_SCALE);
  convert_fp8(p.peer_v + (size_t)layer * NEXP * DM, (uint32_t*)p.Vb, (size_t)NEXP * DM / 4, V_SCALE);
}

DEV void ph_prep(const Params& p, char* smem) {
  norm_rows(p, p.norm_mix, true);
  convert_bf16(p.peer_sk, p.SKb, (size_t)4 * 8 * 2 * 128 * 128 / 4);
  for (int j = 0; j < 2; ++j) {
    xpose(p.fox_w_in + (size_t)j * 1024 * 4112, 1024, 4112, 4224, p.WfinT + (size_t)j * 4224 * 1024, false, smem);
    xpose(p.fox_w_out + (size_t)j * 1024 * 1024, 1024, 1024, 1024, p.WfoutT + (size_t)j * 1024 * 1024, false, smem);
    xpose(p.ret_w_in + (size_t)j * 1024 * 6144, 1024, 6144, 6144, p.WrinT + (size_t)j * 6144 * 1024, true, smem);
    xpose(p.ret_w_out + (size_t)j * 2048 * 1024, 2048, 1024, 1024, p.WroutT + (size_t)j * 1024 * 2048, false, smem);
  }
  for (int l = 0; l < 4; ++l)
    xpose(p.peer_wq + (size_t)l * 1024 * 2048, 1024, 2048, 2048, p.WpqT + (size_t)l * 2048 * 1024, false, smem);
}

DEV void tile_mn(int it, int NT, int& mt, int& nt) {
  const int GM = 8;
  int g = it / (GM * NT), r = it - g * (GM * NT);
  int gm = min(GM, MTILES - g * GM);
  nt = r / gm; mt = g * GM + (r - nt * gm);
}

constexpr int LDK = 72;
template <bool SWAP>
DEV void gemm_tile(const u16* __restrict__ A, int lda, const u16* __restrict__ Bt, int ldb, int K,
                          int m0, int n0, char* smem, f32x4 (&acc)[4][4]) {
  u16* sA = (u16*)smem;
  u16* sB = sA + 128 * LDK;
  int tid = otid(), lane = tid & 63, wid = tid >> 6;
  int wr = wid >> 1, wc = wid & 1, fr = lane & 15, fq = lane >> 4;
#pragma unroll
  for (int m = 0; m < 4; ++m)
#pragma unroll
    for (int n = 0; n < 4; ++n) acc[m][n] = f32x4{0.f, 0.f, 0.f, 0.f};
  u32x4 ra[4], rb[4];
  const u16* Ap = A + (size_t)(m0 + (tid >> 3)) * lda + (tid & 7) * 8;
  const u16* Bp = Bt + (size_t)(n0 + (tid >> 3)) * ldb + (tid & 7) * 8;
#pragma unroll
  for (int i = 0; i < 4; ++i) {
    ra[i] = *(const u32x4*)(Ap + (size_t)(32 * i) * lda);
    rb[i] = *(const u32x4*)(Bp + (size_t)(32 * i) * ldb);
  }
  for (int k0 = 0; k0 < K; k0 += 64) {
    __syncthreads();
#pragma unroll
    for (int i = 0; i < 4; ++i) {
      *(u32x4*)(sA + ((tid >> 3) + 32 * i) * LDK + (tid & 7) * 8) = ra[i];
      *(u32x4*)(sB + ((tid >> 3) + 32 * i) * LDK + (tid & 7) * 8) = rb[i];
    }
    __syncthreads();
    if (k0 + 64 < K) {
#pragma unroll
      for (int i = 0; i < 4; ++i) {
        ra[i] = *(const u32x4*)(Ap + (size_t)(32 * i) * lda + k0 + 64);
        rb[i] = *(const u32x4*)(Bp + (size_t)(32 * i) * ldb + k0 + 64);
      }
    }
#pragma unroll
    for (int ks = 0; ks < 2; ++ks) {
      bf16x8 af[4], bfv[4];
#pragma unroll
      for (int m = 0; m < 4; ++m) af[m] = *(const bf16x8*)(sA + (wr * 64 + m * 16 + fr) * LDK + ks * 32 + fq * 8);
#pragma unroll
      for (int n = 0; n < 4; ++n) bfv[n] = *(const bf16x8*)(sB + (wc * 64 + n * 16 + fr) * LDK + ks * 32 + fq * 8);
#pragma unroll
      for (int m = 0; m < 4; ++m)
#pragma unroll
        for (int n = 0; n < 4; ++n) acc[m][n] = SWAP ? mfma(bfv[n], af[m], acc[m][n]) : mfma(af[m], bfv[n], acc[m][n]);
    }
  }
}

DEV void ph_f1(const Params& p, int jf, char* smem) {
  for (int i = blockIdx.x * blockDim.x + otid(); i < TPAD; i += gridDim.x * blockDim.x) p.SSQ[i] = 0ull;
  const u16* Wt = p.WfinT + (size_t)jf * 4224 * 1024;
  int tid = otid(), lane = tid & 63, wid = tid >> 6;
  int wr = wid >> 1, wc = wid & 1, fr = lane & 15, fq = lane >> 4;
  const int NT = 33;
  for (int it = blockIdx.x; it < MTILES * NT; it += gridDim.x) {
    int mt, nt; tile_mn(it, NT, mt, nt);
    int m0 = mt * 128;
    f32x4 acc[4][4];
    int type = nt >> 3;
    if (type == 2 || type == 4) gemm_tile<false>(p.H, DM, Wt, DM, DM, m0, nt * 128, smem, acc);
    else gemm_tile<true>(p.H, DM, Wt, DM, DM, m0, nt * 128, smem, acc);
    if (type <= 1) {
      int hh = (nt & 7) * 2 + wc;
      const float* gn = (type == 0 ? p.fox_qn : p.fox_kn) + jf * 64;
      const float gs = (type == 0) ? 0.125f * 1.44269504089f : 1.f;
      f32x4 g[4];
#pragma unroll
      for (int n = 0; n < 4; ++n) g[n] = *(const f32x4*)(gn + n * 16 + fq * 4) * gs;
#pragma unroll
      for (int m = 0; m < 4; ++m) {
        float ss = 0.f;
#pragma unroll
        for (int n = 0; n < 4; ++n)
#pragma unroll
          for (int j = 0; j < 4; ++j) ss += acc[m][n][j] * acc[m][n][j];
        ss += __shfl_xor(ss, 16); ss += __shfl_xor(ss, 32);
        float rstd = rsqrtf(ss * (1.f / 64.f) + EPS);
        int row = m0 + wr * 64 + m * 16 + fr;
#pragma unroll
        for (int n = 0; n < 4; ++n) {
          f32x4 v = acc[m][n] * rstd * g[n];
          int col = hh * 64 + n * 16 + fq * 4;
          u32x2 o; o.x = pack2(v.x, v.y); o.y = pack2(v.z, v.w);
          if (type == 0) *(u32x2*)(p.Qf + (size_t)row * DM + col) = o;
          else {
            *(u32x2*)(p.Kf + (size_t)row * DM + col) = o;
            if (row < LP) *(f32x4*)(p.out + O_FKP + ((size_t)jf * LP + row) * 1024 + col) = v;
            else if (row < TTOK) *(f32x4*)(p.out + O_FKS + ((size_t)jf * 128 + (row - LP)) * 1024 + col) = v;
          }
        }
      }
    } else if (type == 2) {
      int hh = (nt & 7) * 2 + wc;
#pragma unroll
      for (int m = 0; m < 4; ++m) {
        int rb = m0 + wr * 64 + m * 16 + fq * 4;
#pragma unroll
        for (int n = 0; n < 4; ++n) {
          int d = n * 16 + fr;
          u32x2 o; o.x = pack2(acc[m][n][0], acc[m][n][1]); o.y = pack2(acc[m][n][2], acc[m][n][3]);
          *(u32x2*)(p.VtF + (size_t)(hh * 64 + d) * TPAD + rb) = o;
#pragma unroll
          for (int j = 0; j < 4; ++j) {
            int row = rb + j; int col = hh * 64 + d;
            if (row < LP) p.out[O_FVP + ((size_t)jf * LP + row) * 1024 + col] = acc[m][n][j];
            else if (row < TTOK) p.out[O_FVS + ((size_t)jf * 128 + (row - LP)) * 1024 + col] = acc[m][n][j];
          }
        }
      }
    } else if (type == 3) {
#pragma unroll
      for (int m = 0; m < 4; ++m)
#pragma unroll
        for (int n = 0; n < 4; ++n) {
          int row = m0 + wr * 64 + m * 16 + fr;
          int col = (nt - 24) * 128 + wc * 64 + n * 16 + fq * 4;
          u32x2 o; o.x = pack2(acc[m][n][0], acc[m][n][1]); o.y = pack2(acc[m][n][2], acc[m][n][3]);
          *(u32x2*)(p.OGf + (size_t)row * DM + col) = o;
        }
    } else {
      float* lfs = (float*)smem;
      __syncthreads();
      if (wc == 0) {
        float bf = p.fox_b_f[jf * 16 + fr];
#pragma unroll
        for (int m = 0; m < 4; ++m)
#pragma unroll
          for (int j = 0; j < 4; ++j) {
            int rl = wr * 64 + m * 16 + fq * 4 + j;
            int row = m0 + rl;
            float lf = logsigmoid_(acc[m][0][j] + bf);
            lfs[rl * 16 + fr] = lf;
            p.LFR[(size_t)row * 16 + fr] = lf;
            if (row < LP) p.out[O_FLP + ((size_t)jf * LP + row) * 16 + fr] = lf;
            else if (row < TTOK) p.out[O_FLS + ((size_t)jf * 128 + (row - LP)) * 16 + fr] = lf;
          }
      }
      __syncthreads();
      if (tid < 16) {
        float run = 0.f;
        for (int r = 0; r < 128; ++r) {
          run += lfs[r * 16 + tid];
          p.LFC[(size_t)(m0 + r) * 16 + tid] = run;
        }
        p.TT[mt * 16 + tid] = run;
      }
    }
  }
}

DEV void f2_prompt(const Params& p, int qt, int h, char* smem) {
  u16* Ks = (u16*)smem;
  u16* Vs = Ks + 2 * 64 * LDK;
  float* cs = (float*)(Vs + 2 * 64 * LDK);
  float* off = cs + 128;
  float* tmp = off + 132;
  int tid = otid(), lane = tid & 63, wid = tid >> 6, fr = lane & 15, fq = lane >> 4;
  __syncthreads();
  if (tid < MTILES) tmp[tid] = p.TT[tid * 16 + h];
  __syncthreads();
  if (tid < MTILES) { float s = 0.f; for (int m = 0; m < tid; ++m) s += tmp[m]; off[tid] = s; }
  __syncthreads();
  int q0 = qt * 256 + wid * 64;
  bf16x8 qf[4][2];
  float cq[4], lrow[4];
  f32x4 o[4][4];
#pragma unroll
  for (int qi = 0; qi < 4; ++qi) {
    int q = q0 + qi * 16 + fr;
#pragma unroll
    for (int ks = 0; ks < 2; ++ks) qf[qi][ks] = *(const bf16x8*)(p.Qf + (size_t)q * DM + h * 64 + ks * 32 + fq * 8);
    cq[qi] = (p.LFC[(size_t)q * 16 + h] + off[q >> 7] - 12.f) * 1.44269504089f;
    lrow[qi] = 0.f;
#pragma unroll
    for (int dt = 0; dt < 4; ++dt) o[dt][qi] = f32x4{0.f, 0.f, 0.f, 0.f};
  }
  int nkt = 4 * (qt + 1);
  if (nkt > (LP + 63) / 64) nkt = (LP + 63) / 64;
  bool wave_valid = q0 < LP;
  u32x4 rk[2], rv[2]; float rc = 0.f;
  const int lrow_ = tid >> 2, lcol = (tid & 3) * 16;
  const u16* kfb = p.Kf + h * 64;
  const u16* vtb = p.VtF + (size_t)h * 64 * TPAD;
  const float* lcb = p.LFC + h;
  const unsigned kvo0 = (unsigned)(lrow_ * DM + lcol), kvo1 = kvo0 + 32u * DM;
  const unsigned vvo0 = (unsigned)(lrow_ * TPAD + lcol), vvo1 = vvo0 + 32u * TPAD;
#define GL(kt_) { int key0_ = (kt_) * 64; \
    const u16* kp_ = p.Kf + (size_t)(key0_ + lrow_) * DM + h * 64 + lcol; \
    const u16* vp_ = p.VtF + (size_t)(h * 64 + lrow_) * TPAD + key0_ + lcol; \
    rk[0] = *(const u32x4*)(kp_); rk[1] = *(const u32x4*)(kp_ + 8); \
    rv[0] = *(const u32x4*)(vp_); rv[1] = *(const u32x4*)(vp_ + 8); \
    if (tid < 64) rc = (p.LFC[(size_t)(key0_ + tid) * 16 + h] + off[(key0_ + tid) >> 7]) * 1.44269504089f; }
  GL(0);
  for (int kt = 0; kt < nkt; ++kt) {
    int buf = kt & 1;
    u16* Kb = Ks + buf * 64 * LDK; u16* Vb = Vs + buf * 64 * LDK; float* cb = cs + buf * 64;
#pragma unroll
    for (int i = 0; i < 2; ++i) {
      *(u32x4*)(Kb + lrow_ * LDK + lcol + 8 * i) = rk[i];
      *(u32x4*)(Vb + lrow_ * LDK + lcol + 8 * i) = rv[i];
    }
    if (tid < 64) cb[tid] = rc;
    __syncthreads();
    if (kt + 1 < nkt) GL(kt + 1);
    int key0 = kt * 64;
    if (wave_valid && key0 <= q0 + 63) {
      bool diag = (key0 + 63 > q0);
#pragma unroll
      for (int pp = 0; pp < 2; ++pp) {
        V8 pfu[4];
#pragma unroll
        for (int kl = 0; kl < 2; ++kl) {
          f32x4 s1[4];
          f32x4 ck = *(const f32x4*)(cb + (2 * pp + kl) * 16 + fq * 4);
#pragma unroll
          for (int qi = 0; qi < 4; ++qi) s1[qi] = cq[qi] - ck;
#pragma unroll
          for (int ks = 0; ks < 2; ++ks) {
            bf16x8 a = *(const bf16x8*)(Kb + ((2 * pp + kl) * 16 + fr) * LDK + ks * 32 + fq * 8);
#pragma unroll
            for (int qi = 0; qi < 4; ++qi) s1[qi] = mfma(a, qf[qi][ks], s1[qi]);
          }
#pragma unroll
          for (int qi = 0; qi < 4; ++qi) {
            int q = q0 + qi * 16 + fr;
            float e[4];
#pragma unroll
            for (int j = 0; j < 4; ++j) {
              float v = s1[qi][j];
              if (diag && (key0 + (2 * pp + kl) * 16 + fq * 4 + j > q)) v = -INFINITY;
              e[j] = __builtin_amdgcn_exp2f(v);
            }
            lrow[qi] += (e[0] + e[1]) + (e[2] + e[3]);
            pfu[qi].u[kl * 2 + 0] = pack2(e[0], e[1]);
            pfu[qi].u[kl * 2 + 1] = pack2(e[2], e[3]);
          }
        }
        bf16x8 pf[4];
#pragma unroll
        for (int qi = 0; qi < 4; ++qi) pf[qi] = pfu[qi].v;
#pragma unroll
        for (int dt = 0; dt < 4; ++dt) {
          V8 a;
          a.d[0] = *(const u32x2*)(Vb + (dt * 16 + fr) * LDK + (2 * pp) * 16 + fq * 4);
          a.d[1] = *(const u32x2*)(Vb + (dt * 16 + fr) * LDK + (2 * pp + 1) * 16 + fq * 4);
#pragma unroll
          for (int qi = 0; qi < 4; ++qi) o[dt][qi] = mfma(a.v, pf[qi], o[dt][qi]);
        }
      }
    }
  }
  int q0e = q0;
  asm volatile("" : "+v"(q0e));
#pragma unroll
  for (int qi = 0; qi < 4; ++qi) {
    float l = lrow[qi];
    l += __shfl_xor(l, 16); l += __shfl_xor(l, 32);
    float inv = 1.f / l;
    int q = q0e + qi * 16 + fr;
    if (q < LP) {
#pragma unroll
      for (int dt = 0; dt < 4; ++dt) {
        int d = dt * 16 + fq * 4;
        u32x2 og = *(const u32x2*)(p.OGf + (size_t)q * DM + h * 64 + d);
        u32x2 r;
        r.x = pack2(o[dt][qi][0] * inv * sigmoidf_(bflo(og.x)), o[dt][qi][1] * inv * sigmoidf_(bfhi(og.x)));
        r.y = pack2(o[dt][qi][2] * inv * sigmoidf_(bflo(og.y)), o[dt][qi][3] * inv * sigmoidf_(bfhi(og.y)));
        *(u32x2*)(p.AO + (size_t)q * DM + h * 64 + d) = r;
      }
    }
  }
}

DEV void f2_sample(const Params& p, int jf, int b, int h, int qh, char* smem) {
  constexpr int NK = PAST + 16;
  float* S = (float*)smem;
  float* qs = S + 8 * NK;
  float* cc = qs + 8 * 64;
  float* part = cc + NK;
  float* invl = part + 256;
  int tid = otid(), lane = tid & 63, wid = tid >> 6;
  __syncthreads();
  for (int e = tid; e < 512; e += 256) {
    int i = e >> 6, d = e & 63;
    qs[e] = bf2f(p.Qf[(size_t)(LP + b * 16 + qh * 8 + i) * DM + h * 64 + d]);
  }
  float lv[5]; float run = 0.f;
#pragma unroll
  for (int u = 0; u < 5; ++u) {
    int j = tid * 5 + u;
    float v = 0.f;
    if (j < PAST) v = p.cache_lf[(((size_t)jf * 8 + b) * PAST + j) * 16 + h];
    else if (j < NK) v = p.LFR[(size_t)(LP + b * 16 + (j - PAST)) * 16 + h];
    run += v; lv[u] = run;
  }
  part[tid] = run;
  __syncthreads();
  float base = 0.f;
  for (int m = 0; m < tid; ++m) base += part[m];
#pragma unroll
  for (int u = 0; u < 5; ++u) { int j = tid * 5 + u; if (j < NK) cc[j] = base + lv[u]; }
  __syncthreads();
  for (int j = tid; j < NK; j += 256) {
    const float* kp;
    if (j < PAST) kp = p.cache_k + ((((size_t)jf * 8 + b) * PAST + j) * 16 + h) * 64;
    else kp = p.out + O_FKS + (((size_t)jf * 128 + b * 16 + (j - PAST)) * 16 + h) * 64;
    f32x4 kv[16];
#pragma unroll
    for (int c = 0; c < 16; ++c) kv[c] = ((const f32x4*)kp)[c];
    float cj = cc[j];
#pragma unroll
    for (int i = 0; i < 8; ++i) {
      float a = 0.f;
#pragma unroll
      for (int c = 0; c < 16; ++c) {
        f32x4 qv = *(const f32x4*)(qs + i * 64 + c * 4);
        a += qv.x * kv[c].x + qv.y * kv[c].y + qv.z * kv[c].z + qv.w * kv[c].w;
      }
      int qi = qh * 8 + i;
      a = a * 0.69314718056f + (cc[PAST + qi] - cj);
      if (j > PAST + qi) a = -INFINITY;
      S[i * NK + j] = a;
    }
  }
  __syncthreads();
  for (int i = wid * 2; i < wid * 2 + 2; ++i) {
    float m = -INFINITY;
    for (int j = lane; j < NK; j += 64) m = fmaxf(m, S[i * NK + j]);
    m = wave_max(m);
    float l = 0.f;
    for (int j = lane; j < NK; j += 64) { float e = __expf(S[i * NK + j] - m); S[i * NK + j] = e; l += e; }
    l = wave_sum(l);
    if (lane == 0) invl[i] = 1.f / l;
  }
  __syncthreads();
  {
    int i = tid >> 5, dq = tid & 31;
    float o0 = 0.f, o1 = 0.f;
    const float* vb = p.cache_v + ((((size_t)jf * 8 + b) * PAST) * 16 + h) * 64 + dq * 2;
#pragma unroll 8
    for (int j = 0; j < PAST; ++j) {
      f32x2 v = *(const f32x2*)(vb + (size_t)j * 1024);
      float pj = S[i * NK + j];
      o0 += pj * v.x; o1 += pj * v.y;
    }
    const float* vn = p.out + O_FVS + (((size_t)jf * 128 + b * 16) * 16 + h) * 64 + dq * 2;
#pragma unroll
    for (int j = 0; j < 16; ++j) {
      f32x2 v = *(const f32x2*)(vn + (size_t)j * 1024);
      float pj = S[i * NK + PAST + j];
      o0 += pj * v.x; o1 += pj * v.y;
    }
    int row = LP + b * 16 + qh * 8 + i;
    float il = invl[i];
    uint32_t og = *(const uint32_t*)(p.OGf + (size_t)row * DM + h * 64 + dq * 2);
    *(uint32_t*)(p.AO + (size_t)row * DM + h * 64 + dq * 2) = pack2(o0 * il * sigmoidf_(bflo(og)), o1 * il * sigmoidf_(bfhi(og)));
  }
}

DEV void ph_f2(const Params& p, int jf, char* smem) {
  const int NP = 65 * 16, NI = NP + 256;
  int G = gridDim.x;
  {
    int gt = blockIdx.x * blockDim.x + otid(), gs = gridDim.x * blockDim.x;
    for (int i = gt; i < (TPAD - TTOK) * DM / 2; i += gs) ((uint32_t*)(p.AO + (size_t)TTOK * DM))[i] = 0u;
  }
  for (int r = 0;; ++r) {
    int pos = (r & 1) ? (G - 1 - (int)blockIdx.x) : (int)blockIdx.x;
    int idx = r * G + pos;
    if (r * G >= NI) break;
    if (idx >= NI) continue;
    if (idx < NP) f2_prompt(p, 64 - idx / 16, idx % 16, smem);
    else { int s = idx - NP; f2_sample(p, jf, s >> 5, (s >> 1) & 15, s & 1, smem); }
  }
  conv_tables(p, jf * 2);
}

DEV void ph_outproj(const Params& p, const u16* A, int K, const u16* Wt, const float* gffn, char* smem) {
  int tid = otid(), lane = tid & 63, wid = tid >> 6;
  int wr = wid >> 1, wc = wid & 1, fr = lane & 15, fq = lane >> 4;
  for (int it = blockIdx.x; it < MTILES * 8; it += gridDim.x) {
    int mt, nt; tile_mn(it, 8, mt, nt);
    f32x4 acc[4][4];
    gemm_tile<true>(A, K, Wt, K, K, mt * 128, nt * 128, smem, acc);
#pragma unroll
    for (int m = 0; m < 4; ++m) {
      int row = mt * 128 + wr * 64 + m * 16 + fr;
      float ss = 0.f;
#pragma unroll
      for (int n = 0; n < 4; ++n) {
        int col = nt * 128 + wc * 64 + n * 16 + fq * 4;
        f32x4* xp = (f32x4*)(p.X + (size_t)row * DM + col);
        f32x4 xn = *xp + acc[m][n];
        *xp = xn;
        f32x4 g = *(const f32x4*)(gffn + col);
        u32x2 o; o.x = pack2(xn.x * g.x, xn.y * g.y); o.y = pack2(xn.z * g.z, xn.w * g.w);
        *(u32x2*)(p.H + (size_t)row * DM + col) = o;
        ss += xn.x * xn.x + xn.y * xn.y + xn.z * xn.z + xn.w * xn.w;
      }
      ss += __shfl_xor(ss, 16); ss += __shfl_xor(ss, 32);
      if (fq == 0) atomicAdd(p.SSQ + row, (unsigned long long)(ss * 1048576.f + 0.5f));
    }
  }
}

DEV void ph_r1(const Params& p, int jr, char* smem) {
  const u16* Wt = p.WrinT + (size_t)jr * 6144 * 1024;
  int tid = otid(), lane = tid & 63, wid = tid >> 6;
  int wr = wid >> 1, wc = wid & 1, fr = lane & 15, fq = lane >> 4;
  {
    int gt = blockIdx.x * blockDim.x + tid, gs = gridDim.x * blockDim.x;
    for (int i = gt; i < LEAD * DM; i += gs) { p.Qr[i] = 0; p.Kr[i] = 0; }
    for (int i = gt; i < TPAD; i += gs) p.SSQ[i] = 0ull;
    for (int i = gt; i < 1024 * LEAD; i += gs) p.KrT[tix(256, (i / LEAD) >> 8, (i / LEAD) & 255, i % LEAD)] = 0;
    for (int i = gt; i < 2048 * LEAD; i += gs) p.VrT[tix(512, (i / LEAD) >> 9, (i / LEAD) & 511, i % LEAD)] = 0;
  }
  const int NT = 48;
  for (int it = blockIdx.x; it < MTILES * NT; it += gridDim.x) {
    int mt, nt; tile_mn(it, NT, mt, nt);
    int m0 = mt * 128;
    f32x4 acc[4][4];
    if (nt >= 8 && nt < 32) gemm_tile<false>(p.H, DM, Wt, DM, DM, m0, nt * 128, smem, acc);
    else gemm_tile<true>(p.H, DM, Wt, DM, DM, m0, nt * 128, smem, acc);
    if (nt < 8) {
      int hh = nt >> 1, half = nt & 1;
#pragma unroll
      for (int pr = 0; pr < 2; ++pr) {
        int g = half * 4 + wc * 2 + pr;
        f32x4 rr = *(const f32x4*)(p.rope_rev + g * 16 + fq * 4);
#pragma unroll
        for (int m = 0; m < 4; ++m) {
          int row = m0 + wr * 64 + m * 16 + fr;
          int pos = (row < LP) ? (row - NMETA) : ((row < TTOK) ? (PAST + ((row - LP) & 15)) : 0);
          float o1[4], o2[4];
#pragma unroll
          for (int j = 0; j < 4; ++j) {
            float rev = (float)pos * rr[j];
            rev -= floorf(rev);
            float sn = __builtin_amdgcn_sinf(rev), cs = __builtin_amdgcn_cosf(rev);
            float x1 = acc[m][2 * pr][j], x2 = acc[m][2 * pr + 1][j];
            o1[j] = (x1 * cs - x2 * sn) * 0.0625f; o2[j] = (x1 * sn + x2 * cs) * 0.0625f;
          }
          u32x2 t1, t2;
          t1.x = pack2(o1[0], o1[1]); t1.y = pack2(o1[2], o1[3]);
          t2.x = pack2(o2[0], o2[1]); t2.y = pack2(o2[2], o2[3]);
          u16* dq = p.Qr + (size_t)(row + LEAD) * DM + hh * 256 + g * 32 + fq * 4;
          *(u32x2*)dq = t1;
          *(u32x2*)(dq + 16) = t2;
        }
      }
    } else if (nt < 16) {
      bool isq = false;
      int hh = (nt & 7) >> 1, half = nt & 1;
      float l2g = ret_l2g(hh);
      u16* dst = isq ? p.Qr : p.Kr;
#pragma unroll
      for (int pr = 0; pr < 2; ++pr) {
        int g = half * 4 + wc * 2 + pr;
        int fi = g * 16 + fr;
        float rr = p.rope_rev[fi];
        int dp1 = g * 32 + fr, dp2 = dp1 + 16;
#pragma unroll
        for (int m = 0; m < 4; ++m) {
          int rb = m0 + wr * 64 + m * 16 + fq * 4;
          float o1[4], o2[4];
#pragma unroll
          for (int j = 0; j < 4; ++j) {
            int row = rb + j;
            int pos = (row < LP) ? (row - NMETA) : ((row < TTOK) ? (PAST + ((row - LP) & 15)) : 0);
            float rev = (float)pos * rr;
            rev -= floorf(rev);
            float sn = __builtin_amdgcn_sinf(rev), cs = __builtin_amdgcn_cosf(rev);
            float x1 = acc[m][2 * pr][j], x2 = acc[m][2 * pr + 1][j];
            float a = x1 * cs - x2 * sn, bb = x1 * sn + x2 * cs;
            if (isq) { a *= 0.0625f; bb *= 0.0625f; }
            o1[j] = a; o2[j] = bb;
            dst[(size_t)(row + LEAD) * DM + hh * 256 + dp1] = f2bf(a);
            dst[(size_t)(row + LEAD) * DM + hh * 256 + dp2] = f2bf(bb);
          }
          if (!isq) {
            float dc[4];
#pragma unroll
            for (int j = 0; j < 4; ++j) dc[j] = exp2f(l2g * (float)(63 - ((rb + j + LEAD) & 63)));
            u32x2 t1, t2;
            t1.x = pack2(o1[0] * dc[0], o1[1] * dc[1]); t1.y = pack2(o1[2] * dc[2], o1[3] * dc[3]);
            t2.x = pack2(o2[0] * dc[0], o2[1] * dc[1]); t2.y = pack2(o2[2] * dc[2], o2[3] * dc[3]);
            *(u32x2*)(p.KrT + tix(256, hh, dp1, rb + LEAD)) = t1;
            *(u32x2*)(p.KrT + tix(256, hh, dp2, rb + LEAD)) = t2;
          }
        }
      }
    } else if (nt < 32) {
      int hh = (nt - 16) >> 2;
#pragma unroll
      for (int m = 0; m < 4; ++m) {
        int rb = m0 + wr * 64 + m * 16 + fq * 4;
#pragma unroll
        for (int n = 0; n < 4; ++n) {
          int e = ((nt - 16) & 3) * 128 + wc * 64 + n * 16 + fr;
          u32x2 o; o.x = pack2(acc[m][n][0], acc[m][n][1]); o.y = pack2(acc[m][n][2], acc[m][n][3]);
          *(u32x2*)(p.VrT + tix(512, hh, e, rb + LEAD)) = o;
        }
      }
    } else {
#pragma unroll
      for (int m = 0; m < 4; ++m)
#pragma unroll
        for (int n = 0; n < 4; ++n) {
          int row = m0 + wr * 64 + m * 16 + fr;
          int col = (nt - 32) * 128 + wc * 64 + n * 16 + fq * 4;
          u32x2 o; o.x = pack2(acc[m][n][0], acc[m][n][1]); o.y = pack2(acc[m][n][2], acc[m][n][3]);
          *(u32x2*)(p.Gr + (size_t)row * 2048 + col) = o;
        }
    }
  }
}

DEV void ph_r2(const Params& p, int jr) {
  int tid = otid(), lane = tid & 63, wid = tid >> 6, fr = lane & 15, fq = lane >> 4;
  for (int it = blockIdx.x; it < 64; it += gridDim.x) {
    int h = it >> 4, sl = it & 15;
    float dec64 = exp2f(ret_l2g(h) * 64.f);
    f32x4 st[4][2];
#pragma unroll
    for (int r = 0; r < 4; ++r)
#pragma unroll
      for (int c = 0; c < 2; ++c) st[r][c] = f32x4{0.f, 0.f, 0.f, 0.f};
    const u16* kbase = p.KrT + tix(256, h, wid * 64 + fr, 0) + fq * 8;
    const u16* vbase = p.VrT + tix(512, h, sl * 32 + fr, 0) + fq * 8;
    bf16x8 A0[8], B0[4], A1[8], B1[4], A2[8], B2[4];
#define R2_LOAD(A, B, n_) { \
    _Pragma("unroll") for (int r = 0; r < 4; ++r) _Pragma("unroll") for (int ks = 0; ks < 2; ++ks) \
      A[r * 2 + ks] = *(const bf16x8*)(kbase + (size_t)(n_) * (256 * 64) + r * 16 * 64 + ks * 32); \
    _Pragma("unroll") for (int c = 0; c < 2; ++c) _Pragma("unroll") for (int ks = 0; ks < 2; ++ks) \
      B[c * 2 + ks] = *(const bf16x8*)(vbase + (size_t)(n_) * (512 * 64) + c * 16 * 64 + ks * 32); }
#define R2_STEP(A, B, n_) { \
    { \
      _Pragma("unroll") for (int c = 0; c < 2; ++c) { \
        u16* sp = p.ST + (((size_t)((n_) * 4 + h) * 16 + wid * 4) * 512 + sl * 32 + c * 16 + fr) * 16 + fq * 4; \
        _Pragma("unroll") for (int r = 0; r < 4; ++r) { \
          u32x2 o; o.x = pack2(st[r][c][0], st[r][c][1]); o.y = pack2(st[r][c][2], st[r][c][3]); \
          *(u32x2*)(sp + r * (512 * 16)) = o; } } } \
    _Pragma("unroll") for (int r = 0; r < 4; ++r) _Pragma("unroll") for (int c = 0; c < 2; ++c) { \
      f32x4 t = st[r][c] * dec64; \
      _Pragma("unroll") for (int ks = 0; ks < 2; ++ks) t = mfma(A[r * 2 + ks], B[c * 2 + ks], t); \
      st[r][c] = t; } }
    R2_LOAD(A0, B0, 0) R2_LOAD(A1, B1, 1) R2_LOAD(A2, B2, 2)
#pragma unroll 1
    for (int n = 0; n < 255; n += 3) {
      R2_STEP(A0, B0, n)
      R2_LOAD(A0, B0, min(n + 3, NCH - 1))
      R2_STEP(A1, B1, n + 1)
      R2_LOAD(A1, B1, min(n + 4, NCH - 1))
      R2_STEP(A2, B2, n + 2)
      R2_LOAD(A2, B2, min(n + 5, NCH - 1))
    }
    R2_STEP(A0, B0, 255)
    R2_STEP(A1, B1, 256)
    int fre = fr, fqe = fq;
    asm volatile("" : "+v"(fre), "+v"(fqe));
#pragma unroll
    for (int r = 0; r < 4; ++r)
#pragma unroll
      for (int c = 0; c < 2; ++c)
#pragma unroll
        for (int j = 0; j < 4; ++j) {
          int dorig = perm_dorig(wid * 64 + r * 16 + fqe * 4 + j);
          p.out[O_SRP + ((size_t)(jr * 4 + h) * 256 + dorig) * 512 + sl * 32 + c * 16 + fre] = st[r][c][j];
        }
  }
}

DEV void r3_prompt(const Params& p, int jr, int n, int h, char* smem) {
  u32x4* Sf = (u32x4*)smem;
  float* red = (float*)(smem + 8192);
  int tid = otid(), lane = tid & 63, w = tid >> 6, fr = lane & 15, fq = lane >> 4;
  int p0 = n * 64;
  float l2g = ret_l2g(h);
  f32x4 acc[8][4];
#pragma unroll
  for (int a = 0; a < 8; ++a)
#pragma unroll
    for (int b = 0; b < 4; ++b) acc[a][b] = f32x4{0.f, 0.f, 0.f, 0.f};
  const u16* qb = p.Qr + (size_t)(p0 + fr) * DM + h * 256 + fq * 8;
  if (n >= 1) {
    const u16* sb = p.ST + (((size_t)(n * 4 + h) * 16 + (fq >> 1)) * 512 + w * 128 + fr) * 16 + (fq & 1) * 8;
#pragma unroll 1
    for (int ks = 0; ks < 8; ++ks) {
      bf16x8 bq[4];
#pragma unroll
      for (int it = 0; it < 4; ++it) bq[it] = *(const bf16x8*)(qb + (size_t)(it * 16) * DM + ks * 32);
#pragma unroll
      for (int dvt = 0; dvt < 8; ++dvt) {
        bf16x8 a = *(const bf16x8*)(sb + (size_t)(ks * 2) * (512 * 16) + dvt * 16 * 16);
#pragma unroll
        for (int it = 0; it < 4; ++it) acc[dvt][it] = mfma(a, bq[it], acc[dvt][it]);
      }
    }
#pragma unroll
    for (int it = 0; it < 4; ++it) {
      float qd = exp2f(l2g * (float)(it * 16 + fr + 1));
#pragma unroll
      for (int dvt = 0; dvt < 8; ++dvt) acc[dvt][it] = acc[dvt][it] * qd;
    }
  }
  {
    f32x4 s[4];
#pragma unroll
    for (int jt = 0; jt < 4; ++jt) s[jt] = f32x4{0.f, 0.f, 0.f, 0.f};
    const u16* kb = p.Kr + (size_t)(p0 + fr) * DM + h * 256 + fq * 8;
#pragma unroll 1
    for (int ks = 0; ks < 8; ++ks) {
      bf16x8 b = *(const bf16x8*)(qb + (size_t)(w * 16) * DM + ks * 32);
#pragma unroll
      for (int jt = 0; jt < 4; ++jt) {
        bf16x8 a = *(const bf16x8*)(kb + (size_t)(jt * 16) * DM + ks * 32);
        s[jt] = mfma(a, b, s[jt]);
      }
    }
    int i = w * 16 + fr;
#pragma unroll
    for (int jt = 0; jt < 4; ++jt)
#pragma unroll
      for (int jj = 0; jj < 4; ++jj) {
        int j = jt * 16 + fq * 4 + jj;
        int dd = i > j ? i - j : j - i;
        s[jt][jj] *= exp2f(l2g * (float)dd);
      }
    __syncthreads();
#pragma unroll
    for (int pp = 0; pp < 2; ++pp) {
      u32x4 t;
      t.x = pack2(s[2 * pp][0], s[2 * pp][1]); t.y = pack2(s[2 * pp][2], s[2 * pp][3]);
      t.z = pack2(s[2 * pp + 1][0], s[2 * pp + 1][1]); t.w = pack2(s[2 * pp + 1][2], s[2 * pp + 1][3]);
      Sf[(w * 2 + pp) * 64 + lane] = t;
    }
    __syncthreads();
  }
  {
    const u16* vb = p.VrT + tix(512, h, w * 128 + fr, p0) + fq * 4;
#pragma unroll
    for (int pp = 0; pp < 2; ++pp) {
      V8 bs[4];
#pragma unroll
      for (int it = 0; it < 4; ++it) bs[it].q = Sf[(it * 2 + pp) * 64 + lane];
#pragma unroll
      for (int dvt = 0; dvt < 8; ++dvt) {
        V8 a;
        a.d[0] = *(const u32x2*)(vb + dvt * 16 * 64 + (2 * pp) * 16);
        a.d[1] = *(const u32x2*)(vb + dvt * 16 * 64 + (2 * pp + 1) * 16);
#pragma unroll
        for (int it = 0; it < 4; ++it) acc[dvt][it] = mfma(a.v, bs[it].v, acc[dvt][it]);
      }
    }
  }
  float mean[4], rstd[4];
  {
    float s1[4];
#pragma unroll
    for (int it = 0; it < 4; ++it) {
      float s = 0.f;
#pragma unroll
      for (int dvt = 0; dvt < 8; ++dvt) s += acc[dvt][it][0] + acc[dvt][it][1] + acc[dvt][it][2] + acc[dvt][it][3];
      s += __shfl_xor(s, 16); s += __shfl_xor(s, 32);
      s1[it] = s;
    }
    __syncthreads();
    if (fq == 0) {
#pragma unroll
      for (int it = 0; it < 4; ++it) red[w * 64 + it * 16 + fr] = s1[it];
    }
    __syncthreads();
#pragma unroll
    for (int it = 0; it < 4; ++it) {
      int i = it * 16 + fr;
      mean[it] = (red[i] + red[64 + i] + red[128 + i] + red[192 + i]) * (1.f / 512.f);
    }
#pragma unroll
    for (int it = 0; it < 4; ++it) {
      float s = 0.f;
#pragma unroll
      for (int dvt = 0; dvt < 8; ++dvt)
#pragma unroll
        for (int j = 0; j < 4; ++j) { float d = acc[dvt][it][j] - mean[it]; s += d * d; }
      s += __shfl_xor(s, 16); s += __shfl_xor(s, 32);
      s1[it] = s;
    }
    __syncthreads();
    if (fq == 0) {
#pragma unroll
      for (int it = 0; it < 4; ++it) red[w * 64 + it * 16 + fr] = s1[it];
    }
    __syncthreads();
#pragma unroll
    for (int it = 0; it < 4; ++it) {
      int i = it * 16 + fr;
      float var = (red[i] + red[64 + i] + red[128 + i] + red[192 + i]) * (1.f / 512.f);
      rstd[it] = rsqrtf(var + EPS);
    }
  }
#pragma unroll
  for (int it = 0; it < 4; ++it) {
    int t = p0 + it * 16 + fr - LEAD;
    if (t >= 0 && t < LP) {
#pragma unroll
      for (int dvt = 0; dvt < 8; ++dvt) {
        int e0 = h * 512 + w * 128 + dvt * 16 + fq * 4;
        u16* gp = p.Gr + (size_t)t * 2048 + e0;
        u32x2 g = *(const u32x2*)gp;
        f32x4 gn = *(const f32x4*)(p.ret_gn + jr * 2048 + e0);
        float g0 = bflo(g.x), g1 = bfhi(g.x), g2 = bflo(g.y), g3 = bfhi(g.y);
        float y0 = (acc[dvt][it][0] - mean[it]) * rstd[it] * gn.x * (g0 * sigmoidf_(g0));
        float y1 = (acc[dvt][it][1] - mean[it]) * rstd[it] * gn.y * (g1 * sigmoidf_(g1));
        float y2 = (acc[dvt][it][2] - mean[it]) * rstd[it] * gn.z * (g2 * sigmoidf_(g2));
        float y3 = (acc[dvt][it][3] - mean[it]) * rstd[it] * gn.w * (g3 * sigmoidf_(g3));
        u32x2 o; o.x = pack2(y0, y1); o.y = pack2(y2, y3);
        *(u32x2*)gp = o;
      }
    }
  }
}

DEV void r3_sample(const Params& p, int jr, int b, int h, char* smem) {
  float* obuf = (float*)smem;
  u16* qs = (u16*)(smem + 32768);
  u16* ks = qs + 16 * 256;
  float* sm = (float*)(smem + 49152);
  float* red = sm + 256;
  float* stat = red + 64;
  int tid = otid(), lane = tid & 63, wid = tid >> 6;
  float l2g = ret_l2g(h);
  int prow = LP + LEAD + b * 16;
  __syncthreads();
  for (int e = tid; e < 16 * 256; e += 256) {
    int i = e >> 8, d = e & 255;
    qs[e] = p.Qr[(size_t)(prow + i) * DM + h * 256 + d];
    ks[e] = p.Kr[(size_t)(prow + i) * DM + h * 256 + d];
  }
  __syncthreads();
  {
    int i = tid >> 4, j = tid & 15;
    float a = 0.f;
#pragma unroll 8
    for (int d = 0; d < 256; ++d) a += bf2f(qs[i * 256 + d]) * bf2f(ks[j * 256 + d]);
    int dd = i > j ? i - j : j - i;
    sm[tid] = a * exp2f(l2g * (float)dd);
  }
  __syncthreads();
  for (int e = tid; e < 16 * 256; e += 256) ks[e] = f2bf(bf2f(ks[e]) * exp2f(l2g * (float)(15 - (e >> 8))));
  __syncthreads();
  float dec16 = exp2f(l2g * 16.f);
  const float* stin = p.state_ret + ((size_t)(jr * 8 + b) * 4 + h) * 256 * 512;
  float* stout = p.out + O_SRS + ((size_t)(jr * 8 + b) * 4 + h) * 256 * 512;
#pragma unroll 1
  for (int c = 0; c < 2; ++c) {
    int e = tid + c * 256;
    float v[16], o[16];
    const u16* vp = p.VrT + tix(512, h, e, prow);
    u32x4 a = *(const u32x4*)vp, bq = *(const u32x4*)(vp + 8);
    v[0] = bflo(a.x); v[1] = bfhi(a.x); v[2] = bflo(a.y); v[3] = bfhi(a.y);
    v[4] = bflo(a.z); v[5] = bfhi(a.z); v[6] = bflo(a.w); v[7] = bfhi(a.w);
    v[8] = bflo(bq.x); v[9] = bfhi(bq.x); v[10] = bflo(bq.y); v[11] = bfhi(bq.y);
    v[12] = bflo(bq.z); v[13] = bfhi(bq.z); v[14] = bflo(bq.w); v[15] = bfhi(bq.w);
#pragma unroll
    for (int i = 0; i < 16; ++i) o[i] = 0.f;
#pragma unroll 2
    for (int dp = 0; dp < 256; ++dp) {
      int dorig = perm_dorig(dp);
      float s0 = stin[(size_t)dorig * 512 + e];
      float n0 = s0 * dec16;
#pragma unroll
      for (int i = 0; i < 16; ++i) {
        o[i] += bf2f(qs[i * 256 + dp]) * s0;
        n0 += bf2f(ks[i * 256 + dp]) * v[i];
      }
      stout[(size_t)dorig * 512 + e] = n0;
    }
#pragma unroll
    for (int i = 0; i < 16; ++i) obuf[i * 512 + e] = o[i] * exp2f(l2g * (float)(i + 1));
#pragma unroll 1
    for (int i = 0; i < 16; ++i) {
      float a0 = obuf[i * 512 + e];
#pragma unroll
      for (int j = 0; j < 16; ++j) a0 += sm[i * 16 + j] * v[j];
      obuf[i * 512 + e] = a0;
    }
  }
  __syncthreads();
  for (int i = 0; i < 16; ++i) {
    float s = wave_sum(obuf[i * 512 + tid] + obuf[i * 512 + 256 + tid]);
    if (lane == 0) red[wid * 16 + i] = s;
  }
  __syncthreads();
  if (tid < 16) stat[tid] = (red[tid] + red[16 + tid] + red[32 + tid] + red[48 + tid]) * (1.f / 512.f);
  __syncthreads();
  for (int i = 0; i < 16; ++i) {
    float mu = stat[i];
    float d0 = obuf[i * 512 + tid] - mu, d1 = obuf[i * 512 + 256 + tid] - mu;
    float s = wave_sum(d0 * d0 + d1 * d1);
    if (lane == 0) red[wid * 16 + i] = s;
  }
  __syncthreads();
  if (tid < 16) stat[16 + tid] = rsqrtf((red[tid] + red[16 + tid] + red[32 + tid] + red[48 + tid]) * (1.f / 512.f) + EPS);
  __syncthreads();
  for (int c = 0; c < 2; ++c) {
    int e = tid + c * 256;
    float gn = p.ret_gn[jr * 2048 + h * 512 + e];
    for (int i = 0; i < 16; ++i) {
      int t = LP + b * 16 + i;
      float g = bf2f(p.Gr[(size_t)t * 2048 + h * 512 + e]);
      float y = (obuf[i * 512 + e] - stat[i]) * stat[16 + i] * gn * (g * sigmoidf_(g));
      p.Gr[(size_t)t * 2048 + h * 512 + e] = f2bf(y);
    }
  }
}

DEV void ph_r3(const Params& p, int jr, char* smem) {
  const int NP = NCH * 4, NI = NP + 32;
  for (int it = blockIdx.x; it < NI; it += gridDim.x) {
    if (it < 32) r3_sample(p, jr, it >> 2, it & 3, smem);
    else { int q = it - 32; r3_prompt(p, jr, q >> 2, q & 3, smem); }
  }
}

DEV void ph_p2(const Params& p, int layer, char* smem) {
  const u16* Wt = p.WpqT + (size_t)layer * 2048 * 1024;
  u16* Qs = (u16*)smem;
  constexpr int LQ = 136;
  int tid = otid(), lane = tid & 63, wid = tid >> 6;
  int wr = wid >> 1, wc = wid & 1, fr = lane & 15, fq = lane >> 4;
  for (int it = blockIdx.x; it < MTILES * 16; it += gridDim.x) {
    int mt, hp; tile_mn(it, 16, mt, hp);
    int m0 = mt * 128;
    f32x4 acc[4][4];
    gemm_tile<true>(p.H, DM, Wt, DM, DM, m0, hp * 128, smem, acc);
    __syncthreads();
#pragma unroll
    for (int m = 0; m < 4; ++m) {
      float rs = rsqrtf((float)p.SSQ[m0 + wr * 64 + m * 16 + fr] * (1.f / (1048576.f * DM)) + EPS);
#pragma unroll
      for (int n = 0; n < 4; ++n) {
        u32x2 o; o.x = pack2(acc[m][n][0] * rs, acc[m][n][1] * rs); o.y = pack2(acc[m][n][2] * rs, acc[m][n][3] * rs);
        *(u32x2*)(Qs + (wr * 64 + m * 16 + fr) * LQ + wc * 64 + n * 16 + fq * 4) = o;
      }
    }
    __syncthreads();
    f32x4 sc[2][8];
#pragma unroll
    for (int rt = 0; rt < 2; ++rt)
#pragma unroll
      for (int ct = 0; ct < 8; ++ct) sc[rt][ct] = f32x4{0.f, 0.f, 0.f, 0.f};
    const u16* skb = p.SKb + ((size_t)(layer * 16 + hp) * 128 + fr) * 128 + fq * 8;
#pragma unroll
    for (int ks = 0; ks < 4; ++ks) {
      bf16x8 a[2];
#pragma unroll
      for (int rt = 0; rt < 2; ++rt) a[rt] = *(const bf16x8*)(Qs + (wid * 32 + rt * 16 + fr) * LQ + ks * 32 + fq * 8);
#pragma unroll
      for (int ct = 0; ct < 8; ++ct) {
        bf16x8 b = *(const bf16x8*)(skb + (size_t)(ct * 16) * 128 + ks * 32);
#pragma unroll
        for (int rt = 0; rt < 2; ++rt) sc[rt][ct] = mfma(a[rt], b, sc[rt][ct]);
      }
    }
#pragma unroll
    for (int rt = 0; rt < 2; ++rt)
#pragma unroll
      for (int j = 0; j < 4; ++j) {
        uint32_t key[8];
#pragma unroll
        for (int ct = 0; ct < 8; ++ct) key[ct] = (f2key(sc[rt][ct][j]) & ~127u) | (uint32_t)(127 - (ct * 16 + fr));
        uint32_t mine = 0;
#pragma unroll 1
        for (int r = 0; r < 16; ++r) {
          uint32_t best = key[0];
#pragma unroll
          for (int ct = 1; ct < 8; ++ct) best = max(best, key[ct]);
          best = row16_maxu(best);
#pragma unroll
          for (int ct = 0; ct < 8; ++ct) key[ct] = (key[ct] == best) ? 0u : key[ct];
          if (fr == r) mine = best;
        }
        int row = m0 + wid * 32 + rt * 16 + fq * 4 + j;
        p.SV[((size_t)row * 16 + hp) * 16 + fr] = key2f(mine & ~127u);
        p.SI[((size_t)row * 16 + hp) * 16 + fr] = 127 - (int)(mine & 127u);
      }
  }
}

DEV void ph_p3(const Params& p, int layer, char* smem) {
  int tid = otid(), lane = tid & 63, wid = tid >> 6;
  int* eidL = (int*)smem + wid * 256;
  float* gateL = (float*)(eidL + 128);
  int ca = 0, cb = 0; bool cvalid = false;
  {
    int cnt = 0;
    for (int a = 0; a < 16; ++a) {
      int nb = 16 / (a + 1);
      if (lane >= cnt && lane < cnt + nb) { ca = a; cb = lane - cnt; cvalid = true; }
      cnt += nb;
    }
  }
  int gw = (blockIdx.x * blockDim.x + tid) >> 6, nw = (gridDim.x * blockDim.x) >> 6;
  for (int t = gw; t < TTOK; t += nw) {
    const float* svp = p.SV + (size_t)t * 256;
    const int* sip = p.SI + (size_t)t * 256;
    for (int h = 0; h < 8; ++h) {
      float cand = cvalid ? (svp[h * 32 + ca] + svp[h * 32 + 16 + cb]) : 0.f;
      uint32_t key = cvalid ? ((f2key(cand) & ~63u) | (uint32_t)(63 - lane)) : 0u;
      uint32_t mine = 0;
#pragma unroll 1
      for (int r = 0; r < 16; ++r) {
        uint32_t best = wave_maxu(key);
        key = (key == best) ? 0u : key;
        if (lane == r) mine = best;
      }
      int src = 63 - (int)(mine & 63u);
      int wa = __shfl(ca, src), wb = __shfl(cb, src);
      float fv = key2f(mine & ~63u);
      float f0 = rdlane(fv, 0);
      float e = (lane < 16) ? __expf(fv - f0) : 0.f;
      float ssum = row16_sum(e);
      if (lane < 16) {
        int eid = sip[h * 32 + wa] * 128 + sip[h * 32 + 16 + wb];
        eidL[h * 16 + lane] = eid;
        gateL[h * 16 + lane] = e / ssum;
      }
    }
    float hf[16];
    {
      u32x4 ha = *(const u32x4*)(p.H + (size_t)t * DM + lane * 16);
      u32x4 hb = *(const u32x4*)(p.H + (size_t)t * DM + lane * 16 + 8);
      hf[0] = bflo(ha.x); hf[1] = bfhi(ha.x); hf[2] = bflo(ha.y); hf[3] = bfhi(ha.y);
      hf[4] = bflo(ha.z); hf[5] = bfhi(ha.z); hf[6] = bflo(ha.w); hf[7] = bfhi(ha.w);
      hf[8] = bflo(hb.x); hf[9] = bfhi(hb.x); hf[10] = bflo(hb.y); hf[11] = bfhi(hb.y);
      hf[12] = bflo(hb.z); hf[13] = bfhi(hb.z); hf[14] = bflo(hb.w); hf[15] = bfhi(hb.w);
      float rs = rsqrtf((float)p.SSQ[t] * (1.f / (1048576.f * DM)) + EPS);
#pragma unroll
      for (int i = 0; i < 16; ++i) hf[i] *= rs;
    }
    const unsigned char* U8 = (const unsigned char*)p.Ub + lane * 16;
    const unsigned char* V8p = (const unsigned char*)p.Vb + lane * 16;
#define P3_LOAD(buf, tab, base) _Pragma("unroll") for (int u = 0; u < 8; ++u) { \
      int eid_ = __builtin_amdgcn_readfirstlane(eidL[(base) + u]); \
      buf[u] = *(const u32x4*)((tab) + (size_t)eid_ * DM); }
#define P3_CVT(f, q) { v2f_t c_; \
      c_ = __builtin_amdgcn_cvt_pk_f32_fp8((int)(q).x, false); f[0] = c_.x; f[1] = c_.y; \
      c_ = __builtin_amdgcn_cvt_pk_f32_fp8((int)(q).x, true);  f[2] = c_.x; f[3] = c_.y; \
      c_ = __builtin_amdgcn_cvt_pk_f32_fp8((int)(q).y, false); f[4] = c_.x; f[5] = c_.y; \
      c_ = __builtin_amdgcn_cvt_pk_f32_fp8((int)(q).y, true);  f[6] = c_.x; f[7] = c_.y; \
      c_ = __builtin_amdgcn_cvt_pk_f32_fp8((int)(q).z, false); f[8] = c_.x; f[9] = c_.y; \
      c_ = __builtin_amdgcn_cvt_pk_f32_fp8((int)(q).z, true);  f[10] = c_.x; f[11] = c_.y; \
      c_ = __builtin_amdgcn_cvt_pk_f32_fp8((int)(q).w, false); f[12] = c_.x; f[13] = c_.y; \
      c_ = __builtin_amdgcn_cvt_pk_f32_fp8((int)(q).w, true);  f[14] = c_.x; f[15] = c_.y; }
#define P3_DOT(buf, base) _Pragma("unroll") for (int u = 0; u < 8; ++u) { \
      float f_[16]; P3_CVT(f_, buf[u]); float d_ = 0.f; \
      _Pragma("unroll") for (int i = 0; i < 16; ++i) d_ += hf[i] * f_[i]; \
      d_ = wave_sum(d_) * (1.f / U_SCALE); \
      int k_ = (base) + u; \
      if (lane == (k_ & 63)) { if (k_ < 64) w0 = d_; else w1 = d_; } }
#define P3_AXPY(buf, base) { float ws_ = ((base) < 64) ? w0 : w1; \
      _Pragma("unroll") for (int u = 0; u < 8; ++u) { \
        float f_[16]; P3_CVT(f_, buf[u]); float wk_ = rdlane(ws_, ((base) + u) & 63); \
        _Pragma("unroll") for (int i = 0; i < 16; ++i) oacc[i] += wk_ * f_[i]; } }
    float w0 = 0.f, w1 = 0.f;
    {
      u32x4 A[8], B[8];
      P3_LOAD(A, U8, 0)
#pragma unroll 1
      for (int kb = 0; kb < 128; kb += 16) {
        P3_LOAD(B, U8, kb + 8)
        P3_DOT(A, kb)
        if (kb + 16 < 128) { P3_LOAD(A, U8, kb + 16) }
        P3_DOT(B, kb + 8)
      }
    }
    w0 = gateL[lane] * gelu_(w0);
    w1 = gateL[64 + lane] * gelu_(w1);
    float oacc[16];
#pragma unroll
    for (int i = 0; i < 16; ++i) oacc[i] = 0.f;
    {
      u32x4 A[8], B[8];
      P3_LOAD(A, V8p, 0)
#pragma unroll 1
      for (int kb = 0; kb < 128; kb += 16) {
        P3_LOAD(B, V8p, kb + 8)
        P3_AXPY(A, kb)
        if (kb + 16 < 128) { P3_LOAD(A, V8p, kb + 16) }
        P3_AXPY(B, kb + 8)
      }
    }
    int te = t, le = lane;
    asm volatile("" : "+v"(te), "+v"(le));
    float* xr = p.X + (size_t)te * DM + le * 16;
    f32x4 xv[4];
#pragma unroll
    for (int c = 0; c < 4; ++c) {
      xv[c] = *(const f32x4*)(xr + c * 4);
      xv[c].x += oacc[c * 4 + 0] * (1.f / V_SCALE); xv[c].y += oacc[c * 4 + 1] * (1.f / V_SCALE);
      xv[c].z += oacc[c * 4 + 2] * (1.f / V_SCALE); xv[c].w += oacc[c * 4 + 3] * (1.f / V_SCALE);
    }
    if (layer < 3) {
      float ss = 0.f;
#pragma unroll
      for (int c = 0; c < 4; ++c) {
        *(f32x4*)(xr + c * 4) = xv[c];
        ss += xv[c].x * xv[c].x + xv[c].y * xv[c].y + xv[c].z * xv[c].z + xv[c].w * xv[c].w;
      }
      ss = wave_sum(ss);
      float rstd = rsqrtf(ss * (1.f / DM) + EPS);
      const float* g = p.norm_mix + (size_t)(layer + 1) * DM + le * 16;
      u32x4 o0, o1;
      f32x4 g0 = *(const f32x4*)(g), g1 = *(const f32x4*)(g + 4), g2 = *(const f32x4*)(g + 8), g3 = *(const f32x4*)(g + 12);
      o0.x = pack2(xv[0].x * rstd * g0.x, xv[0].y * rstd * g0.y); o0.y = pack2(xv[0].z * rstd * g0.z, xv[0].w * rstd * g0.w);
      o0.z = pack2(xv[1].x * rstd * g1.x, xv[1].y * rstd * g1.y); o0.w = pack2(xv[1].z * rstd * g1.z, xv[1].w * rstd * g1.w);
      o1.x = pack2(xv[2].x * rstd * g2.x, xv[2].y * rstd * g2.y); o1.y = pack2(xv[2].z * rstd * g2.z, xv[2].w * rstd * g2.w);
      o1.z = pack2(xv[3].x * rstd * g3.x, xv[3].y * rstd * g3.y); o1.w = pack2(xv[3].z * rstd * g3.z, xv[3].w * rstd * g3.w);
      *(u32x4*)(p.H + (size_t)te * DM + le * 16) = o0;
      *(u32x4*)(p.H + (size_t)te * DM + le * 16 + 8) = o1;
    } else {
      float* yo = nullptr;
      if (te >= NMETA && te < LP) yo = p.out + O_YP + (size_t)(te - NMETA) * DM + le * 16;
      else if (te >= LP) yo = p.out + O_YS + (size_t)(te - LP) * DM + le * 16;
      if (yo) {
#pragma unroll
        for (int c = 0; c < 4; ++c) *(f32x4*)(yo + c * 4) = xv[c];
      }
    }
  }
}

constexpr int NPHASE = 23;
#ifndef DBG_PHASES
#define DBG_PHASES NPHASE
#endif
#ifndef DBG_SCALES
#define DBG_SCALES {1,1,1,1,1,1,1,1,1,1,1,1,1,1,1,1,1,1,1,1}
#endif
#ifndef DBG_POST
#define DBG_POST 0
#endif
DEV void post_scale(const Params& p) {
  const float sc[20] = DBG_SCALES;
  const size_t offs[11] = {O_YP, O_YS, O_FKP, O_FVP, O_FLP, O_SRP, O_FKS, O_FVS, O_FLS, O_SRS, O_SRS + (size_t)2 * 8 * 4 * 256 * 512};
  size_t i0 = (size_t)blockIdx.x * blockDim.x + otid(), st = (size_t)gridDim.x * blockDim.x;
#pragma unroll
  for (int k = 0; k < 20; ++k) {
    float f = sc[k];
    if (f == 1.f) continue;
    size_t a = offs[k >> 1], b = offs[(k >> 1) + 1], mid = a + (b - a) / 2;
    size_t lo = (k & 1) ? mid : a, hi = (k & 1) ? b : mid;
    for (size_t i = lo + i0; i < hi; i += st) p.out[i] *= f;
  }
}
DEV void dump_x(const Params& p) {
  size_t i = (size_t)blockIdx.x * blockDim.x + otid(), st = (size_t)gridDim.x * blockDim.x;
  for (; i < (size_t)(TTOK - NMETA) * DM; i += st) p.out[i] = p.X[(size_t)NMETA * DM + i];
}
__global__ void __launch_bounds__(256, 2) mega(Params p, int ph0, int ph1) {
  __shared__ __attribute__((aligned(16))) char smem[53248];
  for (int ph = ph0; ph < ph1; ++ph) {
    if (ph > ph0) cg::this_grid().sync();
    if (ph == 0) { ph_prep(p, smem); continue; }
    int q = ph - 1, layer, idx;
    if (q < 5) { layer = 0; idx = q; } else if (q < 11) { layer = 1; idx = q - 5; }
    else if (q < 16) { layer = 2; idx = q - 11; } else { layer = 3; idx = q - 16; }
    int j = layer >> 1;
    const float* gffn = p.norm_ffn + (size_t)layer * DM;
    if ((layer & 1) == 0) {
      if (idx == 0) ph_f1(p, j, smem);
      else if (idx == 1) ph_f2(p, j, smem);
      else if (idx == 2) ph_outproj(p, p.AO, 1024, p.WfoutT + (size_t)j * 1024 * 1024, gffn, smem);
      else if (idx == 3) ph_p2(p, layer, smem);
      else ph_p3(p, layer, smem);
    } else {
      if (idx == 0) ph_r1(p, j, smem);
      else if (idx == 1) { ph_r2(p, j); conv_tables(p, layer); }
      else if (idx == 2) ph_r3(p, j, smem);
      else if (idx == 3) ph_outproj(p, p.Gr, 2048, p.WroutT + (size_t)j * 1024 * 2048, gffn, smem);
      else if (idx == 4) ph_p2(p, layer, smem);
      else ph_p3(p, layer, smem);
    }
  }
}

extern "C" void kernel_launch(void* const* d_in, const int* in_sizes, int n_in, void* d_out, int out_size,
                              void* d_ws, size_t ws_size, hipStream_t stream) {
  static int grid_blocks = 0;
  if (!grid_blocks) {
    int dev = 0, cus = 0, per_cu = 0;
    hipGetDevice(&dev);
    hipDeviceGetAttribute(&cus, hipDeviceAttributeMultiprocessorCount, dev);
    hipOccupancyMaxActiveBlocksPerMultiprocessor(&per_cu, mega, 256, 0);
    if (per_cu > 2) per_cu = 2;
    if (per_cu < 1) per_cu = 1;
    grid_blocks = cus * per_cu;
  }
  Params p;
  memset(&p, 0, sizeof(p));
  const float* const* in = (const float* const*)d_in;
  p.x_prompt = in[0]; p.x_sample = in[1]; p.cache_k = in[2]; p.cache_v = in[3]; p.cache_lf = in[4]; p.state_ret = in[5];
  p.meta = in[6]; p.norm_mix = in[7]; p.norm_ffn = in[8]; p.fox_w_in = in[9]; p.fox_b_f = in[10]; p.fox_qn = in[11];
  p.fox_kn = in[12]; p.fox_w_out = in[13]; p.ret_w_in = in[14]; p.ret_gn = in[15]; p.ret_w_out = in[16];
  p.peer_wq = in[17]; p.peer_sk = in[18]; p.peer_u = in[19]; p.peer_v = in[20];
  p.out = (float*)d_out;
  char* w = (char*)d_ws;
  size_t off = 0;
  auto take = [&](size_t bytes) { char* r = w + off; off += (bytes + 255) & ~(size_t)255; return r; };
  p.X = (float*)take((size_t)TPAD * DM * 4);
  p.H = (u16*)take((size_t)TPAD * DM * 2);
  p.WfinT = (u16*)take((size_t)2 * 4224 * 1024 * 2);
  p.WfoutT = (u16*)take((size_t)2 * 1024 * 1024 * 2);
  p.WrinT = (u16*)take((size_t)2 * 6144 * 1024 * 2);
  p.WroutT = (u16*)take((size_t)2 * 1024 * 2048 * 2);
  p.WpqT = (u16*)take((size_t)4 * 2048 * 1024 * 2);
  p.SKb = (u16*)take((size_t)4 * 8 * 2 * 128 * 128 * 2);
  p.Ub = (u16*)take((size_t)NEXP * DM * 2);
  p.Vb = (u16*)take((size_t)NEXP * DM * 2);
  p.SV = (float*)take((size_t)TPAD * 256 * 4);
  p.SI = (int*)take((size_t)TPAD * 256 * 4);
  p.LFC = (float*)take((size_t)TPAD * 16 * 4);
  p.LFR = (float*)take((size_t)TPAD * 16 * 4);
  p.TT = (float*)take((size_t)MTILES * 16 * 4);
  p.SSQ = (unsigned long long*)take((size_t)TPAD * 8);
  size_t region = off;
  p.Qf = (u16*)take((size_t)TPAD * DM * 2);
  p.Kf = (u16*)take((size_t)TPAD * DM * 2);
  p.VtF = (u16*)take((size_t)1024 * TPAD * 2);
  p.OGf = (u16*)take((size_t)TPAD * DM * 2);
  p.AO = (u16*)take((size_t)TPAD * DM * 2);
  off = region;
  p.Qr = (u16*)take((size_t)TP2 * DM * 2);
  p.Kr = (u16*)take((size_t)TP2 * DM * 2);
  p.KrT = (u16*)take((size_t)1024 * TP2 * 2);
  p.VrT = (u16*)take((size_t)2048 * TP2 * 2);
  p.Gr = (u16*)take((size_t)TPAD * 2048 * 2);
  p.ST = (u16*)take((size_t)NCH * 4 * 512 * 256 * 2);
  if (off > ws_size) { fprintf(stderr, "workspace too small: need %zu have %zu\n", off, ws_size); return; }
  for (int i = 0; i < 128; ++i) p.rope_rev[i] = (float)(pow(10000.0, -(double)i / 128.0) / (2.0 * M_PI));
#if ONE_LAUNCH
  int ph0 = 0, ph1 = NPHASE;
  void* args[] = {&p, &ph0, &ph1};
  hipError_t e = hipLaunchCooperativeKernel((void*)mega, dim3(grid_blocks), dim3(256), args, 0, stream);
  if (e != hipSuccess) fprintf(stderr, "cooperative launch failed: %s (grid %d)\n", hipGetErrorString(e), grid_blocks);
#else
  for (int ph = 0; ph < NPHASE; ++ph) mega<<<grid_blocks, 256, 0, stream>>>(p, ph, ph + 1);
#endif
}
```

```cpp
#include <hip/hip_runtime.h>
#include <hip/hip_cooperative_groups.h>
#include <stdint.h>
#include <math.h>
#include <stdio.h>
#include <string.h>
namespace cg = cooperative_groups;

typedef unsigned short u16;
typedef __attribute__((ext_vector_type(8))) short bf16x8;
typedef __attribute__((ext_vector_type(4))) float f32x4;
typedef __attribute__((ext_vector_type(2))) float f32x2;
typedef __attribute__((ext_vector_type(4))) unsigned int u32x4;
typedef __attribute__((ext_vector_type(2))) unsigned int u32x2;
#define DEV __device__ __forceinline__

#ifndef ONE_LAUNCH
#define ONE_LAUNCH 1
#endif

constexpr int DM = 1024;
constexpr int NMETA = 16;
constexpr int LP = 16400;
constexpr int NSMP = 128;
constexpr int TTOK = LP + NSMP;
constexpr int TPAD = 16640;
constexpr int MTILES = 130;
constexpr int LEAD = 48;
constexpr int TP2 = 16704;
constexpr int NCH = 257;
constexpr int PAST = 1024;
constexpr int NEXP = 16384;
constexpr float EPS = 1e-6f;

constexpr size_t O_YP = 0;
constexpr size_t O_YS = O_YP + (size_t)16384 * 1024;
constexpr size_t O_FKP = O_YS + (size_t)128 * 1024;
constexpr size_t O_FVP = O_FKP + (size_t)2 * LP * 1024;
constexpr size_t O_FLP = O_FVP + (size_t)2 * LP * 1024;
constexpr size_t O_SRP = O_FLP + (size_t)2 * LP * 16;
constexpr size_t O_FKS = O_SRP + (size_t)2 * 4 * 256 * 512;
constexpr size_t O_FVS = O_FKS + (size_t)2 * 128 * 1024;
constexpr size_t O_FLS = O_FVS + (size_t)2 * 128 * 1024;
constexpr size_t O_SRS = O_FLS + (size_t)2 * 128 * 16;

struct Params {
  const float *x_prompt, *x_sample, *cache_k, *cache_v, *cache_lf, *state_ret, *meta, *norm_mix, *norm_ffn;
  const float *fox_w_in, *fox_b_f, *fox_qn, *fox_kn, *fox_w_out, *ret_w_in, *ret_gn, *ret_w_out;
  const float *peer_wq, *peer_sk, *peer_u, *peer_v;
  float* out;
  float* X; u16* H;
  u16 *WfinT, *WfoutT, *WrinT, *WroutT, *WpqT, *SKb, *Ub, *Vb;
  float *SV; int* SI;
  float *LFC, *LFR, *TT; unsigned long long* SSQ;
  u16 *Qf, *Kf, *VtF, *OGf, *AO;
  u16 *Qr, *Kr, *KrT, *VrT, *Gr, *ST;
  float rope_rev[128];
};

typedef __attribute__((ext_vector_type(2))) float f2cv_t;
typedef __attribute__((ext_vector_type(2))) __bf16 bf2cv_t;
DEV uint32_t pack2(float a, float b) { f2cv_t v = {a, b}; bf2cv_t r = __builtin_convertvector(v, bf2cv_t); return __builtin_bit_cast(uint32_t, r); }
DEV u16 f2bf(float f) { return (u16)(pack2(f, 0.f) & 0xffffu); }
DEV float bf2f(u16 h) { return __uint_as_float(((uint32_t)h) << 16); }
DEV float bflo(uint32_t u) { return __uint_as_float(u << 16); }
DEV float bfhi(uint32_t u) { return __uint_as_float(u & 0xffff0000u); }

union V8 { bf16x8 v; uint32_t u[4]; u32x2 d[2]; u32x4 q; };

DEV f32x4 mfma(bf16x8 a, bf16x8 b, f32x4 c) { return __builtin_amdgcn_mfma_f32_16x16x32_bf16(a, b, c, 0, 0, 0); }

template <int CTRL> DEV float dppf(float v) {
  return __int_as_float(__builtin_amdgcn_update_dpp(0, __float_as_int(v), CTRL, 0xf, 0xf, false));
}
template <int CTRL> DEV uint32_t dppu(uint32_t v) {
  return (uint32_t)__builtin_amdgcn_update_dpp(0, (int)v, CTRL, 0xf, 0xf, false);
}
DEV float row16_sum(float v) {
  v += dppf<0xB1>(v); v += dppf<0x4E>(v); v += dppf<0x141>(v); v += dppf<0x140>(v);
  return v;
}
DEV uint32_t row16_maxu(uint32_t v) {
  v = max(v, dppu<0xB1>(v)); v = max(v, dppu<0x4E>(v)); v = max(v, dppu<0x141>(v)); v = max(v, dppu<0x140>(v));
  return v;
}
DEV float rdlane(float v, int l) { float r = __int_as_float(__builtin_amdgcn_readlane(__float_as_int(v), l)); asm volatile("" : "+v"(r)); return r; }
DEV float wave_sum(float v) {
  v = row16_sum(v);
  return rdlane(v, 0) + rdlane(v, 16) + rdlane(v, 32) + rdlane(v, 48);
}
DEV float wave_max(float v) {
  v = fmaxf(v, dppf<0xB1>(v)); v = fmaxf(v, dppf<0x4E>(v)); v = fmaxf(v, dppf<0x141>(v)); v = fmaxf(v, dppf<0x140>(v));
  return fmaxf(fmaxf(rdlane(v, 0), rdlane(v, 16)), fmaxf(rdlane(v, 32), rdlane(v, 48)));
}
DEV uint32_t wave_maxu(uint32_t v) {
  v = row16_maxu(v);
  uint32_t a = (uint32_t)__builtin_amdgcn_readlane((int)v, 0), b = (uint32_t)__builtin_amdgcn_readlane((int)v, 16);
  uint32_t c = (uint32_t)__builtin_amdgcn_readlane((int)v, 32), d = (uint32_t)__builtin_amdgcn_readlane((int)v, 48);
  return max(max(a, b), max(c, d));
}
DEV uint32_t f2key(float f) { uint32_t u = __float_as_uint(f); return (u & 0x80000000u) ? ~u : (u | 0x80000000u); }
DEV float key2f(uint32_t k) { uint32_t u = (k & 0x80000000u) ? (k & 0x7fffffffu) : ~k; return __uint_as_float(u); }

DEV float sigmoidf_(float x) { return 1.f / (1.f + __expf(-x)); }
DEV float logsigmoid_(float x) { return fminf(x, 0.f) - log1pf(expf(-fabsf(x))); }
DEV float gelu_(float x) { return 0.5f * x * (1.f + erff(x * 0.70710678118654752f)); }
DEV float ret_l2g(int h) { return log2f(1.f - exp2f(-5.f - (float)h)); }
DEV int otid() { int t = threadIdx.x; asm volatile("" : "+v"(t)); return t; }
DEV size_t tix(int rows, int h, int row, int pp) { return ((size_t)(h * 261 + (pp >> 6)) * rows + row) * 64 + (pp & 63); }
DEV int perm_dorig(int dp) { return ((dp >> 4) & 1) * 128 + (dp >> 5) * 16 + (dp & 15); }

DEV void norm_rows(const Params& p, const float* gain, bool from_input) {
  int tid_ = otid();
  int lane = tid_ & 63;
  int gw = (blockIdx.x * blockDim.x + tid_) >> 6, nw = (gridDim.x * blockDim.x) >> 6;
  for (int t = gw; t < TPAD; t += nw) {
    const float* src;
    if (from_input) {
      if (t < NMETA) src = p.meta + (size_t)t * DM;
      else if (t < LP) src = p.x_prompt + (size_t)(t - NMETA) * DM;
      else if (t < TTOK) src = p.x_sample + (size_t)(t - LP) * DM;
      else src = nullptr;
    } else src = p.X + (size_t)t * DM;
    f32x4 v[4];
    float ss = 0.f;
#pragma unroll
    for (int c = 0; c < 4; ++c) {
      if (src) v[c] = *(const f32x4*)(src + c * 256 + lane * 4); else v[c] = f32x4{0.f, 0.f, 0.f, 0.f};
      ss += v[c].x * v[c].x + v[c].y * v[c].y + v[c].z * v[c].z + v[c].w * v[c].w;
    }
    ss = wave_sum(ss);
    float rstd = rsqrtf(ss * (1.f / DM) + EPS);
#pragma unroll
    for (int c = 0; c < 4; ++c) {
      if (from_input) *(f32x4*)(p.X + (size_t)t * DM + c * 256 + lane * 4) = v[c];
      f32x4 g = *(const f32x4*)(gain + c * 256 + lane * 4);
      u32x2 o;
      o.x = pack2(v[c].x * rstd * g.x, v[c].y * rstd * g.y);
      o.y = pack2(v[c].z * rstd * g.z, v[c].w * rstd * g.w);
      *(u32x2*)(p.H + (size_t)t * DM + c * 256 + lane * 4) = o;
    }
  }
}

DEV void convert_bf16(const float* src, u16* dst, size_t n4) {
  size_t i = (size_t)blockIdx.x * blockDim.x + otid(), st = (size_t)gridDim.x * blockDim.x;
  for (; i < n4; i += st) {
    f32x4 v = ((const f32x4*)src)[i];
    u32x2 o; o.x = pack2(v.x, v.y); o.y = pack2(v.z, v.w);
    ((u32x2*)dst)[i] = o;
  }
}

DEV void xpose(const float* W, int K, int N, int Npad, u16* Wt, bool permq, char* smem) {
  u16* tile = (u16*)smem;
  int tid = otid();
  int ntn = Npad / 64, ntk = K / 64;
  for (int it = blockIdx.x; it < ntn * ntk; it += gridDim.x) {
    int n0 = (it / ntk) * 64, k0 = (it % ntk) * 64;
    int c = tid & 63, r0 = tid >> 6;
    int np = n0 + c;
    int src = np;
    if (permq && np < 2048) src = (np & ~255) + perm_dorig(np & 255);
    __syncthreads();
#pragma unroll
    for (int i = 0; i < 16; ++i) {
      int k = r0 + 4 * i;
      float v = (np < N) ? W[(size_t)(k0 + k) * N + src] : 0.f;
      tile[c * 72 + k] = f2bf(v);
    }
    __syncthreads();
    int nl = tid >> 2, kq = (tid & 3) * 16;
    u32x4 a = *(const u32x4*)(tile + nl * 72 + kq);
    u32x4 b = *(const u32x4*)(tile + nl * 72 + kq + 8);
    *(u32x4*)(Wt + (size_t)(n0 + nl) * K + k0 + kq) = a;
    *(u32x4*)(Wt + (size_t)(n0 + nl) * K + k0 + kq + 8) = b;
  }
}

typedef __attribute__((ext_vector_type(2))) float v2f_t;
constexpr float U_SCALE = 64.f, V_SCALE = 16.f;
DEV void convert_fp8(const float* src, uint32_t* dst, size_t n4, float scale) {
  size_t i = (size_t)blockIdx.x * blockDim.x + otid(), st = (size_t)gridDim.x * blockDim.x;
  for (; i < n4; i += st) {
    f32x4 v = ((const f32x4*)src)[i];
    int w = __builtin_amdgcn_cvt_pk_fp8_f32(v.x * scale, v.y * scale, 0, false);
    w = __builtin_amdgcn_cvt_pk_fp8_f32(v.z * scale, v.w * scale, w, true);
    dst[i] = (uint32_t)w;
  }
}
DEV void conv_tables(const Params& p, int layer) {
  convert_fp8(p.peer_u + (size_t)layer * NEXP * DM, (uint32_t*)p.Ub, (size_t)NEXP * DM / 4, U_SCALE);
  convert_fp8(p.peer_v + (size_t)layer * NEXP * DM, (uint32_t*)p.Vb, (size_t)NEXP * DM / 4, V_SCALE);
}

DEV void ph_prep(const Params& p, char* smem) {
  norm_rows(p, p.norm_mix, true);
  convert_bf16(p.peer_sk, p.SKb, (size_t)4 * 8 * 2 * 128 * 128 / 4);
  for (int j = 0; j < 2; ++j) {
    xpose(p.fox_w_in + (size_t)j * 1024 * 4112, 1024, 4112, 4224, p.WfinT + (size_t)j * 4224 * 1024, false, smem);
    xpose(p.fox_w_out + (size_t)j * 1024 * 1024, 1024, 1024, 1024, p.WfoutT + (size_t)j * 1024 * 1024, false, smem);
    xpose(p.ret_w_in + (size_t)j * 1024 * 6144, 1024, 6144, 6144, p.WrinT + (size_t)j * 6144 * 1024, true, smem);
    xpose(p.ret_w_out + (size_t)j * 2048 * 1024, 2048, 1024, 1024, p.WroutT + (size_t)j * 1024 * 2048, false, smem);
  }
  for (int l = 0; l < 4; ++l)
    xpose(p.peer_wq + (size_t)l * 1024 * 2048, 1024, 2048, 2048, p.WpqT + (size_t)l * 2048 * 1024, false, smem);
}

DEV void tile_mn(int it, int NT, int& mt, int& nt) {
  const int GM = 8;
  int g = it / (GM * NT), r = it - g * (GM * NT);
  int gm = min(GM, MTILES - g * GM);
  nt = r / gm; mt = g * GM + (r - nt * gm);
}

constexpr int LDK = 72;
template <bool SWAP>
DEV void gemm_tile(const u16* __restrict__ A, int lda, const u16* __restrict__ Bt, int ldb, int K,
                          int m0, int n0, char* smem, f32x4 (&acc)[4][4]) {
  u16* sA = (u16*)smem;
  u16* sB = sA + 128 * LDK;
  int tid = otid(), lane = tid & 63, wid = tid >> 6;
  int wr = wid >> 1, wc = wid & 1, fr = lane & 15, fq = lane >> 4;
#pragma unroll
  for (int m = 0; m < 4; ++m)
#pragma unroll
    for (int n = 0; n < 4; ++n) acc[m][n] = f32x4{0.f, 0.f, 0.f, 0.f};
  u32x4 ra[4], rb[4];
  const u16* Ap = A + (size_t)(m0 + (tid >> 3)) * lda + (tid & 7) * 8;
  const u16* Bp = Bt + (size_t)(n0 + (tid >> 3)) * ldb + (tid & 7) * 8;
#pragma unroll
  for (int i = 0; i < 4; ++i) {
    ra[i] = *(const u32x4*)(Ap + (size_t)(32 * i) * lda);
    rb[i] = *(const u32x4*)(Bp + (size_t)(32 * i) * ldb);
  }
  for (int k0 = 0; k0 < K; k0 += 64) {
    __syncthreads();
#pragma unroll
    for (int i = 0; i < 4; ++i) {
      *(u32x4*)(sA + ((tid >> 3) + 32 * i) * LDK + (tid & 7) * 8) = ra[i];
      *(u32x4*)(sB + ((tid >> 3) + 32 * i) * LDK + (tid & 7) * 8) = rb[i];
    }
    __syncthreads();
    if (k0 + 64 < K) {
#pragma unroll
      for (int i = 0; i < 4; ++i) {
        ra[i] = *(const u32x4*)(Ap + (size_t)(32 * i) * lda + k0 + 64);
        rb[i] = *(const u32x4*)(Bp + (size_t)(32 * i) * ldb + k0 + 64);
      }
    }
#pragma unroll
    for (int ks = 0; ks < 2; ++ks) {
      bf16x8 af[4], bfv[4];
#pragma unroll
      for (int m = 0; m < 4; ++m) af[m] = *(const bf16x8*)(sA + (wr * 64 + m * 16 + fr) * LDK + ks * 32 + fq * 8);
#pragma unroll
      for (int n = 0; n < 4; ++n) bfv[n] = *(const bf16x8*)(sB + (wc * 64 + n * 16 + fr) * LDK + ks * 32 + fq * 8);
#pragma unroll
      for (int m = 0; m < 4; ++m)
#pragma unroll
        for (int n = 0; n < 4; ++n) acc[m][n] = SWAP ? mfma(bfv[n], af[m], acc[m][n]) : mfma(af[m], bfv[n], acc[m][n]);
    }
  }
}

DEV void ph_f1(const Params& p, int jf, char* smem) {
  for (int i = blockIdx.x * blockDim.x + otid(); i < TPAD; i += gridDim.x * blockDim.x) p.SSQ[i] = 0ull;
  const u16* Wt = p.WfinT + (size_t)jf * 4224 * 1024;
  int tid = otid(), lane = tid & 63, wid = tid >> 6;
  int wr = wid >> 1, wc = wid & 1, fr = lane & 15, fq = lane >> 4;
  const int NT = 33;
  for (int it = blockIdx.x; it < MTILES * NT; it += gridDim.x) {
    int mt, nt; tile_mn(it, NT, mt, nt);
    int m0 = mt * 128;
    f32x4 acc[4][4];
    int type = nt >> 3;
    if (type == 2 || type == 4) gemm_tile<false>(p.H, DM, Wt, DM, DM, m0, nt * 128, smem, acc);
    else gemm_tile<true>(p.H, DM, Wt, DM, DM, m0, nt * 128, smem, acc);
    if (type <= 1) {
      int hh = (nt & 7) * 2 + wc;
      const float* gn = (type == 0 ? p.fox_qn : p.fox_kn) + jf * 64;
      const float gs = (type == 0) ? 0.125f * 1.44269504089f : 1.f;
      f32x4 g[4];
#pragma unroll
      for (int n = 0; n < 4; ++n) g[n] = *(const f32x4*)(gn + n * 16 + fq * 4) * gs;
#pragma unroll
      for (int m = 0; m < 4; ++m) {
        float ss = 0.f;
#pragma unroll
        for (int n = 0; n < 4; ++n)
#pragma unroll
          for (int j = 0; j < 4; ++j) ss += acc[m][n][j] * acc[m][n][j];
        ss += __shfl_xor(ss, 16); ss += __shfl_xor(ss, 32);
        float rstd = rsqrtf(ss * (1.f / 64.f) + EPS);
        int row = m0 + wr * 64 + m * 16 + fr;
#pragma unroll
        for (int n = 0; n < 4; ++n) {
          f32x4 v = acc[m][n] * rstd * g[n];
          int col = hh * 64 + n * 16 + fq * 4;
          u32x2 o; o.x = pack2(v.x, v.y); o.y = pack2(v.z, v.w);
          if (type == 0) *(u32x2*)(p.Qf + (size_t)row * DM + col) = o;
          else {
            *(u32x2*)(p.Kf + (size_t)row * DM + col) = o;
            if (row < LP) *(f32x4*)(p.out + O_FKP + ((size_t)jf * LP + row) * 1024 + col) = v;
            else if (row < TTOK) *(f32x4*)(p.out + O_FKS + ((size_t)jf * 128 + (row - LP)) * 1024 + col) = v;
          }
        }
      }
    } else if (type == 2) {
      int hh = (nt & 7) * 2 + wc;
#pragma unroll
      for (int m = 0; m < 4; ++m) {
        int rb = m0 + wr * 64 + m * 16 + fq * 4;
#pragma unroll
        for (int n = 0; n < 4; ++n) {
          int d = n * 16 + fr;
          u32x2 o; o.x = pack2(acc[m][n][0], acc[m][n][1]); o.y = pack2(acc[m][n][2], acc[m][n][3]);
          *(u32x2*)(p.VtF + (size_t)(hh * 64 + d) * TPAD + rb) = o;
#pragma unroll
          for (int j = 0; j < 4; ++j) {
            int row = rb + j; int col = hh * 64 + d;
            if (row < LP) p.out[O_FVP + ((size_t)jf * LP + row) * 1024 + col] = acc[m][n][j];
            else if (row < TTOK) p.out[O_FVS + ((size_t)jf * 128 + (row - LP)) * 1024 + col] = acc[m][n][j];
          }
        }
      }
    } else if (type == 3) {
#pragma unroll
      for (int m = 0; m < 4; ++m)
#pragma unroll
        for (int n = 0; n < 4; ++n) {
          int row = m0 + wr * 64 + m * 16 + fr;
          int col = (nt - 24) * 128 + wc * 64 + n * 16 + fq * 4;
          u32x2 o; o.x = pack2(acc[m][n][0], acc[m][n][1]); o.y = pack2(acc[m][n][2], acc[m][n][3]);
          *(u32x2*)(p.OGf + (size_t)row * DM + col) = o;
        }
    } else {
      float* lfs = (float*)smem;
      __syncthreads();
      if (wc == 0) {
        float bf = p.fox_b_f[jf * 16 + fr];
#pragma unroll
        for (int m = 0; m < 4; ++m)
#pragma unroll
          for (int j = 0; j < 4; ++j) {
            int rl = wr * 64 + m * 16 + fq * 4 + j;
            int row = m0 + rl;
            float lf = logsigmoid_(acc[m][0][j] + bf);
            lfs[rl * 16 + fr] = lf;
            p.LFR[(size_t)row * 16 + fr] = lf;
            if (row < LP) p.out[O_FLP + ((size_t)jf * LP + row) * 16 + fr] = lf;
            else if (row < TTOK) p.out[O_FLS + ((size_t)jf * 128 + (row - LP)) * 16 + fr] = lf;
          }
      }
      __syncthreads();
      if (tid < 16) {
        float run = 0.f;
        for (int r = 0; r < 128; ++r) {
          run += lfs[r * 16 + tid];
          p.LFC[(size_t)(m0 + r) * 16 + tid] = run;
        }
        p.TT[mt * 16 + tid] = run;
      }
    }
  }
}

DEV void f2_prompt(const Params& p, int qt, int h, char* smem) {
  u16* Ks = (u16*)smem;
  u16* Vs = Ks + 2 * 64 * LDK;
  float* cs = (float*)(Vs + 2 * 64 * LDK);
  float* off = cs + 128;
  float* tmp = off + 132;
  int tid = otid(), lane = tid & 63, wid = tid >> 6, fr = lane & 15, fq = lane >> 4;
  __syncthreads();
  if (tid < MTILES) tmp[tid] = p.TT[tid * 16 + h];
  __syncthreads();
  if (tid < MTILES) { float s = 0.f; for (int m = 0; m < tid; ++m) s += tmp[m]; off[tid] = s; }
  __syncthreads();
  int q0 = qt * 256 + wid * 64;
  bf16x8 qf[4][2];
  float cq[4], lrow[4];
  f32x4 o[4][4];
#pragma unroll
  for (int qi = 0; qi < 4; ++qi) {
    int q = q0 + qi * 16 + fr;
#pragma unroll
    for (int ks = 0; ks < 2; ++ks) qf[qi][ks] = *(const bf16x8*)(p.Qf + (size_t)q * DM + h * 64 + ks * 32 + fq * 8);
    cq[qi] = (p.LFC[(size_t)q * 16 + h] + off[q >> 7] - 12.f) * 1.44269504089f;
    lrow[qi] = 0.f;
#pragma unroll
    for (int dt = 0; dt < 4; ++dt) o[dt][qi] = f32x4{0.f, 0.f, 0.f, 0.f};
  }
  int nkt = 4 * (qt + 1);
  if (nkt > (LP + 63) / 64) nkt = (LP + 63) / 64;
  bool wave_valid = q0 < LP;
  u32x4 rk[2], rv[2]; float rc = 0.f;
  const int lrow_ = tid >> 2, lcol = (tid & 3) * 16;
  const u16* kfb = p.Kf + h * 64;
  const u16* vtb = p.VtF + (size_t)h * 64 * TPAD;
  const float* lcb = p.LFC + h;
  const unsigned kvo0 = (unsigned)(lrow_ * DM + lcol), kvo1 = kvo0 + 32u * DM;
  const unsigned vvo0 = (unsigned)(lrow_ * TPAD + lcol), vvo1 = vvo0 + 32u * TPAD;
#define GL(kt_) { int key0_ = (kt_) * 64; \
    const u16* kp_ = p.Kf + (size_t)(key0_ + lrow_) * DM + h * 64 + lcol; \
    const u16* vp_ = p.VtF + (size_t)(h * 64 + lrow_) * TPAD + key0_ + lcol; \
    rk[0] = *(const u32x4*)(kp_); rk[1] = *(const u32x4*)(kp_ + 8); \
    rv[0] = *(const u32x4*)(vp_); rv[1] = *(const u32x4*)(vp_ + 8); \
    if (tid < 64) rc = (p.LFC[(size_t)(key0_ + tid) * 16 + h] + off[(key0_ + tid) >> 7]) * 1.44269504089f; }
  GL(0);
  for (int kt = 0; kt < nkt; ++kt) {
    int buf = kt & 1;
    u16* Kb = Ks + buf * 64 * LDK; u16* Vb = Vs + buf * 64 * LDK; float* cb = cs + buf * 64;
#pragma unroll
    for (int i = 0; i < 2; ++i) {
      *(u32x4*)(Kb + lrow_ * LDK + lcol + 8 * i) = rk[i];
      *(u32x4*)(Vb + lrow_ * LDK + lcol + 8 * i) = rv[i];
    }
    if (tid < 64) cb[tid] = rc;
    __syncthreads();
    if (kt + 1 < nkt) GL(kt + 1);
    int key0 = kt * 64;
    if (wave_valid && key0 <= q0 + 63) {
      bool diag = (key0 + 63 > q0);
#pragma unroll
      for (int pp = 0; pp < 2; ++pp) {
        V8 pfu[4];
#pragma unroll
        for (int kl = 0; kl < 2; ++kl) {
          f32x4 s1[4];
          f32x4 ck = *(const f32x4*)(cb + (2 * pp + kl) * 16 + fq * 4);
#pragma unroll
          for (int qi = 0; qi < 4; ++qi) s1[qi] = cq[qi] - ck;
#pragma unroll
          for (int ks = 0; ks < 2; ++ks) {
            bf16x8 a = *(const bf16x8*)(Kb + ((2 * pp + kl) * 16 + fr) * LDK + ks * 32 + fq * 8);
#pragma unroll
            for (int qi = 0; qi < 4; ++qi) s1[qi] = mfma(a, qf[qi][ks], s1[qi]);
          }
#pragma unroll
          for (int qi = 0; qi < 4; ++qi) {
            int q = q0 + qi * 16 + fr;
            float e[4];
#pragma unroll
            for (int j = 0; j < 4; ++j) {
              float v = s1[qi][j];
              if (diag && (key0 + (2 * pp + kl) * 16 + fq * 4 + j > q)) v = -INFINITY;
              e[j] = __builtin_amdgcn_exp2f(v);
            }
            lrow[qi] += (e[0] + e[1]) + (e[2] + e[3]);
            pfu[qi].u[kl * 2 + 0] = pack2(e[0], e[1]);
            pfu[qi].u[kl * 2 + 1] = pack2(e[2], e[3]);
          }
        }
        bf16x8 pf[4];
#pragma unroll
        for (int qi = 0; qi < 4; ++qi) pf[qi] = pfu[qi].v;
#pragma unroll
        for (int dt = 0; dt < 4; ++dt) {
          V8 a;
          a.d[0] = *(const u32x2*)(Vb + (dt * 16 + fr) * LDK + (2 * pp) * 16 + fq * 4);
          a.d[1] = *(const u32x2*)(Vb + (dt * 16 + fr) * LDK + (2 * pp + 1) * 16 + fq * 4);
#pragma unroll
          for (int qi = 0; qi < 4; ++qi) o[dt][qi] = mfma(a.v, pf[qi], o[dt][qi]);
        }
      }
    }
  }
  int q0e = q0;
  asm volatile("" : "+v"(q0e));
#pragma unroll
  for (int qi = 0; qi < 4; ++qi) {
    float l = lrow[qi];
    l += __shfl_xor(l, 16); l += __shfl_xor(l, 32);
    float inv = 1.f / l;
    int q = q0e + qi * 16 + fr;
    if (q < LP) {
#pragma unroll
      for (int dt = 0; dt < 4; ++dt) {
        int d = dt * 16 + fq * 4;
        u32x2 og = *(const u32x2*)(p.OGf + (size_t)q * DM + h * 64 + d);
        u32x2 r;
        r.x = pack2(o[dt][qi][0] * inv * sigmoidf_(bflo(og.x)), o[dt][qi][1] * inv * sigmoidf_(bfhi(og.x)));
        r.y = pack2(o[dt][qi][2] * inv * sigmoidf_(bflo(og.y)), o[dt][qi][3] * inv * sigmoidf_(bfhi(og.y)));
        *(u32x2*)(p.AO + (size_t)q * DM + h * 64 + d) = r;
      }
    }
  }
}

DEV void f2_sample(const Params& p, int jf, int b, int h, int qh, char* smem) {
  constexpr int NK = PAST + 16;
  float* S = (float*)smem;
  float* qs = S + 8 * NK;
  float* cc = qs + 8 * 64;
  float* part = cc + NK;
  float* invl = part + 256;
  int tid = otid(), lane = tid & 63, wid = tid >> 6;
  __syncthreads();
  for (int e = tid; e < 512; e += 256) {
    int i = e >> 6, d = e & 63;
    qs[e] = bf2f(p.Qf[(size_t)(LP + b * 16 + qh * 8 + i) * DM + h * 64 + d]);
  }
  float lv[5]; float run = 0.f;
#pragma unroll
  for (int u = 0; u < 5; ++u) {
    int j = tid * 5 + u;
    float v = 0.f;
    if (j < PAST) v = p.cache_lf[(((size_t)jf * 8 + b) * PAST + j) * 16 + h];
    else if (j < NK) v = p.LFR[(size_t)(LP + b * 16 + (j - PAST)) * 16 + h];
    run += v; lv[u] = run;
  }
  part[tid] = run;
  __syncthreads();
  float base = 0.f;
  for (int m = 0; m < tid; ++m) base += part[m];
#pragma unroll
  for (int u = 0; u < 5; ++u) { int j = tid * 5 + u; if (j < NK) cc[j] = base + lv[u]; }
  __syncthreads();
  for (int j = tid; j < NK; j += 256) {
    const float* kp;
    if (j < PAST) kp = p.cache_k + ((((size_t)jf * 8 + b) * PAST + j) * 16 + h) * 64;
    else kp = p.out + O_FKS + (((size_t)jf * 128 + b * 16 + (j - PAST)) * 16 + h) * 64;
    f32x4 kv[16];
#pragma unroll
    for (int c = 0; c < 16; ++c) kv[c] = ((const f32x4*)kp)[c];
    float cj = cc[j];
#pragma unroll
    for (int i = 0; i < 8; ++i) {
      float a = 0.f;
#pragma unroll
      for (int c = 0; c < 16; ++c) {
        f32x4 qv = *(const f32x4*)(qs + i * 64 + c * 4);
        a += qv.x * kv[c].x + qv.y * kv[c].y + qv.z * kv[c].z + qv.w * kv[c].w;
      }
      int qi = qh * 8 + i;
      a = a * 0.69314718056f + (cc[PAST + qi] - cj);
      if (j > PAST + qi) a = -INFINITY;
      S[i * NK + j] = a;
    }
  }
  __syncthreads();
  for (int i = wid * 2; i < wid * 2 + 2; ++i) {
    float m = -INFINITY;
    for (int j = lane; j < NK; j += 64) m = fmaxf(m, S[i * NK + j]);
    m = wave_max(m);
    float l = 0.f;
    for (int j = lane; j < NK; j += 64) { float e = __expf(S[i * NK + j] - m); S[i * NK + j] = e; l += e; }
    l = wave_sum(l);
    if (lane == 0) invl[i] = 1.f / l;
  }
  __syncthreads();
  {
    int i = tid >> 5, dq = tid & 31;
    float o0 = 0.f, o1 = 0.f;
    const float* vb = p.cache_v + ((((size_t)jf * 8 + b) * PAST) * 16 + h) * 64 + dq * 2;
#pragma unroll 8
    for (int j = 0; j < PAST; ++j) {
      f32x2 v = *(const f32x2*)(vb + (size_t)j * 1024);
      float pj = S[i * NK + j];
      o0 += pj * v.x; o1 += pj * v.y;
    }
    const float* vn = p.out + O_FVS + (((size_t)jf * 128 + b * 16) * 16 + h) * 64 + dq * 2;
#pragma unroll
    for (int j = 0; j < 16; ++j) {
      f32x2 v = *(const f32x2*)(vn + (size_t)j * 1024);
      float pj = S[i * NK + PAST + j];
      o0 += pj * v.x; o1 += pj * v.y;
    }
    int row = LP + b * 16 + qh * 8 + i;
    float il = invl[i];
    uint32_t og = *(const uint32_t*)(p.OGf + (size_t)row * DM + h * 64 + dq * 2);
    *(uint32_t*)(p.AO + (size_t)row * DM + h * 64 + dq * 2) = pack2(o0 * il * sigmoidf_(bflo(og)), o1 * il * sigmoidf_(bfhi(og)));
  }
}

DEV void ph_f2(const Params& p, int jf, char* smem) {
  const int NP = 65 * 16, NI = NP + 256;
  int G = gridDim.x;
  {
    int gt = blockIdx.x * blockDim.x + otid(), gs = gridDim.x * blockDim.x;
    for (int i = gt; i < (TPAD - TTOK) * DM / 2; i += gs) ((uint32_t*)(p.AO + (size_t)TTOK * DM))[i] = 0u;
  }
  for (int r = 0;; ++r) {
    int pos = (r & 1) ? (G - 1 - (int)blockIdx.x) : (int)blockIdx.x;
    int idx = r * G + pos;
    if (r * G >= NI) break;
    if (idx >= NI) continue;
    if (idx < NP) f2_prompt(p, 64 - idx / 16, idx % 16, smem);
    else { int s = idx - NP; f2_sample(p, jf, s >> 5, (s >> 1) & 15, s & 1, smem); }
  }
  conv_tables(p, jf * 2);
}

DEV void ph_outproj(const Params& p, const u16* A, int K, const u16* Wt, const float* gffn, char* smem) {
  int tid = otid(), lane = tid & 63, wid = tid >> 6;
  int wr = wid >> 1, wc = wid & 1, fr = lane & 15, fq = lane >> 4;
  for (int it = blockIdx.x; it < MTILES * 8; it += gridDim.x) {
    int mt, nt; tile_mn(it, 8, mt, nt);
    f32x4 acc[4][4];
    gemm_tile<true>(A, K, Wt, K, K, mt * 128, nt * 128, smem, acc);
#pragma unroll
    for (int m = 0; m < 4; ++m) {
      int row = mt * 128 + wr * 64 + m * 16 + fr;
      float ss = 0.f;
#pragma unroll
      for (int n = 0; n < 4; ++n) {
        int col = nt * 128 + wc * 64 + n * 16 + fq * 4;
        f32x4* xp = (f32x4*)(p.X + (size_t)row * DM + col);
        f32x4 xn = *xp + acc[m][n];
        *xp = xn;
        f32x4 g = *(const f32x4*)(gffn + col);
        u32x2 o; o.x = pack2(xn.x * g.x, xn.y * g.y); o.y = pack2(xn.z * g.z, xn.w * g.w);
        *(u32x2*)(p.H + (size_t)row * DM + col) = o;
        ss += xn.x * xn.x + xn.y * xn.y + xn.z * xn.z + xn.w * xn.w;
      }
      ss += __shfl_xor(ss, 16); ss += __shfl_xor(ss, 32);
      if (fq == 0) atomicAdd(p.SSQ + row, (unsigned long long)(ss * 1048576.f + 0.5f));
    }
  }
}

DEV void ph_r1(const Params& p, int jr, char* smem) {
  const u16* Wt = p.WrinT + (size_t)jr * 6144 * 1024;
  int tid = otid(), lane = tid & 63, wid = tid >> 6;
  int wr = wid >> 1, wc = wid & 1, fr = lane & 15, fq = lane >> 4;
  {
    int gt = blockIdx.x * blockDim.x + tid, gs = gridDim.x * blockDim.x;
    for (int i = gt; i < LEAD * DM; i += gs) { p.Qr[i] = 0; p.Kr[i] = 0; }
    for (int i = gt; i < TPAD; i += gs) p.SSQ[i] = 0ull;
    for (int i = gt; i < 1024 * LEAD; i += gs) p.KrT[tix(256, (i / LEAD) >> 8, (i / LEAD) & 255, i % LEAD)] = 0;
    for (int i = gt; i < 2048 * LEAD; i += gs) p.VrT[tix(512, (i / LEAD) >> 9, (i / LEAD) & 511, i % LEAD)] = 0;
  }
  const int NT = 48;
  for (int it = blockIdx.x; it < MTILES * NT; it += gridDim.x) {
    int mt, nt; tile_mn(it, NT, mt, nt);
    int m0 = mt * 128;
    f32x4 acc[4][4];
    if (nt >= 8 && nt < 32) gemm_tile<false>(p.H, DM, Wt, DM, DM, m0, nt * 128, smem, acc);
    else gemm_tile<true>(p.H, DM, Wt, DM, DM, m0, nt * 128, smem, acc);
    if (nt < 8) {
      int hh = nt >> 1, half = nt & 1;
#pragma unroll
      for (int pr = 0; pr < 2; ++pr) {
        int g = half * 4 + wc * 2 + pr;
        f32x4 rr = *(const f32x4*)(p.rope_rev + g * 16 + fq * 4);
#pragma unroll
        for (int m = 0; m < 4; ++m) {
          int row = m0 + wr * 64 + m * 16 + fr;
          int pos = (row < LP) ? (row - NMETA) : ((row < TTOK) ? (PAST + ((row - LP) & 15)) : 0);
          float o1[4], o2[4];
#pragma unroll
          for (int j = 0; j < 4; ++j) {
            float rev = (float)pos * rr[j];
            rev -= floorf(rev);
            float sn = __builtin_amdgcn_sinf(rev), cs = __builtin_amdgcn_cosf(rev);
            float x1 = acc[m][2 * pr][j], x2 = acc[m][2 * pr + 1][j];
            o1[j] = (x1 * cs - x2 * sn) * 0.0625f; o2[j] = (x1 * sn + x2 * cs) * 0.0625f;
          }
          u32x2 t1, t2;
          t1.x = pack2(o1[0], o1[1]); t1.y = pack2(o1[2], o1[3]);
          t2.x = pack2(o2[0], o2[1]); t2.y = pack2(o2[2], o2[3]);
          u16* dq = p.Qr + (size_t)(row + LEAD) * DM + hh * 256 + g * 32 + fq * 4;
          *(u32x2*)dq = t1;
          *(u32x2*)(dq + 16) = t2;
        }
      }
    } else if (nt < 16) {
      bool isq = false;
      int hh = (nt & 7) >> 1, half = nt & 1;
      float l2g = ret_l2g(hh);
      u16* dst = isq ? p.Qr : p.Kr;
#pragma unroll
      for (int pr = 0; pr < 2; ++pr) {
        int g = half * 4 + wc * 2 + pr;
        int fi = g * 16 + fr;
        float rr = p.rope_rev[fi];
        int dp1 = g * 32 + fr, dp2 = dp1 + 16;
#pragma unroll
        for (int m = 0; m < 4; ++m) {
          int rb = m0 + wr * 64 + m * 16 + fq * 4;
          float o1[4], o2[4];
#pragma unroll
          for (int j = 0; j < 4; ++j) {
            int row = rb + j;
            int pos = (row < LP) ? (row - NMETA) : ((row < TTOK) ? (PAST + ((row - LP) & 15)) : 0);
            float rev = (float)pos * rr;
            rev -= floorf(rev);
            float sn = __builtin_amdgcn_sinf(rev), cs = __builtin_amdgcn_cosf(rev);
            float x1 = acc[m][2 * pr][j], x2 = acc[m][2 * pr + 1][j];
            float a = x1 * cs - x2 * sn, bb = x1 * sn + x2 * cs;
            if (isq) { a *= 0.0625f; bb *= 0.0625f; }
            o1[j] = a; o2[j] = bb;
            dst[(size_t)(row + LEAD) * DM + hh * 256 + dp1] = f2bf(a);
            dst[(size_t)(row + LEAD) * DM + hh * 256 + dp2] = f2bf(bb);
          }
          if (!isq) {
            float dc[4];
#pragma unroll
            for (int j = 0; j < 4; ++j) dc[j] = exp2f(l2g * (float)(63 - ((rb + j + LEAD) & 63)));
            u32x2 t1, t2;
            t1.x = pack2(o1[0] * dc[0], o1[1] * dc[1]); t1.y = pack2(o1[2] * dc[2], o1[3] * dc[3]);
            t2.x = pack2(o2[0] * dc[0], o2[1] * dc[1]); t2.y = pack2(o2[2] * dc[2], o2[3] * dc[3]);
            *(u32x2*)(p.KrT + tix(256, hh, dp1, rb + LEAD)) = t1;
            *(u32x2*)(p.KrT + tix(256, hh, dp2, rb + LEAD)) = t2;
          }
        }
      }
    } else if (nt < 32) {
      int hh = (nt - 16) >> 2;
#pragma unroll
      for (int m = 0; m < 4; ++m) {
        int rb = m0 + wr * 64 + m * 16 + fq * 4;
#pragma unroll
        for (int n = 0; n < 4; ++n) {
          int e = ((nt - 16) & 3) * 128 + wc * 64 + n * 16 + fr;
          u32x2 o; o.x = pack2(acc[m][n][0], acc[m][n][1]); o.y = pack2(acc[m][n][2], acc[m][n][3]);
          *(u32x2*)(p.VrT + tix(512, hh, e, rb + LEAD)) = o;
        }
      }
    } else {
#pragma unroll
      for (int m = 0; m < 4; ++m)
#pragma unroll
        for (int n = 0; n < 4; ++n) {
          int row = m0 + wr * 64 + m * 16 + fr;
          int col = (nt - 32) * 128 + wc * 64 + n * 16 + fq * 4;
          u32x2 o; o.x = pack2(acc[m][n][0], acc[m][n][1]); o.y = pack2(acc[m][n][2], acc[m][n][3]);
          *(u32x2*)(p.Gr + (size_t)row * 2048 + col) = o;
        }
    }
  }
}

DEV void ph_r2(const Params& p, int jr) {
  int tid = otid(), lane = tid & 63, wid = tid >> 6, fr = lane & 15, fq = lane >> 4;
  for (int it = blockIdx.x; it < 256; it += gridDim.x) {
    int h = it >> 6, sl = (it >> 2) & 15, rt = (it & 3) * 4 + wid;
    float dec64 = exp2f(ret_l2g(h) * 64.f);
    f32x4 st[2];
    st[0] = f32x4{0.f, 0.f, 0.f, 0.f}; st[1] = st[0];
    const u16* kb = p.KrT + tix(256, h, rt * 16 + fr, 0) + fq * 8;
    const u16* vb = p.VrT + tix(512, h, sl * 32 + fr, 0) + fq * 8;
    u16* sp0 = p.ST + (((size_t)h * 16 + rt) * 512 + sl * 32 + fr) * 16 + fq * 4;
    bf16x8 A0[2], B0[4], A1[2], B1[4], A2[2], B2[4], A3[2], B3[4], A4[2], B4[4], A5[2], B5[4], A6[2], B6[4], A7[2], B7[4];
#define R2L(A, B, n_) { size_t nn_ = (size_t)min((n_), NCH - 1); \
      A[0] = *(const bf16x8*)(kb + nn_ * (256 * 64)); A[1] = *(const bf16x8*)(kb + nn_ * (256 * 64) + 32); \
      B[0] = *(const bf16x8*)(vb + nn_ * (512 * 64)); B[1] = *(const bf16x8*)(vb + nn_ * (512 * 64) + 32); \
      B[2] = *(const bf16x8*)(vb + nn_ * (512 * 64) + 16 * 64); B[3] = *(const bf16x8*)(vb + nn_ * (512 * 64) + 16 * 64 + 32); }
#define R2S(A, B, n_) { \
      _Pragma("unroll") for (int c = 0; c < 2; ++c) { \
        u32x2 o; o.x = pack2(st[c][0], st[c][1]); o.y = pack2(st[c][2], st[c][3]); \
        *(u32x2*)(sp0 + (size_t)(n_) * (4 * 16 * 512 * 16) + c * 16 * 16) = o; \
        f32x4 t = st[c] * dec64; \
        t = mfma(A[0], B[c * 2], t); t = mfma(A[1], B[c * 2 + 1], t); st[c] = t; } }
    R2L(A0, B0, 0) R2L(A1, B1, 1) R2L(A2, B2, 2) R2L(A3, B3, 3) R2L(A4, B4, 4) R2L(A5, B5, 5) R2L(A6, B6, 6) R2L(A7, B7, 7)
#pragma unroll 1
    for (int n = 0; n < 256; n += 8) {
      R2S(A0, B0, n + 0) R2L(A0, B0, n + 8)
      R2S(A1, B1, n + 1) R2L(A1, B1, n + 9)
      R2S(A2, B2, n + 2) R2L(A2, B2, n + 10)
      R2S(A3, B3, n + 3) R2L(A3, B3, n + 11)
      R2S(A4, B4, n + 4) R2L(A4, B4, n + 12)
      R2S(A5, B5, n + 5) R2L(A5, B5, n + 13)
      R2S(A6, B6, n + 6) R2L(A6, B6, n + 14)
      R2S(A7, B7, n + 7) R2L(A7, B7, n + 15)
    }
    R2S(A0, B0, 256)
    int fre = fr, fqe = fq;
    asm volatile("" : "+v"(fre), "+v"(fqe));
#pragma unroll
    for (int c = 0; c < 2; ++c)
#pragma unroll
      for (int j = 0; j < 4; ++j) {
        int dorig = perm_dorig(rt * 16 + fqe * 4 + j);
        p.out[O_SRP + ((size_t)(jr * 4 + h) * 256 + dorig) * 512 + sl * 32 + c * 16 + fre] = st[c][j];
      }
  }
}

DEV void r3_prompt(const Params& p, int jr, int n, int h, char* smem) {
  u32x4* Sf = (u32x4*)smem;
  float* red = (float*)(smem + 8192);
  int tid = otid(), lane = tid & 63, w = tid >> 6, fr = lane & 15, fq = lane >> 4;
  int p0 = n * 64;
  float l2g = ret_l2g(h);
  f32x4 acc[8][4];
#pragma unroll
  for (int a = 0; a < 8; ++a)
#pragma unroll
    for (int b = 0; b < 4; ++b) acc[a][b] = f32x4{0.f, 0.f, 0.f, 0.f};
  const u16* qb = p.Qr + (size_t)(p0 + fr) * DM + h * 256 + fq * 8;
  if (n >= 1) {
    const u16* sb = p.ST + (((size_t)(n * 4 + h) * 16 + (fq >> 1)) * 512 + w * 128 + fr) * 16 + (fq & 1) * 8;
#pragma unroll 1
    for (int ks = 0; ks < 8; ++ks) {
      bf16x8 bq[4];
#pragma unroll
      for (int it = 0; it < 4; ++it) bq[it] = *(const bf16x8*)(qb + (size_t)(it * 16) * DM + ks * 32);
#pragma unroll
      for (int dvt = 0; dvt < 8; ++dvt) {
        bf16x8 a = *(const bf16x8*)(sb + (size_t)(ks * 2) * (512 * 16) + dvt * 16 * 16);
#pragma unroll
        for (int it = 0; it < 4; ++it) acc[dvt][it] = mfma(a, bq[it], acc[dvt][it]);
      }
    }
#pragma unroll
    for (int it = 0; it < 4; ++it) {
      float qd = exp2f(l2g * (float)(it * 16 + fr + 1));
#pragma unroll
      for (int dvt = 0; dvt < 8; ++dvt) acc[dvt][it] = acc[dvt][it] * qd;
    }
  }
  {
    f32x4 s[4];
#pragma unroll
    for (int jt = 0; jt < 4; ++jt) s[jt] = f32x4{0.f, 0.f, 0.f, 0.f};
    const u16* kb = p.Kr + (size_t)(p0 + fr) * DM + h * 256 + fq * 8;
#pragma unroll 1
    for (int ks = 0; ks < 8; ++ks) {
      bf16x8 b = *(const bf16x8*)(qb + (size_t)(w * 16) * DM + ks * 32);
#pragma unroll
      for (int jt = 0; jt < 4; ++jt) {
        bf16x8 a = *(const bf16x8*)(kb + (size_t)(jt * 16) * DM + ks * 32);
        s[jt] = mfma(a, b, s[jt]);
      }
    }
    int i = w * 16 + fr;
#pragma unroll
    for (int jt = 0; jt < 4; ++jt)
#pragma unroll
      for (int jj = 0; jj < 4; ++jj) {
        int j = jt * 16 + fq * 4 + jj;
        int dd = i > j ? i - j : j - i;
        s[jt][jj] *= exp2f(l2g * (float)dd);
      }
    __syncthreads();
#pragma unroll
    for (int pp = 0; pp < 2; ++pp) {
      u32x4 t;
      t.x = pack2(s[2 * pp][0], s[2 * pp][1]); t.y = pack2(s[2 * pp][2], s[2 * pp][3]);
      t.z = pack2(s[2 * pp + 1][0], s[2 * pp + 1][1]); t.w = pack2(s[2 * pp + 1][2], s[2 * pp + 1][3]);
      Sf[(w * 2 + pp) * 64 + lane] = t;
    }
    __syncthreads();
  }
  {
    const u16* vb = p.VrT + tix(512, h, w * 128 + fr, p0) + fq * 4;
#pragma unroll
    for (int pp = 0; pp < 2; ++pp) {
      V8 bs[4];
#pragma unroll
      for (int it = 0; it < 4; ++it) bs[it].q = Sf[(it * 2 + pp) * 64 + lane];
#pragma unroll
      for (int dvt = 0; dvt < 8; ++dvt) {
        V8 a;
        a.d[0] = *(const u32x2*)(vb + dvt * 16 * 64 + (2 * pp) * 16);
        a.d[1] = *(const u32x2*)(vb + dvt * 16 * 64 + (2 * pp + 1) * 16);
#pragma unroll
        for (int it = 0; it < 4; ++it) acc[dvt][it] = mfma(a.v, bs[it].v, acc[dvt][it]);
      }
    }
  }
  float mean[4], rstd[4];
  {
    float s1[4];
#pragma unroll
    for (int it = 0; it < 4; ++it) {
      float s = 0.f;
#pragma unroll
      for (int dvt = 0; dvt < 8; ++dvt) s += acc[dvt][it][0] + acc[dvt][it][1] + acc[dvt][it][2] + acc[dvt][it][3];
      s += __shfl_xor(s, 16); s += __shfl_xor(s, 32);
      s1[it] = s;
    }
    __syncthreads();
    if (fq == 0) {
#pragma unroll
      for (int it = 0; it < 4; ++it) red[w * 64 + it * 16 + fr] = s1[it];
    }
    __syncthreads();
#pragma unroll
    for (int it = 0; it < 4; ++it) {
      int i = it * 16 + fr;
      mean[it] = (red[i] + red[64 + i] + red[128 + i] + red[192 + i]) * (1.f / 512.f);
    }
#pragma unroll
    for (int it = 0; it < 4; ++it) {
      float s = 0.f;
#pragma unroll
      for (int dvt = 0; dvt < 8; ++dvt)
#pragma unroll
        for (int j = 0; j < 4; ++j) { float d = acc[dvt][it][j] - mean[it]; s += d * d; }
      s += __shfl_xor(s, 16); s += __shfl_xor(s, 32);
      s1[it] = s;
    }
    __syncthreads();
    if (fq == 0) {
#pragma unroll
      for (int it = 0; it < 4; ++it) red[w * 64 + it * 16 + fr] = s1[it];
    }
    __syncthreads();
#pragma unroll
    for (int it = 0; it < 4; ++it) {
      int i = it * 16 + fr;
      float var = (red[i] + red[64 + i] + red[128 + i] + red[192 + i]) * (1.f / 512.f);
      rstd[it] = rsqrtf(var + EPS);
    }
  }
#pragma unroll
  for (int it = 0; it < 4; ++it) {
    int t = p0 + it * 16 + fr - LEAD;
    if (t >= 0 && t < LP) {
#pragma unroll
      for (int dvt = 0; dvt < 8; ++dvt) {
        int e0 = h * 512 + w * 128 + dvt * 16 + fq * 4;
        u16* gp = p.Gr + (size_t)t * 2048 + e0;
        u32x2 g = *(const u32x2*)gp;
        f32x4 gn = *(const f32x4*)(p.ret_gn + jr * 2048 + e0);
        float g0 = bflo(g.x), g1 = bfhi(g.x), g2 = bflo(g.y), g3 = bfhi(g.y);
        float y0 = (acc[dvt][it][0] - mean[it]) * rstd[it] * gn.x * (g0 * sigmoidf_(g0));
        float y1 = (acc[dvt][it][1] - mean[it]) * rstd[it] * gn.y * (g1 * sigmoidf_(g1));
        float y2 = (acc[dvt][it][2] - mean[it]) * rstd[it] * gn.z * (g2 * sigmoidf_(g2));
        float y3 = (acc[dvt][it][3] - mean[it]) * rstd[it] * gn.w * (g3 * sigmoidf_(g3));
        u32x2 o; o.x = pack2(y0, y1); o.y = pack2(y2, y3);
        *(u32x2*)gp = o;
      }
    }
  }
}

DEV void r3_sample(const Params& p, int jr, int b, int h, char* smem) {
  float* obuf = (float*)smem;
  u16* qs = (u16*)(smem + 32768);
  u16* ks = qs + 16 * 256;
  float* sm = (float*)(smem + 49152);
  float* red = sm + 256;
  float* stat = red + 64;
  int tid = otid(), lane = tid & 63, wid = tid >> 6;
  float l2g = ret_l2g(h);
  int prow = LP + LEAD + b * 16;
  __syncthreads();
  for (int e = tid; e < 16 * 256; e += 256) {
    int i = e >> 8, d = e & 255;
    qs[e] = p.Qr[(size_t)(prow + i) * DM + h * 256 + d];
    ks[e] = p.Kr[(size_t)(prow + i) * DM + h * 256 + d];
  }
  __syncthreads();
  {
    int i = tid >> 4, j = tid & 15;
    float a = 0.f;
#pragma unroll 8
    for (int d = 0; d < 256; ++d) a += bf2f(qs[i * 256 + d]) * bf2f(ks[j * 256 + d]);
    int dd = i > j ? i - j : j - i;
    sm[tid] = a * exp2f(l2g * (float)dd);
  }
  __syncthreads();
  for (int e = tid; e < 16 * 256; e += 256) ks[e] = f2bf(bf2f(ks[e]) * exp2f(l2g * (float)(15 - (e >> 8))));
  __syncthreads();
  float dec16 = exp2f(l2g * 16.f);
  const float* stin = p.state_ret + ((size_t)(jr * 8 + b) * 4 + h) * 256 * 512;
  float* stout = p.out + O_SRS + ((size_t)(jr * 8 + b) * 4 + h) * 256 * 512;
#pragma unroll 1
  for (int c = 0; c < 2; ++c) {
    int e = tid + c * 256;
    float v[16], o[16];
    const u16* vp = p.VrT + tix(512, h, e, prow);
    u32x4 a = *(const u32x4*)vp, bq = *(const u32x4*)(vp + 8);
    v[0] = bflo(a.x); v[1] = bfhi(a.x); v[2] = bflo(a.y); v[3] = bfhi(a.y);
    v[4] = bflo(a.z); v[5] = bfhi(a.z); v[6] = bflo(a.w); v[7] = bfhi(a.w);
    v[8] = bflo(bq.x); v[9] = bfhi(bq.x); v[10] = bflo(bq.y); v[11] = bfhi(bq.y);
    v[12] = bflo(bq.z); v[13] = bfhi(bq.z); v[14] = bflo(bq.w); v[15] = bfhi(bq.w);
#pragma unroll
    for (int i = 0; i < 16; ++i) o[i] = 0.f;
#pragma unroll 2
    for (int dp = 0; dp < 256; ++dp) {
      int dorig = perm_dorig(dp);
      float s0 = stin[(size_t)dorig * 512 + e];
      float n0 = s0 * dec16;
#pragma unroll
      for (int i = 0; i < 16; ++i) {
        o[i] += bf2f(qs[i * 256 + dp]) * s0;
        n0 += bf2f(ks[i * 256 + dp]) * v[i];
      }
      stout[(size_t)dorig * 512 + e] = n0;
    }
#pragma unroll
    for (int i = 0; i < 16; ++i) obuf[i * 512 + e] = o[i] * exp2f(l2g * (float)(i + 1));
#pragma unroll 1
    for (int i = 0; i < 16; ++i) {
      float a0 = obuf[i * 512 + e];
#pragma unroll
      for (int j = 0; j < 16; ++j) a0 += sm[i * 16 + j] * v[j];
      obuf[i * 512 + e] = a0;
    }
  }
  __syncthreads();
  for (int i = 0; i < 16; ++i) {
    float s = wave_sum(obuf[i * 512 + tid] + obuf[i * 512 + 256 + tid]);
    if (lane == 0) red[wid * 16 + i] = s;
  }
  __syncthreads();
  if (tid < 16) stat[tid] = (red[tid] + red[16 + tid] + red[32 + tid] + red[48 + tid]) * (1.f / 512.f);
  __syncthreads();
  for (int i = 0; i < 16; ++i) {
    float mu = stat[i];
    float d0 = obuf[i * 512 + tid] - mu, d1 = obuf[i * 512 + 256 + tid] - mu;
    float s = wave_sum(d0 * d0 + d1 * d1);
    if (lane == 0) red[wid * 16 + i] = s;
  }
  __syncthreads();
  if (tid < 16) stat[16 + tid] = rsqrtf((red[tid] + red[16 + tid] + red[32 + tid] + red[48 + tid]) * (1.f / 512.f) + EPS);
  __syncthreads();
  for (int c = 0; c < 2; ++c) {
    int e = tid + c * 256;
    float gn = p.ret_gn[jr * 2048 + h * 512 + e];
    for (int i = 0; i < 16; ++i) {
      int t = LP + b * 16 + i;
      float g = bf2f(p.Gr[(size_t)t * 2048 + h * 512 + e]);
      float y = (obuf[i * 512 + e] - stat[i]) * stat[16 + i] * gn * (g * sigmoidf_(g));
      p.Gr[(size_t)t * 2048 + h * 512 + e] = f2bf(y);
    }
  }
}

DEV void ph_r3(const Params& p, int jr, char* smem) {
  const int NP = NCH * 4, NI = NP + 32;
  for (int it = blockIdx.x; it < NI; it += gridDim.x) {
    if (it < 32) r3_sample(p, jr, it >> 2, it & 3, smem);
    else { int q = it - 32; r3_prompt(p, jr, q >> 2, q & 3, smem); }
  }
}

DEV void ph_p2(const Params& p, int layer, char* smem) {
  const u16* Wt = p.WpqT + (size_t)layer * 2048 * 1024;
  u16* Qs = (u16*)smem;
  constexpr int LQ = 136;
  int tid = otid(), lane = tid & 63, wid = tid >> 6;
  int wr = wid >> 1, wc = wid & 1, fr = lane & 15, fq = lane >> 4;
  for (int it = blockIdx.x; it < MTILES * 16; it += gridDim.x) {
    int mt, hp; tile_mn(it, 16, mt, hp);
    int m0 = mt * 128;
    f32x4 acc[4][4];
    gemm_tile<true>(p.H, DM, Wt, DM, DM, m0, hp * 128, smem, acc);
    __syncthreads();
#pragma unroll
    for (int m = 0; m < 4; ++m) {
      float rs = rsqrtf((float)p.SSQ[m0 + wr * 64 + m * 16 + fr] * (1.f / (1048576.f * DM)) + EPS);
#pragma unroll
      for (int n = 0; n < 4; ++n) {
        u32x2 o; o.x = pack2(acc[m][n][0] * rs, acc[m][n][1] * rs); o.y = pack2(acc[m][n][2] * rs, acc[m][n][3] * rs);
        *(u32x2*)(Qs + (wr * 64 + m * 16 + fr) * LQ + wc * 64 + n * 16 + fq * 4) = o;
      }
    }
    __syncthreads();
    f32x4 sc[2][8];
#pragma unroll
    for (int rt = 0; rt < 2; ++rt)
#pragma unroll
      for (int ct = 0; ct < 8; ++ct) sc[rt][ct] = f32x4{0.f, 0.f, 0.f, 0.f};
    const u16* skb = p.SKb + ((size_t)(layer * 16 + hp) * 128 + fr) * 128 + fq * 8;
#pragma unroll
    for (int ks = 0; ks < 4; ++ks) {
      bf16x8 a[2];
#pragma unroll
      for (int rt = 0; rt < 2; ++rt) a[rt] = *(const bf16x8*)(Qs + (wid * 32 + rt * 16 + fr) * LQ + ks * 32 + fq * 8);
#pragma unroll
      for (int ct = 0; ct < 8; ++ct) {
        bf16x8 b = *(const bf16x8*)(skb + (size_t)(ct * 16) * 128 + ks * 32);
#pragma unroll
        for (int rt = 0; rt < 2; ++rt) sc[rt][ct] = mfma(a[rt], b, sc[rt][ct]);
      }
    }
#pragma unroll
    for (int rt = 0; rt < 2; ++rt)
#pragma unroll
      for (int j = 0; j < 4; ++j) {
        uint32_t key[8];
#pragma unroll
        for (int ct = 0; ct < 8; ++ct) key[ct] = (f2key(sc[rt][ct][j]) & ~127u) | (uint32_t)(127 - (ct * 16 + fr));
        uint32_t mine = 0;
#pragma unroll 1
        for (int r = 0; r < 16; ++r) {
          uint32_t best = key[0];
#pragma unroll
          for (int ct = 1; ct < 8; ++ct) best = max(best, key[ct]);
          best = row16_maxu(best);
#pragma unroll
          for (int ct = 0; ct < 8; ++ct) key[ct] = (key[ct] == best) ? 0u : key[ct];
          if (fr == r) mine = best;
        }
        int row = m0 + wid * 32 + rt * 16 + fq * 4 + j;
        p.SV[((size_t)row * 16 + hp) * 16 + fr] = key2f(mine & ~127u);
        p.SI[((size_t)row * 16 + hp) * 16 + fr] = 127 - (int)(mine & 127u);
      }
  }
}

DEV void p3_partial(const Params& p, int t, int h0, int nh, int lane, int* eidL, float* gateL,
                    int ca, int cb, bool cvalid, float (&oacc)[16]) {
  const int ne = nh * 16;
  const float* svp = p.SV + (size_t)t * 256;
  const int* sip = p.SI + (size_t)t * 256;
  for (int hl = 0; hl < nh; ++hl) {
    int h = h0 + hl;
    float cand = cvalid ? (svp[h * 32 + ca] + svp[h * 32 + 16 + cb]) : 0.f;
    uint32_t key = cvalid ? ((f2key(cand) & ~63u) | (uint32_t)(63 - lane)) : 0u;
    uint32_t mine = 0;
#pragma unroll 1
    for (int r = 0; r < 16; ++r) {
      uint32_t best = wave_maxu(key);
      key = (key == best) ? 0u : key;
      if (lane == r) mine = best;
    }
    int src = 63 - (int)(mine & 63u);
    int wa = __shfl(ca, src), wb = __shfl(cb, src);
    float fv = key2f(mine & ~63u);
    float f0 = rdlane(fv, 0);
    float e = (lane < 16) ? __expf(fv - f0) : 0.f;
    float ssum = row16_sum(e);
    if (lane < 16) {
      int eid = sip[h * 32 + wa] * 128 + sip[h * 32 + 16 + wb];
      eidL[hl * 16 + lane] = eid;
      gateL[hl * 16 + lane] = e / ssum;
    }
  }
  float hf[16];
  {
    u32x4 ha = *(const u32x4*)(p.H + (size_t)t * DM + lane * 16);
    u32x4 hb = *(const u32x4*)(p.H + (size_t)t * DM + lane * 16 + 8);
    hf[0] = bflo(ha.x); hf[1] = bfhi(ha.x); hf[2] = bflo(ha.y); hf[3] = bfhi(ha.y);
    hf[4] = bflo(ha.z); hf[5] = bfhi(ha.z); hf[6] = bflo(ha.w); hf[7] = bfhi(ha.w);
    hf[8] = bflo(hb.x); hf[9] = bfhi(hb.x); hf[10] = bflo(hb.y); hf[11] = bfhi(hb.y);
    hf[12] = bflo(hb.z); hf[13] = bfhi(hb.z); hf[14] = bflo(hb.w); hf[15] = bfhi(hb.w);
    float rs = rsqrtf((float)p.SSQ[t] * (1.f / (1048576.f * DM)) + EPS);
#pragma unroll
    for (int i = 0; i < 16; ++i) hf[i] *= rs;
  }
  const unsigned char* U8 = (const unsigned char*)p.Ub + lane * 16;
  const unsigned char* V8p = (const unsigned char*)p.Vb + lane * 16;
#define P3_LOAD(buf, tab, base) _Pragma("unroll") for (int u = 0; u < 8; ++u) { \
      int eid_ = __builtin_amdgcn_readfirstlane(eidL[(base) + u]); \
      buf[u] = *(const u32x4*)((tab) + (size_t)eid_ * DM); }
#define P3_CVT(f, q) { v2f_t c_; \
      c_ = __builtin_amdgcn_cvt_pk_f32_fp8((int)(q).x, false); f[0] = c_.x; f[1] = c_.y; \
      c_ = __builtin_amdgcn_cvt_pk_f32_fp8((int)(q).x, true);  f[2] = c_.x; f[3] = c_.y; \
      c_ = __builtin_amdgcn_cvt_pk_f32_fp8((int)(q).y, false); f[4] = c_.x; f[5] = c_.y; \
      c_ = __builtin_amdgcn_cvt_pk_f32_fp8((int)(q).y, true);  f[6] = c_.x; f[7] = c_.y; \
      c_ = __builtin_amdgcn_cvt_pk_f32_fp8((int)(q).z, false); f[8] = c_.x; f[9] = c_.y; \
      c_ = __builtin_amdgcn_cvt_pk_f32_fp8((int)(q).z, true);  f[10] = c_.x; f[11] = c_.y; \
      c_ = __builtin_amdgcn_cvt_pk_f32_fp8((int)(q).w, false); f[12] = c_.x; f[13] = c_.y; \
      c_ = __builtin_amdgcn_cvt_pk_f32_fp8((int)(q).w, true);  f[14] = c_.x; f[15] = c_.y; }
#define P3_DOT(buf, base) _Pragma("unroll") for (int u = 0; u < 8; ++u) { \
      float f_[16]; P3_CVT(f_, buf[u]); float d_ = 0.f; \
      _Pragma("unroll") for (int i = 0; i < 16; ++i) d_ += hf[i] * f_[i]; \
      d_ = wave_sum(d_) * (1.f / U_SCALE); \
      int k_ = (base) + u; \
      if (lane == (k_ & 63)) { if (k_ < 64) w0 = d_; else w1 = d_; } }
#define P3_AXPY(buf, base) { float ws_ = ((base) < 64) ? w0 : w1; \
      _Pragma("unroll") for (int u = 0; u < 8; ++u) { \
        float f_[16]; P3_CVT(f_, buf[u]); float wk_ = rdlane(ws_, ((base) + u) & 63); \
        _Pragma("unroll") for (int i = 0; i < 16; ++i) oacc[i] += wk_ * f_[i]; } }
  float w0 = 0.f, w1 = 0.f;
  {
    u32x4 A[8], B[8];
    P3_LOAD(A, U8, 0)
#pragma unroll 1
    for (int kb = 0; kb < ne; kb += 16) {
      P3_LOAD(B, U8, kb + 8)
      P3_DOT(A, kb)
      if (kb + 16 < ne) { P3_LOAD(A, U8, kb + 16) }
      P3_DOT(B, kb + 8)
    }
  }
  w0 = gateL[lane] * gelu_(w0);
  w1 = gateL[64 + lane] * gelu_(w1);
  {
    u32x4 A[8], B[8];
    P3_LOAD(A, V8p, 0)
#pragma unroll 1
    for (int kb = 0; kb < ne; kb += 16) {
      P3_LOAD(B, V8p, kb + 8)
      P3_AXPY(A, kb)
      if (kb + 16 < ne) { P3_LOAD(A, V8p, kb + 16) }
      P3_AXPY(B, kb + 8)
    }
  }
}

DEV void p3_finish(const Params& p, int layer, int t, int lane, float (&oacc)[16]) {
  int te = t, le = lane;
  asm volatile("" : "+v"(te), "+v"(le));
  float* xr = p.X + (size_t)te * DM + le * 16;
  f32x4 xv[4];
#pragma unroll
  for (int c = 0; c < 4; ++c) {
    xv[c] = *(const f32x4*)(xr + c * 4);
    xv[c].x += oacc[c * 4 + 0] * (1.f / V_SCALE); xv[c].y += oacc[c * 4 + 1] * (1.f / V_SCALE);
    xv[c].z += oacc[c * 4 + 2] * (1.f / V_SCALE); xv[c].w += oacc[c * 4 + 3] * (1.f / V_SCALE);
  }
  if (layer < 3) {
    float ss = 0.f;
#pragma unroll
    for (int c = 0; c < 4; ++c) {
      *(f32x4*)(xr + c * 4) = xv[c];
      ss += xv[c].x * xv[c].x + xv[c].y * xv[c].y + xv[c].z * xv[c].z + xv[c].w * xv[c].w;
    }
    ss = wave_sum(ss);
    float rstd = rsqrtf(ss * (1.f / DM) + EPS);
    const float* g = p.norm_mix + (size_t)(layer + 1) * DM + le * 16;
    u32x4 o0, o1;
    f32x4 g0 = *(const f32x4*)(g), g1 = *(const f32x4*)(g + 4), g2 = *(const f32x4*)(g + 8), g3 = *(const f32x4*)(g + 12);
    o0.x = pack2(xv[0].x * rstd * g0.x, xv[0].y * rstd * g0.y); o0.y = pack2(xv[0].z * rstd * g0.z, xv[0].w * rstd * g0.w);
    o0.z = pack2(xv[1].x * rstd * g1.x, xv[1].y * rstd * g1.y); o0.w = pack2(xv[1].z * rstd * g1.z, xv[1].w * rstd * g1.w);
    o1.x = pack2(xv[2].x * rstd * g2.x, xv[2].y * rstd * g2.y); o1.y = pack2(xv[2].z * rstd * g2.z, xv[2].w * rstd * g2.w);
    o1.z = pack2(xv[3].x * rstd * g3.x, xv[3].y * rstd * g3.y); o1.w = pack2(xv[3].z * rstd * g3.z, xv[3].w * rstd * g3.w);
    *(u32x4*)(p.H + (size_t)te * DM + le * 16) = o0;
    *(u32x4*)(p.H + (size_t)te * DM + le * 16 + 8) = o1;
  } else {
    float* yo = nullptr;
    if (te >= NMETA && te < LP) yo = p.out + O_YP + (size_t)(te - NMETA) * DM + le * 16;
    else if (te >= LP) yo = p.out + O_YS + (size_t)(te - LP) * DM + le * 16;
    if (yo) {
#pragma unroll
      for (int c = 0; c < 4; ++c) *(f32x4*)(yo + c * 4) = xv[c];
    }
  }
}

DEV void ph_p3(const Params& p, int layer, char* smem) {
  int tid = otid(), lane = tid & 63, wid = tid >> 6;
  int* eidL = (int*)smem + wid * 256;
  float* gateL = (float*)(eidL + 128);
  float* part = (float*)(smem + 4096);
  int ca = 0, cb = 0; bool cvalid = false;
  {
    int cnt = 0;
    for (int a = 0; a < 16; ++a) {
      int nb = 16 / (a + 1);
      if (lane >= cnt && lane < cnt + nb) { ca = a; cb = lane - cnt; cvalid = true; }
      cnt += nb;
    }
  }
  int gw = (blockIdx.x * blockDim.x + tid) >> 6, nw = (gridDim.x * blockDim.x) >> 6;
  int tmain = (TTOK / nw) * nw;
  for (int t = gw; t < tmain; t += nw) {
    float oacc[16];
#pragma unroll
    for (int i = 0; i < 16; ++i) oacc[i] = 0.f;
    p3_partial(p, t, 0, 8, lane, eidL, gateL, ca, cb, cvalid, oacc);
    p3_finish(p, layer, t, lane, oacc);
  }
  for (int t = tmain + blockIdx.x; t < TTOK; t += gridDim.x) {
    float oacc[16];
#pragma unroll
    for (int i = 0; i < 16; ++i) oacc[i] = 0.f;
    p3_partial(p, t, wid * 2, 2, lane, eidL, gateL, ca, cb, cvalid, oacc);
    __syncthreads();
#pragma unroll
    for (int i = 0; i < 16; ++i) part[(wid * 64 + lane) * 16 + i] = oacc[i];
    __syncthreads();
    if (wid == 0) {
#pragma unroll
      for (int i = 0; i < 16; ++i) oacc[i] = part[lane * 16 + i] + part[(64 + lane) * 16 + i] + part[(128 + lane) * 16 + i] + part[(192 + lane) * 16 + i];
      p3_finish(p, layer, t, lane, oacc);
    }
  }
}

constexpr int NPHASE = 23;
#ifndef DBG_PHASES
#define DBG_PHASES NPHASE
#endif
#ifndef DBG_SCALES
#define DBG_SCALES {1,1,1,1,1,1,1,1,1,1,1,1,1,1,1,1,1,1,1,1}
#endif
#ifndef DBG_POST
#define DBG_POST 0
#endif
DEV void post_scale(const Params& p) {
  const float sc[20] = DBG_SCALES;
  const size_t offs[11] = {O_YP, O_YS, O_FKP, O_FVP, O_FLP, O_SRP, O_FKS, O_FVS, O_FLS, O_SRS, O_SRS + (size_t)2 * 8 * 4 * 256 * 512};
  size_t i0 = (size_t)blockIdx.x * blockDim.x + otid(), st = (size_t)gridDim.x * blockDim.x;
#pragma unroll
  for (int k = 0; k < 20; ++k) {
    float f = sc[k];
    if (f == 1.f) continue;
    size_t a = offs[k >> 1], b = offs[(k >> 1) + 1], mid = a + (b - a) / 2;
    size_t lo = (k & 1) ? mid : a, hi = (k & 1) ? b : mid;
    for (size_t i = lo + i0; i < hi; i += st) p.out[i] *= f;
  }
}
DEV void dump_x(const Params& p) {
  size_t i = (size_t)blockIdx.x * blockDim.x + otid(), st = (size_t)gridDim.x * blockDim.x;
  for (; i < (size_t)(TTOK - NMETA) * DM; i += st) p.out[i] = p.X[(size_t)NMETA * DM + i];
}
__global__ void __launch_bounds__(256, 2) mega(Params p, int ph0, int ph1) {
  __shared__ __attribute__((aligned(16))) char smem[53248];
  for (int ph = ph0; ph < ph1; ++ph) {
    if (ph > ph0) cg::this_grid().sync();
    if (ph == 0) { ph_prep(p, smem); continue; }
    int q = ph - 1, layer, idx;
    if (q < 5) { layer = 0; idx = q; } else if (q < 11) { layer = 1; idx = q - 5; }
    else if (q < 16) { layer = 2; idx = q - 11; } else { layer = 3; idx = q - 16; }
    int j = layer >> 1;
    const float* gffn = p.norm_ffn + (size_t)layer * DM;
    if ((layer & 1) == 0) {
      if (idx == 0) ph_f1(p, j, smem);
      else if (idx == 1) ph_f2(p, j, smem);
      else if (idx == 2) ph_outproj(p, p.AO, 1024, p.WfoutT + (size_t)j * 1024 * 1024, gffn, smem);
      else if (idx == 3) ph_p2(p, layer, smem);
      else ph_p3(p, layer, smem);
    } else {
      if (idx == 0) ph_r1(p, j, smem);
      else if (idx == 1) { ph_r2(p, j); conv_tables(p, layer); }
      else if (idx == 2) ph_r3(p, j, smem);
      else if (idx == 3) ph_outproj(p, p.Gr, 2048, p.WroutT + (size_t)j * 1024 * 2048, gffn, smem);
      else if (idx == 4) ph_p2(p, layer, smem);
      else ph_p3(p, layer, smem);
    }
  }
}

extern "C" void kernel_launch(void* const* d_in, const int* in_sizes, int n_in, void* d_out, int out_size,
                              void* d_ws, size_t ws_size, hipStream_t stream) {
  static int grid_blocks = 0;
  if (!grid_blocks) {
    int dev = 0, cus = 0, per_cu = 0;
    hipGetDevice(&dev);
    hipDeviceGetAttribute(&cus, hipDeviceAttributeMultiprocessorCount, dev);
    hipOccupancyMaxActiveBlocksPerMultiprocessor(&per_cu, mega, 256, 0);
    if (per_cu > 2) per_cu = 2;
    if (per_cu < 1) per_cu = 1;
    grid_blocks = cus * per_cu;
  }
  Params p;
  memset(&p, 0, sizeof(p));
  const float* const* in = (const float* const*)d_in;
  p.x_prompt = in[0]; p.x_sample = in[1]; p.cache_k = in[2]; p.cache_v = in[3]; p.cache_lf = in[4]; p.state_ret = in[5];
  p.meta = in[6]; p.norm_mix = in[7]; p.norm_ffn = in[8]; p.fox_w_in = in[9]; p.fox_b_f = in[10]; p.fox_qn = in[11];
  p.fox_kn = in[12]; p.fox_w_out = in[13]; p.ret_w_in = in[14]; p.ret_gn = in[15]; p.ret_w_out = in[16];
  p.peer_wq = in[17]; p.peer_sk = in[18]; p.peer_u = in[19]; p.peer_v = in[20];
  p.out = (float*)d_out;
  char* w = (char*)d_ws;
  size_t off = 0;
  auto take = [&](size_t bytes) { char* r = w + off; off += (bytes + 255) & ~(size_t)255; return r; };
  p.X = (float*)take((size_t)TPAD * DM * 4);
  p.H = (u16*)take((size_t)TPAD * DM * 2);
  p.WfinT = (u16*)take((size_t)2 * 4224 * 1024 * 2);
  p.WfoutT = (u16*)take((size_t)2 * 1024 * 1024 * 2);
  p.WrinT = (u16*)take((size_t)2 * 6144 * 1024 * 2);
  p.WroutT = (u16*)take((size_t)2 * 1024 * 2048 * 2);
  p.WpqT = (u16*)take((size_t)4 * 2048 * 1024 * 2);
  p.SKb = (u16*)take((size_t)4 * 8 * 2 * 128 * 128 * 2);
  p.Ub = (u16*)take((size_t)NEXP * DM * 2);
  p.Vb = (u16*)take((size_t)NEXP * DM * 2);
  p.SV = (float*)take((size_t)TPAD * 256 * 4);
  p.SI = (int*)take((size_t)TPAD * 256 * 4);
  p.LFC = (float*)take((size_t)TPAD * 16 * 4);
  p.LFR = (float*)take((size_t)TPAD * 16 * 4);
  p.TT = (float*)take((size_t)MTILES * 16 * 4);
  p.SSQ = (unsigned long long*)take((size_t)TPAD * 8);
  size_t region = off;
  p.Qf = (u16*)take((size_t)TPAD * DM * 2);
  p.Kf = (u16*)take((size_t)TPAD * DM * 2);
  p.VtF = (u16*)take((size_t)1024 * TPAD * 2);
  p.OGf = (u16*)take((size_t)TPAD * DM * 2);
  p.AO = (u16*)take((size_t)TPAD * DM * 2);
  off = region;
  p.Qr = (u16*)take((size_t)TP2 * DM * 2);
  p.Kr = (u16*)take((size_t)TP2 * DM * 2);
  p.KrT = (u16*)take((size_t)1024 * TP2 * 2);
  p.VrT = (u16*)take((size_t)2048 * TP2 * 2);
  p.Gr = (u16*)take((size_t)TPAD * 2048 * 2);
  p.ST = (u16*)take((size_t)NCH * 4 * 512 * 256 * 2);
  if (off > ws_size) { fprintf(stderr, "workspace too small: need %zu have %zu\n", off, ws_size); return; }
  for (int i = 0; i < 128; ++i) p.rope_rev[i] = (float)(pow(10000.0, -(double)i / 128.0) / (2.0 * M_PI));
#if ONE_LAUNCH
  int ph0 = 0, ph1 = NPHASE;
  void* args[] = {&p, &ph0, &ph1};
  hipError_t e = hipLaunchCooperativeKernel((void*)mega, dim3(grid_blocks), dim3(256), args, 0, stream);
  if (e != hipSuccess) fprintf(stderr, "cooperative launch failed: %s (grid %d)\n", hipGetErrorString(e), grid_blocks);
#else
  for (int ph = 0; ph < NPHASE; ++ph) mega<<<grid_blocks, 256, 0, stream>>>(p, ph, ph + 1);
#endif
}
```

```cpp
#include <hip/hip_runtime.h>
#include <hip/hip_cooperative_groups.h>
#include <stdint.h>
#include <math.h>
#include <stdio.h>
#include <string.h>
namespace cg = cooperative_groups;

typedef unsigned short u16;
typedef __attribute__((ext_vector_type(8))) short bf16x8;
typedef __attribute__((ext_vector_type(4))) float f32x4;
typedef __attribute__((ext_vector_type(2))) float f32x2;
typedef __attribute__((ext_vector_type(4))) unsigned int u32x4;
typedef __attribute__((ext_vector_type(2))) unsigned int u32x2;
#define DEV __device__ __forceinline__

#ifndef ONE_LAUNCH
#define ONE_LAUNCH 1
#endif

constexpr int DM = 1024;
constexpr int NMETA = 16;
constexpr int LP = 16400;
constexpr int NSMP = 128;
constexpr int TTOK = LP + NSMP;
constexpr int TPAD = 16640;
constexpr int MTILES = 130;
constexpr int LEAD = 48;
constexpr int TP2 = 16704;
constexpr int NCH = 257;
constexpr int PAST = 1024;
constexpr int NEXP = 16384;
constexpr float EPS = 1e-6f;

constexpr size_t O_YP = 0;
constexpr size_t O_YS = O_YP + (size_t)16384 * 1024;
constexpr size_t O_FKP = O_YS + (size_t)128 * 1024;
constexpr size_t O_FVP = O_FKP + (size_t)2 * LP * 1024;
constexpr size_t O_FLP = O_FVP + (size_t)2 * LP * 1024;
constexpr size_t O_SRP = O_FLP + (size_t)2 * LP * 16;
constexpr size_t O_FKS = O_SRP + (size_t)2 * 4 * 256 * 512;
constexpr size_t O_FVS = O_FKS + (size_t)2 * 128 * 1024;
constexpr size_t O_FLS = O_FVS + (size_t)2 * 128 * 1024;
constexpr size_t O_SRS = O_FLS + (size_t)2 * 128 * 16;

struct Params {
  const float *x_prompt, *x_sample, *cache_k, *cache_v, *cache_lf, *state_ret, *meta, *norm_mix, *norm_ffn;
  const float *fox_w_in, *fox_b_f, *fox_qn, *fox_kn, *fox_w_out, *ret_w_in, *ret_gn, *ret_w_out;
  const float *peer_wq, *peer_sk, *peer_u, *peer_v;
  float* out;
  float* X; u16* H;
  u16 *WfinT, *WfoutT, *WrinT, *WroutT, *WpqT, *SKb, *Ub, *Vb;
  float *SV; int* SI;
  float *LFC, *LFR, *TT; unsigned long long* SSQ;
  u16 *Qf, *Kf, *VtF, *OGf, *AO;
  u16 *Qr, *Kr, *KrT, *VrT, *Gr, *ST;
  float rope_rev[128];
};

typedef __attribute__((ext_vector_type(2))) float f2cv_t;
typedef __attribute__((ext_vector_type(2))) __bf16 bf2cv_t;
DEV uint32_t pack2(float a, float b) { f2cv_t v = {a, b}; bf2cv_t r = __builtin_convertvector(v, bf2cv_t); return __builtin_bit_cast(uint32_t, r); }
DEV u16 f2bf(float f) { return (u16)(pack2(f, 0.f) & 0xffffu); }
DEV float bf2f(u16 h) { return __uint_as_float(((uint32_t)h) << 16); }
DEV float bflo(uint32_t u) { return __uint_as_float(u << 16); }
DEV float bfhi(uint32_t u) { return __uint_as_float(u & 0xffff0000u); }

union V8 { bf16x8 v; uint32_t u[4]; u32x2 d[2]; u32x4 q; };

DEV f32x4 mfma(bf16x8 a, bf16x8 b, f32x4 c) { return __builtin_amdgcn_mfma_f32_16x16x32_bf16(a, b, c, 0, 0, 0); }

template <int CTRL> DEV float dppf(float v) {
  return __int_as_float(__builtin_amdgcn_update_dpp(0, __float_as_int(v), CTRL, 0xf, 0xf, false));
}
template <int CTRL> DEV uint32_t dppu(uint32_t v) {
  return (uint32_t)__builtin_amdgcn_update_dpp(0, (int)v, CTRL, 0xf, 0xf, false);
}
DEV float row16_sum(float v) {
  v += dppf<0xB1>(v); v += dppf<0x4E>(v); v += dppf<0x141>(v); v += dppf<0x140>(v);
  return v;
}
DEV uint32_t row16_maxu(uint32_t v) {
  v = max(v, dppu<0xB1>(v)); v = max(v, dppu<0x4E>(v)); v = max(v, dppu<0x141>(v)); v = max(v, dppu<0x140>(v));
  return v;
}
DEV float rdlane(float v, int l) { float r = __int_as_float(__builtin_amdgcn_readlane(__float_as_int(v), l)); asm volatile("" : "+v"(r)); return r; }
DEV float wave_sum(float v) {
  v = row16_sum(v);
  return rdlane(v, 0) + rdlane(v, 16) + rdlane(v, 32) + rdlane(v, 48);
}
DEV float wave_max(float v) {
  v = fmaxf(v, dppf<0xB1>(v)); v = fmaxf(v, dppf<0x4E>(v)); v = fmaxf(v, dppf<0x141>(v)); v = fmaxf(v, dppf<0x140>(v));
  return fmaxf(fmaxf(rdlane(v, 0), rdlane(v, 16)), fmaxf(rdlane(v, 32), rdlane(v, 48)));
}
DEV uint32_t wave_maxu(uint32_t v) {
  v = row16_maxu(v);
  uint32_t a = (uint32_t)__builtin_amdgcn_readlane((int)v, 0), b = (uint32_t)__builtin_amdgcn_readlane((int)v, 16);
  uint32_t c = (uint32_t)__builtin_amdgcn_readlane((int)v, 32), d = (uint32_t)__builtin_amdgcn_readlane((int)v, 48);
  return max(max(a, b), max(c, d));
}
DEV uint32_t f2key(float f) { uint32_t u = __float_as_uint(f); return (u & 0x80000000u) ? ~u : (u | 0x80000000u); }
DEV float key2f(uint32_t k) { uint32_t u = (k & 0x80000000u) ? (k & 0x7fffffffu) : ~k; return __uint_as_float(u); }

DEV float sigmoidf_(float x) { return 1.f / (1.f + __expf(-x)); }
DEV float logsigmoid_(float x) { return fminf(x, 0.f) - log1pf(expf(-fabsf(x))); }
DEV float gelu_(float x) { return 0.5f * x * (1.f + erff(x * 0.70710678118654752f)); }
DEV float ret_l2g(int h) { return log2f(1.f - exp2f(-5.f - (float)h)); }
DEV int otid() { int t = threadIdx.x; asm volatile("" : "+v"(t)); return t; }
DEV size_t tix(int rows, int h, int row, int pp) { return ((size_t)(h * 261 + (pp >> 6)) * rows + row) * 64 + (pp & 63); }
DEV int perm_dorig(int dp) { return ((dp >> 4) & 1) * 128 + (dp >> 5) * 16 + (dp & 15); }

DEV void norm_rows(const Params& p, const float* gain, bool from_input) {
  int tid_ = otid();
  int lane = tid_ & 63;
  int gw = (blockIdx.x * blockDim.x + tid_) >> 6, nw = (gridDim.x * blockDim.x) >> 6;
  for (int t = gw; t < TPAD; t += nw) {
    const float* src;
    if (from_input) {
      if (t < NMETA) src = p.meta + (size_t)t * DM;
      else if (t < LP) src = p.x_prompt + (size_t)(t - NMETA) * DM;
      else if (t < TTOK) src = p.x_sample + (size_t)(t - LP) * DM;
      else src = nullptr;
    } else src = p.X + (size_t)t * DM;
    f32x4 v[4];
    float ss = 0.f;
#pragma unroll
    for (int c = 0; c < 4; ++c) {
      if (src) v[c] = *(const f32x4*)(src + c * 256 + lane * 4); else v[c] = f32x4{0.f, 0.f, 0.f, 0.f};
      ss += v[c].x * v[c].x + v[c].y * v[c].y + v[c].z * v[c].z + v[c].w * v[c].w;
    }
    ss = wave_sum(ss);
    float rstd = rsqrtf(ss * (1.f / DM) + EPS);
#pragma unroll
    for (int c = 0; c < 4; ++c) {
      if (from_input) *(f32x4*)(p.X + (size_t)t * DM + c * 256 + lane * 4) = v[c];
      f32x4 g = *(const f32x4*)(gain + c * 256 + lane * 4);
      u32x2 o;
      o.x = pack2(v[c].x * rstd * g.x, v[c].y * rstd * g.y);
      o.y = pack2(v[c].z * rstd * g.z, v[c].w * rstd * g.w);
      *(u32x2*)(p.H + (size_t)t * DM + c * 256 + lane * 4) = o;
    }
  }
}

DEV void convert_bf16(const float* src, u16* dst, size_t n4) {
  size_t i = (size_t)blockIdx.x * blockDim.x + otid(), st = (size_t)gridDim.x * blockDim.x;
  for (; i < n4; i += st) {
    f32x4 v = ((const f32x4*)src)[i];
    u32x2 o; o.x = pack2(v.x, v.y); o.y = pack2(v.z, v.w);
    ((u32x2*)dst)[i] = o;
  }
}

DEV void xpose(const float* W, int K, int N, int Npad, u16* Wt, bool permq, char* smem) {
  u16* tile = (u16*)smem;
  int tid = otid();
  int ntn = Npad / 64, ntk = K / 64;
  for (int it = blockIdx.x; it < ntn * ntk; it += gridDim.x) {
    int n0 = (it / ntk) * 64, k0 = (it % ntk) * 64;
    int c = tid & 63, r0 = tid >> 6;
    int np = n0 + c;
    int src = np;
    if (permq && np < 2048) src = (np & ~255) + perm_dorig(np & 255);
    __syncthreads();
#pragma unroll
    for (int i = 0; i < 16; ++i) {
      int k = r0 + 4 * i;
      float v = (np < N) ? W[(size_t)(k0 + k) * N + src] : 0.f;
      tile[c * 72 + k] = f2bf(v);
    }
    __syncthreads();
    int nl = tid >> 2, kq = (tid & 3) * 16;
    u32x4 a = *(const u32x4*)(tile + nl * 72 + kq);
    u32x4 b = *(const u32x4*)(tile + nl * 72 + kq + 8);
    *(u32x4*)(Wt + (size_t)(n0 + nl) * K + k0 + kq) = a;
    *(u32x4*)(Wt + (size_t)(n0 + nl) * K + k0 + kq + 8) = b;
  }
}

typedef __attribute__((ext_vector_type(2))) float v2f_t;
constexpr float U_SCALE = 64.f, V_SCALE = 16.f;
DEV void convert_fp8(const float* src, uint32_t* dst, size_t n4, float scale) {
  size_t i = (size_t)blockIdx.x * blockDim.x + otid(), st = (size_t)gridDim.x * blockDim.x;
  for (; i < n4; i += st) {
    f32x4 v = ((const f32x4*)src)[i];
    int w = __builtin_amdgcn_cvt_pk_fp8_f32(v.x * scale, v.y * scale, 0, false);
    w = __builtin_amdgcn_cvt_pk_fp8_f32(v.z * scale, v.w * scale, w, true);
    dst[i] = (uint32_t)w;
  }
}
DEV void conv_tables(const Params& p, int layer) {
  convert_fp8(p.peer_u + (size_t)layer * NEXP * DM, (uint32_t*)p.Ub, (size_t)NEXP * DM / 4, U_SCALE);
  convert_fp8(p.peer_v + (size_t)layer * NEXP * DM, (uint32_t*)p.Vb, (size_t)NEXP * DM / 4, V_SCALE);
}

DEV void ph_prep(const Params& p, char* smem) {
  norm_rows(p, p.norm_mix, true);
  convert_bf16(p.peer_sk, p.SKb, (size_t)4 * 8 * 2 * 128 * 128 / 4);
  for (int j = 0; j < 2; ++j) {
    xpose(p.fox_w_in + (size_t)j * 1024 * 4112, 1024, 4112, 4224, p.WfinT + (size_t)j * 4224 * 1024, false, smem);
    xpose(p.fox_w_out + (size_t)j * 1024 * 1024, 1024, 1024, 1024, p.WfoutT + (size_t)j * 1024 * 1024, false, smem);
    xpose(p.ret_w_in + (size_t)j * 1024 * 6144, 1024, 6144, 6144, p.WrinT + (size_t)j * 6144 * 1024, true, smem);
    xpose(p.ret_w_out + (size_t)j * 2048 * 1024, 2048, 1024, 1024, p.WroutT + (size_t)j * 1024 * 2048, false, smem);
  }
  for (int l = 0; l < 4; ++l)
    xpose(p.peer_wq + (size_t)l * 1024 * 2048, 1024, 2048, 2048, p.WpqT + (size_t)l * 2048 * 1024, false, smem);
}

DEV void tile_mn(int it, int NT, int& mt, int& nt) {
  const int GM = 8;
  int g = it / (GM * NT), r = it - g * (GM * NT);
  int gm = min(GM, MTILES - g * GM);
  nt = r / gm; mt = g * GM + (r - nt * gm);
}

constexpr int LDK = 72;
template <bool SWAP>
DEV void gemm_tile(const u16* __restrict__ A, int lda, const u16* __restrict__ Bt, int ldb, int K,
                          int m0, int n0, char* smem, f32x4 (&acc)[4][4]) {
  u16* sA = (u16*)smem;
  u16* sB = sA + 128 * LDK;
  int tid = otid(), lane = tid & 63, wid = tid >> 6;
  int wr = wid >> 1, wc = wid & 1, fr = lane & 15, fq = lane >> 4;
#pragma unroll
  for (int m = 0; m < 4; ++m)
#pragma unroll
    for (int n = 0; n < 4; ++n) acc[m][n] = f32x4{0.f, 0.f, 0.f, 0.f};
  u32x4 ra[4], rb[4];
  const u16* Ap = A + (size_t)(m0 + (tid >> 3)) * lda + (tid & 7) * 8;
  const u16* Bp = Bt + (size_t)(n0 + (tid >> 3)) * ldb + (tid & 7) * 8;
#pragma unroll
  for (int i = 0; i < 4; ++i) {
    ra[i] = *(const u32x4*)(Ap + (size_t)(32 * i) * lda);
    rb[i] = *(const u32x4*)(Bp + (size_t)(32 * i) * ldb);
  }
  for (int k0 = 0; k0 < K; k0 += 64) {
    __syncthreads();
#pragma unroll
    for (int i = 0; i < 4; ++i) {
      *(u32x4*)(sA + ((tid >> 3) + 32 * i) * LDK + (tid & 7) * 8) = ra[i];
      *(u32x4*)(sB + ((tid >> 3) + 32 * i) * LDK + (tid & 7) * 8) = rb[i];
    }
    __syncthreads();
    if (k0 + 64 < K) {
#pragma unroll
      for (int i = 0; i < 4; ++i) {
        ra[i] = *(const u32x4*)(Ap + (size_t)(32 * i) * lda + k0 + 64);
        rb[i] = *(const u32x4*)(Bp + (size_t)(32 * i) * ldb + k0 + 64);
      }
    }
#pragma unroll
    for (int ks = 0; ks < 2; ++ks) {
      bf16x8 af[4], bfv[4];
#pragma unroll
      for (int m = 0; m < 4; ++m) af[m] = *(const bf16x8*)(sA + (wr * 64 + m * 16 + fr) * LDK + ks * 32 + fq * 8);
#pragma unroll
      for (int n = 0; n < 4; ++n) bfv[n] = *(const bf16x8*)(sB + (wc * 64 + n * 16 + fr) * LDK + ks * 32 + fq * 8);
#pragma unroll
      for (int m = 0; m < 4; ++m)
#pragma unroll
        for (int n = 0; n < 4; ++n) acc[m][n] = SWAP ? mfma(bfv[n], af[m], acc[m][n]) : mfma(af[m], bfv[n], acc[m][n]);
    }
  }
}

DEV void ph_f1(const Params& p, int jf, char* smem) {
  { unsigned int z_ = 0; asm volatile("" : "+v"(z_));
    for (int i = blockIdx.x * blockDim.x + otid(); i < TPAD; i += gridDim.x * blockDim.x) p.SSQ[i] = (unsigned long long)z_; }
  const u16* Wt = p.WfinT + (size_t)jf * 4224 * 1024;
  int tid = otid(), lane = tid & 63, wid = tid >> 6;
  int wr = wid >> 1, wc = wid & 1, fr = lane & 15, fq = lane >> 4;
  const int NT = 33;
  for (int it = blockIdx.x; it < MTILES * NT; it += gridDim.x) {
    int mt, nt; tile_mn(it, NT, mt, nt);
    int m0 = mt * 128;
    f32x4 acc[4][4];
    int type = nt >> 3;
    if (type == 2 || type == 4) gemm_tile<false>(p.H, DM, Wt, DM, DM, m0, nt * 128, smem, acc);
    else gemm_tile<true>(p.H, DM, Wt, DM, DM, m0, nt * 128, smem, acc);
    if (type <= 1) {
      int hh = (nt & 7) * 2 + wc;
      const float* gn = (type == 0 ? p.fox_qn : p.fox_kn) + jf * 64;
      const float gs = (type == 0) ? 0.125f * 1.44269504089f : 1.f;
      f32x4 g[4];
#pragma unroll
      for (int n = 0; n < 4; ++n) g[n] = *(const f32x4*)(gn + n * 16 + fq * 4) * gs;
#pragma unroll
      for (int m = 0; m < 4; ++m) {
        float ss = 0.f;
#pragma unroll
        for (int n = 0; n < 4; ++n)
#pragma unroll
          for (int j = 0; j < 4; ++j) ss += acc[m][n][j] * acc[m][n][j];
        ss += __shfl_xor(ss, 16); ss += __shfl_xor(ss, 32);
        float rstd = rsqrtf(ss * (1.f / 64.f) + EPS);
        int row = m0 + wr * 64 + m * 16 + fr;
#pragma unroll
        for (int n = 0; n < 4; ++n) {
          f32x4 v = acc[m][n] * rstd * g[n];
          int col = hh * 64 + n * 16 + fq * 4;
          u32x2 o; o.x = pack2(v.x, v.y); o.y = pack2(v.z, v.w);
          if (type == 0) *(u32x2*)(p.Qf + (size_t)row * DM + col) = o;
          else {
            *(u32x2*)(p.Kf + (size_t)row * DM + col) = o;
            if (row < LP) *(f32x4*)(p.out + O_FKP + ((size_t)jf * LP + row) * 1024 + col) = v;
            else if (row < TTOK) *(f32x4*)(p.out + O_FKS + ((size_t)jf * 128 + (row - LP)) * 1024 + col) = v;
          }
        }
      }
    } else if (type == 2) {
      int hh = (nt & 7) * 2 + wc;
#pragma unroll
      for (int m = 0; m < 4; ++m) {
        int rb = m0 + wr * 64 + m * 16 + fq * 4;
#pragma unroll
        for (int n = 0; n < 4; ++n) {
          int d = n * 16 + fr;
          u32x2 o; o.x = pack2(acc[m][n][0], acc[m][n][1]); o.y = pack2(acc[m][n][2], acc[m][n][3]);
          *(u32x2*)(p.VtF + (size_t)(hh * 64 + d) * TPAD + rb) = o;
#pragma unroll
          for (int j = 0; j < 4; ++j) {
            int row = rb + j; int col = hh * 64 + d;
            if (row < LP) p.out[O_FVP + ((size_t)jf * LP + row) * 1024 + col] = acc[m][n][j];
            else if (row < TTOK) p.out[O_FVS + ((size_t)jf * 128 + (row - LP)) * 1024 + col] = acc[m][n][j];
          }
        }
      }
    } else if (type == 3) {
#pragma unroll
      for (int m = 0; m < 4; ++m)
#pragma unroll
        for (int n = 0; n < 4; ++n) {
          int row = m0 + wr * 64 + m * 16 + fr;
          int col = (nt - 24) * 128 + wc * 64 + n * 16 + fq * 4;
          u32x2 o; o.x = pack2(acc[m][n][0], acc[m][n][1]); o.y = pack2(acc[m][n][2], acc[m][n][3]);
          *(u32x2*)(p.OGf + (size_t)row * DM + col) = o;
        }
    } else {
      float* lfs = (float*)smem;
      __syncthreads();
      if (wc == 0) {
        float bf = p.fox_b_f[jf * 16 + fr];
#pragma unroll
        for (int m = 0; m < 4; ++m)
#pragma unroll
          for (int j = 0; j < 4; ++j) {
            int rl = wr * 64 + m * 16 + fq * 4 + j;
            int row = m0 + rl;
            float lf = logsigmoid_(acc[m][0][j] + bf);
            lfs[rl * 16 + fr] = lf;
            p.LFR[(size_t)row * 16 + fr] = lf;
            if (row < LP) p.out[O_FLP + ((size_t)jf * LP + row) * 16 + fr] = lf;
            else if (row < TTOK) p.out[O_FLS + ((size_t)jf * 128 + (row - LP)) * 16 + fr] = lf;
          }
      }
      __syncthreads();
      if (tid < 16) {
        float run = 0.f;
        for (int r = 0; r < 128; ++r) {
          run += lfs[r * 16 + tid];
          p.LFC[(size_t)(m0 + r) * 16 + tid] = run;
        }
        p.TT[mt * 16 + tid] = run;
      }
    }
  }
}

template <bool MASK>
DEV void attn_tile(const u16* Kb, const u16* Vb, const float* cb, int key0, int q0, int fr, int fq,
                   const bf16x8 (&qf)[4][2], const float (&cq)[4], float (&lrow)[4], f32x4 (&o)[4][4]) {
  const bool diag = MASK;
#pragma unroll
  for (int pp = 0; pp < 2; ++pp) {
        V8 pfu[4];
#pragma unroll
        for (int kl = 0; kl < 2; ++kl) {
          f32x4 s1[4];
          f32x4 ck = *(const f32x4*)(cb + (2 * pp + kl) * 16 + fq * 4);
#pragma unroll
          for (int qi = 0; qi < 4; ++qi) s1[qi] = cq[qi] - ck;
#pragma unroll
          for (int ks = 0; ks < 2; ++ks) {
            bf16x8 a = *(const bf16x8*)(Kb + ((2 * pp + kl) * 16 + fr) * LDK + ks * 32 + fq * 8);
#pragma unroll
            for (int qi = 0; qi < 4; ++qi) s1[qi] = mfma(a, qf[qi][ks], s1[qi]);
          }
#pragma unroll
          for (int qi = 0; qi < 4; ++qi) {
            int q = q0 + qi * 16 + fr;
            float e[4];
#pragma unroll
            for (int j = 0; j < 4; ++j) {
              float v = s1[qi][j];
              if (diag && (key0 + (2 * pp + kl) * 16 + fq * 4 + j > q)) v = -INFINITY;
              e[j] = __builtin_amdgcn_exp2f(v);
            }
            lrow[qi] += (e[0] + e[1]) + (e[2] + e[3]);
            pfu[qi].u[kl * 2 + 0] = pack2(e[0], e[1]);
            pfu[qi].u[kl * 2 + 1] = pack2(e[2], e[3]);
          }
        }
        bf16x8 pf[4];
#pragma unroll
        for (int qi = 0; qi < 4; ++qi) pf[qi] = pfu[qi].v;
#pragma unroll
        for (int dt = 0; dt < 4; ++dt) {
          V8 a;
          a.d[0] = *(const u32x2*)(Vb + (dt * 16 + fr) * LDK + (2 * pp) * 16 + fq * 4);
          a.d[1] = *(const u32x2*)(Vb + (dt * 16 + fr) * LDK + (2 * pp + 1) * 16 + fq * 4);
#pragma unroll
          for (int qi = 0; qi < 4; ++qi) o[dt][qi] = mfma(a.v, pf[qi], o[dt][qi]);
        }
      }
}

DEV void f2_prompt(const Params& p, int qt, int h, char* smem) {
  u16* Ks = (u16*)smem;
  u16* Vs = Ks + 2 * 64 * LDK;
  float* cs = (float*)(Vs + 2 * 64 * LDK);
  float* off = cs + 128;
  float* tmp = off + 132;
  int tid = otid(), lane = tid & 63, wid = tid >> 6, fr = lane & 15, fq = lane >> 4;
  __syncthreads();
  if (tid < MTILES) tmp[tid] = p.TT[tid * 16 + h];
  __syncthreads();
  if (tid < MTILES) { float s = 0.f; for (int m = 0; m < tid; ++m) s += tmp[m]; off[tid] = s; }
  __syncthreads();
  int q0 = qt * 256 + wid * 64;
  bf16x8 qf[4][2];
  float cq[4], lrow[4];
  f32x4 o[4][4];
#pragma unroll
  for (int qi = 0; qi < 4; ++qi) {
    int q = q0 + qi * 16 + fr;
#pragma unroll
    for (int ks = 0; ks < 2; ++ks) qf[qi][ks] = *(const bf16x8*)(p.Qf + (size_t)q * DM + h * 64 + ks * 32 + fq * 8);
    cq[qi] = (p.LFC[(size_t)q * 16 + h] + off[q >> 7] - 12.f) * 1.44269504089f;
    lrow[qi] = 0.f;
#pragma unroll
    for (int dt = 0; dt < 4; ++dt) o[dt][qi] = f32x4{0.f, 0.f, 0.f, 0.f};
  }
  int nkt = 4 * (qt + 1);
  if (nkt > (LP + 63) / 64) nkt = (LP + 63) / 64;
  bool wave_valid = q0 < LP;
  u32x4 rk[2], rv[2]; float rc = 0.f;
  const int lrow_ = tid >> 2, lcol = (tid & 3) * 16;
  const u16* kfb = p.Kf + h * 64;
  const u16* vtb = p.VtF + (size_t)h * 64 * TPAD;
  const float* lcb = p.LFC + h;
  const unsigned kvo0 = (unsigned)(lrow_ * DM + lcol), kvo1 = kvo0 + 32u * DM;
  const unsigned vvo0 = (unsigned)(lrow_ * TPAD + lcol), vvo1 = vvo0 + 32u * TPAD;
#define GL(kt_) { int key0_ = (kt_) * 64; \
    const u16* kp_ = p.Kf + (size_t)(key0_ + lrow_) * DM + h * 64 + lcol; \
    const u16* vp_ = p.VtF + (size_t)(h * 64 + lrow_) * TPAD + key0_ + lcol; \
    rk[0] = *(const u32x4*)(kp_); rk[1] = *(const u32x4*)(kp_ + 8); \
    rv[0] = *(const u32x4*)(vp_); rv[1] = *(const u32x4*)(vp_ + 8); \
    if (tid < 64) rc = (p.LFC[(size_t)(key0_ + tid) * 16 + h] + off[(key0_ + tid) >> 7]) * 1.44269504089f; }
  GL(0);
  for (int kt = 0; kt < nkt; ++kt) {
    int buf = kt & 1;
    u16* Kb = Ks + buf * 64 * LDK; u16* Vb = Vs + buf * 64 * LDK; float* cb = cs + buf * 64;
#pragma unroll
    for (int i = 0; i < 2; ++i) {
      *(u32x4*)(Kb + lrow_ * LDK + lcol + 8 * i) = rk[i];
      *(u32x4*)(Vb + lrow_ * LDK + lcol + 8 * i) = rv[i];
    }
    if (tid < 64) cb[tid] = rc;
    __syncthreads();
    if (kt + 1 < nkt) GL(kt + 1);
    int key0 = kt * 64;
    if (wave_valid && key0 <= q0 + 63) {
      if (key0 + 63 > q0) attn_tile<true>(Kb, Vb, cb, key0, q0, fr, fq, qf, cq, lrow, o);
      else attn_tile<false>(Kb, Vb, cb, key0, q0, fr, fq, qf, cq, lrow, o);
    }
  }
  int q0e = q0;
  asm volatile("" : "+v"(q0e));
#pragma unroll
  for (int qi = 0; qi < 4; ++qi) {
    float l = lrow[qi];
    l += __shfl_xor(l, 16); l += __shfl_xor(l, 32);
    float inv = 1.f / l;
    int q = q0e + qi * 16 + fr;
    if (q < LP) {
#pragma unroll
      for (int dt = 0; dt < 4; ++dt) {
        int d = dt * 16 + fq * 4;
        u32x2 og = *(const u32x2*)(p.OGf + (size_t)q * DM + h * 64 + d);
        u32x2 r;
        r.x = pack2(o[dt][qi][0] * inv * sigmoidf_(bflo(og.x)), o[dt][qi][1] * inv * sigmoidf_(bfhi(og.x)));
        r.y = pack2(o[dt][qi][2] * inv * sigmoidf_(bflo(og.y)), o[dt][qi][3] * inv * sigmoidf_(bfhi(og.y)));
        *(u32x2*)(p.AO + (size_t)q * DM + h * 64 + d) = r;
      }
    }
  }
}

DEV void f2_sample(const Params& p, int jf, int b, int h, int qh, char* smem) {
  constexpr int NK = PAST + 16;
  float* S = (float*)smem;
  float* qs = S + 8 * NK;
  float* cc = qs + 8 * 64;
  float* part = cc + NK;
  float* invl = part + 256;
  int tid = otid(), lane = tid & 63, wid = tid >> 6;
  __syncthreads();
  for (int e = tid; e < 512; e += 256) {
    int i = e >> 6, d = e & 63;
    qs[e] = bf2f(p.Qf[(size_t)(LP + b * 16 + qh * 8 + i) * DM + h * 64 + d]);
  }
  float lv[5]; float run = 0.f;
#pragma unroll
  for (int u = 0; u < 5; ++u) {
    int j = tid * 5 + u;
    float v = 0.f;
    if (j < PAST) v = p.cache_lf[(((size_t)jf * 8 + b) * PAST + j) * 16 + h];
    else if (j < NK) v = p.LFR[(size_t)(LP + b * 16 + (j - PAST)) * 16 + h];
    run += v; lv[u] = run;
  }
  part[tid] = run;
  __syncthreads();
  float base = 0.f;
  for (int m = 0; m < tid; ++m) base += part[m];
#pragma unroll
  for (int u = 0; u < 5; ++u) { int j = tid * 5 + u; if (j < NK) cc[j] = base + lv[u]; }
  __syncthreads();
  for (int j = tid; j < NK; j += 256) {
    const float* kp;
    if (j < PAST) kp = p.cache_k + ((((size_t)jf * 8 + b) * PAST + j) * 16 + h) * 64;
    else kp = p.out + O_FKS + (((size_t)jf * 128 + b * 16 + (j - PAST)) * 16 + h) * 64;
    f32x4 kv[16];
#pragma unroll
    for (int c = 0; c < 16; ++c) kv[c] = ((const f32x4*)kp)[c];
    float cj = cc[j];
#pragma unroll
    for (int i = 0; i < 8; ++i) {
      float a = 0.f;
#pragma unroll
      for (int c = 0; c < 16; ++c) {
        f32x4 qv = *(const f32x4*)(qs + i * 64 + c * 4);
        a += qv.x * kv[c].x + qv.y * kv[c].y + qv.z * kv[c].z + qv.w * kv[c].w;
      }
      int qi = qh * 8 + i;
      a = a * 0.69314718056f + (cc[PAST + qi] - cj);
      if (j > PAST + qi) a = -INFINITY;
      S[i * NK + j] = a;
    }
  }
  __syncthreads();
  for (int i = wid * 2; i < wid * 2 + 2; ++i) {
    float m = -INFINITY;
    for (int j = lane; j < NK; j += 64) m = fmaxf(m, S[i * NK + j]);
    m = wave_max(m);
    float l = 0.f;
    for (int j = lane; j < NK; j += 64) { float e = __expf(S[i * NK + j] - m); S[i * NK + j] = e; l += e; }
    l = wave_sum(l);
    if (lane == 0) invl[i] = 1.f / l;
  }
  __syncthreads();
  {
    int i = tid >> 5, dq = tid & 31;
    float o0 = 0.f, o1 = 0.f;
    const float* vb = p.cache_v + ((((size_t)jf * 8 + b) * PAST) * 16 + h) * 64 + dq * 2;
#pragma unroll 8
    for (int j = 0; j < PAST; ++j) {
      f32x2 v = *(const f32x2*)(vb + (size_t)j * 1024);
      float pj = S[i * NK + j];
      o0 += pj * v.x; o1 += pj * v.y;
    }
    const float* vn = p.out + O_FVS + (((size_t)jf * 128 + b * 16) * 16 + h) * 64 + dq * 2;
#pragma unroll
    for (int j = 0; j < 16; ++j) {
      f32x2 v = *(const f32x2*)(vn + (size_t)j * 1024);
      float pj = S[i * NK + PAST + j];
      o0 += pj * v.x; o1 += pj * v.y;
    }
    int row = LP + b * 16 + qh * 8 + i;
    float il = invl[i];
    uint32_t og = *(const uint32_t*)(p.OGf + (size_t)row * DM + h * 64 + dq * 2);
    *(uint32_t*)(p.AO + (size_t)row * DM + h * 64 + dq * 2) = pack2(o0 * il * sigmoidf_(bflo(og)), o1 * il * sigmoidf_(bfhi(og)));
  }
}

DEV void ph_f2(const Params& p, int jf, char* smem) {
  const int NP = 65 * 16, NI = NP + 256;
  int G = gridDim.x;
  {
    int gt = blockIdx.x * blockDim.x + otid(), gs = gridDim.x * blockDim.x;
    for (int i = gt; i < (TPAD - TTOK) * DM / 2; i += gs) ((uint32_t*)(p.AO + (size_t)TTOK * DM))[i] = 0u;
  }
  for (int r = 0;; ++r) {
    int pos = (r & 1) ? (G - 1 - (int)blockIdx.x) : (int)blockIdx.x;
    int idx = r * G + pos;
    if (r * G >= NI) break;
    if (idx >= NI) continue;
    if (idx < NP) f2_prompt(p, 64 - idx / 16, idx % 16, smem);
    else { int s = idx - NP; f2_sample(p, jf, s >> 5, (s >> 1) & 15, s & 1, smem); }
  }
  conv_tables(p, jf * 2);
}

DEV void ph_outproj(const Params& p, const u16* A, int K, const u16* Wt, const float* gffn, char* smem) {
  int tid = otid(), lane = tid & 63, wid = tid >> 6;
  int wr = wid >> 1, wc = wid & 1, fr = lane & 15, fq = lane >> 4;
  for (int it = blockIdx.x; it < MTILES * 8; it += gridDim.x) {
    int mt, nt; tile_mn(it, 8, mt, nt);
    f32x4 acc[4][4];
    gemm_tile<true>(A, K, Wt, K, K, mt * 128, nt * 128, smem, acc);
#pragma unroll
    for (int m = 0; m < 4; ++m) {
      int row = mt * 128 + wr * 64 + m * 16 + fr;
      float ss = 0.f;
#pragma unroll
      for (int n = 0; n < 4; ++n) {
        int col = nt * 128 + wc * 64 + n * 16 + fq * 4;
        f32x4* xp = (f32x4*)(p.X + (size_t)row * DM + col);
        f32x4 xn = *xp + acc[m][n];
        *xp = xn;
        f32x4 g = *(const f32x4*)(gffn + col);
        u32x2 o; o.x = pack2(xn.x * g.x, xn.y * g.y); o.y = pack2(xn.z * g.z, xn.w * g.w);
        *(u32x2*)(p.H + (size_t)row * DM + col) = o;
        ss += xn.x * xn.x + xn.y * xn.y + xn.z * xn.z + xn.w * xn.w;
      }
      ss += __shfl_xor(ss, 16); ss += __shfl_xor(ss, 32);
      if (fq == 0) atomicAdd(p.SSQ + row, (unsigned long long)(ss * 1048576.f + 0.5f));
    }
  }
}

DEV void ph_r1(const Params& p, int jr, char* smem) {
  const u16* Wt = p.WrinT + (size_t)jr * 6144 * 1024;
  int tid = otid(), lane = tid & 63, wid = tid >> 6;
  int wr = wid >> 1, wc = wid & 1, fr = lane & 15, fq = lane >> 4;
  {
    int gt = blockIdx.x * blockDim.x + tid, gs = gridDim.x * blockDim.x;
    for (int i = gt; i < LEAD * DM; i += gs) { p.Qr[i] = 0; p.Kr[i] = 0; }
    { unsigned int z_ = 0; asm volatile("" : "+v"(z_)); for (int i = gt; i < TPAD; i += gs) p.SSQ[i] = (unsigned long long)z_; }
    for (int i = gt; i < 1024 * LEAD; i += gs) p.KrT[tix(256, (i / LEAD) >> 8, (i / LEAD) & 255, i % LEAD)] = 0;
    for (int i = gt; i < 2048 * LEAD; i += gs) p.VrT[tix(512, (i / LEAD) >> 9, (i / LEAD) & 511, i % LEAD)] = 0;
  }
  const int NT = 48;
  for (int it = blockIdx.x; it < MTILES * NT; it += gridDim.x) {
    int mt, nt; tile_mn(it, NT, mt, nt);
    int m0 = mt * 128;
    f32x4 acc[4][4];
    if (nt >= 8 && nt < 32) gemm_tile<false>(p.H, DM, Wt, DM, DM, m0, nt * 128, smem, acc);
    else gemm_tile<true>(p.H, DM, Wt, DM, DM, m0, nt * 128, smem, acc);
    if (nt < 8) {
      int hh = nt >> 1, half = nt & 1;
#pragma unroll
      for (int pr = 0; pr < 2; ++pr) {
        int g = half * 4 + wc * 2 + pr;
        f32x4 rr = *(const f32x4*)(p.rope_rev + g * 16 + fq * 4);
#pragma unroll
        for (int m = 0; m < 4; ++m) {
          int row = m0 + wr * 64 + m * 16 + fr;
          int pos = (row < LP) ? (row - NMETA) : ((row < TTOK) ? (PAST + ((row - LP) & 15)) : 0);
          float o1[4], o2[4];
#pragma unroll
          for (int j = 0; j < 4; ++j) {
            float rev = (float)pos * rr[j];
            rev -= floorf(rev);
            float sn = __builtin_amdgcn_sinf(rev), cs = __builtin_amdgcn_cosf(rev);
            float x1 = acc[m][2 * pr][j], x2 = acc[m][2 * pr + 1][j];
            o1[j] = (x1 * cs - x2 * sn) * 0.0625f; o2[j] = (x1 * sn + x2 * cs) * 0.0625f;
          }
          u32x2 t1, t2;
          t1.x = pack2(o1[0], o1[1]); t1.y = pack2(o1[2], o1[3]);
          t2.x = pack2(o2[0], o2[1]); t2.y = pack2(o2[2], o2[3]);
          u16* dq = p.Qr + (size_t)(row + LEAD) * DM + hh * 256 + g * 32 + fq * 4;
          *(u32x2*)dq = t1;
          *(u32x2*)(dq + 16) = t2;
        }
      }
    } else if (nt < 16) {
      bool isq = false;
      int hh = (nt & 7) >> 1, half = nt & 1;
      float l2g = ret_l2g(hh);
      u16* dst = isq ? p.Qr : p.Kr;
#pragma unroll
      for (int pr = 0; pr < 2; ++pr) {
        int g = half * 4 + wc * 2 + pr;
        int fi = g * 16 + fr;
        float rr = p.rope_rev[fi];
        int dp1 = g * 32 + fr, dp2 = dp1 + 16;
#pragma unroll
        for (int m = 0; m < 4; ++m) {
          int rb = m0 + wr * 64 + m * 16 + fq * 4;
          float o1[4], o2[4];
#pragma unroll
          for (int j = 0; j < 4; ++j) {
            int row = rb + j;
            int pos = (row < LP) ? (row - NMETA) : ((row < TTOK) ? (PAST + ((row - LP) & 15)) : 0);
            float rev = (float)pos * rr;
            rev -= floorf(rev);
            float sn = __builtin_amdgcn_sinf(rev), cs = __builtin_amdgcn_cosf(rev);
            float x1 = acc[m][2 * pr][j], x2 = acc[m][2 * pr + 1][j];
            float a = x1 * cs - x2 * sn, bb = x1 * sn + x2 * cs;
            if (isq) { a *= 0.0625f; bb *= 0.0625f; }
            o1[j] = a; o2[j] = bb;
            dst[(size_t)(row + LEAD) * DM + hh * 256 + dp1] = f2bf(a);
            dst[(size_t)(row + LEAD) * DM + hh * 256 + dp2] = f2bf(bb);
          }
          if (!isq) {
            float dc[4];
#pragma unroll
            for (int j = 0; j < 4; ++j) dc[j] = exp2f(l2g * (float)(63 - ((rb + j + LEAD) & 63)));
            u32x2 t1, t2;
            t1.x = pack2(o1[0] * dc[0], o1[1] * dc[1]); t1.y = pack2(o1[2] * dc[2], o1[3] * dc[3]);
            t2.x = pack2(o2[0] * dc[0], o2[1] * dc[1]); t2.y = pack2(o2[2] * dc[2], o2[3] * dc[3]);
            *(u32x2*)(p.KrT + tix(256, hh, dp1, rb + LEAD)) = t1;
            *(u32x2*)(p.KrT + tix(256, hh, dp2, rb + LEAD)) = t2;
          }
        }
      }
    } else if (nt < 32) {
      int hh = (nt - 16) >> 2;
#pragma unroll
      for (int m = 0; m < 4; ++m) {
        int rb = m0 + wr * 64 + m * 16 + fq * 4;
#pragma unroll
        for (int n = 0; n < 4; ++n) {
          int e = ((nt - 16) & 3) * 128 + wc * 64 + n * 16 + fr;
          u32x2 o; o.x = pack2(acc[m][n][0], acc[m][n][1]); o.y = pack2(acc[m][n][2], acc[m][n][3]);
          *(u32x2*)(p.VrT + tix(512, hh, e, rb + LEAD)) = o;
        }
      }
    } else {
#pragma unroll
      for (int m = 0; m < 4; ++m)
#pragma unroll
        for (int n = 0; n < 4; ++n) {
          int row = m0 + wr * 64 + m * 16 + fr;
          int col = (nt - 32) * 128 + wc * 64 + n * 16 + fq * 4;
          u32x2 o; o.x = pack2(acc[m][n][0], acc[m][n][1]); o.y = pack2(acc[m][n][2], acc[m][n][3]);
          *(u32x2*)(p.Gr + (size_t)row * 2048 + col) = o;
        }
    }
  }
}

DEV void ph_r2(const Params& p, int jr) {
  int tid = otid(), lane = tid & 63, wid = tid >> 6, fr = lane & 15, fq = lane >> 4;
  for (int it = blockIdx.x; it < 256; it += gridDim.x) {
    int h = it >> 6, sl = (it >> 2) & 15, rt = (it & 3) * 4 + wid;
    float dec64 = exp2f(ret_l2g(h) * 64.f);
    f32x4 st[2];
    st[0] = f32x4{0.f, 0.f, 0.f, 0.f}; st[1] = st[0];
    const u16* kb = p.KrT + tix(256, h, rt * 16 + fr, 0) + fq * 8;
    const u16* vb = p.VrT + tix(512, h, sl * 32 + fr, 0) + fq * 8;
    u16* sp0 = p.ST + (((size_t)h * 16 + rt) * 512 + sl * 32 + fr) * 16 + fq * 4;
    bf16x8 A0[2], B0[4], A1[2], B1[4], A2[2], B2[4], A3[2], B3[4], A4[2], B4[4], A5[2], B5[4], A6[2], B6[4], A7[2], B7[4];
#define R2L(A, B, n_) { size_t nn_ = (size_t)min((n_), NCH - 1); \
      A[0] = *(const bf16x8*)(kb + nn_ * (256 * 64)); A[1] = *(const bf16x8*)(kb + nn_ * (256 * 64) + 32); \
      B[0] = *(const bf16x8*)(vb + nn_ * (512 * 64)); B[1] = *(const bf16x8*)(vb + nn_ * (512 * 64) + 32); \
      B[2] = *(const bf16x8*)(vb + nn_ * (512 * 64) + 16 * 64); B[3] = *(const bf16x8*)(vb + nn_ * (512 * 64) + 16 * 64 + 32); }
#define R2S(A, B, n_) { \
      _Pragma("unroll") for (int c = 0; c < 2; ++c) { \
        u32x2 o; o.x = pack2(st[c][0], st[c][1]); o.y = pack2(st[c][2], st[c][3]); \
        *(u32x2*)(sp0 + (size_t)(n_) * (4 * 16 * 512 * 16) + c * 16 * 16) = o; \
        f32x4 t = st[c] * dec64; \
        t = mfma(A[0], B[c * 2], t); t = mfma(A[1], B[c * 2 + 1], t); st[c] = t; } }
    R2L(A0, B0, 0) R2L(A1, B1, 1) R2L(A2, B2, 2) R2L(A3, B3, 3) R2L(A4, B4, 4) R2L(A5, B5, 5) R2L(A6, B6, 6) R2L(A7, B7, 7)
#pragma unroll 1
    for (int n = 0; n < 256; n += 8) {
      R2S(A0, B0, n + 0) R2L(A0, B0, n + 8)
      R2S(A1, B1, n + 1) R2L(A1, B1, n + 9)
      R2S(A2, B2, n + 2) R2L(A2, B2, n + 10)
      R2S(A3, B3, n + 3) R2L(A3, B3, n + 11)
      R2S(A4, B4, n + 4) R2L(A4, B4, n + 12)
      R2S(A5, B5, n + 5) R2L(A5, B5, n + 13)
      R2S(A6, B6, n + 6) R2L(A6, B6, n + 14)
      R2S(A7, B7, n + 7) R2L(A7, B7, n + 15)
    }
    R2S(A0, B0, 256)
    int fre = fr, fqe = fq;
    asm volatile("" : "+v"(fre), "+v"(fqe));
#pragma unroll
    for (int c = 0; c < 2; ++c)
#pragma unroll
      for (int j = 0; j < 4; ++j) {
        int dorig = perm_dorig(rt * 16 + fqe * 4 + j);
        p.out[O_SRP + ((size_t)(jr * 4 + h) * 256 + dorig) * 512 + sl * 32 + c * 16 + fre] = st[c][j];
      }
  }
}

DEV void r3_prompt(const Params& p, int jr, int n, int h, char* smem) {
  u32x4* Sf = (u32x4*)smem;
  float* red = (float*)(smem + 8192);
  int tid = otid(), lane = tid & 63, w = tid >> 6, fr = lane & 15, fq = lane >> 4;
  int p0 = n * 64;
  float l2g = ret_l2g(h);
  f32x4 acc[8][4];
#pragma unroll
  for (int a = 0; a < 8; ++a)
#pragma unroll
    for (int b = 0; b < 4; ++b) acc[a][b] = f32x4{0.f, 0.f, 0.f, 0.f};
  const u16* qb = p.Qr + (size_t)(p0 + fr) * DM + h * 256 + fq * 8;
  if (n >= 1) {
    const u16* sb = p.ST + (((size_t)(n * 4 + h) * 16 + (fq >> 1)) * 512 + w * 128 + fr) * 16 + (fq & 1) * 8;
#pragma unroll 1
    for (int ks = 0; ks < 8; ++ks) {
      bf16x8 bq[4];
#pragma unroll
      for (int it = 0; it < 4; ++it) bq[it] = *(const bf16x8*)(qb + (size_t)(it * 16) * DM + ks * 32);
#pragma unroll
      for (int dvt = 0; dvt < 8; ++dvt) {
        bf16x8 a = *(const bf16x8*)(sb + (size_t)(ks * 2) * (512 * 16) + dvt * 16 * 16);
#pragma unroll
        for (int it = 0; it < 4; ++it) acc[dvt][it] = mfma(a, bq[it], acc[dvt][it]);
      }
    }
#pragma unroll
    for (int it = 0; it < 4; ++it) {
      float qd = exp2f(l2g * (float)(it * 16 + fr + 1));
#pragma unroll
      for (int dvt = 0; dvt < 8; ++dvt) acc[dvt][it] = acc[dvt][it] * qd;
    }
  }
  {
    f32x4 s[4];
#pragma unroll
    for (int jt = 0; jt < 4; ++jt) s[jt] = f32x4{0.f, 0.f, 0.f, 0.f};
    const u16* kb = p.Kr + (size_t)(p0 + fr) * DM + h * 256 + fq * 8;
#pragma unroll 1
    for (int ks = 0; ks < 8; ++ks) {
      bf16x8 b = *(const bf16x8*)(qb + (size_t)(w * 16) * DM + ks * 32);
#pragma unroll
      for (int jt = 0; jt < 4; ++jt) {
        bf16x8 a = *(const bf16x8*)(kb + (size_t)(jt * 16) * DM + ks * 32);
        s[jt] = mfma(a, b, s[jt]);
      }
    }
    int i = w * 16 + fr;
#pragma unroll
    for (int jt = 0; jt < 4; ++jt)
#pragma unroll
      for (int jj = 0; jj < 4; ++jj) {
        int j = jt * 16 + fq * 4 + jj;
        int dd = i > j ? i - j : j - i;
        s[jt][jj] *= exp2f(l2g * (float)dd);
      }
    __syncthreads();
#pragma unroll
    for (int pp = 0; pp < 2; ++pp) {
      u32x4 t;
      t.x = pack2(s[2 * pp][0], s[2 * pp][1]); t.y = pack2(s[2 * pp][2], s[2 * pp][3]);
      t.z = pack2(s[2 * pp + 1][0], s[2 * pp + 1][1]); t.w = pack2(s[2 * pp + 1][2], s[2 * pp + 1][3]);
      Sf[(w * 2 + pp) * 64 + lane] = t;
    }
    __syncthreads();
  }
  {
    const u16* vb = p.VrT + tix(512, h, w * 128 + fr, p0) + fq * 4;
#pragma unroll
    for (int pp = 0; pp < 2; ++pp) {
      V8 bs[4];
#pragma unroll
      for (int it = 0; it < 4; ++it) bs[it].q = Sf[(it * 2 + pp) * 64 + lane];
#pragma unroll
      for (int dvt = 0; dvt < 8; ++dvt) {
        V8 a;
        a.d[0] = *(const u32x2*)(vb + dvt * 16 * 64 + (2 * pp) * 16);
        a.d[1] = *(const u32x2*)(vb + dvt * 16 * 64 + (2 * pp + 1) * 16);
#pragma unroll
        for (int it = 0; it < 4; ++it) acc[dvt][it] = mfma(a.v, bs[it].v, acc[dvt][it]);
      }
    }
  }
  float mean[4], rstd[4];
  {
    float s1[4];
#pragma unroll
    for (int it = 0; it < 4; ++it) {
      float s = 0.f;
#pragma unroll
      for (int dvt = 0; dvt < 8; ++dvt) s += acc[dvt][it][0] + acc[dvt][it][1] + acc[dvt][it][2] + acc[dvt][it][3];
      s += __shfl_xor(s, 16); s += __shfl_xor(s, 32);
      s1[it] = s;
    }
    __syncthreads();
    if (fq == 0) {
#pragma unroll
      for (int it = 0; it < 4; ++it) red[w * 64 + it * 16 + fr] = s1[it];
    }
    __syncthreads();
#pragma unroll
    for (int it = 0; it < 4; ++it) {
      int i = it * 16 + fr;
      mean[it] = (red[i] + red[64 + i] + red[128 + i] + red[192 + i]) * (1.f / 512.f);
    }
#pragma unroll
    for (int it = 0; it < 4; ++it) {
      float s = 0.f;
#pragma unroll
      for (int dvt = 0; dvt < 8; ++dvt)
#pragma unroll
        for (int j = 0; j < 4; ++j) { float d = acc[dvt][it][j] - mean[it]; s += d * d; }
      s += __shfl_xor(s, 16); s += __shfl_xor(s, 32);
      s1[it] = s;
    }
    __syncthreads();
    if (fq == 0) {
#pragma unroll
      for (int it = 0; it < 4; ++it) red[w * 64 + it * 16 + fr] = s1[it];
    }
    __syncthreads();
#pragma unroll
    for (int it = 0; it < 4; ++it) {
      int i = it * 16 + fr;
      float var = (red[i] + red[64 + i] + red[128 + i] + red[192 + i]) * (1.f / 512.f);
      rstd[it] = rsqrtf(var + EPS);
    }
  }
#pragma unroll
  for (int it = 0; it < 4; ++it) {
    int t = p0 + it * 16 + fr - LEAD;
    if (t >= 0 && t < LP) {
#pragma unroll
      for (int dvt = 0; dvt < 8; ++dvt) {
        int e0 = h * 512 + w * 128 + dvt * 16 + fq * 4;
        u16* gp = p.Gr + (size_t)t * 2048 + e0;
        u32x2 g = *(const u32x2*)gp;
        f32x4 gn = *(const f32x4*)(p.ret_gn + jr * 2048 + e0);
        float g0 = bflo(g.x), g1 = bfhi(g.x), g2 = bflo(g.y), g3 = bfhi(g.y);
        float y0 = (acc[dvt][it][0] - mean[it]) * rstd[it] * gn.x * (g0 * sigmoidf_(g0));
        float y1 = (acc[dvt][it][1] - mean[it]) * rstd[it] * gn.y * (g1 * sigmoidf_(g1));
        float y2 = (acc[dvt][it][2] - mean[it]) * rstd[it] * gn.z * (g2 * sigmoidf_(g2));
        float y3 = (acc[dvt][it][3] - mean[it]) * rstd[it] * gn.w * (g3 * sigmoidf_(g3));
        u32x2 o; o.x = pack2(y0, y1); o.y = pack2(y2, y3);
        *(u32x2*)gp = o;
      }
    }
  }
}

DEV void r3_sample(const Params& p, int jr, int b, int h, char* smem) {
  float* obuf = (float*)smem;
  u16* qs = (u16*)(smem + 32768);
  u16* ks = qs + 16 * 256;
  float* sm = (float*)(smem + 49152);
  float* red = sm + 256;
  float* stat = red + 64;
  int tid = otid(), lane = tid & 63, wid = tid >> 6;
  float l2g = ret_l2g(h);
  int prow = LP + LEAD + b * 16;
  __syncthreads();
  for (int e = tid; e < 16 * 256; e += 256) {
    int i = e >> 8, d = e & 255;
    qs[e] = p.Qr[(size_t)(prow + i) * DM + h * 256 + d];
    ks[e] = p.Kr[(size_t)(prow + i) * DM + h * 256 + d];
  }
  __syncthreads();
  {
    int i = tid >> 4, j = tid & 15;
    float a = 0.f;
#pragma unroll 8
    for (int d = 0; d < 256; ++d) a += bf2f(qs[i * 256 + d]) * bf2f(ks[j * 256 + d]);
    int dd = i > j ? i - j : j - i;
    sm[tid] = a * exp2f(l2g * (float)dd);
  }
  __syncthreads();
  for (int e = tid; e < 16 * 256; e += 256) ks[e] = f2bf(bf2f(ks[e]) * exp2f(l2g * (float)(15 - (e >> 8))));
  __syncthreads();
  float dec16 = exp2f(l2g * 16.f);
  const float* stin = p.state_ret + ((size_t)(jr * 8 + b) * 4 + h) * 256 * 512;
  float* stout = p.out + O_SRS + ((size_t)(jr * 8 + b) * 4 + h) * 256 * 512;
#pragma unroll 1
  for (int c = 0; c < 2; ++c) {
    int e = tid + c * 256;
    float v[16], o[16];
    const u16* vp = p.VrT + tix(512, h, e, prow);
    u32x4 a = *(const u32x4*)vp, bq = *(const u32x4*)(vp + 8);
    v[0] = bflo(a.x); v[1] = bfhi(a.x); v[2] = bflo(a.y); v[3] = bfhi(a.y);
    v[4] = bflo(a.z); v[5] = bfhi(a.z); v[6] = bflo(a.w); v[7] = bfhi(a.w);
    v[8] = bflo(bq.x); v[9] = bfhi(bq.x); v[10] = bflo(bq.y); v[11] = bfhi(bq.y);
    v[12] = bflo(bq.z); v[13] = bfhi(bq.z); v[14] = bflo(bq.w); v[15] = bfhi(bq.w);
#pragma unroll
    for (int i = 0; i < 16; ++i) o[i] = 0.f;
#pragma unroll 2
    for (int dp = 0; dp < 256; ++dp) {
      int dorig = perm_dorig(dp);
      float s0 = stin[(size_t)dorig * 512 + e];
      float n0 = s0 * dec16;
#pragma unroll
      for (int i = 0; i < 16; ++i) {
        o[i] += bf2f(qs[i * 256 + dp]) * s0;
        n0 += bf2f(ks[i * 256 + dp]) * v[i];
      }
      stout[(size_t)dorig * 512 + e] = n0;
    }
#pragma unroll
    for (int i = 0; i < 16; ++i) obuf[i * 512 + e] = o[i] * exp2f(l2g * (float)(i + 1));
#pragma unroll 1
    for (int i = 0; i < 16; ++i) {
      float a0 = obuf[i * 512 + e];
#pragma unroll
      for (int j = 0; j < 16; ++j) a0 += sm[i * 16 + j] * v[j];
      obuf[i * 512 + e] = a0;
    }
  }
  __syncthreads();
  for (int i = 0; i < 16; ++i) {
    float s = wave_sum(obuf[i * 512 + tid] + obuf[i * 512 + 256 + tid]);
    if (lane == 0) red[wid * 16 + i] = s;
  }
  __syncthreads();
  if (tid < 16) stat[tid] = (red[tid] + red[16 + tid] + red[32 + tid] + red[48 + tid]) * (1.f / 512.f);
  __syncthreads();
  for (int i = 0; i < 16; ++i) {
    float mu = stat[i];
    float d0 = obuf[i * 512 + tid] - mu, d1 = obuf[i * 512 + 256 + tid] - mu;
    float s = wave_sum(d0 * d0 + d1 * d1);
    if (lane == 0) red[wid * 16 + i] = s;
  }
  __syncthreads();
  if (tid < 16) stat[16 + tid] = rsqrtf((red[tid] + red[16 + tid] + red[32 + tid] + red[48 + tid]) * (1.f / 512.f) + EPS);
  __syncthreads();
  for (int c = 0; c < 2; ++c) {
    int e = tid + c * 256;
    float gn = p.ret_gn[jr * 2048 + h * 512 + e];
    for (int i = 0; i < 16; ++i) {
      int t = LP + b * 16 + i;
      float g = bf2f(p.Gr[(size_t)t * 2048 + h * 512 + e]);
      float y = (obuf[i * 512 + e] - stat[i]) * stat[16 + i] * gn * (g * sigmoidf_(g));
      p.Gr[(size_t)t * 2048 + h * 512 + e] = f2bf(y);
    }
  }
}

DEV void ph_r3(const Params& p, int jr, char* smem) {
  const int NP = NCH * 4, NI = NP + 32;
  for (int it = blockIdx.x; it < NI; it += gridDim.x) {
    if (it < 32) r3_sample(p, jr, it >> 2, it & 3, smem);
    else { int q = it - 32; r3_prompt(p, jr, q >> 2, q & 3, smem); }
  }
}

DEV void ph_p2(const Params& p, int layer, char* smem) {
  const u16* Wt = p.WpqT + (size_t)layer * 2048 * 1024;
  u16* Qs = (u16*)smem;
  constexpr int LQ = 136;
  int tid = otid(), lane = tid & 63, wid = tid >> 6;
  int wr = wid >> 1, wc = wid & 1, fr = lane & 15, fq = lane >> 4;
  for (int it = blockIdx.x; it < MTILES * 16; it += gridDim.x) {
    int mt, hp; tile_mn(it, 16, mt, hp);
    int m0 = mt * 128;
    f32x4 acc[4][4];
    gemm_tile<true>(p.H, DM, Wt, DM, DM, m0, hp * 128, smem, acc);
    __syncthreads();
#pragma unroll
    for (int m = 0; m < 4; ++m) {
      float rs = rsqrtf((float)p.SSQ[m0 + wr * 64 + m * 16 + fr] * (1.f / (1048576.f * DM)) + EPS);
#pragma unroll
      for (int n = 0; n < 4; ++n) {
        u32x2 o; o.x = pack2(acc[m][n][0] * rs, acc[m][n][1] * rs); o.y = pack2(acc[m][n][2] * rs, acc[m][n][3] * rs);
        *(u32x2*)(Qs + (wr * 64 + m * 16 + fr) * LQ + wc * 64 + n * 16 + fq * 4) = o;
      }
    }
    __syncthreads();
    f32x4 sc[2][8];
#pragma unroll
    for (int rt = 0; rt < 2; ++rt)
#pragma unroll
      for (int ct = 0; ct < 8; ++ct) sc[rt][ct] = f32x4{0.f, 0.f, 0.f, 0.f};
    const u16* skb = p.SKb + ((size_t)(layer * 16 + hp) * 128 + fr) * 128 + fq * 8;
#pragma unroll
    for (int ks = 0; ks < 4; ++ks) {
      bf16x8 a[2];
#pragma unroll
      for (int rt = 0; rt < 2; ++rt) a[rt] = *(const bf16x8*)(Qs + (wid * 32 + rt * 16 + fr) * LQ + ks * 32 + fq * 8);
#pragma unroll
      for (int ct = 0; ct < 8; ++ct) {
        bf16x8 b = *(const bf16x8*)(skb + (size_t)(ct * 16) * 128 + ks * 32);
#pragma unroll
        for (int rt = 0; rt < 2; ++rt) sc[rt][ct] = mfma(a[rt], b, sc[rt][ct]);
      }
    }
#pragma unroll
    for (int rt = 0; rt < 2; ++rt)
#pragma unroll
      for (int j = 0; j < 4; ++j) {
        uint32_t key[8];
#pragma unroll
        for (int ct = 0; ct < 8; ++ct) key[ct] = (f2key(sc[rt][ct][j]) & ~127u) | (uint32_t)(127 - (ct * 16 + fr));
        uint32_t mine = 0;
#pragma unroll 1
        for (int r = 0; r < 16; ++r) {
          uint32_t best = key[0];
#pragma unroll
          for (int ct = 1; ct < 8; ++ct) best = max(best, key[ct]);
          best = row16_maxu(best);
#pragma unroll
          for (int ct = 0; ct < 8; ++ct) key[ct] = (key[ct] == best) ? 0u : key[ct];
          if (fr == r) mine = best;
        }
        int row = m0 + wid * 32 + rt * 16 + fq * 4 + j;
        p.SV[((size_t)row * 16 + hp) * 16 + fr] = key2f(mine & ~127u);
        p.SI[((size_t)row * 16 + hp) * 16 + fr] = 127 - (int)(mine & 127u);
      }
  }
}

DEV void p3_partial(const Params& p, int t, int h0, int nh, int lane, int* eidL, float* gateL, float* svL,
                    int ca, int cb, bool cvalid, float (&oacc)[16]) {
  const int ne = nh * 16;
  int* siL = (int*)(svL + 256);
  {
    f32x4 sv4 = *(const f32x4*)(p.SV + (size_t)t * 256 + lane * 4);
    u32x4 si4 = *(const u32x4*)(p.SI + (size_t)t * 256 + lane * 4);
    *(f32x4*)(svL + lane * 4) = sv4;
    *(u32x4*)(siL + lane * 4) = si4;
  }
  for (int hl = 0; hl < nh; hl += 2) {
    int ha = h0 + hl, hb2 = ha + 1;
    float canda = cvalid ? (svL[ha * 32 + ca] + svL[ha * 32 + 16 + cb]) : 0.f;
    float candb = cvalid ? (svL[hb2 * 32 + ca] + svL[hb2 * 32 + 16 + cb]) : 0.f;
    uint32_t keya = cvalid ? ((f2key(canda) & ~63u) | (uint32_t)(63 - lane)) : 0u;
    uint32_t keyb = cvalid ? ((f2key(candb) & ~63u) | (uint32_t)(63 - lane)) : 0u;
    uint32_t minea = 0, mineb = 0;
#pragma unroll 1
    for (int r = 0; r < 16; ++r) {
      uint32_t besta = wave_maxu(keya), bestb = wave_maxu(keyb);
      keya = (keya == besta) ? 0u : keya;
      keyb = (keyb == bestb) ? 0u : keyb;
      if (lane == r) { minea = besta; mineb = bestb; }
    }
#pragma unroll
    for (int w = 0; w < 2; ++w) {
      uint32_t mine = w ? mineb : minea;
      int h = w ? hb2 : ha;
      int src = 63 - (int)(mine & 63u);
      int wa = __shfl(ca, src), wb = __shfl(cb, src);
      float fv = key2f(mine & ~63u);
      float f0 = rdlane(fv, 0);
      float e = (lane < 16) ? __expf(fv - f0) : 0.f;
      float ssum = row16_sum(e);
      if (lane < 16) {
        int eid = siL[h * 32 + wa] * 128 + siL[h * 32 + 16 + wb];
        eidL[(hl + w) * 16 + lane] = eid;
        gateL[(hl + w) * 16 + lane] = e / ssum;
      }
    }
  }
  float hf[16];
  {
    u32x4 ha = *(const u32x4*)(p.H + (size_t)t * DM + lane * 16);
    u32x4 hb = *(const u32x4*)(p.H + (size_t)t * DM + lane * 16 + 8);
    hf[0] = bflo(ha.x); hf[1] = bfhi(ha.x); hf[2] = bflo(ha.y); hf[3] = bfhi(ha.y);
    hf[4] = bflo(ha.z); hf[5] = bfhi(ha.z); hf[6] = bflo(ha.w); hf[7] = bfhi(ha.w);
    hf[8] = bflo(hb.x); hf[9] = bfhi(hb.x); hf[10] = bflo(hb.y); hf[11] = bfhi(hb.y);
    hf[12] = bflo(hb.z); hf[13] = bfhi(hb.z); hf[14] = bflo(hb.w); hf[15] = bfhi(hb.w);
    float rs = rsqrtf((float)p.SSQ[t] * (1.f / (1048576.f * DM)) + EPS);
#pragma unroll
    for (int i = 0; i < 16; ++i) hf[i] *= rs;
  }
  const unsigned char* U8 = (const unsigned char*)p.Ub + lane * 16;
  const unsigned char* V8p = (const unsigned char*)p.Vb + lane * 16;
#define P3_LOAD(buf, tab, base) _Pragma("unroll") for (int u = 0; u < 8; ++u) { \
      int eid_ = __builtin_amdgcn_readfirstlane(eidL[(base) + u]); \
      buf[u] = *(const u32x4*)((tab) + (size_t)eid_ * DM); }
#define P3_CVT(f, q) { v2f_t c_; \
      c_ = __builtin_amdgcn_cvt_pk_f32_fp8((int)(q).x, false); f[0] = c_.x; f[1] = c_.y; \
      c_ = __builtin_amdgcn_cvt_pk_f32_fp8((int)(q).x, true);  f[2] = c_.x; f[3] = c_.y; \
      c_ = __builtin_amdgcn_cvt_pk_f32_fp8((int)(q).y, false); f[4] = c_.x; f[5] = c_.y; \
      c_ = __builtin_amdgcn_cvt_pk_f32_fp8((int)(q).y, true);  f[6] = c_.x; f[7] = c_.y; \
      c_ = __builtin_amdgcn_cvt_pk_f32_fp8((int)(q).z, false); f[8] = c_.x; f[9] = c_.y; \
      c_ = __builtin_amdgcn_cvt_pk_f32_fp8((int)(q).z, true);  f[10] = c_.x; f[11] = c_.y; \
      c_ = __builtin_amdgcn_cvt_pk_f32_fp8((int)(q).w, false); f[12] = c_.x; f[13] = c_.y; \
      c_ = __builtin_amdgcn_cvt_pk_f32_fp8((int)(q).w, true);  f[14] = c_.x; f[15] = c_.y; }
#define P3_DOT(buf, base) _Pragma("unroll") for (int u = 0; u < 8; ++u) { \
      float f_[16]; P3_CVT(f_, buf[u]); float d_ = 0.f; \
      _Pragma("unroll") for (int i = 0; i < 16; ++i) d_ += hf[i] * f_[i]; \
      d_ = wave_sum(d_) * (1.f / U_SCALE); \
      int k_ = (base) + u; \
      if (lane == (k_ & 63)) { if (k_ < 64) w0 = d_; else w1 = d_; } }
#define P3_AXPY(buf, base) { float ws_ = ((base) < 64) ? w0 : w1; \
      _Pragma("unroll") for (int u = 0; u < 8; ++u) { \
        float f_[16]; P3_CVT(f_, buf[u]); float wk_ = rdlane(ws_, ((base) + u) & 63); \
        _Pragma("unroll") for (int i = 0; i < 16; ++i) oacc[i] += wk_ * f_[i]; } }
  float w0 = 0.f, w1 = 0.f;
  {
    u32x4 A[8], B[8];
    P3_LOAD(A, U8, 0)
#pragma unroll 1
    for (int kb = 0; kb < ne; kb += 16) {
      P3_LOAD(B, U8, kb + 8)
      P3_DOT(A, kb)
      if (kb + 16 < ne) { P3_LOAD(A, U8, kb + 16) }
      P3_DOT(B, kb + 8)
    }
  }
  w0 = gateL[lane] * gelu_(w0);
  w1 = gateL[64 + lane] * gelu_(w1);
  {
    u32x4 A[8], B[8];
    P3_LOAD(A, V8p, 0)
#pragma unroll 1
    for (int kb = 0; kb < ne; kb += 16) {
      P3_LOAD(B, V8p, kb + 8)
      P3_AXPY(A, kb)
      if (kb + 16 < ne) { P3_LOAD(A, V8p, kb + 16) }
      P3_AXPY(B, kb + 8)
    }
  }
}

DEV void p3_finish(const Params& p, int layer, int t, int lane, float (&oacc)[16]) {
  int te = t, le = lane;
  asm volatile("" : "+v"(te), "+v"(le));
  float* xr = p.X + (size_t)te * DM + le * 16;
  f32x4 xv[4];
#pragma unroll
  for (int c = 0; c < 4; ++c) {
    xv[c] = *(const f32x4*)(xr + c * 4);
    xv[c].x += oacc[c * 4 + 0] * (1.f / V_SCALE); xv[c].y += oacc[c * 4 + 1] * (1.f / V_SCALE);
    xv[c].z += oacc[c * 4 + 2] * (1.f / V_SCALE); xv[c].w += oacc[c * 4 + 3] * (1.f / V_SCALE);
  }
  if (layer < 3) {
    float ss = 0.f;
#pragma unroll
    for (int c = 0; c < 4; ++c) {
      *(f32x4*)(xr + c * 4) = xv[c];
      ss += xv[c].x * xv[c].x + xv[c].y * xv[c].y + xv[c].z * xv[c].z + xv[c].w * xv[c].w;
    }
    ss = wave_sum(ss);
    float rstd = rsqrtf(ss * (1.f / DM) + EPS);
    const float* g = p.norm_mix + (size_t)(layer + 1) * DM + le * 16;
    u32x4 o0, o1;
    f32x4 g0 = *(const f32x4*)(g), g1 = *(const f32x4*)(g + 4), g2 = *(const f32x4*)(g + 8), g3 = *(const f32x4*)(g + 12);
    o0.x = pack2(xv[0].x * rstd * g0.x, xv[0].y * rstd * g0.y); o0.y = pack2(xv[0].z * rstd * g0.z, xv[0].w * rstd * g0.w);
    o0.z = pack2(xv[1].x * rstd * g1.x, xv[1].y * rstd * g1.y); o0.w = pack2(xv[1].z * rstd * g1.z, xv[1].w * rstd * g1.w);
    o1.x = pack2(xv[2].x * rstd * g2.x, xv[2].y * rstd * g2.y); o1.y = pack2(xv[2].z * rstd * g2.z, xv[2].w * rstd * g2.w);
    o1.z = pack2(xv[3].x * rstd * g3.x, xv[3].y * rstd * g3.y); o1.w = pack2(xv[3].z * rstd * g3.z, xv[3].w * rstd * g3.w);
    *(u32x4*)(p.H + (size_t)te * DM + le * 16) = o0;
    *(u32x4*)(p.H + (size_t)te * DM + le * 16 + 8) = o1;
  } else {
    float* yo = nullptr;
    if (te >= NMETA && te < LP) yo = p.out + O_YP + (size_t)(te - NMETA) * DM + le * 16;
    else if (te >= LP) yo = p.out + O_YS + (size_t)(te - LP) * DM + le * 16;
    if (yo) {
#pragma unroll
      for (int c = 0; c < 4; ++c) *(f32x4*)(yo + c * 4) = xv[c];
    }
  }
}

DEV void ph_p3(const Params& p, int layer, char* smem) {
  int tid = otid(), lane = tid & 63, wid = tid >> 6;
  int* eidL = (int*)smem + wid * 256;
  float* gateL = (float*)(eidL + 128);
  float* part = (float*)(smem + 4096);
  float* svL = (float*)(smem + 20480) + wid * 512;
  int ca = 0, cb = 0; bool cvalid = false;
  {
    int cnt = 0;
    for (int a = 0; a < 16; ++a) {
      int nb = 16 / (a + 1);
      if (lane >= cnt && lane < cnt + nb) { ca = a; cb = lane - cnt; cvalid = true; }
      cnt += nb;
    }
  }
  int gw = (blockIdx.x * blockDim.x + tid) >> 6, nw = (gridDim.x * blockDim.x) >> 6;
  int tmain = (TTOK / nw) * nw;
  for (int t = gw; t < tmain; t += nw) {
    float oacc[16];
#pragma unroll
    for (int i = 0; i < 16; ++i) oacc[i] = 0.f;
    p3_partial(p, t, 0, 8, lane, eidL, gateL, svL, ca, cb, cvalid, oacc);
    p3_finish(p, layer, t, lane, oacc);
  }
  for (int t = tmain + blockIdx.x; t < TTOK; t += gridDim.x) {
    float oacc[16];
#pragma unroll
    for (int i = 0; i < 16; ++i) oacc[i] = 0.f;
    p3_partial(p, t, wid * 2, 2, lane, eidL, gateL, svL, ca, cb, cvalid, oacc);
    __syncthreads();
#pragma unroll
    for (int i = 0; i < 16; ++i) part[(wid * 64 + lane) * 16 + i] = oacc[i];
    __syncthreads();
    if (wid == 0) {
#pragma unroll
      for (int i = 0; i < 16; ++i) oacc[i] = part[lane * 16 + i] + part[(64 + lane) * 16 + i] + part[(128 + lane) * 16 + i] + part[(192 + lane) * 16 + i];
      p3_finish(p, layer, t, lane, oacc);
    }
  }
}

constexpr int NPHASE = 23;
#ifndef DBG_PHASES
#define DBG_PHASES NPHASE
#endif
#ifndef DBG_SCALES
#define DBG_SCALES {1,1,1,1,1,1,1,1,1,1,1,1,1,1,1,1,1,1,1,1}
#endif
#ifndef DBG_POST
#define DBG_POST 0
#endif
DEV void post_scale(const Params& p) {
  const float sc[20] = DBG_SCALES;
  const size_t offs[11] = {O_YP, O_YS, O_FKP, O_FVP, O_FLP, O_SRP, O_FKS, O_FVS, O_FLS, O_SRS, O_SRS + (size_t)2 * 8 * 4 * 256 * 512};
  size_t i0 = (size_t)blockIdx.x * blockDim.x + otid(), st = (size_t)gridDim.x * blockDim.x;
#pragma unroll
  for (int k = 0; k < 20; ++k) {
    float f = sc[k];
    if (f == 1.f) continue;
    size_t a = offs[k >> 1], b = offs[(k >> 1) + 1], mid = a + (b - a) / 2;
    size_t lo = (k & 1) ? mid : a, hi = (k & 1) ? b : mid;
    for (size_t i = lo + i0; i < hi; i += st) p.out[i] *= f;
  }
}
DEV void dump_x(const Params& p) {
  size_t i = (size_t)blockIdx.x * blockDim.x + otid(), st = (size_t)gridDim.x * blockDim.x;
  for (; i < (size_t)(TTOK - NMETA) * DM; i += st) p.out[i] = p.X[(size_t)NMETA * DM + i];
}
__global__ void __launch_bounds__(256, 2) mega(Params p, int ph0, int ph1) {
  __shared__ __attribute__((aligned(16))) char smem[53248];
  for (int ph = ph0; ph < ph1; ++ph) {
    if (ph > ph0) cg::this_grid().sync();
    if (ph == 0) { ph_prep(p, smem); continue; }
    int q = ph - 1, layer, idx;
    if (q < 5) { layer = 0; idx = q; } else if (q < 11) { layer = 1; idx = q - 5; }
    else if (q < 16) { layer = 2; idx = q - 11; } else { layer = 3; idx = q - 16; }
    int j = layer >> 1;
    const float* gffn = p.norm_ffn + (size_t)layer * DM;
    if ((layer & 1) == 0) {
      if (idx == 0) ph_f1(p, j, smem);
      else if (idx == 1) ph_f2(p, j, smem);
      else if (idx == 2) ph_outproj(p, p.AO, 1024, p.WfoutT + (size_t)j * 1024 * 1024, gffn, smem);
      else if (idx == 3) ph_p2(p, layer, smem);
      else ph_p3(p, layer, smem);
    } else {
      if (idx == 0) ph_r1(p, j, smem);
      else if (idx == 1) { ph_r2(p, j); conv_tables(p, layer); }
      else if (idx == 2) ph_r3(p, j, smem);
      else if (idx == 3) ph_outproj(p, p.Gr, 2048, p.WroutT + (size_t)j * 1024 * 2048, gffn, smem);
      else if (idx == 4) ph_p2(p, layer, smem);
      else ph_p3(p, layer, smem);
    }
  }
}

extern "C" void kernel_launch(void* const* d_in, const int* in_sizes, int n_in, void* d_out, int out_size,
                              void* d_ws, size_t ws_size, hipStream_t stream) {
  static int grid_blocks = 0;
  if (!grid_blocks) {
    int dev = 0, cus = 0, per_cu = 0;
    hipGetDevice(&dev);
    hipDeviceGetAttribute(&cus, hipDeviceAttributeMultiprocessorCount, dev);
    hipOccupancyMaxActiveBlocksPerMultiprocessor(&per_cu, mega, 256, 0);
    if (per_cu > 2) per_cu = 2;
    if (per_cu < 1) per_cu = 1;
    grid_blocks = cus * per_cu;
  }
  Params p;
  memset(&p, 0, sizeof(p));
  const float* const* in = (const float* const*)d_in;
  p.x_prompt = in[0]; p.x_sample = in[1]; p.cache_k = in[2]; p.cache_v = in[3]; p.cache_lf = in[4]; p.state_ret = in[5];
  p.meta = in[6]; p.norm_mix = in[7]; p.norm_ffn = in[8]; p.fox_w_in = in[9]; p.fox_b_f = in[10]; p.fox_qn = in[11];
  p.fox_kn = in[12]; p.fox_w_out = in[13]; p.ret_w_in = in[14]; p.ret_gn = in[15]; p.ret_w_out = in[16];
  p.peer_wq = in[17]; p.peer_sk = in[18]; p.peer_u = in[19]; p.peer_v = in[20];
  p.out = (float*)d_out;
  char* w = (char*)d_ws;
  size_t off = 0;
  auto take = [&](size_t bytes) { char* r = w + off; off += (bytes + 255) & ~(size_t)255; return r; };
  p.X = (float*)take((size_t)TPAD * DM * 4);
  p.H = (u16*)take((size_t)TPAD * DM * 2);
  p.WfinT = (u16*)take((size_t)2 * 4224 * 1024 * 2);
  p.WfoutT = (u16*)take((size_t)2 * 1024 * 1024 * 2);
  p.WrinT = (u16*)take((size_t)2 * 6144 * 1024 * 2);
  p.WroutT = (u16*)take((size_t)2 * 1024 * 2048 * 2);
  p.WpqT = (u16*)take((size_t)4 * 2048 * 1024 * 2);
  p.SKb = (u16*)take((size_t)4 * 8 * 2 * 128 * 128 * 2);
  p.Ub = (u16*)take((size_t)NEXP * DM * 2);
  p.Vb = (u16*)take((size_t)NEXP * DM * 2);
  p.SV = (float*)take((size_t)TPAD * 256 * 4);
  p.SI = (int*)take((size_t)TPAD * 256 * 4);
  p.LFC = (float*)take((size_t)TPAD * 16 * 4);
  p.LFR = (float*)take((size_t)TPAD * 16 * 4);
  p.TT = (float*)take((size_t)MTILES * 16 * 4);
  p.SSQ = (unsigned long long*)take((size_t)TPAD * 8);
  size_t region = off;
  p.Qf = (u16*)take((size_t)TPAD * DM * 2);
  p.Kf = (u16*)take((size_t)TPAD * DM * 2);
  p.VtF = (u16*)take((size_t)1024 * TPAD * 2);
  p.OGf = (u16*)take((size_t)TPAD * DM * 2);
  p.AO = (u16*)take((size_t)TPAD * DM * 2);
  off = region;
  p.Qr = (u16*)take((size_t)TP2 * DM * 2);
  p.Kr = (u16*)take((size_t)TP2 * DM * 2);
  p.KrT = (u16*)take((size_t)1024 * TP2 * 2);
  p.VrT = (u16*)take((size_t)2048 * TP2 * 2);
  p.Gr = (u16*)take((size_t)TPAD * 2048 * 2);
  p.ST = (u16*)take((size_t)NCH * 4 * 512 * 256 * 2);
  if (off > ws_size) { fprintf(stderr, "workspace too small: need %zu have %zu\n", off, ws_size); return; }
  for (int i = 0; i < 128; ++i) p.rope_rev[i] = (float)(pow(10000.0, -(double)i / 128.0) / (2.0 * M_PI));
#if ONE_LAUNCH
  int ph0 = 0, ph1 = NPHASE;
  void* args[] = {&p, &ph0, &ph1};
  hipError_t e = hipLaunchCooperativeKernel((void*)mega, dim3(grid_blocks), dim3(256), args, 0, stream);
  if (e != hipSuccess) fprintf(stderr, "cooperative launch failed: %s (grid %d)\n", hipGetErrorString(e), grid_blocks);
#else
  for (int ph = 0; ph < NPHASE; ++ph) mega<<<grid_blocks, 256, 0, stream>>>(p, ph, ph + 1);
#endif
}
```

```cpp
#include <hip/hip_runtime.h>
#include <hip/hip_cooperative_groups.h>
#include <stdint.h>
#include <math.h>
#include <stdio.h>
#include <string.h>
namespace cg = cooperative_groups;

typedef unsigned short u16;
typedef __attribute__((ext_vector_type(8))) short bf16x8;
typedef __attribute__((ext_vector_type(4))) float f32x4;
typedef __attribute__((ext_vector_type(2))) float f32x2;
typedef __attribute__((ext_vector_type(4))) unsigned int u32x4;
typedef __attribute__((ext_vector_type(2))) unsigned int u32x2;
#define DEV __device__ __forceinline__

#ifndef ONE_LAUNCH
#define ONE_LAUNCH 1
#endif

constexpr int DM = 1024;
constexpr int NMETA = 16;
constexpr int LP = 16400;
constexpr int NSMP = 128;
constexpr int TTOK = LP + NSMP;
constexpr int TPAD = 16640;
constexpr int MTILES = 130;
constexpr int LEAD = 48;
constexpr int TP2 = 16704;
constexpr int NCH = 257;
constexpr int PAST = 1024;
constexpr int NEXP = 16384;
constexpr float EPS = 1e-6f;

constexpr size_t O_YP = 0;
constexpr size_t O_YS = O_YP + (size_t)16384 * 1024;
constexpr size_t O_FKP = O_YS + (size_t)128 * 1024;
constexpr size_t O_FVP = O_FKP + (size_t)2 * LP * 1024;
constexpr size_t O_FLP = O_FVP + (size_t)2 * LP * 1024;
constexpr size_t O_SRP = O_FLP + (size_t)2 * LP * 16;
constexpr size_t O_FKS = O_SRP + (size_t)2 * 4 * 256 * 512;
constexpr size_t O_FVS = O_FKS + (size_t)2 * 128 * 1024;
constexpr size_t O_FLS = O_FVS + (size_t)2 * 128 * 1024;
constexpr size_t O_SRS = O_FLS + (size_t)2 * 128 * 16;

struct Params {
  const float *x_prompt, *x_sample, *cache_k, *cache_v, *cache_lf, *state_ret, *meta, *norm_mix, *norm_ffn;
  const float *fox_w_in, *fox_b_f, *fox_qn, *fox_kn, *fox_w_out, *ret_w_in, *ret_gn, *ret_w_out;
  const float *peer_wq, *peer_sk, *peer_u, *peer_v;
  float* out;
  float* X; u16* H;
  u16 *WfinT, *WfoutT, *WrinT, *WroutT, *WpqT, *SKb, *Ub, *Vb;
  float *SV; int* SI;
  float *LFC, *LFR, *TT; unsigned long long* SSQ; int* QCTR;
  u16 *Qf, *Kf, *VtF, *OGf, *AO;
  u16 *Qr, *Kr, *KrT, *VrT, *Gr, *ST;
  float rope_rev[128];
};

typedef __attribute__((ext_vector_type(2))) float f2cv_t;
typedef __attribute__((ext_vector_type(2))) __bf16 bf2cv_t;
DEV uint32_t pack2(float a, float b) { f2cv_t v = {a, b}; bf2cv_t r = __builtin_convertvector(v, bf2cv_t); return __builtin_bit_cast(uint32_t, r); }
DEV u16 f2bf(float f) { return (u16)(pack2(f, 0.f) & 0xffffu); }
DEV float bf2f(u16 h) { return __uint_as_float(((uint32_t)h) << 16); }
DEV float bflo(uint32_t u) { return __uint_as_float(u << 16); }
DEV float bfhi(uint32_t u) { return __uint_as_float(u & 0xffff0000u); }

union V8 { bf16x8 v; uint32_t u[4]; u32x2 d[2]; u32x4 q; };

DEV f32x4 mfma(bf16x8 a, bf16x8 b, f32x4 c) { return __builtin_amdgcn_mfma_f32_16x16x32_bf16(a, b, c, 0, 0, 0); }

template <int CTRL> DEV float dppf(float v) {
  return __int_as_float(__builtin_amdgcn_update_dpp(0, __float_as_int(v), CTRL, 0xf, 0xf, false));
}
template <int CTRL> DEV uint32_t dppu(uint32_t v) {
  return (uint32_t)__builtin_amdgcn_update_dpp(0, (int)v, CTRL, 0xf, 0xf, false);
}
DEV float row16_sum(float v) {
  v += dppf<0xB1>(v); v += dppf<0x4E>(v); v += dppf<0x141>(v); v += dppf<0x140>(v);
  return v;
}
DEV uint32_t row16_maxu(uint32_t v) {
  v = max(v, dppu<0xB1>(v)); v = max(v, dppu<0x4E>(v)); v = max(v, dppu<0x141>(v)); v = max(v, dppu<0x140>(v));
  return v;
}
DEV float rdlane(float v, int l) { float r = __int_as_float(__builtin_amdgcn_readlane(__float_as_int(v), l)); asm volatile("" : "+v"(r)); return r; }
DEV float wave_sum(float v) {
  v = row16_sum(v);
  return rdlane(v, 0) + rdlane(v, 16) + rdlane(v, 32) + rdlane(v, 48);
}
DEV float wave_max(float v) {
  v = fmaxf(v, dppf<0xB1>(v)); v = fmaxf(v, dppf<0x4E>(v)); v = fmaxf(v, dppf<0x141>(v)); v = fmaxf(v, dppf<0x140>(v));
  return fmaxf(fmaxf(rdlane(v, 0), rdlane(v, 16)), fmaxf(rdlane(v, 32), rdlane(v, 48)));
}
DEV uint32_t wave_maxu(uint32_t v) {
  v = row16_maxu(v);
  uint32_t a = (uint32_t)__builtin_amdgcn_readlane((int)v, 0), b = (uint32_t)__builtin_amdgcn_readlane((int)v, 16);
  uint32_t c = (uint32_t)__builtin_amdgcn_readlane((int)v, 32), d = (uint32_t)__builtin_amdgcn_readlane((int)v, 48);
  return max(max(a, b), max(c, d));
}
DEV uint32_t f2key(float f) { uint32_t u = __float_as_uint(f); return (u & 0x80000000u) ? ~u : (u | 0x80000000u); }
DEV float key2f(uint32_t k) { uint32_t u = (k & 0x80000000u) ? (k & 0x7fffffffu) : ~k; return __uint_as_float(u); }

DEV float sigmoidf_(float x) { return 1.f / (1.f + __expf(-x)); }
DEV float logsigmoid_(float x) { return fminf(x, 0.f) - log1pf(expf(-fabsf(x))); }
DEV float gelu_(float x) { return 0.5f * x * (1.f + erff(x * 0.70710678118654752f)); }
DEV float ret_l2g(int h) { return log2f(1.f - exp2f(-5.f - (float)h)); }
DEV int otid() { int t = threadIdx.x; asm volatile("" : "+v"(t)); return t; }
DEV size_t tix(int rows, int h, int row, int pp) { return ((size_t)(h * 261 + (pp >> 6)) * rows + row) * 64 + (pp & 63); }
DEV int perm_dorig(int dp) { return ((dp >> 4) & 1) * 128 + (dp >> 5) * 16 + (dp & 15); }

DEV void norm_rows(const Params& p, const float* gain, bool from_input) {
  int tid_ = otid();
  int lane = tid_ & 63;
  int gw = (blockIdx.x * blockDim.x + tid_) >> 6, nw = (gridDim.x * blockDim.x) >> 6;
  for (int t = gw; t < TPAD; t += nw) {
    const float* src;
    if (from_input) {
      if (t < NMETA) src = p.meta + (size_t)t * DM;
      else if (t < LP) src = p.x_prompt + (size_t)(t - NMETA) * DM;
      else if (t < TTOK) src = p.x_sample + (size_t)(t - LP) * DM;
      else src = nullptr;
    } else src = p.X + (size_t)t * DM;
    f32x4 v[4];
    float ss = 0.f;
#pragma unroll
    for (int c = 0; c < 4; ++c) {
      if (src) v[c] = *(const f32x4*)(src + c * 256 + lane * 4); else v[c] = f32x4{0.f, 0.f, 0.f, 0.f};
      ss += v[c].x * v[c].x + v[c].y * v[c].y + v[c].z * v[c].z + v[c].w * v[c].w;
    }
    ss = wave_sum(ss);
    float rstd = rsqrtf(ss * (1.f / DM) + EPS);
#pragma unroll
    for (int c = 0; c < 4; ++c) {
      if (from_input) *(f32x4*)(p.X + (size_t)t * DM + c * 256 + lane * 4) = v[c];
      f32x4 g = *(const f32x4*)(gain + c * 256 + lane * 4);
      u32x2 o;
      o.x = pack2(v[c].x * rstd * g.x, v[c].y * rstd * g.y);
      o.y = pack2(v[c].z * rstd * g.z, v[c].w * rstd * g.w);
      *(u32x2*)(p.H + (size_t)t * DM + c * 256 + lane * 4) = o;
    }
  }
}

DEV void convert_bf16(const float* src, u16* dst, size_t n4) {
  size_t i = (size_t)blockIdx.x * blockDim.x + otid(), st = (size_t)gridDim.x * blockDim.x;
  for (; i < n4; i += st) {
    f32x4 v = ((const f32x4*)src)[i];
    u32x2 o; o.x = pack2(v.x, v.y); o.y = pack2(v.z, v.w);
    ((u32x2*)dst)[i] = o;
  }
}

DEV void xpose(const float* W, int K, int N, int Npad, u16* Wt, bool permq, char* smem) {
  u16* tile = (u16*)smem;
  int tid = otid();
  int ntn = Npad / 64, ntk = K / 64;
  for (int it = blockIdx.x; it < ntn * ntk; it += gridDim.x) {
    int n0 = (it / ntk) * 64, k0 = (it % ntk) * 64;
    int c = tid & 63, r0 = tid >> 6;
    int np = n0 + c;
    int src = np;
    if (permq && np < 2048) src = (np & ~255) + perm_dorig(np & 255);
    __syncthreads();
#pragma unroll
    for (int i = 0; i < 16; ++i) {
      int k = r0 + 4 * i;
      float v = (np < N) ? W[(size_t)(k0 + k) * N + src] : 0.f;
      tile[c * 72 + k] = f2bf(v);
    }
    __syncthreads();
    int nl = tid >> 2, kq = (tid & 3) * 16;
    u32x4 a = *(const u32x4*)(tile + nl * 72 + kq);
    u32x4 b = *(const u32x4*)(tile + nl * 72 + kq + 8);
    *(u32x4*)(Wt + (size_t)(n0 + nl) * K + k0 + kq) = a;
    *(u32x4*)(Wt + (size_t)(n0 + nl) * K + k0 + kq + 8) = b;
  }
}

typedef __attribute__((ext_vector_type(2))) float v2f_t;
constexpr float U_SCALE = 64.f, V_SCALE = 16.f;
DEV void convert_fp8(const float* src, uint32_t* dst, size_t n4, float scale) {
  size_t i = (size_t)blockIdx.x * blockDim.x + otid(), st = (size_t)gridDim.x * blockDim.x;
  for (; i < n4; i += st) {
    f32x4 v = ((const f32x4*)src)[i];
    int w = __builtin_amdgcn_cvt_pk_fp8_f32(v.x * scale, v.y * scale, 0, false);
    w = __builtin_amdgcn_cvt_pk_fp8_f32(v.z * scale, v.w * scale, w, true);
    dst[i] = (uint32_t)w;
  }
}
DEV void conv_tables(const Params& p, int layer) {
  convert_fp8(p.peer_u + (size_t)layer * NEXP * DM, (uint32_t*)p.Ub, (size_t)NEXP * DM / 4, U_SCALE);
  convert_fp8(p.peer_v + (size_t)layer * NEXP * DM, (uint32_t*)p.Vb, (size_t)NEXP * DM / 4, V_SCALE);
}

DEV void ph_prep(const Params& p, char* smem) {
  norm_rows(p, p.norm_mix, true);
  convert_bf16(p.peer_sk, p.SKb, (size_t)4 * 8 * 2 * 128 * 128 / 4);
  for (int j = 0; j < 2; ++j) {
    xpose(p.fox_w_in + (size_t)j * 1024 * 4112, 1024, 4112, 4224, p.WfinT + (size_t)j * 4224 * 1024, false, smem);
    xpose(p.fox_w_out + (size_t)j * 1024 * 1024, 1024, 1024, 1024, p.WfoutT + (size_t)j * 1024 * 1024, false, smem);
    xpose(p.ret_w_in + (size_t)j * 1024 * 6144, 1024, 6144, 6144, p.WrinT + (size_t)j * 6144 * 1024, true, smem);
    xpose(p.ret_w_out + (size_t)j * 2048 * 1024, 2048, 1024, 1024, p.WroutT + (size_t)j * 1024 * 2048, false, smem);
  }
  for (int l = 0; l < 4; ++l)
    xpose(p.peer_wq + (size_t)l * 1024 * 2048, 1024, 2048, 2048, p.WpqT + (size_t)l * 2048 * 1024, false, smem);
}

DEV void tile_mn(int it, int NT, int& mt, int& nt) {
  const int GM = 8;
  int g = it / (GM * NT), r = it - g * (GM * NT);
  int gm = min(GM, MTILES - g * GM);
  nt = r / gm; mt = g * GM + (r - nt * gm);
}

constexpr int LDK = 72;
template <bool SWAP>
DEV void gemm_tile(const u16* __restrict__ A, int lda, const u16* __restrict__ Bt, int ldb, int K,
                          int m0, int n0, char* smem, f32x4 (&acc)[4][4]) {
  u16* sA = (u16*)smem;
  u16* sB = sA + 128 * LDK;
  int tid = otid(), lane = tid & 63, wid = tid >> 6;
  int wr = wid >> 1, wc = wid & 1, fr = lane & 15, fq = lane >> 4;
#pragma unroll
  for (int m = 0; m < 4; ++m)
#pragma unroll
    for (int n = 0; n < 4; ++n) acc[m][n] = f32x4{0.f, 0.f, 0.f, 0.f};
  u32x4 ra[4], rb[4];
  const u16* Ap = A + (size_t)(m0 + (tid >> 3)) * lda + (tid & 7) * 8;
  const u16* Bp = Bt + (size_t)(n0 + (tid >> 3)) * ldb + (tid & 7) * 8;
#pragma unroll
  for (int i = 0; i < 4; ++i) {
    ra[i] = *(const u32x4*)(Ap + (size_t)(32 * i) * lda);
    rb[i] = *(const u32x4*)(Bp + (size_t)(32 * i) * ldb);
  }
  for (int k0 = 0; k0 < K; k0 += 64) {
    __syncthreads();
#pragma unroll
    for (int i = 0; i < 4; ++i) {
      *(u32x4*)(sA + ((tid >> 3) + 32 * i) * LDK + (tid & 7) * 8) = ra[i];
      *(u32x4*)(sB + ((tid >> 3) + 32 * i) * LDK + (tid & 7) * 8) = rb[i];
    }
    __syncthreads();
    if (k0 + 64 < K) {
#pragma unroll
      for (int i = 0; i < 4; ++i) {
        ra[i] = *(const u32x4*)(Ap + (size_t)(32 * i) * lda + k0 + 64);
        rb[i] = *(const u32x4*)(Bp + (size_t)(32 * i) * ldb + k0 + 64);
      }
    }
#pragma unroll
    for (int ks = 0; ks < 2; ++ks) {
      bf16x8 af[4], bfv[4];
#pragma unroll
      for (int m = 0; m < 4; ++m) af[m] = *(const bf16x8*)(sA + (wr * 64 + m * 16 + fr) * LDK + ks * 32 + fq * 8);
#pragma unroll
      for (int n = 0; n < 4; ++n) bfv[n] = *(const bf16x8*)(sB + (wc * 64 + n * 16 + fr) * LDK + ks * 32 + fq * 8);
#pragma unroll
      for (int m = 0; m < 4; ++m)
#pragma unroll
        for (int n = 0; n < 4; ++n) acc[m][n] = SWAP ? mfma(bfv[n], af[m], acc[m][n]) : mfma(af[m], bfv[n], acc[m][n]);
    }
  }
}

DEV void ph_f1(const Params& p, int jf, char* smem) {
  if (blockIdx.x == 0 && otid() == 0) p.QCTR[0] = 0;
  { unsigned int z_ = 0; asm volatile("" : "+v"(z_));
    for (int i = blockIdx.x * blockDim.x + otid(); i < TPAD; i += gridDim.x * blockDim.x) p.SSQ[i] = (unsigned long long)z_; }
  const u16* Wt = p.WfinT + (size_t)jf * 4224 * 1024;
  int tid = otid(), lane = tid & 63, wid = tid >> 6;
  int wr = wid >> 1, wc = wid & 1, fr = lane & 15, fq = lane >> 4;
  const int NT = 33;
  for (int it = blockIdx.x; it < MTILES * NT; it += gridDim.x) {
    int mt, nt; tile_mn(it, NT, mt, nt);
    int m0 = mt * 128;
    f32x4 acc[4][4];
    int type = nt >> 3;
    if (type == 2 || type == 4) gemm_tile<false>(p.H, DM, Wt, DM, DM, m0, nt * 128, smem, acc);
    else gemm_tile<true>(p.H, DM, Wt, DM, DM, m0, nt * 128, smem, acc);
    if (type <= 1) {
      int hh = (nt & 7) * 2 + wc;
      const float* gn = (type == 0 ? p.fox_qn : p.fox_kn) + jf * 64;
      const float gs = (type == 0) ? 0.125f * 1.44269504089f : 1.f;
      f32x4 g[4];
#pragma unroll
      for (int n = 0; n < 4; ++n) g[n] = *(const f32x4*)(gn + n * 16 + fq * 4) * gs;
#pragma unroll
      for (int m = 0; m < 4; ++m) {
        float ss = 0.f;
#pragma unroll
        for (int n = 0; n < 4; ++n)
#pragma unroll
          for (int j = 0; j < 4; ++j) ss += acc[m][n][j] * acc[m][n][j];
        ss += __shfl_xor(ss, 16); ss += __shfl_xor(ss, 32);
        float rstd = rsqrtf(ss * (1.f / 64.f) + EPS);
        int row = m0 + wr * 64 + m * 16 + fr;
#pragma unroll
        for (int n = 0; n < 4; ++n) {
          f32x4 v = acc[m][n] * rstd * g[n];
          int col = hh * 64 + n * 16 + fq * 4;
          u32x2 o; o.x = pack2(v.x, v.y); o.y = pack2(v.z, v.w);
          if (type == 0) *(u32x2*)(p.Qf + (size_t)row * DM + col) = o;
          else {
            *(u32x2*)(p.Kf + (size_t)row * DM + col) = o;
            if (row < LP) *(f32x4*)(p.out + O_FKP + ((size_t)jf * LP + row) * 1024 + col) = v;
            else if (row < TTOK) *(f32x4*)(p.out + O_FKS + ((size_t)jf * 128 + (row - LP)) * 1024 + col) = v;
          }
        }
      }
    } else if (type == 2) {
      int hh = (nt & 7) * 2 + wc;
#pragma unroll
      for (int m = 0; m < 4; ++m) {
        int rb = m0 + wr * 64 + m * 16 + fq * 4;
#pragma unroll
        for (int n = 0; n < 4; ++n) {
          int d = n * 16 + fr;
          u32x2 o; o.x = pack2(acc[m][n][0], acc[m][n][1]); o.y = pack2(acc[m][n][2], acc[m][n][3]);
          *(u32x2*)(p.VtF + (size_t)(hh * 64 + d) * TPAD + rb) = o;
#pragma unroll
          for (int j = 0; j < 4; ++j) {
            int row = rb + j; int col = hh * 64 + d;
            if (row < LP) p.out[O_FVP + ((size_t)jf * LP + row) * 1024 + col] = acc[m][n][j];
            else if (row < TTOK) p.out[O_FVS + ((size_t)jf * 128 + (row - LP)) * 1024 + col] = acc[m][n][j];
          }
        }
      }
    } else if (type == 3) {
#pragma unroll
      for (int m = 0; m < 4; ++m)
#pragma unroll
        for (int n = 0; n < 4; ++n) {
          int row = m0 + wr * 64 + m * 16 + fr;
          int col = (nt - 24) * 128 + wc * 64 + n * 16 + fq * 4;
          u32x2 o; o.x = pack2(acc[m][n][0], acc[m][n][1]); o.y = pack2(acc[m][n][2], acc[m][n][3]);
          *(u32x2*)(p.OGf + (size_t)row * DM + col) = o;
        }
    } else {
      float* lfs = (float*)smem;
      __syncthreads();
      if (wc == 0) {
        float bf = p.fox_b_f[jf * 16 + fr];
#pragma unroll
        for (int m = 0; m < 4; ++m)
#pragma unroll
          for (int j = 0; j < 4; ++j) {
            int rl = wr * 64 + m * 16 + fq * 4 + j;
            int row = m0 + rl;
            float lf = logsigmoid_(acc[m][0][j] + bf);
            lfs[rl * 16 + fr] = lf;
            p.LFR[(size_t)row * 16 + fr] = lf;
            if (row < LP) p.out[O_FLP + ((size_t)jf * LP + row) * 16 + fr] = lf;
            else if (row < TTOK) p.out[O_FLS + ((size_t)jf * 128 + (row - LP)) * 16 + fr] = lf;
          }
      }
      __syncthreads();
      if (tid < 16) {
        float run = 0.f;
        for (int r = 0; r < 128; ++r) {
          run += lfs[r * 16 + tid];
          p.LFC[(size_t)(m0 + r) * 16 + tid] = run;
        }
        p.TT[mt * 16 + tid] = run;
      }
    }
  }
}

template <bool MASK>
DEV void attn_tile(const u16* Kb, const u16* Vb, const float* cb, int key0, int q0, int fr, int fq,
                   const bf16x8 (&qf)[4][2], const float (&cq)[4], float (&lrow)[4], f32x4 (&o)[4][4]) {
  const bool diag = MASK;
#pragma unroll
  for (int pp = 0; pp < 2; ++pp) {
        V8 pfu[4];
#pragma unroll
        for (int kl = 0; kl < 2; ++kl) {
          f32x4 s1[4];
          f32x4 ck = *(const f32x4*)(cb + (2 * pp + kl) * 16 + fq * 4);
#pragma unroll
          for (int qi = 0; qi < 4; ++qi) s1[qi] = cq[qi] - ck;
#pragma unroll
          for (int ks = 0; ks < 2; ++ks) {
            bf16x8 a = *(const bf16x8*)(Kb + ((2 * pp + kl) * 16 + fr) * LDK + ks * 32 + fq * 8);
#pragma unroll
            for (int qi = 0; qi < 4; ++qi) s1[qi] = mfma(a, qf[qi][ks], s1[qi]);
          }
#pragma unroll
          for (int qi = 0; qi < 4; ++qi) {
            int q = q0 + qi * 16 + fr;
            float e[4];
#pragma unroll
            for (int j = 0; j < 4; ++j) {
              float v = s1[qi][j];
              if (diag && (key0 + (2 * pp + kl) * 16 + fq * 4 + j > q)) v = -INFINITY;
              e[j] = __builtin_amdgcn_exp2f(v);
            }
            lrow[qi] += (e[0] + e[1]) + (e[2] + e[3]);
            pfu[qi].u[kl * 2 + 0] = pack2(e[0], e[1]);
            pfu[qi].u[kl * 2 + 1] = pack2(e[2], e[3]);
          }
        }
        bf16x8 pf[4];
#pragma unroll
        for (int qi = 0; qi < 4; ++qi) pf[qi] = pfu[qi].v;
#pragma unroll
        for (int dt = 0; dt < 4; ++dt) {
          V8 a;
          a.d[0] = *(const u32x2*)(Vb + (dt * 16 + fr) * LDK + (2 * pp) * 16 + fq * 4);
          a.d[1] = *(const u32x2*)(Vb + (dt * 16 + fr) * LDK + (2 * pp + 1) * 16 + fq * 4);
#pragma unroll
          for (int qi = 0; qi < 4; ++qi) o[dt][qi] = mfma(a.v, pf[qi], o[dt][qi]);
        }
      }
}

DEV void f2_prompt(const Params& p, int qt, int h, char* smem) {
  u16* Ks = (u16*)smem;
  u16* Vs = Ks + 2 * 64 * LDK;
  float* cs = (float*)(Vs + 2 * 64 * LDK);
  float* off = cs + 128;
  float* tmp = off + 132;
  int tid = otid(), lane = tid & 63, wid = tid >> 6, fr = lane & 15, fq = lane >> 4;
  __syncthreads();
  if (tid < MTILES) tmp[tid] = p.TT[tid * 16 + h];
  __syncthreads();
  if (tid < MTILES) { float s = 0.f; for (int m = 0; m < tid; ++m) s += tmp[m]; off[tid] = s; }
  __syncthreads();
  int q0 = qt * 256 + wid * 64;
  bf16x8 qf[4][2];
  float cq[4], lrow[4];
  f32x4 o[4][4];
#pragma unroll
  for (int qi = 0; qi < 4; ++qi) {
    int q = q0 + qi * 16 + fr;
#pragma unroll
    for (int ks = 0; ks < 2; ++ks) qf[qi][ks] = *(const bf16x8*)(p.Qf + (size_t)q * DM + h * 64 + ks * 32 + fq * 8);
    cq[qi] = (p.LFC[(size_t)q * 16 + h] + off[q >> 7] - 12.f) * 1.44269504089f;
    lrow[qi] = 0.f;
#pragma unroll
    for (int dt = 0; dt < 4; ++dt) o[dt][qi] = f32x4{0.f, 0.f, 0.f, 0.f};
  }
  int nkt = 4 * (qt + 1);
  if (nkt > (LP + 63) / 64) nkt = (LP + 63) / 64;
  int* kst = (int*)(tmp + 132);
  if (tid == 0) {
    float cref = off[qt * 2];
    int m = 0;
    while (m < qt * 2 && cref - off[m + 1] < -45.f) ++m;
    kst[0] = m * 2;
  }
  __syncthreads();
  const int kt0 = kst[0];
  bool wave_valid = q0 < LP;
  u32x4 rk[2], rv[2]; float rc = 0.f;
  const int lrow_ = tid >> 2, lcol = (tid & 3) * 16;
  const u16* kfb = p.Kf + h * 64;
  const u16* vtb = p.VtF + (size_t)h * 64 * TPAD;
  const float* lcb = p.LFC + h;
  const unsigned kvo0 = (unsigned)(lrow_ * DM + lcol), kvo1 = kvo0 + 32u * DM;
  const unsigned vvo0 = (unsigned)(lrow_ * TPAD + lcol), vvo1 = vvo0 + 32u * TPAD;
#define GL(kt_) { int key0_ = (kt_) * 64; \
    const u16* kp_ = p.Kf + (size_t)(key0_ + lrow_) * DM + h * 64 + lcol; \
    const u16* vp_ = p.VtF + (size_t)(h * 64 + lrow_) * TPAD + key0_ + lcol; \
    rk[0] = *(const u32x4*)(kp_); rk[1] = *(const u32x4*)(kp_ + 8); \
    rv[0] = *(const u32x4*)(vp_); rv[1] = *(const u32x4*)(vp_ + 8); \
    if (tid < 64) rc = (p.LFC[(size_t)(key0_ + tid) * 16 + h] + off[(key0_ + tid) >> 7]) * 1.44269504089f; }
  GL(kt0);
  for (int kt = kt0; kt < nkt; ++kt) {
    int buf = kt & 1;
    u16* Kb = Ks + buf * 64 * LDK; u16* Vb = Vs + buf * 64 * LDK; float* cb = cs + buf * 64;
#pragma unroll
    for (int i = 0; i < 2; ++i) {
      *(u32x4*)(Kb + lrow_ * LDK + lcol + 8 * i) = rk[i];
      *(u32x4*)(Vb + lrow_ * LDK + lcol + 8 * i) = rv[i];
    }
    if (tid < 64) cb[tid] = rc;
    __syncthreads();
    if (kt + 1 < nkt) GL(kt + 1);
    int key0 = kt * 64;
    if (wave_valid && key0 <= q0 + 63) {
      if (key0 + 63 > q0) attn_tile<true>(Kb, Vb, cb, key0, q0, fr, fq, qf, cq, lrow, o);
      else attn_tile<false>(Kb, Vb, cb, key0, q0, fr, fq, qf, cq, lrow, o);
    }
  }
  int q0e = q0;
  asm volatile("" : "+v"(q0e));
#pragma unroll
  for (int qi = 0; qi < 4; ++qi) {
    float l = lrow[qi];
    l += __shfl_xor(l, 16); l += __shfl_xor(l, 32);
    float inv = 1.f / l;
    int q = q0e + qi * 16 + fr;
    if (q < LP) {
#pragma unroll
      for (int dt = 0; dt < 4; ++dt) {
        int d = dt * 16 + fq * 4;
        u32x2 og = *(const u32x2*)(p.OGf + (size_t)q * DM + h * 64 + d);
        u32x2 r;
        r.x = pack2(o[dt][qi][0] * inv * sigmoidf_(bflo(og.x)), o[dt][qi][1] * inv * sigmoidf_(bfhi(og.x)));
        r.y = pack2(o[dt][qi][2] * inv * sigmoidf_(bflo(og.y)), o[dt][qi][3] * inv * sigmoidf_(bfhi(og.y)));
        *(u32x2*)(p.AO + (size_t)q * DM + h * 64 + d) = r;
      }
    }
  }
}

DEV void f2_sample(const Params& p, int jf, int b, int h, int qh, char* smem) {
  constexpr int NK = PAST + 16;
  float* S = (float*)smem;
  float* qs = S + 8 * NK;
  float* cc = qs + 8 * 64;
  float* part = cc + NK;
  float* invl = part + 256;
  int tid = otid(), lane = tid & 63, wid = tid >> 6;
  __syncthreads();
  for (int e = tid; e < 512; e += 256) {
    int i = e >> 6, d = e & 63;
    qs[e] = bf2f(p.Qf[(size_t)(LP + b * 16 + qh * 8 + i) * DM + h * 64 + d]);
  }
  float lv[5]; float run = 0.f;
#pragma unroll
  for (int u = 0; u < 5; ++u) {
    int j = tid * 5 + u;
    float v = 0.f;
    if (j < PAST) v = p.cache_lf[(((size_t)jf * 8 + b) * PAST + j) * 16 + h];
    else if (j < NK) v = p.LFR[(size_t)(LP + b * 16 + (j - PAST)) * 16 + h];
    run += v; lv[u] = run;
  }
  part[tid] = run;
  __syncthreads();
  float base = 0.f;
  for (int m = 0; m < tid; ++m) base += part[m];
#pragma unroll
  for (int u = 0; u < 5; ++u) { int j = tid * 5 + u; if (j < NK) cc[j] = base + lv[u]; }
  __syncthreads();
  for (int j = tid; j < NK; j += 256) {
    const float* kp;
    if (j < PAST) kp = p.cache_k + ((((size_t)jf * 8 + b) * PAST + j) * 16 + h) * 64;
    else kp = p.out + O_FKS + (((size_t)jf * 128 + b * 16 + (j - PAST)) * 16 + h) * 64;
    f32x4 kv[16];
#pragma unroll
    for (int c = 0; c < 16; ++c) kv[c] = ((const f32x4*)kp)[c];
    float cj = cc[j];
#pragma unroll
    for (int i = 0; i < 8; ++i) {
      float a = 0.f;
#pragma unroll
      for (int c = 0; c < 16; ++c) {
        f32x4 qv = *(const f32x4*)(qs + i * 64 + c * 4);
        a += qv.x * kv[c].x + qv.y * kv[c].y + qv.z * kv[c].z + qv.w * kv[c].w;
      }
      int qi = qh * 8 + i;
      a = a * 0.69314718056f + (cc[PAST + qi] - cj);
      if (j > PAST + qi) a = -INFINITY;
      S[i * NK + j] = a;
    }
  }
  __syncthreads();
  for (int i = wid * 2; i < wid * 2 + 2; ++i) {
    float m = -INFINITY;
    for (int j = lane; j < NK; j += 64) m = fmaxf(m, S[i * NK + j]);
    m = wave_max(m);
    float l = 0.f;
    for (int j = lane; j < NK; j += 64) { float e = __expf(S[i * NK + j] - m); S[i * NK + j] = e; l += e; }
    l = wave_sum(l);
    if (lane == 0) invl[i] = 1.f / l;
  }
  __syncthreads();
  {
    int i = tid >> 5, dq = tid & 31;
    float o0 = 0.f, o1 = 0.f;
    const float* vb = p.cache_v + ((((size_t)jf * 8 + b) * PAST) * 16 + h) * 64 + dq * 2;
#pragma unroll 8
    for (int j = 0; j < PAST; ++j) {
      f32x2 v = *(const f32x2*)(vb + (size_t)j * 1024);
      float pj = S[i * NK + j];
      o0 += pj * v.x; o1 += pj * v.y;
    }
    const float* vn = p.out + O_FVS + (((size_t)jf * 128 + b * 16) * 16 + h) * 64 + dq * 2;
#pragma unroll
    for (int j = 0; j < 16; ++j) {
      f32x2 v = *(const f32x2*)(vn + (size_t)j * 1024);
      float pj = S[i * NK + PAST + j];
      o0 += pj * v.x; o1 += pj * v.y;
    }
    int row = LP + b * 16 + qh * 8 + i;
    float il = invl[i];
    uint32_t og = *(const uint32_t*)(p.OGf + (size_t)row * DM + h * 64 + dq * 2);
    *(uint32_t*)(p.AO + (size_t)row * DM + h * 64 + dq * 2) = pack2(o0 * il * sigmoidf_(bflo(og)), o1 * il * sigmoidf_(bfhi(og)));
  }
}

DEV void ph_f2(const Params& p, int jf, char* smem) {
  const int NP = 65 * 16, NI = NP + 256;
  {
    int gt = blockIdx.x * blockDim.x + otid(), gs = gridDim.x * blockDim.x;
    for (int i = gt; i < (TPAD - TTOK) * DM / 2; i += gs) ((uint32_t*)(p.AO + (size_t)TTOK * DM))[i] = 0u;
  }
  int* qslot = (int*)(smem + 53248 - 16);
  for (;;) {
    __syncthreads();
    if (otid() == 0) qslot[0] = atomicAdd(p.QCTR, 1);
    __syncthreads();
    int idx = qslot[0];
    if (idx >= NI) break;
    if (idx < NP) f2_prompt(p, 64 - idx / 16, idx % 16, smem);
    else { int s = idx - NP; f2_sample(p, jf, s >> 5, (s >> 1) & 15, s & 1, smem); }
  }
  conv_tables(p, jf * 2);
}

DEV void ph_outproj(const Params& p, const u16* A, int K, const u16* Wt, const float* gffn, char* smem) {
  int tid = otid(), lane = tid & 63, wid = tid >> 6;
  int wr = wid >> 1, wc = wid & 1, fr = lane & 15, fq = lane >> 4;
  for (int it = blockIdx.x; it < MTILES * 8; it += gridDim.x) {
    int mt, nt; tile_mn(it, 8, mt, nt);
    f32x4 acc[4][4];
    gemm_tile<true>(A, K, Wt, K, K, mt * 128, nt * 128, smem, acc);
#pragma unroll
    for (int m = 0; m < 4; ++m) {
      int row = mt * 128 + wr * 64 + m * 16 + fr;
      float ss = 0.f;
#pragma unroll
      for (int n = 0; n < 4; ++n) {
        int col = nt * 128 + wc * 64 + n * 16 + fq * 4;
        f32x4* xp = (f32x4*)(p.X + (size_t)row * DM + col);
        f32x4 xn = *xp + acc[m][n];
        *xp = xn;
        f32x4 g = *(const f32x4*)(gffn + col);
        u32x2 o; o.x = pack2(xn.x * g.x, xn.y * g.y); o.y = pack2(xn.z * g.z, xn.w * g.w);
        *(u32x2*)(p.H + (size_t)row * DM + col) = o;
        ss += xn.x * xn.x + xn.y * xn.y + xn.z * xn.z + xn.w * xn.w;
      }
      ss += __shfl_xor(ss, 16); ss += __shfl_xor(ss, 32);
      if (fq == 0) atomicAdd(p.SSQ + row, (unsigned long long)(ss * 1048576.f + 0.5f));
    }
  }
}

DEV void ph_r1(const Params& p, int jr, char* smem) {
  const u16* Wt = p.WrinT + (size_t)jr * 6144 * 1024;
  int tid = otid(), lane = tid & 63, wid = tid >> 6;
  int wr = wid >> 1, wc = wid & 1, fr = lane & 15, fq = lane >> 4;
  {
    int gt = blockIdx.x * blockDim.x + tid, gs = gridDim.x * blockDim.x;
    for (int i = gt; i < LEAD * DM; i += gs) { p.Qr[i] = 0; p.Kr[i] = 0; }
    { unsigned int z_ = 0; asm volatile("" : "+v"(z_)); for (int i = gt; i < TPAD; i += gs) p.SSQ[i] = (unsigned long long)z_; }
    for (int i = gt; i < 1024 * LEAD; i += gs) p.KrT[tix(256, (i / LEAD) >> 8, (i / LEAD) & 255, i % LEAD)] = 0;
    for (int i = gt; i < 2048 * LEAD; i += gs) p.VrT[tix(512, (i / LEAD) >> 9, (i / LEAD) & 511, i % LEAD)] = 0;
  }
  const int NT = 48;
  for (int it = blockIdx.x; it < MTILES * NT; it += gridDim.x) {
    int mt, nt; tile_mn(it, NT, mt, nt);
    int m0 = mt * 128;
    f32x4 acc[4][4];
    if (nt >= 8 && nt < 32) gemm_tile<false>(p.H, DM, Wt, DM, DM, m0, nt * 128, smem, acc);
    else gemm_tile<true>(p.H, DM, Wt, DM, DM, m0, nt * 128, smem, acc);
    if (nt < 8) {
      int hh = nt >> 1, half = nt & 1;
#pragma unroll
      for (int pr = 0; pr < 2; ++pr) {
        int g = half * 4 + wc * 2 + pr;
        f32x4 rr = *(const f32x4*)(p.rope_rev + g * 16 + fq * 4);
#pragma unroll
        for (int m = 0; m < 4; ++m) {
          int row = m0 + wr * 64 + m * 16 + fr;
          int pos = (row < LP) ? (row - NMETA) : ((row < TTOK) ? (PAST + ((row - LP) & 15)) : 0);
          float o1[4], o2[4];
#pragma unroll
          for (int j = 0; j < 4; ++j) {
            float rev = (float)pos * rr[j];
            rev -= floorf(rev);
            float sn = __builtin_amdgcn_sinf(rev), cs = __builtin_amdgcn_cosf(rev);
            float x1 = acc[m][2 * pr][j], x2 = acc[m][2 * pr + 1][j];
            o1[j] = (x1 * cs - x2 * sn) * 0.0625f; o2[j] = (x1 * sn + x2 * cs) * 0.0625f;
          }
          u32x2 t1, t2;
          t1.x = pack2(o1[0], o1[1]); t1.y = pack2(o1[2], o1[3]);
          t2.x = pack2(o2[0], o2[1]); t2.y = pack2(o2[2], o2[3]);
          u16* dq = p.Qr + (size_t)(row + LEAD) * DM + hh * 256 + g * 32 + fq * 4;
          *(u32x2*)dq = t1;
          *(u32x2*)(dq + 16) = t2;
        }
      }
    } else if (nt < 16) {
      bool isq = false;
      int hh = (nt & 7) >> 1, half = nt & 1;
      float l2g = ret_l2g(hh);
      u16* dst = isq ? p.Qr : p.Kr;
#pragma unroll
      for (int pr = 0; pr < 2; ++pr) {
        int g = half * 4 + wc * 2 + pr;
        int fi = g * 16 + fr;
        float rr = p.rope_rev[fi];
        int dp1 = g * 32 + fr, dp2 = dp1 + 16;
#pragma unroll
        for (int m = 0; m < 4; ++m) {
          int rb = m0 + wr * 64 + m * 16 + fq * 4;
          float o1[4], o2[4];
#pragma unroll
          for (int j = 0; j < 4; ++j) {
            int row = rb + j;
            int pos = (row < LP) ? (row - NMETA) : ((row < TTOK) ? (PAST + ((row - LP) & 15)) : 0);
            float rev = (float)pos * rr;
            rev -= floorf(rev);
            float sn = __builtin_amdgcn_sinf(rev), cs = __builtin_amdgcn_cosf(rev);
            float x1 = acc[m][2 * pr][j], x2 = acc[m][2 * pr + 1][j];
            float a = x1 * cs - x2 * sn, bb = x1 * sn + x2 * cs;
            if (isq) { a *= 0.0625f; bb *= 0.0625f; }
            o1[j] = a; o2[j] = bb;
            dst[(size_t)(row + LEAD) * DM + hh * 256 + dp1] = f2bf(a);
            dst[(size_t)(row + LEAD) * DM + hh * 256 + dp2] = f2bf(bb);
          }
          if (!isq) {
            float dc[4];
#pragma unroll
            for (int j = 0; j < 4; ++j) dc[j] = exp2f(l2g * (float)(63 - ((rb + j + LEAD) & 63)));
            u32x2 t1, t2;
            t1.x = pack2(o1[0] * dc[0], o1[1] * dc[1]); t1.y = pack2(o1[2] * dc[2], o1[3] * dc[3]);
            t2.x = pack2(o2[0] * dc[0], o2[1] * dc[1]); t2.y = pack2(o2[2] * dc[2], o2[3] * dc[3]);
            *(u32x2*)(p.KrT + tix(256, hh, dp1, rb + LEAD)) = t1;
            *(u32x2*)(p.KrT + tix(256, hh, dp2, rb + LEAD)) = t2;
          }
        }
      }
    } else if (nt < 32) {
      int hh = (nt - 16) >> 2;
#pragma unroll
      for (int m = 0; m < 4; ++m) {
        int rb = m0 + wr * 64 + m * 16 + fq * 4;
#pragma unroll
        for (int n = 0; n < 4; ++n) {
          int e = ((nt - 16) & 3) * 128 + wc * 64 + n * 16 + fr;
          u32x2 o; o.x = pack2(acc[m][n][0], acc[m][n][1]); o.y = pack2(acc[m][n][2], acc[m][n][3]);
          *(u32x2*)(p.VrT + tix(512, hh, e, rb + LEAD)) = o;
        }
      }
    } else {
#pragma unroll
      for (int m = 0; m < 4; ++m)
#pragma unroll
        for (int n = 0; n < 4; ++n) {
          int row = m0 + wr * 64 + m * 16 + fr;
          int col = (nt - 32) * 128 + wc * 64 + n * 16 + fq * 4;
          u32x2 o; o.x = pack2(acc[m][n][0], acc[m][n][1]); o.y = pack2(acc[m][n][2], acc[m][n][3]);
          *(u32x2*)(p.Gr + (size_t)row * 2048 + col) = o;
        }
    }
  }
}

DEV void ph_r2(const Params& p, int jr) {
  int tid = otid(), lane = tid & 63, wid = tid >> 6, fr = lane & 15, fq = lane >> 4;
  for (int it = blockIdx.x; it < 256; it += gridDim.x) {
    int h = it >> 6, sl = (it >> 2) & 15, rt = (it & 3) * 4 + wid;
    float dec64 = exp2f(ret_l2g(h) * 64.f);
    f32x4 st[2];
    st[0] = f32x4{0.f, 0.f, 0.f, 0.f}; st[1] = st[0];
    const u16* kb = p.KrT + tix(256, h, rt * 16 + fr, 0) + fq * 8;
    const u16* vb = p.VrT + tix(512, h, sl * 32 + fr, 0) + fq * 8;
    u16* sp0 = p.ST + (((size_t)h * 16 + rt) * 512 + sl * 32 + fr) * 16 + fq * 4;
    bf16x8 A0[2], B0[4], A1[2], B1[4], A2[2], B2[4], A3[2], B3[4], A4[2], B4[4], A5[2], B5[4], A6[2], B6[4], A7[2], B7[4];
#define R2L(A, B, n_) { size_t nn_ = (size_t)min((n_), NCH - 1); \
      A[0] = *(const bf16x8*)(kb + nn_ * (256 * 64)); A[1] = *(const bf16x8*)(kb + nn_ * (256 * 64) + 32); \
      B[0] = *(const bf16x8*)(vb + nn_ * (512 * 64)); B[1] = *(const bf16x8*)(vb + nn_ * (512 * 64) + 32); \
      B[2] = *(const bf16x8*)(vb + nn_ * (512 * 64) + 16 * 64); B[3] = *(const bf16x8*)(vb + nn_ * (512 * 64) + 16 * 64 + 32); }
#define R2S(A, B, n_) { \
      _Pragma("unroll") for (int c = 0; c < 2; ++c) { \
        u32x2 o; o.x = pack2(st[c][0], st[c][1]); o.y = pack2(st[c][2], st[c][3]); \
        *(u32x2*)(sp0 + (size_t)(n_) * (4 * 16 * 512 * 16) + c * 16 * 16) = o; \
        f32x4 t = st[c] * dec64; \
        t = mfma(A[0], B[c * 2], t); t = mfma(A[1], B[c * 2 + 1], t); st[c] = t; } }
    R2L(A0, B0, 0) R2L(A1, B1, 1) R2L(A2, B2, 2) R2L(A3, B3, 3) R2L(A4, B4, 4) R2L(A5, B5, 5) R2L(A6, B6, 6) R2L(A7, B7, 7)
#pragma unroll 1
    for (int n = 0; n < 256; n += 8) {
      R2S(A0, B0, n + 0) R2L(A0, B0, n + 8)
      R2S(A1, B1, n + 1) R2L(A1, B1, n + 9)
      R2S(A2, B2, n + 2) R2L(A2, B2, n + 10)
      R2S(A3, B3, n + 3) R2L(A3, B3, n + 11)
      R2S(A4, B4, n + 4) R2L(A4, B4, n + 12)
      R2S(A5, B5, n + 5) R2L(A5, B5, n + 13)
      R2S(A6, B6, n + 6) R2L(A6, B6, n + 14)
      R2S(A7, B7, n + 7) R2L(A7, B7, n + 15)
    }
    R2S(A0, B0, 256)
    int fre = fr, fqe = fq;
    asm volatile("" : "+v"(fre), "+v"(fqe));
#pragma unroll
    for (int c = 0; c < 2; ++c)
#pragma unroll
      for (int j = 0; j < 4; ++j) {
        int dorig = perm_dorig(rt * 16 + fqe * 4 + j);
        p.out[O_SRP + ((size_t)(jr * 4 + h) * 256 + dorig) * 512 + sl * 32 + c * 16 + fre] = st[c][j];
      }
  }
}

DEV void r3_prompt(const Params& p, int jr, int n, int h, char* smem) {
  u32x4* Sf = (u32x4*)smem;
  float* red = (float*)(smem + 8192);
  int tid = otid(), lane = tid & 63, w = tid >> 6, fr = lane & 15, fq = lane >> 4;
  int p0 = n * 64;
  float l2g = ret_l2g(h);
  f32x4 acc[8][4];
#pragma unroll
  for (int a = 0; a < 8; ++a)
#pragma unroll
    for (int b = 0; b < 4; ++b) acc[a][b] = f32x4{0.f, 0.f, 0.f, 0.f};
  const u16* qb = p.Qr + (size_t)(p0 + fr) * DM + h * 256 + fq * 8;
  if (n >= 1) {
    const u16* sb = p.ST + (((size_t)(n * 4 + h) * 16 + (fq >> 1)) * 512 + w * 128 + fr) * 16 + (fq & 1) * 8;
#pragma unroll 1
    for (int ks = 0; ks < 8; ++ks) {
      bf16x8 bq[4];
#pragma unroll
      for (int it = 0; it < 4; ++it) bq[it] = *(const bf16x8*)(qb + (size_t)(it * 16) * DM + ks * 32);
#pragma unroll
      for (int dvt = 0; dvt < 8; ++dvt) {
        bf16x8 a = *(const bf16x8*)(sb + (size_t)(ks * 2) * (512 * 16) + dvt * 16 * 16);
#pragma unroll
        for (int it = 0; it < 4; ++it) acc[dvt][it] = mfma(a, bq[it], acc[dvt][it]);
      }
    }
#pragma unroll
    for (int it = 0; it < 4; ++it) {
      float qd = exp2f(l2g * (float)(it * 16 + fr + 1));
#pragma unroll
      for (int dvt = 0; dvt < 8; ++dvt) acc[dvt][it] = acc[dvt][it] * qd;
    }
  }
  {
    f32x4 s[4];
#pragma unroll
    for (int jt = 0; jt < 4; ++jt) s[jt] = f32x4{0.f, 0.f, 0.f, 0.f};
    const u16* kb = p.Kr + (size_t)(p0 + fr) * DM + h * 256 + fq * 8;
#pragma unroll 1
    for (int ks = 0; ks < 8; ++ks) {
      bf16x8 b = *(const bf16x8*)(qb + (size_t)(w * 16) * DM + ks * 32);
#pragma unroll
      for (int jt = 0; jt < 4; ++jt) {
        bf16x8 a = *(const bf16x8*)(kb + (size_t)(jt * 16) * DM + ks * 32);
        s[jt] = mfma(a, b, s[jt]);
      }
    }
    int i = w * 16 + fr;
#pragma unroll
    for (int jt = 0; jt < 4; ++jt)
#pragma unroll
      for (int jj = 0; jj < 4; ++jj) {
        int j = jt * 16 + fq * 4 + jj;
        int dd = i > j ? i - j : j - i;
        s[jt][jj] *= exp2f(l2g * (float)dd);
      }
    __syncthreads();
#pragma unroll
    for (int pp = 0; pp < 2; ++pp) {
      u32x4 t;
      t.x = pack2(s[2 * pp][0], s[2 * pp][1]); t.y = pack2(s[2 * pp][2], s[2 * pp][3]);
      t.z = pack2(s[2 * pp + 1][0], s[2 * pp + 1][1]); t.w = pack2(s[2 * pp + 1][2], s[2 * pp + 1][3]);
      Sf[(w * 2 + pp) * 64 + lane] = t;
    }
    __syncthreads();
  }
  {
    const u16* vb = p.VrT + tix(512, h, w * 128 + fr, p0) + fq * 4;
#pragma unroll
    for (int pp = 0; pp < 2; ++pp) {
      V8 bs[4];
#pragma unroll
      for (int it = 0; it < 4; ++it) bs[it].q = Sf[(it * 2 + pp) * 64 + lane];
#pragma unroll
      for (int dvt = 0; dvt < 8; ++dvt) {
        V8 a;
        a.d[0] = *(const u32x2*)(vb + dvt * 16 * 64 + (2 * pp) * 16);
        a.d[1] = *(const u32x2*)(vb + dvt * 16 * 64 + (2 * pp + 1) * 16);
#pragma unroll
        for (int it = 0; it < 4; ++it) acc[dvt][it] = mfma(a.v, bs[it].v, acc[dvt][it]);
      }
    }
  }
  float mean[4], rstd[4];
  {
    float s1[4];
#pragma unroll
    for (int it = 0; it < 4; ++it) {
      float s = 0.f;
#pragma unroll
      for (int dvt = 0; dvt < 8; ++dvt) s += acc[dvt][it][0] + acc[dvt][it][1] + acc[dvt][it][2] + acc[dvt][it][3];
      s += __shfl_xor(s, 16); s += __shfl_xor(s, 32);
      s1[it] = s;
    }
    __syncthreads();
    if (fq == 0) {
#pragma unroll
      for (int it = 0; it < 4; ++it) red[w * 64 + it * 16 + fr] = s1[it];
    }
    __syncthreads();
#pragma unroll
    for (int it = 0; it < 4; ++it) {
      int i = it * 16 + fr;
      mean[it] = (red[i] + red[64 + i] + red[128 + i] + red[192 + i]) * (1.f / 512.f);
    }
#pragma unroll
    for (int it = 0; it < 4; ++it) {
      float s = 0.f;
#pragma unroll
      for (int dvt = 0; dvt < 8; ++dvt)
#pragma unroll
        for (int j = 0; j < 4; ++j) { float d = acc[dvt][it][j] - mean[it]; s += d * d; }
      s += __shfl_xor(s, 16); s += __shfl_xor(s, 32);
      s1[it] = s;
    }
    __syncthreads();
    if (fq == 0) {
#pragma unroll
      for (int it = 0; it < 4; ++it) red[w * 64 + it * 16 + fr] = s1[it];
    }
    __syncthreads();
#pragma unroll
    for (int it = 0; it < 4; ++it) {
      int i = it * 16 + fr;
      float var = (red[i] + red[64 + i] + red[128 + i] + red[192 + i]) * (1.f / 512.f);
      rstd[it] = rsqrtf(var + EPS);
    }
  }
#pragma unroll
  for (int it = 0; it < 4; ++it) {
    int t = p0 + it * 16 + fr - LEAD;
    if (t >= 0 && t < LP) {
#pragma unroll
      for (int dvt = 0; dvt < 8; ++dvt) {
        int e0 = h * 512 + w * 128 + dvt * 16 + fq * 4;
        u16* gp = p.Gr + (size_t)t * 2048 + e0;
        u32x2 g = *(const u32x2*)gp;
        f32x4 gn = *(const f32x4*)(p.ret_gn + jr * 2048 + e0);
        float g0 = bflo(g.x), g1 = bfhi(g.x), g2 = bflo(g.y), g3 = bfhi(g.y);
        float y0 = (acc[dvt][it][0] - mean[it]) * rstd[it] * gn.x * (g0 * sigmoidf_(g0));
        float y1 = (acc[dvt][it][1] - mean[it]) * rstd[it] * gn.y * (g1 * sigmoidf_(g1));
        float y2 = (acc[dvt][it][2] - mean[it]) * rstd[it] * gn.z * (g2 * sigmoidf_(g2));
        float y3 = (acc[dvt][it][3] - mean[it]) * rstd[it] * gn.w * (g3 * sigmoidf_(g3));
        u32x2 o; o.x = pack2(y0, y1); o.y = pack2(y2, y3);
        *(u32x2*)gp = o;
      }
    }
  }
}

DEV void r3_sample(const Params& p, int jr, int b, int h, char* smem) {
  float* obuf = (float*)smem;
  u16* qs = (u16*)(smem + 32768);
  u16* ks = qs + 16 * 256;
  float* sm = (float*)(smem + 49152);
  float* red = sm + 256;
  float* stat = red + 64;
  int tid = otid(), lane = tid & 63, wid = tid >> 6;
  float l2g = ret_l2g(h);
  int prow = LP + LEAD + b * 16;
  __syncthreads();
  for (int e = tid; e < 16 * 256; e += 256) {
    int i = e >> 8, d = e & 255;
    qs[e] = p.Qr[(size_t)(prow + i) * DM + h * 256 + d];
    ks[e] = p.Kr[(size_t)(prow + i) * DM + h * 256 + d];
  }
  __syncthreads();
  {
    int i = tid >> 4, j = tid & 15;
    float a = 0.f;
#pragma unroll 8
    for (int d = 0; d < 256; ++d) a += bf2f(qs[i * 256 + d]) * bf2f(ks[j * 256 + d]);
    int dd = i > j ? i - j : j - i;
    sm[tid] = a * exp2f(l2g * (float)dd);
  }
  __syncthreads();
  for (int e = tid; e < 16 * 256; e += 256) ks[e] = f2bf(bf2f(ks[e]) * exp2f(l2g * (float)(15 - (e >> 8))));
  __syncthreads();
  float dec16 = exp2f(l2g * 16.f);
  const float* stin = p.state_ret + ((size_t)(jr * 8 + b) * 4 + h) * 256 * 512;
  float* stout = p.out + O_SRS + ((size_t)(jr * 8 + b) * 4 + h) * 256 * 512;
#pragma unroll 1
  for (int c = 0; c < 2; ++c) {
    int e = tid + c * 256;
    float v[16], o[16];
    const u16* vp = p.VrT + tix(512, h, e, prow);
    u32x4 a = *(const u32x4*)vp, bq = *(const u32x4*)(vp + 8);
    v[0] = bflo(a.x); v[1] = bfhi(a.x); v[2] = bflo(a.y); v[3] = bfhi(a.y);
    v[4] = bflo(a.z); v[5] = bfhi(a.z); v[6] = bflo(a.w); v[7] = bfhi(a.w);
    v[8] = bflo(bq.x); v[9] = bfhi(bq.x); v[10] = bflo(bq.y); v[11] = bfhi(bq.y);
    v[12] = bflo(bq.z); v[13] = bfhi(bq.z); v[14] = bflo(bq.w); v[15] = bfhi(bq.w);
#pragma unroll
    for (int i = 0; i < 16; ++i) o[i] = 0.f;
#pragma unroll 2
    for (int dp = 0; dp < 256; ++dp) {
      int dorig = perm_dorig(dp);
      float s0 = stin[(size_t)dorig * 512 + e];
      float n0 = s0 * dec16;
#pragma unroll
      for (int i = 0; i < 16; ++i) {
        o[i] += bf2f(qs[i * 256 + dp]) * s0;
        n0 += bf2f(ks[i * 256 + dp]) * v[i];
      }
      stout[(size_t)dorig * 512 + e] = n0;
    }
#pragma unroll
    for (int i = 0; i < 16; ++i) obuf[i * 512 + e] = o[i] * exp2f(l2g * (float)(i + 1));
#pragma unroll 1
    for (int i = 0; i < 16; ++i) {
      float a0 = obuf[i * 512 + e];
#pragma unroll
      for (int j = 0; j < 16; ++j) a0 += sm[i * 16 + j] * v[j];
      obuf[i * 512 + e] = a0;
    }
  }
  __syncthreads();
  for (int i = 0; i < 16; ++i) {
    float s = wave_sum(obuf[i * 512 + tid] + obuf[i * 512 + 256 + tid]);
    if (lane == 0) red[wid * 16 + i] = s;
  }
  __syncthreads();
  if (tid < 16) stat[tid] = (red[tid] + red[16 + tid] + red[32 + tid] + red[48 + tid]) * (1.f / 512.f);
  __syncthreads();
  for (int i = 0; i < 16; ++i) {
    float mu = stat[i];
    float d0 = obuf[i * 512 + tid] - mu, d1 = obuf[i * 512 + 256 + tid] - mu;
    float s = wave_sum(d0 * d0 + d1 * d1);
    if (lane == 0) red[wid * 16 + i] = s;
  }
  __syncthreads();
  if (tid < 16) stat[16 + tid] = rsqrtf((red[tid] + red[16 + tid] + red[32 + tid] + red[48 + tid]) * (1.f / 512.f) + EPS);
  __syncthreads();
  for (int c = 0; c < 2; ++c) {
    int e = tid + c * 256;
    float gn = p.ret_gn[jr * 2048 + h * 512 + e];
    for (int i = 0; i < 16; ++i) {
      int t = LP + b * 16 + i;
      float g = bf2f(p.Gr[(size_t)t * 2048 + h * 512 + e]);
      float y = (obuf[i * 512 + e] - stat[i]) * stat[16 + i] * gn * (g * sigmoidf_(g));
      p.Gr[(size_t)t * 2048 + h * 512 + e] = f2bf(y);
    }
  }
}

DEV void ph_r3(const Params& p, int jr, char* smem) {
  const int NP = NCH * 4, NI = NP + 32;
  for (int it = blockIdx.x; it < NI; it += gridDim.x) {
    if (it < 32) r3_sample(p, jr, it >> 2, it & 3, smem);
    else { int q = it - 32; r3_prompt(p, jr, q >> 2, q & 3, smem); }
  }
}

DEV void ph_p2(const Params& p, int layer, char* smem) {
  const u16* Wt = p.WpqT + (size_t)layer * 2048 * 1024;
  u16* Qs = (u16*)smem;
  constexpr int LQ = 136;
  int tid = otid(), lane = tid & 63, wid = tid >> 6;
  int wr = wid >> 1, wc = wid & 1, fr = lane & 15, fq = lane >> 4;
  for (int it = blockIdx.x; it < MTILES * 16; it += gridDim.x) {
    int mt, hp; tile_mn(it, 16, mt, hp);
    int m0 = mt * 128;
    f32x4 acc[4][4];
    gemm_tile<true>(p.H, DM, Wt, DM, DM, m0, hp * 128, smem, acc);
    __syncthreads();
#pragma unroll
    for (int m = 0; m < 4; ++m) {
      float rs = rsqrtf((float)p.SSQ[m0 + wr * 64 + m * 16 + fr] * (1.f / (1048576.f * DM)) + EPS);
#pragma unroll
      for (int n = 0; n < 4; ++n) {
        u32x2 o; o.x = pack2(acc[m][n][0] * rs, acc[m][n][1] * rs); o.y = pack2(acc[m][n][2] * rs, acc[m][n][3] * rs);
        *(u32x2*)(Qs + (wr * 64 + m * 16 + fr) * LQ + wc * 64 + n * 16 + fq * 4) = o;
      }
    }
    __syncthreads();
    f32x4 sc[2][8];
#pragma unroll
    for (int rt = 0; rt < 2; ++rt)
#pragma unroll
      for (int ct = 0; ct < 8; ++ct) sc[rt][ct] = f32x4{0.f, 0.f, 0.f, 0.f};
    const u16* skb = p.SKb + ((size_t)(layer * 16 + hp) * 128 + fr) * 128 + fq * 8;
#pragma unroll
    for (int ks = 0; ks < 4; ++ks) {
      bf16x8 a[2];
#pragma unroll
      for (int rt = 0; rt < 2; ++rt) a[rt] = *(const bf16x8*)(Qs + (wid * 32 + rt * 16 + fr) * LQ + ks * 32 + fq * 8);
#pragma unroll
      for (int ct = 0; ct < 8; ++ct) {
        bf16x8 b = *(const bf16x8*)(skb + (size_t)(ct * 16) * 128 + ks * 32);
#pragma unroll
        for (int rt = 0; rt < 2; ++rt) sc[rt][ct] = mfma(a[rt], b, sc[rt][ct]);
      }
    }
#pragma unroll
    for (int rt = 0; rt < 2; ++rt)
#pragma unroll
      for (int j = 0; j < 4; ++j) {
        uint32_t key[8];
#pragma unroll
        for (int ct = 0; ct < 8; ++ct) key[ct] = (f2key(sc[rt][ct][j]) & ~127u) | (uint32_t)(127 - (ct * 16 + fr));
        uint32_t mine = 0;
#pragma unroll 1
        for (int r = 0; r < 16; ++r) {
          uint32_t best = key[0];
#pragma unroll
          for (int ct = 1; ct < 8; ++ct) best = max(best, key[ct]);
          best = row16_maxu(best);
#pragma unroll
          for (int ct = 0; ct < 8; ++ct) key[ct] = (key[ct] == best) ? 0u : key[ct];
          if (fr == r) mine = best;
        }
        int row = m0 + wid * 32 + rt * 16 + fq * 4 + j;
        p.SV[((size_t)row * 16 + hp) * 16 + fr] = key2f(mine & ~127u);
        p.SI[((size_t)row * 16 + hp) * 16 + fr] = 127 - (int)(mine & 127u);
      }
  }
}

DEV void p3_partial(const Params& p, int t, int h0, int nh, int lane, int* eidL, float* gateL, float* svL,
                    int ca, int cb, bool cvalid, float (&oacc)[16]) {
  const int ne = nh * 16;
  int* siL = (int*)(svL + 256);
  {
    f32x4 sv4 = *(const f32x4*)(p.SV + (size_t)t * 256 + lane * 4);
    u32x4 si4 = *(const u32x4*)(p.SI + (size_t)t * 256 + lane * 4);
    *(f32x4*)(svL + lane * 4) = sv4;
    *(u32x4*)(siL + lane * 4) = si4;
  }
  for (int hl = 0; hl < nh; hl += 2) {
    int ha = h0 + hl, hb2 = ha + 1;
    float canda = cvalid ? (svL[ha * 32 + ca] + svL[ha * 32 + 16 + cb]) : 0.f;
    float candb = cvalid ? (svL[hb2 * 32 + ca] + svL[hb2 * 32 + 16 + cb]) : 0.f;
    uint32_t keya = cvalid ? ((f2key(canda) & ~63u) | (uint32_t)(63 - lane)) : 0u;
    uint32_t keyb = cvalid ? ((f2key(candb) & ~63u) | (uint32_t)(63 - lane)) : 0u;
    uint32_t minea = 0, mineb = 0;
#pragma unroll 1
    for (int r = 0; r < 16; ++r) {
      uint32_t besta = wave_maxu(keya), bestb = wave_maxu(keyb);
      keya = (keya == besta) ? 0u : keya;
      keyb = (keyb == bestb) ? 0u : keyb;
      if (lane == r) { minea = besta; mineb = bestb; }
    }
#pragma unroll
    for (int w = 0; w < 2; ++w) {
      uint32_t mine = w ? mineb : minea;
      int h = w ? hb2 : ha;
      int src = 63 - (int)(mine & 63u);
      int wa = __shfl(ca, src), wb = __shfl(cb, src);
      float fv = key2f(mine & ~63u);
      float f0 = rdlane(fv, 0);
      float e = (lane < 16) ? __expf(fv - f0) : 0.f;
      float ssum = row16_sum(e);
      if (lane < 16) {
        int eid = siL[h * 32 + wa] * 128 + siL[h * 32 + 16 + wb];
        eidL[(hl + w) * 16 + lane] = eid;
        gateL[(hl + w) * 16 + lane] = e / ssum;
      }
    }
  }
  float hf[16];
  {
    u32x4 ha = *(const u32x4*)(p.H + (size_t)t * DM + lane * 16);
    u32x4 hb = *(const u32x4*)(p.H + (size_t)t * DM + lane * 16 + 8);
    hf[0] = bflo(ha.x); hf[1] = bfhi(ha.x); hf[2] = bflo(ha.y); hf[3] = bfhi(ha.y);
    hf[4] = bflo(ha.z); hf[5] = bfhi(ha.z); hf[6] = bflo(ha.w); hf[7] = bfhi(ha.w);
    hf[8] = bflo(hb.x); hf[9] = bfhi(hb.x); hf[10] = bflo(hb.y); hf[11] = bfhi(hb.y);
    hf[12] = bflo(hb.z); hf[13] = bfhi(hb.z); hf[14] = bflo(hb.w); hf[15] = bfhi(hb.w);
    float rs = rsqrtf((float)p.SSQ[t] * (1.f / (1048576.f * DM)) + EPS);
#pragma unroll
    for (int i = 0; i < 16; ++i) hf[i] *= rs;
  }
  const unsigned char* U8 = (const unsigned char*)p.Ub + lane * 16;
  const unsigned char* V8p = (const unsigned char*)p.Vb + lane * 16;
#define P3_LOAD(buf, tab, base) _Pragma("unroll") for (int u = 0; u < 8; ++u) { \
      int eid_ = __builtin_amdgcn_readfirstlane(eidL[(base) + u]); \
      buf[u] = *(const u32x4*)((tab) + (size_t)eid_ * DM); }
#define P3_CVT(f, q) { v2f_t c_; \
      c_ = __builtin_amdgcn_cvt_pk_f32_fp8((int)(q).x, false); f[0] = c_.x; f[1] = c_.y; \
      c_ = __builtin_amdgcn_cvt_pk_f32_fp8((int)(q).x, true);  f[2] = c_.x; f[3] = c_.y; \
      c_ = __builtin_amdgcn_cvt_pk_f32_fp8((int)(q).y, false); f[4] = c_.x; f[5] = c_.y; \
      c_ = __builtin_amdgcn_cvt_pk_f32_fp8((int)(q).y, true);  f[6] = c_.x; f[7] = c_.y; \
      c_ = __builtin_amdgcn_cvt_pk_f32_fp8((int)(q).z, false); f[8] = c_.x; f[9] = c_.y; \
      c_ = __builtin_amdgcn_cvt_pk_f32_fp8((int)(q).z, true);  f[10] = c_.x; f[11] = c_.y; \
      c_ = __builtin_amdgcn_cvt_pk_f32_fp8((int)(q).w, false); f[12] = c_.x; f[13] = c_.y; \
      c_ = __builtin_amdgcn_cvt_pk_f32_fp8((int)(q).w, true);  f[14] = c_.x; f[15] = c_.y; }
#define P3_DOT(buf, base) _Pragma("unroll") for (int u = 0; u < 8; ++u) { \
      float f_[16]; P3_CVT(f_, buf[u]); float d_ = 0.f; \
      _Pragma("unroll") for (int i = 0; i < 16; ++i) d_ += hf[i] * f_[i]; \
      d_ = wave_sum(d_) * (1.f / U_SCALE); \
      int k_ = (base) + u; \
      if (lane == (k_ & 63)) { if (k_ < 64) w0 = d_; else w1 = d_; } }
#define P3_AXPY(buf, base) { float ws_ = ((base) < 64) ? w0 : w1; \
      _Pragma("unroll") for (int u = 0; u < 8; ++u) { \
        float f_[16]; P3_CVT(f_, buf[u]); float wk_ = rdlane(ws_, ((base) + u) & 63); \
        _Pragma("unroll") for (int i = 0; i < 16; ++i) oacc[i] += wk_ * f_[i]; } }
  float w0 = 0.f, w1 = 0.f;
  {
    u32x4 A[8], B[8];
    P3_LOAD(A, U8, 0)
#pragma unroll 1
    for (int kb = 0; kb < ne; kb += 16) {
      P3_LOAD(B, U8, kb + 8)
      P3_DOT(A, kb)
      if (kb + 16 < ne) { P3_LOAD(A, U8, kb + 16) }
      P3_DOT(B, kb + 8)
    }
  }
  w0 = gateL[lane] * gelu_(w0);
  w1 = gateL[64 + lane] * gelu_(w1);
  {
    u32x4 A[8], B[8];
    P3_LOAD(A, V8p, 0)
#pragma unroll 1
    for (int kb = 0; kb < ne; kb += 16) {
      P3_LOAD(B, V8p, kb + 8)
      P3_AXPY(A, kb)
      if (kb + 16 < ne) { P3_LOAD(A, V8p, kb + 16) }
      P3_AXPY(B, kb + 8)
    }
  }
}

DEV void p3_finish(const Params& p, int layer, int t, int lane, float (&oacc)[16]) {
  int te = t, le = lane;
  asm volatile("" : "+v"(te), "+v"(le));
  float* xr = p.X + (size_t)te * DM + le * 16;
  f32x4 xv[4];
#pragma unroll
  for (int c = 0; c < 4; ++c) {
    xv[c] = *(const f32x4*)(xr + c * 4);
    xv[c].x += oacc[c * 4 + 0] * (1.f / V_SCALE); xv[c].y += oacc[c * 4 + 1] * (1.f / V_SCALE);
    xv[c].z += oacc[c * 4 + 2] * (1.f / V_SCALE); xv[c].w += oacc[c * 4 + 3] * (1.f / V_SCALE);
  }
  if (layer < 3) {
    float ss = 0.f;
#pragma unroll
    for (int c = 0; c < 4; ++c) {
      *(f32x4*)(xr + c * 4) = xv[c];
      ss += xv[c].x * xv[c].x + xv[c].y * xv[c].y + xv[c].z * xv[c].z + xv[c].w * xv[c].w;
    }
    ss = wave_sum(ss);
    float rstd = rsqrtf(ss * (1.f / DM) + EPS);
    const float* g = p.norm_mix + (size_t)(layer + 1) * DM + le * 16;
    u32x4 o0, o1;
    f32x4 g0 = *(const f32x4*)(g), g1 = *(const f32x4*)(g + 4), g2 = *(const f32x4*)(g + 8), g3 = *(const f32x4*)(g + 12);
    o0.x = pack2(xv[0].x * rstd * g0.x, xv[0].y * rstd * g0.y); o0.y = pack2(xv[0].z * rstd * g0.z, xv[0].w * rstd * g0.w);
    o0.z = pack2(xv[1].x * rstd * g1.x, xv[1].y * rstd * g1.y); o0.w = pack2(xv[1].z * rstd * g1.z, xv[1].w * rstd * g1.w);
    o1.x = pack2(xv[2].x * rstd * g2.x, xv[2].y * rstd * g2.y); o1.y = pack2(xv[2].z * rstd * g2.z, xv[2].w * rstd * g2.w);
    o1.z = pack2(xv[3].x * rstd * g3.x, xv[3].y * rstd * g3.y); o1.w = pack2(xv[3].z * rstd * g3.z, xv[3].w * rstd * g3.w);
    *(u32x4*)(p.H + (size_t)te * DM + le * 16) = o0;
    *(u32x4*)(p.H + (size_t)te * DM + le * 16 + 8) = o1;
  } else {
    float* yo = nullptr;
    if (te >= NMETA && te < LP) yo = p.out + O_YP + (size_t)(te - NMETA) * DM + le * 16;
    else if (te >= LP) yo = p.out + O_YS + (size_t)(te - LP) * DM + le * 16;
    if (yo) {
#pragma unroll
      for (int c = 0; c < 4; ++c) *(f32x4*)(yo + c * 4) = xv[c];
    }
  }
}

DEV void ph_p3(const Params& p, int layer, char* smem) {
  int tid = otid(), lane = tid & 63, wid = tid >> 6;
  int* eidL = (int*)smem + wid * 256;
  float* gateL = (float*)(eidL + 128);
  float* part = (float*)(smem + 4096);
  float* svL = (float*)(smem + 20480) + wid * 512;
  int ca = 0, cb = 0; bool cvalid = false;
  {
    int cnt = 0;
    for (int a = 0; a < 16; ++a) {
      int nb = 16 / (a + 1);
      if (lane >= cnt && lane < cnt + nb) { ca = a; cb = lane - cnt; cvalid = true; }
      cnt += nb;
    }
  }
  int gw = (blockIdx.x * blockDim.x + tid) >> 6, nw = (gridDim.x * blockDim.x) >> 6;
  int tmain = (TTOK / nw) * nw;
  for (int t = gw; t < tmain; t += nw) {
    float oacc[16];
#pragma unroll
    for (int i = 0; i < 16; ++i) oacc[i] = 0.f;
    p3_partial(p, t, 0, 8, lane, eidL, gateL, svL, ca, cb, cvalid, oacc);
    p3_finish(p, layer, t, lane, oacc);
  }
  for (int t = tmain + blockIdx.x; t < TTOK; t += gridDim.x) {
    float oacc[16];
#pragma unroll
    for (int i = 0; i < 16; ++i) oacc[i] = 0.f;
    p3_partial(p, t, wid * 2, 2, lane, eidL, gateL, svL, ca, cb, cvalid, oacc);
    __syncthreads();
#pragma unroll
    for (int i = 0; i < 16; ++i) part[(wid * 64 + lane) * 16 + i] = oacc[i];
    __syncthreads();
    if (wid == 0) {
#pragma unroll
      for (int i = 0; i < 16; ++i) oacc[i] = part[lane * 16 + i] + part[(64 + lane) * 16 + i] + part[(128 + lane) * 16 + i] + part[(192 + lane) * 16 + i];
      p3_finish(p, layer, t, lane, oacc);
    }
  }
}

constexpr int NPHASE = 23;
#ifndef DBG_PHASES
#define DBG_PHASES NPHASE
#endif
#ifndef DBG_SCALES
#define DBG_SCALES {1,1,1,1,1,1,1,1,1,1,1,1,1,1,1,1,1,1,1,1}
#endif
#ifndef DBG_POST
#define DBG_POST 0
#endif
DEV void post_scale(const Params& p) {
  const float sc[20] = DBG_SCALES;
  const size_t offs[11] = {O_YP, O_YS, O_FKP, O_FVP, O_FLP, O_SRP, O_FKS, O_FVS, O_FLS, O_SRS, O_SRS + (size_t)2 * 8 * 4 * 256 * 512};
  size_t i0 = (size_t)blockIdx.x * blockDim.x + otid(), st = (size_t)gridDim.x * blockDim.x;
#pragma unroll
  for (int k = 0; k < 20; ++k) {
    float f = sc[k];
    if (f == 1.f) continue;
    size_t a = offs[k >> 1], b = offs[(k >> 1) + 1], mid = a + (b - a) / 2;
    size_t lo = (k & 1) ? mid : a, hi = (k & 1) ? b : mid;
    for (size_t i = lo + i0; i < hi; i += st) p.out[i] *= f;
  }
}
DEV void dump_x(const Params& p) {
  size_t i = (size_t)blockIdx.x * blockDim.x + otid(), st = (size_t)gridDim.x * blockDim.x;
  for (; i < (size_t)(TTOK - NMETA) * DM; i += st) p.out[i] = p.X[(size_t)NMETA * DM + i];
}
__global__ void __launch_bounds__(256, 2) mega(Params p, int ph0, int ph1) {
  __shared__ __attribute__((aligned(16))) char smem[53248];
  for (int ph = ph0; ph < ph1; ++ph) {
    if (ph > ph0) cg::this_grid().sync();
    if (ph == 0) { ph_prep(p, smem); continue; }
    int q = ph - 1, layer, idx;
    if (q < 5) { layer = 0; idx = q; } else if (q < 11) { layer = 1; idx = q - 5; }
    else if (q < 16) { layer = 2; idx = q - 11; } else { layer = 3; idx = q - 16; }
    int j = layer >> 1;
    const float* gffn = p.norm_ffn + (size_t)layer * DM;
    if ((layer & 1) == 0) {
      if (idx == 0) ph_f1(p, j, smem);
      else if (idx == 1) ph_f2(p, j, smem);
      else if (idx == 2) ph_outproj(p, p.AO, 1024, p.WfoutT + (size_t)j * 1024 * 1024, gffn, smem);
      else if (idx == 3) ph_p2(p, layer, smem);
      else ph_p3(p, layer, smem);
    } else {
      if (idx == 0) ph_r1(p, j, smem);
      else if (idx == 1) { ph_r2(p, j); conv_tables(p, layer); }
      else if (idx == 2) ph_r3(p, j, smem);
      else if (idx == 3) ph_outproj(p, p.Gr, 2048, p.WroutT + (size_t)j * 1024 * 2048, gffn, smem);
      else if (idx == 4) ph_p2(p, layer, smem);
      else ph_p3(p, layer, smem);
    }
  }
}

extern "C" void kernel_launch(void* const* d_in, const int* in_sizes, int n_in, void* d_out, int out_size,
                              void* d_ws, size_t ws_size, hipStream_t stream) {
  static int grid_blocks = 0;
  if (!grid_blocks) {
    int dev = 0, cus = 0, per_cu = 0;
    hipGetDevice(&dev);
    hipDeviceGetAttribute(&cus, hipDeviceAttributeMultiprocessorCount, dev);
    hipOccupancyMaxActiveBlocksPerMultiprocessor(&per_cu, mega, 256, 0);
    if (per_cu > 2) per_cu = 2;
    if (per_cu < 1) per_cu = 1;
    grid_blocks = cus * per_cu;
  }
  Params p;
  memset(&p, 0, sizeof(p));
  const float* const* in = (const float* const*)d_in;
  p.x_prompt = in[0]; p.x_sample = in[1]; p.cache_k = in[2]; p.cache_v = in[3]; p.cache_lf = in[4]; p.state_ret = in[5];
  p.meta = in[6]; p.norm_mix = in[7]; p.norm_ffn = in[8]; p.fox_w_in = in[9]; p.fox_b_f = in[10]; p.fox_qn = in[11];
  p.fox_kn = in[12]; p.fox_w_out = in[13]; p.ret_w_in = in[14]; p.ret_gn = in[15]; p.ret_w_out = in[16];
  p.peer_wq = in[17]; p.peer_sk = in[18]; p.peer_u = in[19]; p.peer_v = in[20];
  p.out = (float*)d_out;
  char* w = (char*)d_ws;
  size_t off = 0;
  auto take = [&](size_t bytes) { char* r = w + off; off += (bytes + 255) & ~(size_t)255; return r; };
  p.X = (float*)take((size_t)TPAD * DM * 4);
  p.H = (u16*)take((size_t)TPAD * DM * 2);
  p.WfinT = (u16*)take((size_t)2 * 4224 * 1024 * 2);
  p.WfoutT = (u16*)take((size_t)2 * 1024 * 1024 * 2);
  p.WrinT = (u16*)take((size_t)2 * 6144 * 1024 * 2);
  p.WroutT = (u16*)take((size_t)2 * 1024 * 2048 * 2);
  p.WpqT = (u16*)take((size_t)4 * 2048 * 1024 * 2);
  p.SKb = (u16*)take((size_t)4 * 8 * 2 * 128 * 128 * 2);
  p.Ub = (u16*)take((size_t)NEXP * DM * 2);
  p.Vb = (u16*)take((size_t)NEXP * DM * 2);
  p.SV = (float*)take((size_t)TPAD * 256 * 4);
  p.SI = (int*)take((size_t)TPAD * 256 * 4);
  p.LFC = (float*)take((size_t)TPAD * 16 * 4);
  p.LFR = (float*)take((size_t)TPAD * 16 * 4);
  p.TT = (float*)take((size_t)MTILES * 16 * 4);
  p.SSQ = (unsigned long long*)take((size_t)TPAD * 8);
  p.QCTR = (int*)take(256);
  size_t region = off;
  p.Qf = (u16*)take((size_t)TPAD * DM * 2);
  p.Kf = (u16*)take((size_t)TPAD * DM * 2);
  p.VtF = (u16*)take((size_t)1024 * TPAD * 2);
  p.OGf = (u16*)take((size_t)TPAD * DM * 2);
  p.AO = (u16*)take((size_t)TPAD * DM * 2);
  off = region;
  p.Qr = (u16*)take((size_t)TP2 * DM * 2);
  p.Kr = (u16*)take((size_t)TP2 * DM * 2);
  p.KrT = (u16*)take((size_t)1024 * TP2 * 2);
  p.VrT = (u16*)take((size_t)2048 * TP2 * 2);
  p.Gr = (u16*)take((size_t)TPAD * 2048 * 2);
  p.ST = (u16*)take((size_t)NCH * 4 * 512 * 256 * 2);
  if (off > ws_size) { fprintf(stderr, "workspace too small: need %zu have %zu\n", off, ws_size); return; }
  for (int i = 0; i < 128; ++i) p.rope_rev[i] = (float)(pow(10000.0, -(double)i / 128.0) / (2.0 * M_PI));
#if ONE_LAUNCH
  int ph0 = 0, ph1 = NPHASE;
  void* args[] = {&p, &ph0, &ph1};
  hipError_t e = hipLaunchCooperativeKernel((void*)mega, dim3(grid_blocks), dim3(256), args, 0, stream);
  if (e != hipSuccess) fprintf(stderr, "cooperative launch failed: %s (grid %d)\n", hipGetErrorString(e), grid_blocks);
#else
  for (int ph = 0; ph < NPHASE; ++ph) mega<<<grid_blocks, 256, 0, stream>>>(p, ph, ph + 1);
#endif
}
```

```cpp
#include <hip/hip_runtime.h>
#include <hip/hip_cooperative_groups.h>
#include <stdint.h>
#include <math.h>
#include <stdio.h>
#include <string.h>
namespace cg = cooperative_groups;

typedef unsigned short u16;
typedef __attribute__((ext_vector_type(8))) short bf16x8;
typedef __attribute__((ext_vector_type(4))) float f32x4;
typedef __attribute__((ext_vector_type(2))) float f32x2;
typedef __attribute__((ext_vector_type(4))) unsigned int u32x4;
typedef __attribute__((ext_vector_type(2))) unsigned int u32x2;
#define DEV __device__ __forceinline__

#ifndef ONE_LAUNCH
#define ONE_LAUNCH 1
#endif

constexpr int DM = 1024;
constexpr int NMETA = 16;
constexpr int LP = 16400;
constexpr int NSMP = 128;
constexpr int TTOK = LP + NSMP;
constexpr int TPAD = 16640;
constexpr int MTILES = 130;
constexpr int LEAD = 48;
constexpr int TP2 = 16704;
constexpr int NCH = 257;
constexpr int PAST = 1024;
constexpr int NEXP = 16384;
constexpr float EPS = 1e-6f;

constexpr size_t O_YP = 0;
constexpr size_t O_YS = O_YP + (size_t)16384 * 1024;
constexpr size_t O_FKP = O_YS + (size_t)128 * 1024;
constexpr size_t O_FVP = O_FKP + (size_t)2 * LP * 1024;
constexpr size_t O_FLP = O_FVP + (size_t)2 * LP * 1024;
constexpr size_t O_SRP = O_FLP + (size_t)2 * LP * 16;
constexpr size_t O_FKS = O_SRP + (size_t)2 * 4 * 256 * 512;
constexpr size_t O_FVS = O_FKS + (size_t)2 * 128 * 1024;
constexpr size_t O_FLS = O_FVS + (size_t)2 * 128 * 1024;
constexpr size_t O_SRS = O_FLS + (size_t)2 * 128 * 16;

struct Params {
  const float *x_prompt, *x_sample, *cache_k, *cache_v, *cache_lf, *state_ret, *meta, *norm_mix, *norm_ffn;
  const float *fox_w_in, *fox_b_f, *fox_qn, *fox_kn, *fox_w_out, *ret_w_in, *ret_gn, *ret_w_out;
  const float *peer_wq, *peer_sk, *peer_u, *peer_v;
  float* out;
  float* X; u16* H;
  u16 *WfinT, *WfoutT, *WrinT, *WroutT, *WpqT, *SKb, *Ub, *Vb;
  float *SV; int* SI;
  float *LFC, *LFR, *TT; unsigned long long* SSQ; int* QCTR;
  u16 *Qf, *Kf, *VtF, *OGf, *AO;
  u16 *Qr, *Kr, *KrT, *VrT, *Gr, *ST;
  float rope_rev[128];
};

typedef __attribute__((ext_vector_type(2))) float f2cv_t;
typedef __attribute__((ext_vector_type(2))) __bf16 bf2cv_t;
DEV uint32_t pack2(float a, float b) { f2cv_t v = {a, b}; bf2cv_t r = __builtin_convertvector(v, bf2cv_t); return __builtin_bit_cast(uint32_t, r); }
DEV u16 f2bf(float f) { return (u16)(pack2(f, 0.f) & 0xffffu); }
DEV float bf2f(u16 h) { return __uint_as_float(((uint32_t)h) << 16); }
DEV float bflo(uint32_t u) { return __uint_as_float(u << 16); }
DEV float bfhi(uint32_t u) { return __uint_as_float(u & 0xffff0000u); }

union V8 { bf16x8 v; uint32_t u[4]; u32x2 d[2]; u32x4 q; };

DEV f32x4 mfma(bf16x8 a, bf16x8 b, f32x4 c) { return __builtin_amdgcn_mfma_f32_16x16x32_bf16(a, b, c, 0, 0, 0); }

template <int CTRL> DEV float dppf(float v) {
  return __int_as_float(__builtin_amdgcn_update_dpp(0, __float_as_int(v), CTRL, 0xf, 0xf, false));
}
template <int CTRL> DEV uint32_t dppu(uint32_t v) {
  return (uint32_t)__builtin_amdgcn_update_dpp(0, (int)v, CTRL, 0xf, 0xf, false);
}
DEV float row16_sum(float v) {
  v += dppf<0xB1>(v); v += dppf<0x4E>(v); v += dppf<0x141>(v); v += dppf<0x140>(v);
  return v;
}
DEV uint32_t row16_maxu(uint32_t v) {
  v = max(v, dppu<0xB1>(v)); v = max(v, dppu<0x4E>(v)); v = max(v, dppu<0x141>(v)); v = max(v, dppu<0x140>(v));
  return v;
}
DEV float rdlane(float v, int l) { float r = __int_as_float(__builtin_amdgcn_readlane(__float_as_int(v), l)); asm volatile("" : "+v"(r)); return r; }
DEV float wave_sum(float v) {
  v = row16_sum(v);
  return rdlane(v, 0) + rdlane(v, 16) + rdlane(v, 32) + rdlane(v, 48);
}
DEV float wave_max(float v) {
  v = fmaxf(v, dppf<0xB1>(v)); v = fmaxf(v, dppf<0x4E>(v)); v = fmaxf(v, dppf<0x141>(v)); v = fmaxf(v, dppf<0x140>(v));
  return fmaxf(fmaxf(rdlane(v, 0), rdlane(v, 16)), fmaxf(rdlane(v, 32), rdlane(v, 48)));
}
DEV uint32_t wave_maxu(uint32_t v) {
  v = row16_maxu(v);
  uint32_t a = (uint32_t)__builtin_amdgcn_readlane((int)v, 0), b = (uint32_t)__builtin_amdgcn_readlane((int)v, 16);
  uint32_t c = (uint32_t)__builtin_amdgcn_readlane((int)v, 32), d = (uint32_t)__builtin_amdgcn_readlane((int)v, 48);
  return max(max(a, b), max(c, d));
}
DEV uint32_t f2key(float f) { uint32_t u = __float_as_uint(f); return (u & 0x80000000u) ? ~u : (u | 0x80000000u); }
DEV float key2f(uint32_t k) { uint32_t u = (k & 0x80000000u) ? (k & 0x7fffffffu) : ~k; return __uint_as_float(u); }

DEV float sigmoidf_(float x) { return 1.f / (1.f + __expf(-x)); }
DEV float logsigmoid_(float x) { return fminf(x, 0.f) - log1pf(expf(-fabsf(x))); }
DEV float gelu_(float x) { return 0.5f * x * (1.f + erff(x * 0.70710678118654752f)); }
DEV float ret_l2g(int h) { return log2f(1.f - exp2f(-5.f - (float)h)); }
DEV int otid() { int t = threadIdx.x; asm volatile("" : "+v"(t)); return t; }
DEV size_t tix(int rows, int h, int row, int pp) { return ((size_t)(h * 261 + (pp >> 6)) * rows + row) * 64 + (pp & 63); }
DEV int perm_dorig(int dp) { return ((dp >> 4) & 1) * 128 + (dp >> 5) * 16 + (dp & 15); }

DEV void norm_rows(const Params& p, const float* gain, bool from_input) {
  int tid_ = otid();
  int lane = tid_ & 63;
  int gw = (blockIdx.x * blockDim.x + tid_) >> 6, nw = (gridDim.x * blockDim.x) >> 6;
  for (int t = gw; t < TPAD; t += nw) {
    const float* src;
    if (from_input) {
      if (t < NMETA) src = p.meta + (size_t)t * DM;
      else if (t < LP) src = p.x_prompt + (size_t)(t - NMETA) * DM;
      else if (t < TTOK) src = p.x_sample + (size_t)(t - LP) * DM;
      else src = nullptr;
    } else src = p.X + (size_t)t * DM;
    f32x4 v[4];
    float ss = 0.f;
#pragma unroll
    for (int c = 0; c < 4; ++c) {
      if (src) v[c] = *(const f32x4*)(src + c * 256 + lane * 4); else v[c] = f32x4{0.f, 0.f, 0.f, 0.f};
      ss += v[c].x * v[c].x + v[c].y * v[c].y + v[c].z * v[c].z + v[c].w * v[c].w;
    }
    ss = wave_sum(ss);
    float rstd = rsqrtf(ss * (1.f / DM) + EPS);
#pragma unroll
    for (int c = 0; c < 4; ++c) {
      if (from_input) *(f32x4*)(p.X + (size_t)t * DM + c * 256 + lane * 4) = v[c];
      f32x4 g = *(const f32x4*)(gain + c * 256 + lane * 4);
      u32x2 o;
      o.x = pack2(v[c].x * rstd * g.x, v[c].y * rstd * g.y);
      o.y = pack2(v[c].z * rstd * g.z, v[c].w * rstd * g.w);
      *(u32x2*)(p.H + (size_t)t * DM + c * 256 + lane * 4) = o;
    }
  }
}

DEV void convert_bf16(const float* src, u16* dst, size_t n4) {
  size_t i = (size_t)blockIdx.x * blockDim.x + otid(), st = (size_t)gridDim.x * blockDim.x;
  for (; i < n4; i += st) {
    f32x4 v = ((const f32x4*)src)[i];
    u32x2 o; o.x = pack2(v.x, v.y); o.y = pack2(v.z, v.w);
    ((u32x2*)dst)[i] = o;
  }
}

DEV void xpose(const float* W, int K, int N, int Npad, u16* Wt, bool permq, char* smem) {
  u16* tile = (u16*)smem;
  int tid = otid();
  int ntn = Npad / 64, ntk = K / 64;
  for (int it = blockIdx.x; it < ntn * ntk; it += gridDim.x) {
    int n0 = (it / ntk) * 64, k0 = (it % ntk) * 64;
    int c = tid & 63, r0 = tid >> 6;
    int np = n0 + c;
    int src = np;
    if (permq && np < 2048) src = (np & ~255) + perm_dorig(np & 255);
    __syncthreads();
#pragma unroll
    for (int i = 0; i < 16; ++i) {
      int k = r0 + 4 * i;
      float v = (np < N) ? W[(size_t)(k0 + k) * N + src] : 0.f;
      tile[c * 72 + k] = f2bf(v);
    }
    __syncthreads();
    int nl = tid >> 2, kq = (tid & 3) * 16;
    u32x4 a = *(const u32x4*)(tile + nl * 72 + kq);
    u32x4 b = *(const u32x4*)(tile + nl * 72 + kq + 8);
    *(u32x4*)(Wt + (size_t)(n0 + nl) * K + k0 + kq) = a;
    *(u32x4*)(Wt + (size_t)(n0 + nl) * K + k0 + kq + 8) = b;
  }
}

typedef __attribute__((ext_vector_type(2))) float v2f_t;
constexpr float U_SCALE = 64.f, V_SCALE = 16.f;
DEV void convert_fp8(const float* src, uint32_t* dst, size_t n4, float scale) {
  size_t i = (size_t)blockIdx.x * blockDim.x + otid(), st = (size_t)gridDim.x * blockDim.x;
  for (; i < n4; i += st) {
    f32x4 v = ((const f32x4*)src)[i];
    int w = __builtin_amdgcn_cvt_pk_fp8_f32(v.x * scale, v.y * scale, 0, false);
    w = __builtin_amdgcn_cvt_pk_fp8_f32(v.z * scale, v.w * scale, w, true);
    dst[i] = (uint32_t)w;
  }
}
DEV void conv_tables(const Params& p, int layer) {
  convert_fp8(p.peer_u + (size_t)layer * NEXP * DM, (uint32_t*)p.Ub, (size_t)NEXP * DM / 4, U_SCALE);
  convert_fp8(p.peer_v + (size_t)layer * NEXP * DM, (uint32_t*)p.Vb, (size_t)NEXP * DM / 4, V_SCALE);
}

DEV void ph_prep(const Params& p, char* smem) {
  norm_rows(p, p.norm_mix, true);
  convert_bf16(p.peer_sk, p.SKb, (size_t)4 * 8 * 2 * 128 * 128 / 4);
  for (int j = 0; j < 2; ++j) {
    xpose(p.fox_w_in + (size_t)j * 1024 * 4112, 1024, 4112, 4224, p.WfinT + (size_t)j * 4224 * 1024, false, smem);
    xpose(p.fox_w_out + (size_t)j * 1024 * 1024, 1024, 1024, 1024, p.WfoutT + (size_t)j * 1024 * 1024, false, smem);
    xpose(p.ret_w_in + (size_t)j * 1024 * 6144, 1024, 6144, 6144, p.WrinT + (size_t)j * 6144 * 1024, true, smem);
    xpose(p.ret_w_out + (size_t)j * 2048 * 1024, 2048, 1024, 1024, p.WroutT + (size_t)j * 1024 * 2048, false, smem);
  }
  for (int l = 0; l < 4; ++l)
    xpose(p.peer_wq + (size_t)l * 1024 * 2048, 1024, 2048, 2048, p.WpqT + (size_t)l * 2048 * 1024, false, smem);
}

DEV void tile_mn(int it, int NT, int& mt, int& nt) {
  const int GM = 8;
  int g = it / (GM * NT), r = it - g * (GM * NT);
  int gm = min(GM, MTILES - g * GM);
  nt = r / gm; mt = g * GM + (r - nt * gm);
}

constexpr int LDK = 72;
template <bool SWAP>
DEV void gemm_tile(const u16* __restrict__ A, int lda, const u16* __restrict__ Bt, int ldb, int K,
                          int m0, int n0, char* smem, f32x4 (&acc)[4][4]) {
  u16* sA = (u16*)smem;
  u16* sB = sA + 128 * LDK;
  int tid = otid(), lane = tid & 63, wid = tid >> 6;
  int wr = wid >> 1, wc = wid & 1, fr = lane & 15, fq = lane >> 4;
#pragma unroll
  for (int m = 0; m < 4; ++m)
#pragma unroll
    for (int n = 0; n < 4; ++n) acc[m][n] = f32x4{0.f, 0.f, 0.f, 0.f};
  u32x4 ra[4], rb[4];
  const u16* Ap = A + (size_t)(m0 + (tid >> 3)) * lda + (tid & 7) * 8;
  const u16* Bp = Bt + (size_t)(n0 + (tid >> 3)) * ldb + (tid & 7) * 8;
#pragma unroll
  for (int i = 0; i < 4; ++i) {
    ra[i] = *(const u32x4*)(Ap + (size_t)(32 * i) * lda);
    rb[i] = *(const u32x4*)(Bp + (size_t)(32 * i) * ldb);
  }
  for (int k0 = 0; k0 < K; k0 += 64) {
    __syncthreads();
#pragma unroll
    for (int i = 0; i < 4; ++i) {
      *(u32x4*)(sA + ((tid >> 3) + 32 * i) * LDK + (tid & 7) * 8) = ra[i];
      *(u32x4*)(sB + ((tid >> 3) + 32 * i) * LDK + (tid & 7) * 8) = rb[i];
    }
    __syncthreads();
    if (k0 + 64 < K) {
#pragma unroll
      for (int i = 0; i < 4; ++i) {
        ra[i] = *(const u32x4*)(Ap + (size_t)(32 * i) * lda + k0 + 64);
        rb[i] = *(const u32x4*)(Bp + (size_t)(32 * i) * ldb + k0 + 64);
      }
    }
#pragma unroll
    for (int ks = 0; ks < 2; ++ks) {
      bf16x8 af[4], bfv[4];
#pragma unroll
      for (int m = 0; m < 4; ++m) af[m] = *(const bf16x8*)(sA + (wr * 64 + m * 16 + fr) * LDK + ks * 32 + fq * 8);
#pragma unroll
      for (int n = 0; n < 4; ++n) bfv[n] = *(const bf16x8*)(sB + (wc * 64 + n * 16 + fr) * LDK + ks * 32 + fq * 8);
#pragma unroll
      for (int m = 0; m < 4; ++m)
#pragma unroll
        for (int n = 0; n < 4; ++n) acc[m][n] = SWAP ? mfma(bfv[n], af[m], acc[m][n]) : mfma(af[m], bfv[n], acc[m][n]);
    }
  }
}

DEV void ph_f1(const Params& p, int jf, char* smem) {
  if (blockIdx.x == 0 && otid() == 0) p.QCTR[0] = 0;
  { unsigned int z_ = 0; asm volatile("" : "+v"(z_));
    for (int i = blockIdx.x * blockDim.x + otid(); i < TPAD; i += gridDim.x * blockDim.x) p.SSQ[i] = (unsigned long long)z_; }
  const u16* Wt = p.WfinT + (size_t)jf * 4224 * 1024;
  int tid = otid(), lane = tid & 63, wid = tid >> 6;
  int wr = wid >> 1, wc = wid & 1, fr = lane & 15, fq = lane >> 4;
  const int NT = 33;
  for (int it = blockIdx.x; it < MTILES * NT; it += gridDim.x) {
    int mt, nt; tile_mn(it, NT, mt, nt);
    int m0 = mt * 128;
    f32x4 acc[4][4];
    int type = nt >> 3;
    if (type == 2 || type == 4) gemm_tile<false>(p.H, DM, Wt, DM, DM, m0, nt * 128, smem, acc);
    else gemm_tile<true>(p.H, DM, Wt, DM, DM, m0, nt * 128, smem, acc);
    if (type <= 1) {
      int hh = (nt & 7) * 2 + wc;
      const float* gn = (type == 0 ? p.fox_qn : p.fox_kn) + jf * 64;
      const float gs = (type == 0) ? 0.125f * 1.44269504089f : 1.f;
      f32x4 g[4];
#pragma unroll
      for (int n = 0; n < 4; ++n) g[n] = *(const f32x4*)(gn + n * 16 + fq * 4) * gs;
#pragma unroll
      for (int m = 0; m < 4; ++m) {
        float ss = 0.f;
#pragma unroll
        for (int n = 0; n < 4; ++n)
#pragma unroll
          for (int j = 0; j < 4; ++j) ss += acc[m][n][j] * acc[m][n][j];
        ss += __shfl_xor(ss, 16); ss += __shfl_xor(ss, 32);
        float rstd = rsqrtf(ss * (1.f / 64.f) + EPS);
        int row = m0 + wr * 64 + m * 16 + fr;
#pragma unroll
        for (int n = 0; n < 4; ++n) {
          f32x4 v = acc[m][n] * rstd * g[n];
          int col = hh * 64 + n * 16 + fq * 4;
          u32x2 o; o.x = pack2(v.x, v.y); o.y = pack2(v.z, v.w);
          if (type == 0) *(u32x2*)(p.Qf + (size_t)row * DM + col) = o;
          else {
            *(u32x2*)(p.Kf + (size_t)row * DM + col) = o;
            if (row < LP) *(f32x4*)(p.out + O_FKP + ((size_t)jf * LP + row) * 1024 + col) = v;
            else if (row < TTOK) *(f32x4*)(p.out + O_FKS + ((size_t)jf * 128 + (row - LP)) * 1024 + col) = v;
          }
        }
      }
    } else if (type == 2) {
      int hh = (nt & 7) * 2 + wc;
#pragma unroll
      for (int m = 0; m < 4; ++m) {
        int rb = m0 + wr * 64 + m * 16 + fq * 4;
#pragma unroll
        for (int n = 0; n < 4; ++n) {
          int d = n * 16 + fr;
          u32x2 o; o.x = pack2(acc[m][n][0], acc[m][n][1]); o.y = pack2(acc[m][n][2], acc[m][n][3]);
          *(u32x2*)(p.VtF + (size_t)(hh * 64 + d) * TPAD + rb) = o;
#pragma unroll
          for (int j = 0; j < 4; ++j) {
            int row = rb + j; int col = hh * 64 + d;
            if (row < LP) p.out[O_FVP + ((size_t)jf * LP + row) * 1024 + col] = acc[m][n][j];
            else if (row < TTOK) p.out[O_FVS + ((size_t)jf * 128 + (row - LP)) * 1024 + col] = acc[m][n][j];
          }
        }
      }
    } else if (type == 3) {
#pragma unroll
      for (int m = 0; m < 4; ++m)
#pragma unroll
        for (int n = 0; n < 4; ++n) {
          int row = m0 + wr * 64 + m * 16 + fr;
          int col = (nt - 24) * 128 + wc * 64 + n * 16 + fq * 4;
          u32x2 o; o.x = pack2(acc[m][n][0], acc[m][n][1]); o.y = pack2(acc[m][n][2], acc[m][n][3]);
          *(u32x2*)(p.OGf + (size_t)row * DM + col) = o;
        }
    } else {
      float* lfs = (float*)smem;
      __syncthreads();
      if (wc == 0) {
        float bf = p.fox_b_f[jf * 16 + fr];
#pragma unroll
        for (int m = 0; m < 4; ++m)
#pragma unroll
          for (int j = 0; j < 4; ++j) {
            int rl = wr * 64 + m * 16 + fq * 4 + j;
            int row = m0 + rl;
            float lf = logsigmoid_(acc[m][0][j] + bf);
            lfs[rl * 16 + fr] = lf;
            p.LFR[(size_t)row * 16 + fr] = lf;
            if (row < LP) p.out[O_FLP + ((size_t)jf * LP + row) * 16 + fr] = lf;
            else if (row < TTOK) p.out[O_FLS + ((size_t)jf * 128 + (row - LP)) * 16 + fr] = lf;
          }
      }
      __syncthreads();
      if (tid < 16) {
        float run = 0.f;
        for (int r = 0; r < 128; ++r) {
          run += lfs[r * 16 + tid];
          p.LFC[(size_t)(m0 + r) * 16 + tid] = run;
        }
        p.TT[mt * 16 + tid] = run;
      }
    }
  }
}

template <bool MASK>
DEV void attn_tile(const u16* Kb, const u16* Vb, const float* cb, int key0, int q0, int fr, int fq,
                   const bf16x8 (&qf)[4][2], const float (&cq)[4], float (&lrow)[4], f32x4 (&o)[4][4]) {
  const bool diag = MASK;
#pragma unroll
  for (int pp = 0; pp < 2; ++pp) {
        V8 pfu[4];
#pragma unroll
        for (int kl = 0; kl < 2; ++kl) {
          f32x4 s1[4];
          f32x4 ck = *(const f32x4*)(cb + (2 * pp + kl) * 16 + fq * 4);
#pragma unroll
          for (int qi = 0; qi < 4; ++qi) s1[qi] = cq[qi] - ck;
#pragma unroll
          for (int ks = 0; ks < 2; ++ks) {
            bf16x8 a = *(const bf16x8*)(Kb + ((2 * pp + kl) * 16 + fr) * LDK + ks * 32 + fq * 8);
#pragma unroll
            for (int qi = 0; qi < 4; ++qi) s1[qi] = mfma(a, qf[qi][ks], s1[qi]);
          }
#pragma unroll
          for (int qi = 0; qi < 4; ++qi) {
            int q = q0 + qi * 16 + fr;
            float e[4];
#pragma unroll
            for (int j = 0; j < 4; ++j) {
              float v = s1[qi][j];
              if (diag && (key0 + (2 * pp + kl) * 16 + fq * 4 + j > q)) v = -INFINITY;
              e[j] = __builtin_amdgcn_exp2f(v);
            }
            lrow[qi] += (e[0] + e[1]) + (e[2] + e[3]);
            pfu[qi].u[kl * 2 + 0] = pack2(e[0], e[1]);
            pfu[qi].u[kl * 2 + 1] = pack2(e[2], e[3]);
          }
        }
        bf16x8 pf[4];
#pragma unroll
        for (int qi = 0; qi < 4; ++qi) pf[qi] = pfu[qi].v;
#pragma unroll
        for (int dt = 0; dt < 4; ++dt) {
          V8 a;
          a.d[0] = *(const u32x2*)(Vb + (dt * 16 + fr) * LDK + (2 * pp) * 16 + fq * 4);
          a.d[1] = *(const u32x2*)(Vb + (dt * 16 + fr) * LDK + (2 * pp + 1) * 16 + fq * 4);
#pragma unroll
          for (int qi = 0; qi < 4; ++qi) o[dt][qi] = mfma(a.v, pf[qi], o[dt][qi]);
        }
      }
}

DEV void f2_prompt(const Params& p, int qt, int h, char* smem) {
  u16* Ks = (u16*)smem;
  u16* Vs = Ks + 2 * 64 * LDK;
  float* cs = (float*)(Vs + 2 * 64 * LDK);
  float* off = cs + 128;
  float* tmp = off + 132;
  int tid = otid(), lane = tid & 63, wid = tid >> 6, fr = lane & 15, fq = lane >> 4;
  __syncthreads();
  if (tid < MTILES) tmp[tid] = p.TT[tid * 16 + h];
  __syncthreads();
  if (tid < MTILES) { float s = 0.f; for (int m = 0; m < tid; ++m) s += tmp[m]; off[tid] = s; }
  __syncthreads();
  int q0 = qt * 256 + wid * 64;
  bf16x8 qf[4][2];
  float cq[4], lrow[4];
  f32x4 o[4][4];
#pragma unroll
  for (int qi = 0; qi < 4; ++qi) {
    int q = q0 + qi * 16 + fr;
#pragma unroll
    for (int ks = 0; ks < 2; ++ks) qf[qi][ks] = *(const bf16x8*)(p.Qf + (size_t)q * DM + h * 64 + ks * 32 + fq * 8);
    cq[qi] = (p.LFC[(size_t)q * 16 + h] + off[q >> 7] - 12.f) * 1.44269504089f;
    lrow[qi] = 0.f;
#pragma unroll
    for (int dt = 0; dt < 4; ++dt) o[dt][qi] = f32x4{0.f, 0.f, 0.f, 0.f};
  }
  int nkt = 4 * (qt + 1);
  if (nkt > (LP + 63) / 64) nkt = (LP + 63) / 64;
  int* kst = (int*)(tmp + 132);
  if (tid == 0) {
    float cref = off[qt * 2];
    int m = 0;
    while (m < qt * 2 && cref - off[m + 1] < -45.f) ++m;
    kst[0] = m * 2;
  }
  __syncthreads();
  const int kt0 = kst[0];
  bool wave_valid = q0 < LP;
  u32x4 rk[2], rv[2]; float rc = 0.f;
  const int lrow_ = tid >> 2, lcol = (tid & 3) * 16;
  const u16* kfb = p.Kf + h * 64;
  const u16* vtb = p.VtF + (size_t)h * 64 * TPAD;
  const float* lcb = p.LFC + h;
  const unsigned kvo0 = (unsigned)(lrow_ * DM + lcol), kvo1 = kvo0 + 32u * DM;
  const unsigned vvo0 = (unsigned)(lrow_ * TPAD + lcol), vvo1 = vvo0 + 32u * TPAD;
#define GL(kt_) { int key0_ = (kt_) * 64; \
    const u16* kp_ = p.Kf + (size_t)(key0_ + lrow_) * DM + h * 64 + lcol; \
    const u16* vp_ = p.VtF + (size_t)(h * 64 + lrow_) * TPAD + key0_ + lcol; \
    rk[0] = *(const u32x4*)(kp_); rk[1] = *(const u32x4*)(kp_ + 8); \
    rv[0] = *(const u32x4*)(vp_); rv[1] = *(const u32x4*)(vp_ + 8); \
    if (tid < 64) rc = (p.LFC[(size_t)(key0_ + tid) * 16 + h] + off[(key0_ + tid) >> 7]) * 1.44269504089f; }
  GL(kt0);
  for (int kt = kt0; kt < nkt; ++kt) {
    int buf = kt & 1;
    u16* Kb = Ks + buf * 64 * LDK; u16* Vb = Vs + buf * 64 * LDK; float* cb = cs + buf * 64;
#pragma unroll
    for (int i = 0; i < 2; ++i) {
      *(u32x4*)(Kb + lrow_ * LDK + lcol + 8 * i) = rk[i];
      *(u32x4*)(Vb + lrow_ * LDK + lcol + 8 * i) = rv[i];
    }
    if (tid < 64) cb[tid] = rc;
    __syncthreads();
    if (kt + 1 < nkt) GL(kt + 1);
    int key0 = kt * 64;
    if (wave_valid && key0 <= q0 + 63) {
      if (key0 + 63 > q0) attn_tile<true>(Kb, Vb, cb, key0, q0, fr, fq, qf, cq, lrow, o);
      else attn_tile<false>(Kb, Vb, cb, key0, q0, fr, fq, qf, cq, lrow, o);
    }
  }
  int q0e = q0;
  asm volatile("" : "+v"(q0e));
#pragma unroll
  for (int qi = 0; qi < 4; ++qi) {
    float l = lrow[qi];
    l += __shfl_xor(l, 16); l += __shfl_xor(l, 32);
    float inv = 1.f / l;
    int q = q0e + qi * 16 + fr;
    if (q < LP) {
#pragma unroll
      for (int dt = 0; dt < 4; ++dt) {
        int d = dt * 16 + fq * 4;
        u32x2 og = *(const u32x2*)(p.OGf + (size_t)q * DM + h * 64 + d);
        u32x2 r;
        r.x = pack2(o[dt][qi][0] * inv * sigmoidf_(bflo(og.x)), o[dt][qi][1] * inv * sigmoidf_(bfhi(og.x)));
        r.y = pack2(o[dt][qi][2] * inv * sigmoidf_(bflo(og.y)), o[dt][qi][3] * inv * sigmoidf_(bfhi(og.y)));
        *(u32x2*)(p.AO + (size_t)q * DM + h * 64 + d) = r;
      }
    }
  }
}

DEV void f2_sample(const Params& p, int jf, int b, int h, int qh, char* smem) {
  constexpr int NK = PAST + 16;
  float* S = (float*)smem;
  float* qs = S + 8 * NK;
  float* cc = qs + 8 * 64;
  float* part = cc + NK;
  float* invl = part + 256;
  int tid = otid(), lane = tid & 63, wid = tid >> 6;
  __syncthreads();
  for (int e = tid; e < 512; e += 256) {
    int i = e >> 6, d = e & 63;
    qs[e] = bf2f(p.Qf[(size_t)(LP + b * 16 + qh * 8 + i) * DM + h * 64 + d]);
  }
  float lv[5]; float run = 0.f;
#pragma unroll
  for (int u = 0; u < 5; ++u) {
    int j = tid * 5 + u;
    float v = 0.f;
    if (j < PAST) v = p.cache_lf[(((size_t)jf * 8 + b) * PAST + j) * 16 + h];
    else if (j < NK) v = p.LFR[(size_t)(LP + b * 16 + (j - PAST)) * 16 + h];
    run += v; lv[u] = run;
  }
  part[tid] = run;
  __syncthreads();
  float base = 0.f;
  for (int m = 0; m < tid; ++m) base += part[m];
#pragma unroll
  for (int u = 0; u < 5; ++u) { int j = tid * 5 + u; if (j < NK) cc[j] = base + lv[u]; }
  __syncthreads();
  for (int j = tid; j < NK; j += 256) {
    const float* kp;
    if (j < PAST) kp = p.cache_k + ((((size_t)jf * 8 + b) * PAST + j) * 16 + h) * 64;
    else kp = p.out + O_FKS + (((size_t)jf * 128 + b * 16 + (j - PAST)) * 16 + h) * 64;
    f32x4 kv[16];
#pragma unroll
    for (int c = 0; c < 16; ++c) kv[c] = ((const f32x4*)kp)[c];
    float cj = cc[j];
#pragma unroll
    for (int i = 0; i < 8; ++i) {
      float a = 0.f;
#pragma unroll
      for (int c = 0; c < 16; ++c) {
        f32x4 qv = *(const f32x4*)(qs + i * 64 + c * 4);
        a += qv.x * kv[c].x + qv.y * kv[c].y + qv.z * kv[c].z + qv.w * kv[c].w;
      }
      int qi = qh * 8 + i;
      a = a * 0.69314718056f + (cc[PAST + qi] - cj);
      if (j > PAST + qi) a = -INFINITY;
      S[i * NK + j] = a;
    }
  }
  __syncthreads();
  for (int i = wid * 2; i < wid * 2 + 2; ++i) {
    float m = -INFINITY;
    for (int j = lane; j < NK; j += 64) m = fmaxf(m, S[i * NK + j]);
    m = wave_max(m);
    float l = 0.f;
    for (int j = lane; j < NK; j += 64) { float e = __expf(S[i * NK + j] - m); S[i * NK + j] = e; l += e; }
    l = wave_sum(l);
    if (lane == 0) invl[i] = 1.f / l;
  }
  __syncthreads();
  {
    int i = tid >> 5, dq = tid & 31;
    float o0 = 0.f, o1 = 0.f;
    const float* vb = p.cache_v + ((((size_t)jf * 8 + b) * PAST) * 16 + h) * 64 + dq * 2;
#pragma unroll 8
    for (int j = 0; j < PAST; ++j) {
      f32x2 v = *(const f32x2*)(vb + (size_t)j * 1024);
      float pj = S[i * NK + j];
      o0 += pj * v.x; o1 += pj * v.y;
    }
    const float* vn = p.out + O_FVS + (((size_t)jf * 128 + b * 16) * 16 + h) * 64 + dq * 2;
#pragma unroll
    for (int j = 0; j < 16; ++j) {
      f32x2 v = *(const f32x2*)(vn + (size_t)j * 1024);
      float pj = S[i * NK + PAST + j];
      o0 += pj * v.x; o1 += pj * v.y;
    }
    int row = LP + b * 16 + qh * 8 + i;
    float il = invl[i];
    uint32_t og = *(const uint32_t*)(p.OGf + (size_t)row * DM + h * 64 + dq * 2);
    *(uint32_t*)(p.AO + (size_t)row * DM + h * 64 + dq * 2) = pack2(o0 * il * sigmoidf_(bflo(og)), o1 * il * sigmoidf_(bfhi(og)));
  }
}

DEV void ph_f2(const Params& p, int jf, char* smem) {
  const int NP = 65 * 16, NI = NP + 256;
  {
    int gt = blockIdx.x * blockDim.x + otid(), gs = gridDim.x * blockDim.x;
    for (int i = gt; i < (TPAD - TTOK) * DM / 2; i += gs) ((uint32_t*)(p.AO + (size_t)TTOK * DM))[i] = 0u;
  }
  int* qslot = (int*)(smem + 53248 - 16);
  for (;;) {
    __syncthreads();
    if (otid() == 0) qslot[0] = atomicAdd(p.QCTR, 1);
    __syncthreads();
    int idx = qslot[0];
    if (idx >= NI) break;
    if (idx >= 256) { int pi = idx - 256; f2_prompt(p, 64 - pi / 16, pi % 16, smem); }
    else f2_sample(p, jf, idx >> 5, (idx >> 1) & 15, idx & 1, smem);
  }
  conv_tables(p, jf * 2);
}

DEV void ph_outproj(const Params& p, const u16* A, int K, const u16* Wt, const float* gffn, char* smem) {
  int tid = otid(), lane = tid & 63, wid = tid >> 6;
  int wr = wid >> 1, wc = wid & 1, fr = lane & 15, fq = lane >> 4;
  for (int it = blockIdx.x; it < MTILES * 8; it += gridDim.x) {
    int mt, nt; tile_mn(it, 8, mt, nt);
    f32x4 acc[4][4];
    gemm_tile<true>(A, K, Wt, K, K, mt * 128, nt * 128, smem, acc);
#pragma unroll
    for (int m = 0; m < 4; ++m) {
      int row = mt * 128 + wr * 64 + m * 16 + fr;
      float ss = 0.f;
#pragma unroll
      for (int n = 0; n < 4; ++n) {
        int col = nt * 128 + wc * 64 + n * 16 + fq * 4;
        f32x4* xp = (f32x4*)(p.X + (size_t)row * DM + col);
        f32x4 xn = *xp + acc[m][n];
        *xp = xn;
        f32x4 g = *(const f32x4*)(gffn + col);
        u32x2 o; o.x = pack2(xn.x * g.x, xn.y * g.y); o.y = pack2(xn.z * g.z, xn.w * g.w);
        *(u32x2*)(p.H + (size_t)row * DM + col) = o;
        ss += xn.x * xn.x + xn.y * xn.y + xn.z * xn.z + xn.w * xn.w;
      }
      ss += __shfl_xor(ss, 16); ss += __shfl_xor(ss, 32);
      if (fq == 0) atomicAdd(p.SSQ + row, (unsigned long long)(ss * 1048576.f + 0.5f));
    }
  }
}

DEV void ph_r1(const Params& p, int jr, char* smem) {
  const u16* Wt = p.WrinT + (size_t)jr * 6144 * 1024;
  int tid = otid(), lane = tid & 63, wid = tid >> 6;
  int wr = wid >> 1, wc = wid & 1, fr = lane & 15, fq = lane >> 4;
  {
    int gt = blockIdx.x * blockDim.x + tid, gs = gridDim.x * blockDim.x;
    for (int i = gt; i < LEAD * DM; i += gs) { p.Qr[i] = 0; p.Kr[i] = 0; }
    { unsigned int z_ = 0; asm volatile("" : "+v"(z_)); for (int i = gt; i < TPAD; i += gs) p.SSQ[i] = (unsigned long long)z_; }
    for (int i = gt; i < 1024 * LEAD; i += gs) p.KrT[tix(256, (i / LEAD) >> 8, (i / LEAD) & 255, i % LEAD)] = 0;
    for (int i = gt; i < 2048 * LEAD; i += gs) p.VrT[tix(512, (i / LEAD) >> 9, (i / LEAD) & 511, i % LEAD)] = 0;
  }
  const int NT = 48;
  for (int it = blockIdx.x; it < MTILES * NT; it += gridDim.x) {
    int mt, nt; tile_mn(it, NT, mt, nt);
    int m0 = mt * 128;
    f32x4 acc[4][4];
    if (nt >= 8 && nt < 32) gemm_tile<false>(p.H, DM, Wt, DM, DM, m0, nt * 128, smem, acc);
    else gemm_tile<true>(p.H, DM, Wt, DM, DM, m0, nt * 128, smem, acc);
    if (nt < 8) {
      int hh = nt >> 1, half = nt & 1;
#pragma unroll
      for (int pr = 0; pr < 2; ++pr) {
        int g = half * 4 + wc * 2 + pr;
        f32x4 rr = *(const f32x4*)(p.rope_rev + g * 16 + fq * 4);
#pragma unroll
        for (int m = 0; m < 4; ++m) {
          int row = m0 + wr * 64 + m * 16 + fr;
          int pos = (row < LP) ? (row - NMETA) : ((row < TTOK) ? (PAST + ((row - LP) & 15)) : 0);
          float o1[4], o2[4];
#pragma unroll
          for (int j = 0; j < 4; ++j) {
            float rev = (float)pos * rr[j];
            rev -= floorf(rev);
            float sn = __builtin_amdgcn_sinf(rev), cs = __builtin_amdgcn_cosf(rev);
            float x1 = acc[m][2 * pr][j], x2 = acc[m][2 * pr + 1][j];
            o1[j] = (x1 * cs - x2 * sn) * 0.0625f; o2[j] = (x1 * sn + x2 * cs) * 0.0625f;
          }
          u32x2 t1, t2;
          t1.x = pack2(o1[0], o1[1]); t1.y = pack2(o1[2], o1[3]);
          t2.x = pack2(o2[0], o2[1]); t2.y = pack2(o2[2], o2[3]);
          u16* dq = p.Qr + (size_t)(row + LEAD) * DM + hh * 256 + g * 32 + fq * 4;
          *(u32x2*)dq = t1;
          *(u32x2*)(dq + 16) = t2;
        }
      }
    } else if (nt < 16) {
      bool isq = false;
      int hh = (nt & 7) >> 1, half = nt & 1;
      float l2g = ret_l2g(hh);
      u16* dst = isq ? p.Qr : p.Kr;
#pragma unroll
      for (int pr = 0; pr < 2; ++pr) {
        int g = half * 4 + wc * 2 + pr;
        int fi = g * 16 + fr;
        float rr = p.rope_rev[fi];
        int dp1 = g * 32 + fr, dp2 = dp1 + 16;
#pragma unroll
        for (int m = 0; m < 4; ++m) {
          int rb = m0 + wr * 64 + m * 16 + fq * 4;
          float o1[4], o2[4];
#pragma unroll
          for (int j = 0; j < 4; ++j) {
            int row = rb + j;
            int pos = (row < LP) ? (row - NMETA) : ((row < TTOK) ? (PAST + ((row - LP) & 15)) : 0);
            float rev = (float)pos * rr;
            rev -= floorf(rev);
            float sn = __builtin_amdgcn_sinf(rev), cs = __builtin_amdgcn_cosf(rev);
            float x1 = acc[m][2 * pr][j], x2 = acc[m][2 * pr + 1][j];
            float a = x1 * cs - x2 * sn, bb = x1 * sn + x2 * cs;
            if (isq) { a *= 0.0625f; bb *= 0.0625f; }
            o1[j] = a; o2[j] = bb;
            dst[(size_t)(row + LEAD) * DM + hh * 256 + dp1] = f2bf(a);
            dst[(size_t)(row + LEAD) * DM + hh * 256 + dp2] = f2bf(bb);
          }
          if (!isq) {
            float dc[4];
#pragma unroll
            for (int j = 0; j < 4; ++j) dc[j] = exp2f(l2g * (float)(63 - ((rb + j + LEAD) & 63)));
            u32x2 t1, t2;
            t1.x = pack2(o1[0] * dc[0], o1[1] * dc[1]); t1.y = pack2(o1[2] * dc[2], o1[3] * dc[3]);
            t2.x = pack2(o2[0] * dc[0], o2[1] * dc[1]); t2.y = pack2(o2[2] * dc[2], o2[3] * dc[3]);
            *(u32x2*)(p.KrT + tix(256, hh, dp1, rb + LEAD)) = t1;
            *(u32x2*)(p.KrT + tix(256, hh, dp2, rb + LEAD)) = t2;
          }
        }
      }
    } else if (nt < 32) {
      int hh = (nt - 16) >> 2;
#pragma unroll
      for (int m = 0; m < 4; ++m) {
        int rb = m0 + wr * 64 + m * 16 + fq * 4;
#pragma unroll
        for (int n = 0; n < 4; ++n) {
          int e = ((nt - 16) & 3) * 128 + wc * 64 + n * 16 + fr;
          u32x2 o; o.x = pack2(acc[m][n][0], acc[m][n][1]); o.y = pack2(acc[m][n][2], acc[m][n][3]);
          *(u32x2*)(p.VrT + tix(512, hh, e, rb + LEAD)) = o;
        }
      }
    } else {
#pragma unroll
      for (int m = 0; m < 4; ++m)
#pragma unroll
        for (int n = 0; n < 4; ++n) {
          int row = m0 + wr * 64 + m * 16 + fr;
          int col = (nt - 32) * 128 + wc * 64 + n * 16 + fq * 4;
          u32x2 o; o.x = pack2(acc[m][n][0], acc[m][n][1]); o.y = pack2(acc[m][n][2], acc[m][n][3]);
          *(u32x2*)(p.Gr + (size_t)row * 2048 + col) = o;
        }
    }
  }
}

DEV void ph_r2(const Params& p, int jr) {
  int tid = otid(), lane = tid & 63, wid = tid >> 6, fr = lane & 15, fq = lane >> 4;
  for (int it = blockIdx.x; it < 256; it += gridDim.x) {
    int h = it >> 6, sl = (it >> 2) & 15, rt = (it & 3) * 4 + wid;
    float dec64 = exp2f(ret_l2g(h) * 64.f);
    f32x4 st[2];
    st[0] = f32x4{0.f, 0.f, 0.f, 0.f}; st[1] = st[0];
    const u16* kb = p.KrT + tix(256, h, rt * 16 + fr, 0) + fq * 8;
    const u16* vb = p.VrT + tix(512, h, sl * 32 + fr, 0) + fq * 8;
    u16* sp0 = p.ST + (((size_t)h * 16 + rt) * 512 + sl * 32 + fr) * 16 + fq * 4;
    bf16x8 A0[2], B0[4], A1[2], B1[4], A2[2], B2[4], A3[2], B3[4], A4[2], B4[4], A5[2], B5[4], A6[2], B6[4], A7[2], B7[4];
#define R2L(A, B, n_) { size_t nn_ = (size_t)min((n_), NCH - 1); \
      A[0] = *(const bf16x8*)(kb + nn_ * (256 * 64)); A[1] = *(const bf16x8*)(kb + nn_ * (256 * 64) + 32); \
      B[0] = *(const bf16x8*)(vb + nn_ * (512 * 64)); B[1] = *(const bf16x8*)(vb + nn_ * (512 * 64) + 32); \
      B[2] = *(const bf16x8*)(vb + nn_ * (512 * 64) + 16 * 64); B[3] = *(const bf16x8*)(vb + nn_ * (512 * 64) + 16 * 64 + 32); }
#define R2S(A, B, n_) { \
      _Pragma("unroll") for (int c = 0; c < 2; ++c) { \
        u32x2 o; o.x = pack2(st[c][0], st[c][1]); o.y = pack2(st[c][2], st[c][3]); \
        *(u32x2*)(sp0 + (size_t)(n_) * (4 * 16 * 512 * 16) + c * 16 * 16) = o; \
        f32x4 t = st[c] * dec64; \
        t = mfma(A[0], B[c * 2], t); t = mfma(A[1], B[c * 2 + 1], t); st[c] = t; } }
    R2L(A0, B0, 0) R2L(A1, B1, 1) R2L(A2, B2, 2) R2L(A3, B3, 3) R2L(A4, B4, 4) R2L(A5, B5, 5) R2L(A6, B6, 6) R2L(A7, B7, 7)
#pragma unroll 1
    for (int n = 0; n < 256; n += 8) {
      R2S(A0, B0, n + 0) R2L(A0, B0, n + 8)
      R2S(A1, B1, n + 1) R2L(A1, B1, n + 9)
      R2S(A2, B2, n + 2) R2L(A2, B2, n + 10)
      R2S(A3, B3, n + 3) R2L(A3, B3, n + 11)
      R2S(A4, B4, n + 4) R2L(A4, B4, n + 12)
      R2S(A5, B5, n + 5) R2L(A5, B5, n + 13)
      R2S(A6, B6, n + 6) R2L(A6, B6, n + 14)
      R2S(A7, B7, n + 7) R2L(A7, B7, n + 15)
    }
    R2S(A0, B0, 256)
    int fre = fr, fqe = fq;
    asm volatile("" : "+v"(fre), "+v"(fqe));
#pragma unroll
    for (int c = 0; c < 2; ++c)
#pragma unroll
      for (int j = 0; j < 4; ++j) {
        int dorig = perm_dorig(rt * 16 + fqe * 4 + j);
        p.out[O_SRP + ((size_t)(jr * 4 + h) * 256 + dorig) * 512 + sl * 32 + c * 16 + fre] = st[c][j];
      }
  }
}

DEV void r3_prompt(const Params& p, int jr, int n, int h, char* smem) {
  u32x4* Sf = (u32x4*)smem;
  float* red = (float*)(smem + 8192);
  int tid = otid(), lane = tid & 63, w = tid >> 6, fr = lane & 15, fq = lane >> 4;
  int p0 = n * 64;
  float l2g = ret_l2g(h);
  f32x4 acc[8][4];
#pragma unroll
  for (int a = 0; a < 8; ++a)
#pragma unroll
    for (int b = 0; b < 4; ++b) acc[a][b] = f32x4{0.f, 0.f, 0.f, 0.f};
  const u16* qb = p.Qr + (size_t)(p0 + fr) * DM + h * 256 + fq * 8;
  if (n >= 1) {
    const u16* sb = p.ST + (((size_t)(n * 4 + h) * 16 + (fq >> 1)) * 512 + w * 128 + fr) * 16 + (fq & 1) * 8;
#pragma unroll 1
    for (int ks = 0; ks < 8; ++ks) {
      bf16x8 bq[4];
#pragma unroll
      for (int it = 0; it < 4; ++it) bq[it] = *(const bf16x8*)(qb + (size_t)(it * 16) * DM + ks * 32);
#pragma unroll
      for (int dvt = 0; dvt < 8; ++dvt) {
        bf16x8 a = *(const bf16x8*)(sb + (size_t)(ks * 2) * (512 * 16) + dvt * 16 * 16);
#pragma unroll
        for (int it = 0; it < 4; ++it) acc[dvt][it] = mfma(a, bq[it], acc[dvt][it]);
      }
    }
#pragma unroll
    for (int it = 0; it < 4; ++it) {
      float qd = exp2f(l2g * (float)(it * 16 + fr + 1));
#pragma unroll
      for (int dvt = 0; dvt < 8; ++dvt) acc[dvt][it] = acc[dvt][it] * qd;
    }
  }
  {
    f32x4 s[4];
#pragma unroll
    for (int jt = 0; jt < 4; ++jt) s[jt] = f32x4{0.f, 0.f, 0.f, 0.f};
    const u16* kb = p.Kr + (size_t)(p0 + fr) * DM + h * 256 + fq * 8;
#pragma unroll 1
    for (int ks = 0; ks < 8; ++ks) {
      bf16x8 b = *(const bf16x8*)(qb + (size_t)(w * 16) * DM + ks * 32);
#pragma unroll
      for (int jt = 0; jt < 4; ++jt) {
        bf16x8 a = *(const bf16x8*)(kb + (size_t)(jt * 16) * DM + ks * 32);
        s[jt] = mfma(a, b, s[jt]);
      }
    }
    int i = w * 16 + fr;
#pragma unroll
    for (int jt = 0; jt < 4; ++jt)
#pragma unroll
      for (int jj = 0; jj < 4; ++jj) {
        int j = jt * 16 + fq * 4 + jj;
        int dd = i > j ? i - j : j - i;
        s[jt][jj] *= exp2f(l2g * (float)dd);
      }
    __syncthreads();
#pragma unroll
    for (int pp = 0; pp < 2; ++pp) {
      u32x4 t;
      t.x = pack2(s[2 * pp][0], s[2 * pp][1]); t.y = pack2(s[2 * pp][2], s[2 * pp][3]);
      t.z = pack2(s[2 * pp + 1][0], s[2 * pp + 1][1]); t.w = pack2(s[2 * pp + 1][2], s[2 * pp + 1][3]);
      Sf[(w * 2 + pp) * 64 + lane] = t;
    }
    __syncthreads();
  }
  {
    const u16* vb = p.VrT + tix(512, h, w * 128 + fr, p0) + fq * 4;
#pragma unroll
    for (int pp = 0; pp < 2; ++pp) {
      V8 bs[4];
#pragma unroll
      for (int it = 0; it < 4; ++it) bs[it].q = Sf[(it * 2 + pp) * 64 + lane];
#pragma unroll
      for (int dvt = 0; dvt < 8; ++dvt) {
        V8 a;
        a.d[0] = *(const u32x2*)(vb + dvt * 16 * 64 + (2 * pp) * 16);
        a.d[1] = *(const u32x2*)(vb + dvt * 16 * 64 + (2 * pp + 1) * 16);
#pragma unroll
        for (int it = 0; it < 4; ++it) acc[dvt][it] = mfma(a.v, bs[it].v, acc[dvt][it]);
      }
    }
  }
  float mean[4], rstd[4];
  {
    float s1[4];
#pragma unroll
    for (int it = 0; it < 4; ++it) {
      float s = 0.f;
#pragma unroll
      for (int dvt = 0; dvt < 8; ++dvt) s += acc[dvt][it][0] + acc[dvt][it][1] + acc[dvt][it][2] + acc[dvt][it][3];
      s += __shfl_xor(s, 16); s += __shfl_xor(s, 32);
      s1[it] = s;
    }
    __syncthreads();
    if (fq == 0) {
#pragma unroll
      for (int it = 0; it < 4; ++it) red[w * 64 + it * 16 + fr] = s1[it];
    }
    __syncthreads();
#pragma unroll
    for (int it = 0; it < 4; ++it) {
      int i = it * 16 + fr;
      mean[it] = (red[i] + red[64 + i] + red[128 + i] + red[192 + i]) * (1.f / 512.f);
    }
#pragma unroll
    for (int it = 0; it < 4; ++it) {
      float s = 0.f;
#pragma unroll
      for (int dvt = 0; dvt < 8; ++dvt)
#pragma unroll
        for (int j = 0; j < 4; ++j) { float d = acc[dvt][it][j] - mean[it]; s += d * d; }
      s += __shfl_xor(s, 16); s += __shfl_xor(s, 32);
      s1[it] = s;
    }
    __syncthreads();
    if (fq == 0) {
#pragma unroll
      for (int it = 0; it < 4; ++it) red[w * 64 + it * 16 + fr] = s1[it];
    }
    __syncthreads();
#pragma unroll
    for (int it = 0; it < 4; ++it) {
      int i = it * 16 + fr;
      float var = (red[i] + red[64 + i] + red[128 + i] + red[192 + i]) * (1.f / 512.f);
      rstd[it] = rsqrtf(var + EPS);
    }
  }
#pragma unroll
  for (int it = 0; it < 4; ++it) {
    int t = p0 + it * 16 + fr - LEAD;
    if (t >= 0 && t < LP) {
#pragma unroll
      for (int dvt = 0; dvt < 8; ++dvt) {
        int e0 = h * 512 + w * 128 + dvt * 16 + fq * 4;
        u16* gp = p.Gr + (size_t)t * 2048 + e0;
        u32x2 g = *(const u32x2*)gp;
        f32x4 gn = *(const f32x4*)(p.ret_gn + jr * 2048 + e0);
        float g0 = bflo(g.x), g1 = bfhi(g.x), g2 = bflo(g.y), g3 = bfhi(g.y);
        float y0 = (acc[dvt][it][0] - mean[it]) * rstd[it] * gn.x * (g0 * sigmoidf_(g0));
        float y1 = (acc[dvt][it][1] - mean[it]) * rstd[it] * gn.y * (g1 * sigmoidf_(g1));
        float y2 = (acc[dvt][it][2] - mean[it]) * rstd[it] * gn.z * (g2 * sigmoidf_(g2));
        float y3 = (acc[dvt][it][3] - mean[it]) * rstd[it] * gn.w * (g3 * sigmoidf_(g3));
        u32x2 o; o.x = pack2(y0, y1); o.y = pack2(y2, y3);
        *(u32x2*)gp = o;
      }
    }
  }
}

DEV void r3_sample(const Params& p, int jr, int b, int h, char* smem) {
  float* obuf = (float*)smem;
  u16* qs = (u16*)(smem + 32768);
  u16* ks = qs + 16 * 256;
  float* sm = (float*)(smem + 49152);
  float* red = sm + 256;
  float* stat = red + 64;
  int tid = otid(), lane = tid & 63, wid = tid >> 6;
  float l2g = ret_l2g(h);
  int prow = LP + LEAD + b * 16;
  __syncthreads();
  for (int e = tid; e < 16 * 256; e += 256) {
    int i = e >> 8, d = e & 255;
    qs[e] = p.Qr[(size_t)(prow + i) * DM + h * 256 + d];
    ks[e] = p.Kr[(size_t)(prow + i) * DM + h * 256 + d];
  }
  __syncthreads();
  {
    int i = tid >> 4, j = tid & 15;
    float a = 0.f;
#pragma unroll 8
    for (int d = 0; d < 256; ++d) a += bf2f(qs[i * 256 + d]) * bf2f(ks[j * 256 + d]);
    int dd = i > j ? i - j : j - i;
    sm[tid] = a * exp2f(l2g * (float)dd);
  }
  __syncthreads();
  for (int e = tid; e < 16 * 256; e += 256) ks[e] = f2bf(bf2f(ks[e]) * exp2f(l2g * (float)(15 - (e >> 8))));
  __syncthreads();
  float dec16 = exp2f(l2g * 16.f);
  const float* stin = p.state_ret + ((size_t)(jr * 8 + b) * 4 + h) * 256 * 512;
  float* stout = p.out + O_SRS + ((size_t)(jr * 8 + b) * 4 + h) * 256 * 512;
#pragma unroll 1
  for (int c = 0; c < 2; ++c) {
    int e = tid + c * 256;
    float v[16], o[16];
    const u16* vp = p.VrT + tix(512, h, e, prow);
    u32x4 a = *(const u32x4*)vp, bq = *(const u32x4*)(vp + 8);
    v[0] = bflo(a.x); v[1] = bfhi(a.x); v[2] = bflo(a.y); v[3] = bfhi(a.y);
    v[4] = bflo(a.z); v[5] = bfhi(a.z); v[6] = bflo(a.w); v[7] = bfhi(a.w);
    v[8] = bflo(bq.x); v[9] = bfhi(bq.x); v[10] = bflo(bq.y); v[11] = bfhi(bq.y);
    v[12] = bflo(bq.z); v[13] = bfhi(bq.z); v[14] = bflo(bq.w); v[15] = bfhi(bq.w);
#pragma unroll
    for (int i = 0; i < 16; ++i) o[i] = 0.f;
#pragma unroll 2
    for (int dp = 0; dp < 256; ++dp) {
      int dorig = perm_dorig(dp);
      float s0 = stin[(size_t)dorig * 512 + e];
      float n0 = s0 * dec16;
#pragma unroll
      for (int i = 0; i < 16; ++i) {
        o[i] += bf2f(qs[i * 256 + dp]) * s0;
        n0 += bf2f(ks[i * 256 + dp]) * v[i];
      }
      stout[(size_t)dorig * 512 + e] = n0;
    }
#pragma unroll
    for (int i = 0; i < 16; ++i) obuf[i * 512 + e] = o[i] * exp2f(l2g * (float)(i + 1));
#pragma unroll 1
    for (int i = 0; i < 16; ++i) {
      float a0 = obuf[i * 512 + e];
#pragma unroll
      for (int j = 0; j < 16; ++j) a0 += sm[i * 16 + j] * v[j];
      obuf[i * 512 + e] = a0;
    }
  }
  __syncthreads();
  for (int i = 0; i < 16; ++i) {
    float s = wave_sum(obuf[i * 512 + tid] + obuf[i * 512 + 256 + tid]);
    if (lane == 0) red[wid * 16 + i] = s;
  }
  __syncthreads();
  if (tid < 16) stat[tid] = (red[tid] + red[16 + tid] + red[32 + tid] + red[48 + tid]) * (1.f / 512.f);
  __syncthreads();
  for (int i = 0; i < 16; ++i) {
    float mu = stat[i];
    float d0 = obuf[i * 512 + tid] - mu, d1 = obuf[i * 512 + 256 + tid] - mu;
    float s = wave_sum(d0 * d0 + d1 * d1);
    if (lane == 0) red[wid * 16 + i] = s;
  }
  __syncthreads();
  if (tid < 16) stat[16 + tid] = rsqrtf((red[tid] + red[16 + tid] + red[32 + tid] + red[48 + tid]) * (1.f / 512.f) + EPS);
  __syncthreads();
  for (int c = 0; c < 2; ++c) {
    int e = tid + c * 256;
    float gn = p.ret_gn[jr * 2048 + h * 512 + e];
    for (int i = 0; i < 16; ++i) {
      int t = LP + b * 16 + i;
      float g = bf2f(p.Gr[(size_t)t * 2048 + h * 512 + e]);
      float y = (obuf[i * 512 + e] - stat[i]) * stat[16 + i] * gn * (g * sigmoidf_(g));
      p.Gr[(size_t)t * 2048 + h * 512 + e] = f2bf(y);
    }
  }
}

DEV void ph_r3(const Params& p, int jr, char* smem) {
  const int NP = NCH * 4, NI = NP + 32;
  for (int it = blockIdx.x; it < NI; it += gridDim.x) {
    if (it < 32) r3_sample(p, jr, it >> 2, it & 3, smem);
    else { int q = it - 32; r3_prompt(p, jr, q >> 2, q & 3, smem); }
  }
}

DEV void ph_p2(const Params& p, int layer, char* smem) {
  const u16* Wt = p.WpqT + (size_t)layer * 2048 * 1024;
  u16* Qs = (u16*)smem;
  constexpr int LQ = 136;
  int tid = otid(), lane = tid & 63, wid = tid >> 6;
  int wr = wid >> 1, wc = wid & 1, fr = lane & 15, fq = lane >> 4;
  for (int it = blockIdx.x; it < MTILES * 16; it += gridDim.x) {
    int mt, hp; tile_mn(it, 16, mt, hp);
    int m0 = mt * 128;
    f32x4 acc[4][4];
    gemm_tile<true>(p.H, DM, Wt, DM, DM, m0, hp * 128, smem, acc);
    __syncthreads();
#pragma unroll
    for (int m = 0; m < 4; ++m) {
      float rs = rsqrtf((float)p.SSQ[m0 + wr * 64 + m * 16 + fr] * (1.f / (1048576.f * DM)) + EPS);
#pragma unroll
      for (int n = 0; n < 4; ++n) {
        u32x2 o; o.x = pack2(acc[m][n][0] * rs, acc[m][n][1] * rs); o.y = pack2(acc[m][n][2] * rs, acc[m][n][3] * rs);
        *(u32x2*)(Qs + (wr * 64 + m * 16 + fr) * LQ + wc * 64 + n * 16 + fq * 4) = o;
      }
    }
    __syncthreads();
    f32x4 sc[2][8];
#pragma unroll
    for (int rt = 0; rt < 2; ++rt)
#pragma unroll
      for (int ct = 0; ct < 8; ++ct) sc[rt][ct] = f32x4{0.f, 0.f, 0.f, 0.f};
    const u16* skb = p.SKb + ((size_t)(layer * 16 + hp) * 128 + fr) * 128 + fq * 8;
#pragma unroll
    for (int ks = 0; ks < 4; ++ks) {
      bf16x8 a[2];
#pragma unroll
      for (int rt = 0; rt < 2; ++rt) a[rt] = *(const bf16x8*)(Qs + (wid * 32 + rt * 16 + fr) * LQ + ks * 32 + fq * 8);
#pragma unroll
      for (int ct = 0; ct < 8; ++ct) {
        bf16x8 b = *(const bf16x8*)(skb + (size_t)(ct * 16) * 128 + ks * 32);
#pragma unroll
        for (int rt = 0; rt < 2; ++rt) sc[rt][ct] = mfma(a[rt], b, sc[rt][ct]);
      }
    }
#pragma unroll
    for (int rt = 0; rt < 2; ++rt)
#pragma unroll
      for (int j = 0; j < 4; ++j) {
        uint32_t key[8];
#pragma unroll
        for (int ct = 0; ct < 8; ++ct) key[ct] = (f2key(sc[rt][ct][j]) & ~127u) | (uint32_t)(127 - (ct * 16 + fr));
        uint32_t mine = 0;
#pragma unroll 1
        for (int r = 0; r < 16; ++r) {
          uint32_t best = key[0];
#pragma unroll
          for (int ct = 1; ct < 8; ++ct) best = max(best, key[ct]);
          best = row16_maxu(best);
#pragma unroll
          for (int ct = 0; ct < 8; ++ct) key[ct] = (key[ct] == best) ? 0u : key[ct];
          if (fr == r) mine = best;
        }
        int row = m0 + wid * 32 + rt * 16 + fq * 4 + j;
        p.SV[((size_t)row * 16 + hp) * 16 + fr] = key2f(mine & ~127u);
        p.SI[((size_t)row * 16 + hp) * 16 + fr] = 127 - (int)(mine & 127u);
      }
  }
}

DEV void p3_partial(const Params& p, int t, int h0, int nh, int lane, int* eidL, float* gateL, float* svL,
                    int ca, int cb, bool cvalid, float (&oacc)[16]) {
  const int ne = nh * 16;
  int* siL = (int*)(svL + 256);
  {
    f32x4 sv4 = *(const f32x4*)(p.SV + (size_t)t * 256 + lane * 4);
    u32x4 si4 = *(const u32x4*)(p.SI + (size_t)t * 256 + lane * 4);
    *(f32x4*)(svL + lane * 4) = sv4;
    *(u32x4*)(siL + lane * 4) = si4;
  }
  for (int hl = 0; hl < nh; hl += 2) {
    int ha = h0 + hl, hb2 = ha + 1;
    float canda = cvalid ? (svL[ha * 32 + ca] + svL[ha * 32 + 16 + cb]) : 0.f;
    float candb = cvalid ? (svL[hb2 * 32 + ca] + svL[hb2 * 32 + 16 + cb]) : 0.f;
    uint32_t keya = cvalid ? ((f2key(canda) & ~63u) | (uint32_t)(63 - lane)) : 0u;
    uint32_t keyb = cvalid ? ((f2key(candb) & ~63u) | (uint32_t)(63 - lane)) : 0u;
    uint32_t minea = 0, mineb = 0;
#pragma unroll 1
    for (int r = 0; r < 16; ++r) {
      uint32_t besta = wave_maxu(keya), bestb = wave_maxu(keyb);
      keya = (keya == besta) ? 0u : keya;
      keyb = (keyb == bestb) ? 0u : keyb;
      if (lane == r) { minea = besta; mineb = bestb; }
    }
#pragma unroll
    for (int w = 0; w < 2; ++w) {
      uint32_t mine = w ? mineb : minea;
      int h = w ? hb2 : ha;
      int src = 63 - (int)(mine & 63u);
      int wa = __shfl(ca, src), wb = __shfl(cb, src);
      float fv = key2f(mine & ~63u);
      float f0 = rdlane(fv, 0);
      float e = (lane < 16) ? __expf(fv - f0) : 0.f;
      float ssum = row16_sum(e);
      if (lane < 16) {
        int eid = siL[h * 32 + wa] * 128 + siL[h * 32 + 16 + wb];
        eidL[(hl + w) * 16 + lane] = eid;
        gateL[(hl + w) * 16 + lane] = e / ssum;
      }
    }
  }
  float hf[16];
  {
    u32x4 ha = *(const u32x4*)(p.H + (size_t)t * DM + lane * 16);
    u32x4 hb = *(const u32x4*)(p.H + (size_t)t * DM + lane * 16 + 8);
    hf[0] = bflo(ha.x); hf[1] = bfhi(ha.x); hf[2] = bflo(ha.y); hf[3] = bfhi(ha.y);
    hf[4] = bflo(ha.z); hf[5] = bfhi(ha.z); hf[6] = bflo(ha.w); hf[7] = bfhi(ha.w);
    hf[8] = bflo(hb.x); hf[9] = bfhi(hb.x); hf[10] = bflo(hb.y); hf[11] = bfhi(hb.y);
    hf[12] = bflo(hb.z); hf[13] = bfhi(hb.z); hf[14] = bflo(hb.w); hf[15] = bfhi(hb.w);
    float rs = rsqrtf((float)p.SSQ[t] * (1.f / (1048576.f * DM)) + EPS);
#pragma unroll
    for (int i = 0; i < 16; ++i) hf[i] *= rs;
  }
  const unsigned char* U8 = (const unsigned char*)p.Ub + lane * 16;
  const unsigned char* V8p = (const unsigned char*)p.Vb + lane * 16;
#define P3_LOAD(buf, tab, base) _Pragma("unroll") for (int u = 0; u < 8; ++u) { \
      int eid_ = __builtin_amdgcn_readfirstlane(eidL[(base) + u]); \
      buf[u] = *(const u32x4*)((tab) + (size_t)eid_ * DM); }
#define P3_CVT(f, q) { v2f_t c_; \
      c_ = __builtin_amdgcn_cvt_pk_f32_fp8((int)(q).x, false); f[0] = c_.x; f[1] = c_.y; \
      c_ = __builtin_amdgcn_cvt_pk_f32_fp8((int)(q).x, true);  f[2] = c_.x; f[3] = c_.y; \
      c_ = __builtin_amdgcn_cvt_pk_f32_fp8((int)(q).y, false); f[4] = c_.x; f[5] = c_.y; \
      c_ = __builtin_amdgcn_cvt_pk_f32_fp8((int)(q).y, true);  f[6] = c_.x; f[7] = c_.y; \
      c_ = __builtin_amdgcn_cvt_pk_f32_fp8((int)(q).z, false); f[8] = c_.x; f[9] = c_.y; \
      c_ = __builtin_amdgcn_cvt_pk_f32_fp8((int)(q).z, true);  f[10] = c_.x; f[11] = c_.y; \
      c_ = __builtin_amdgcn_cvt_pk_f32_fp8((int)(q).w, false); f[12] = c_.x; f[13] = c_.y; \
      c_ = __builtin_amdgcn_cvt_pk_f32_fp8((int)(q).w, true);  f[14] = c_.x; f[15] = c_.y; }
#define P3_DOT(buf, base) _Pragma("unroll") for (int u = 0; u < 8; ++u) { \
      float f_[16]; P3_CVT(f_, buf[u]); float d_ = 0.f; \
      _Pragma("unroll") for (int i = 0; i < 16; ++i) d_ += hf[i] * f_[i]; \
      d_ = wave_sum(d_) * (1.f / U_SCALE); \
      int k_ = (base) + u; \
      if (lane == (k_ & 63)) { if (k_ < 64) w0 = d_; else w1 = d_; } }
#define P3_AXPY(buf, base) { float ws_ = ((base) < 64) ? w0 : w1; \
      _Pragma("unroll") for (int u = 0; u < 8; ++u) { \
        float f_[16]; P3_CVT(f_, buf[u]); float wk_ = rdlane(ws_, ((base) + u) & 63); \
        _Pragma("unroll") for (int i = 0; i < 16; ++i) oacc[i] += wk_ * f_[i]; } }
  float w0 = 0.f, w1 = 0.f;
  {
    u32x4 A[8], B[8];
    P3_LOAD(A, U8, 0)
#pragma unroll 1
    for (int kb = 0; kb < ne; kb += 16) {
      P3_LOAD(B, U8, kb + 8)
      P3_DOT(A, kb)
      if (kb + 16 < ne) { P3_LOAD(A, U8, kb + 16) }
      P3_DOT(B, kb + 8)
    }
  }
  w0 = gateL[lane] * gelu_(w0);
  w1 = gateL[64 + lane] * gelu_(w1);
  {
    u32x4 A[8], B[8];
    P3_LOAD(A, V8p, 0)
#pragma unroll 1
    for (int kb = 0; kb < ne; kb += 16) {
      P3_LOAD(B, V8p, kb + 8)
      P3_AXPY(A, kb)
      if (kb + 16 < ne) { P3_LOAD(A, V8p, kb + 16) }
      P3_AXPY(B, kb + 8)
    }
  }
}

DEV void p3_finish(const Params& p, int layer, int t, int lane, float (&oacc)[16]) {
  int te = t, le = lane;
  asm volatile("" : "+v"(te), "+v"(le));
  float* xr = p.X + (size_t)te * DM + le * 16;
  f32x4 xv[4];
#pragma unroll
  for (int c = 0; c < 4; ++c) {
    xv[c] = *(const f32x4*)(xr + c * 4);
    xv[c].x += oacc[c * 4 + 0] * (1.f / V_SCALE); xv[c].y += oacc[c * 4 + 1] * (1.f / V_SCALE);
    xv[c].z += oacc[c * 4 + 2] * (1.f / V_SCALE); xv[c].w += oacc[c * 4 + 3] * (1.f / V_SCALE);
  }
  if (layer < 3) {
    float ss = 0.f;
#pragma unroll
    for (int c = 0; c < 4; ++c) {
      *(f32x4*)(xr + c * 4) = xv[c];
      ss += xv[c].x * xv[c].x + xv[c].y * xv[c].y + xv[c].z * xv[c].z + xv[c].w * xv[c].w;
    }
    ss = wave_sum(ss);
    float rstd = rsqrtf(ss * (1.f / DM) + EPS);
    const float* g = p.norm_mix + (size_t)(layer + 1) * DM + le * 16;
    u32x4 o0, o1;
    f32x4 g0 = *(const f32x4*)(g), g1 = *(const f32x4*)(g + 4), g2 = *(const f32x4*)(g + 8), g3 = *(const f32x4*)(g + 12);
    o0.x = pack2(xv[0].x * rstd * g0.x, xv[0].y * rstd * g0.y); o0.y = pack2(xv[0].z * rstd * g0.z, xv[0].w * rstd * g0.w);
    o0.z = pack2(xv[1].x * rstd * g1.x, xv[1].y * rstd * g1.y); o0.w = pack2(xv[1].z * rstd * g1.z, xv[1].w * rstd * g1.w);
    o1.x = pack2(xv[2].x * rstd * g2.x, xv[2].y * rstd * g2.y); o1.y = pack2(xv[2].z * rstd * g2.z, xv[2].w * rstd * g2.w);
    o1.z = pack2(xv[3].x * rstd * g3.x, xv[3].y * rstd * g3.y); o1.w = pack2(xv[3].z * rstd * g3.z, xv[3].w * rstd * g3.w);
    *(u32x4*)(p.H + (size_t)te * DM + le * 16) = o0;
    *(u32x4*)(p.H + (size_t)te * DM + le * 16 + 8) = o1;
  } else {
    float* yo = nullptr;
    if (te >= NMETA && te < LP) yo = p.out + O_YP + (size_t)(te - NMETA) * DM + le * 16;
    else if (te >= LP) yo = p.out + O_YS + (size_t)(te - LP) * DM + le * 16;
    if (yo) {
#pragma unroll
      for (int c = 0; c < 4; ++c) *(f32x4*)(yo + c * 4) = xv[c];
    }
  }
}

DEV void ph_p3(const Params& p, int layer, char* smem) {
  int tid = otid(), lane = tid & 63, wid = tid >> 6;
  int* eidL = (int*)smem + wid * 256;
  float* gateL = (float*)(eidL + 128);
  float* part = (float*)(smem + 4096);
  float* svL = (float*)(smem + 20480) + wid * 512;
  int ca = 0, cb = 0; bool cvalid = false;
  {
    int cnt = 0;
    for (int a = 0; a < 16; ++a) {
      int nb = 16 / (a + 1);
      if (lane >= cnt && lane < cnt + nb) { ca = a; cb = lane - cnt; cvalid = true; }
      cnt += nb;
    }
  }
  int gw = (blockIdx.x * blockDim.x + tid) >> 6, nw = (gridDim.x * blockDim.x) >> 6;
  int tmain = (TTOK / nw) * nw;
  for (int t = gw; t < tmain; t += nw) {
    float oacc[16];
#pragma unroll
    for (int i = 0; i < 16; ++i) oacc[i] = 0.f;
    p3_partial(p, t, 0, 8, lane, eidL, gateL, svL, ca, cb, cvalid, oacc);
    p3_finish(p, layer, t, lane, oacc);
  }
  for (int t = tmain + blockIdx.x; t < TTOK; t += gridDim.x) {
    float oacc[16];
#pragma unroll
    for (int i = 0; i < 16; ++i) oacc[i] = 0.f;
    p3_partial(p, t, wid * 2, 2, lane, eidL, gateL, svL, ca, cb, cvalid, oacc);
    __syncthreads();
#pragma unroll
    for (int i = 0; i < 16; ++i) part[(wid * 64 + lane) * 16 + i] = oacc[i];
    __syncthreads();
    if (wid == 0) {
#pragma unroll
      for (int i = 0; i < 16; ++i) oacc[i] = part[lane * 16 + i] + part[(64 + lane) * 16 + i] + part[(128 + lane) * 16 + i] + part[(192 + lane) * 16 + i];
      p3_finish(p, layer, t, lane, oacc);
    }
  }
}

constexpr int NPHASE = 23;
#ifndef DBG_PHASES
#define DBG_PHASES NPHASE
#endif
#ifndef DBG_SCALES
#define DBG_SCALES {1,1,1,1,1,1,1,1,1,1,1,1,1,1,1,1,1,1,1,1}
#endif
#ifndef DBG_POST
#define DBG_POST 0
#endif
DEV void post_scale(const Params& p) {
  const float sc[20] = DBG_SCALES;
  const size_t offs[11] = {O_YP, O_YS, O_FKP, O_FVP, O_FLP, O_SRP, O_FKS, O_FVS, O_FLS, O_SRS, O_SRS + (size_t)2 * 8 * 4 * 256 * 512};
  size_t i0 = (size_t)blockIdx.x * blockDim.x + otid(), st = (size_t)gridDim.x * blockDim.x;
#pragma unroll
  for (int k = 0; k < 20; ++k) {
    float f = sc[k];
    if (f == 1.f) continue;
    size_t a = offs[k >> 1], b = offs[(k >> 1) + 1], mid = a + (b - a) / 2;
    size_t lo = (k & 1) ? mid : a, hi = (k & 1) ? b : mid;
    for (size_t i = lo + i0; i < hi; i += st) p.out[i] *= f;
  }
}
DEV void dump_x(const Params& p) {
  size_t i = (size_t)blockIdx.x * blockDim.x + otid(), st = (size_t)gridDim.x * blockDim.x;
  for (; i < (size_t)(TTOK - NMETA) * DM; i += st) p.out[i] = p.X[(size_t)NMETA * DM + i];
}
__global__ void __launch_bounds__(256, 2) mega(Params p, int ph0, int ph1) {
  __shared__ __attribute__((aligned(16))) char smem[53248];
  for (int ph = ph0; ph < ph1; ++ph) {
    if (ph > ph0) cg::this_grid().sync();
    if (ph == 0) { ph_prep(p, smem); continue; }
    int q = ph - 1, layer, idx;
    if (q < 5) { layer = 0; idx = q; } else if (q < 11) { layer = 1; idx = q - 5; }
    else if (q < 16) { layer = 2; idx = q - 11; } else { layer = 3; idx = q - 16; }
    int j = layer >> 1;
    const float* gffn = p.norm_ffn + (size_t)layer * DM;
    if ((layer & 1) == 0) {
      if (idx == 0) ph_f1(p, j, smem);
      else if (idx == 1) ph_f2(p, j, smem);
      else if (idx == 2) ph_outproj(p, p.AO, 1024, p.WfoutT + (size_t)j * 1024 * 1024, gffn, smem);
      else if (idx == 3) ph_p2(p, layer, smem);
      else ph_p3(p, layer, smem);
    } else {
      if (idx == 0) ph_r1(p, j, smem);
      else if (idx == 1) { ph_r2(p, j); conv_tables(p, layer); }
      else if (idx == 2) ph_r3(p, j, smem);
      else if (idx == 3) ph_outproj(p, p.Gr, 2048, p.WroutT + (size_t)j * 1024 * 2048, gffn, smem);
      else if (idx == 4) ph_p2(p, layer, smem);
      else ph_p3(p, layer, smem);
    }
  }
}

extern "C" void kernel_launch(void* const* d_in, const int* in_sizes, int n_in, void* d_out, int out_size,
                              void* d_ws, size_t ws_size, hipStream_t stream) {
  static int grid_blocks = 0;
  if (!grid_blocks) {
    int dev = 0, cus = 0, per_cu = 0;
    hipGetDevice(&dev);
    hipDeviceGetAttribute(&cus, hipDeviceAttributeMultiprocessorCount, dev);
    hipOccupancyMaxActiveBlocksPerMultiprocessor(&per_cu, mega, 256, 0);
    if (per_cu > 2) per_cu = 2;
    if (per_cu < 1) per_cu = 1;
    grid_blocks = cus * per_cu;
  }
  Params p;
  memset(&p, 0, sizeof(p));
  const float* const* in = (const float* const*)d_in;
  p.x_prompt = in[0]; p.x_sample = in[1]; p.cache_k = in[2]; p.cache_v = in[3]; p.cache_lf = in[4]; p.state_ret = in[5];
  p.meta = in[6]; p.norm_mix = in[7]; p.norm_ffn = in[8]; p.fox_w_in = in[9]; p.fox_b_f = in[10]; p.fox_qn = in[11];
  p.fox_kn = in[12]; p.fox_w_out = in[13]; p.ret_w_in = in[14]; p.ret_gn = in[15]; p.ret_w_out = in[16];
  p.peer_wq = in[17]; p.peer_sk = in[18]; p.peer_u = in[19]; p.peer_v = in[20];
  p.out = (float*)d_out;
  char* w = (char*)d_ws;
  size_t off = 0;
  auto take = [&](size_t bytes) { char* r = w + off; off += (bytes + 255) & ~(size_t)255; return r; };
  p.X = (float*)take((size_t)TPAD * DM * 4);
  p.H = (u16*)take((size_t)TPAD * DM * 2);
  p.WfinT = (u16*)take((size_t)2 * 4224 * 1024 * 2);
  p.WfoutT = (u16*)take((size_t)2 * 1024 * 1024 * 2);
  p.WrinT = (u16*)take((size_t)2 * 6144 * 1024 * 2);
  p.WroutT = (u16*)take((size_t)2 * 1024 * 2048 * 2);
  p.WpqT = (u16*)take((size_t)4 * 2048 * 1024 * 2);
  p.SKb = (u16*)take((size_t)4 * 8 * 2 * 128 * 128 * 2);
  p.Ub = (u16*)take((size_t)NEXP * DM * 2);
  p.Vb = (u16*)take((size_t)NEXP * DM * 2);
  p.SV = (float*)take((size_t)TPAD * 256 * 4);
  p.SI = (int*)take((size_t)TPAD * 256 * 4);
  p.LFC = (float*)take((size_t)TPAD * 16 * 4);
  p.LFR = (float*)take((size_t)TPAD * 16 * 4);
  p.TT = (float*)take((size_t)MTILES * 16 * 4);
  p.SSQ = (unsigned long long*)take((size_t)TPAD * 8);
  p.QCTR = (int*)take(256);
  size_t region = off;
  p.Qf = (u16*)take((size_t)TPAD * DM * 2);
  p.Kf = (u16*)take((size_t)TPAD * DM * 2);
  p.VtF = (u16*)take((size_t)1024 * TPAD * 2);
  p.OGf = (u16*)take((size_t)TPAD * DM * 2);
  p.AO = (u16*)take((size_t)TPAD * DM * 2);
  off = region;
  p.Qr = (u16*)take((size_t)TP2 * DM * 2);
  p.Kr = (u16*)take((size_t)TP2 * DM * 2);
  p.KrT = (u16*)take((size_t)1024 * TP2 * 2);
  p.VrT = (u16*)take((size_t)2048 * TP2 * 2);
  p.Gr = (u16*)take((size_t)TPAD * 2048 * 2);
  p.ST = (u16*)take((size_t)NCH * 4 * 512 * 256 * 2);
  if (off > ws_size) { fprintf(stderr, "workspace too small: need %zu have %zu\n", off, ws_size); return; }
  for (int i = 0; i < 128; ++i) p.rope_rev[i] = (float)(pow(10000.0, -(double)i / 128.0) / (2.0 * M_PI));
#if ONE_LAUNCH
  int ph0 = 0, ph1 = NPHASE;
  void* args[] = {&p, &ph0, &ph1};
  hipError_t e = hipLaunchCooperativeKernel((void*)mega, dim3(grid_blocks), dim3(256), args, 0, stream);
  if (e != hipSuccess) fprintf(stderr, "cooperative launch failed: %s (grid %d)\n", hipGetErrorString(e), grid_blocks);
#else
  for (int ph = 0; ph < NPHASE; ++ph) mega<<<grid_blocks, 256, 0, stream>>>(p, ph, ph + 1);
#endif
}
```

```cpp
#include <hip/hip_runtime.h>
#include <hip/hip_cooperative_groups.h>
#include <stdint.h>
#include <math.h>
#include <stdio.h>
#include <string.h>
namespace cg = cooperative_groups;

typedef unsigned short u16;
typedef __attribute__((ext_vector_type(8))) short bf16x8;
typedef __attribute__((ext_vector_type(4))) float f32x4;
typedef __attribute__((ext_vector_type(2))) float f32x2;
typedef __attribute__((ext_vector_type(4))) unsigned int u32x4;
typedef __attribute__((ext_vector_type(2))) unsigned int u32x2;
#define DEV __device__ __forceinline__

#ifndef ONE_LAUNCH
#define ONE_LAUNCH 1
#endif

constexpr int DM = 1024;
constexpr int NMETA = 16;
constexpr int LP = 16400;
constexpr int NSMP = 128;
constexpr int TTOK = LP + NSMP;
constexpr int TPAD = 16640;
constexpr int MTILES = 130;
constexpr int LEAD = 48;
constexpr int TP2 = 16704;
constexpr int NCH = 257;
constexpr int PAST = 1024;
constexpr int NEXP = 16384;
constexpr float EPS = 1e-6f;

constexpr size_t O_YP = 0;
constexpr size_t O_YS = O_YP + (size_t)16384 * 1024;
constexpr size_t O_FKP = O_YS + (size_t)128 * 1024;
constexpr size_t O_FVP = O_FKP + (size_t)2 * LP * 1024;
constexpr size_t O_FLP = O_FVP + (size_t)2 * LP * 1024;
constexpr size_t O_SRP = O_FLP + (size_t)2 * LP * 16;
constexpr size_t O_FKS = O_SRP + (size_t)2 * 4 * 256 * 512;
constexpr size_t O_FVS = O_FKS + (size_t)2 * 128 * 1024;
constexpr size_t O_FLS = O_FVS + (size_t)2 * 128 * 1024;
constexpr size_t O_SRS = O_FLS + (size_t)2 * 128 * 16;

struct Params {
  const float *x_prompt, *x_sample, *cache_k, *cache_v, *cache_lf, *state_ret, *meta, *norm_mix, *norm_ffn;
  const float *fox_w_in, *fox_b_f, *fox_qn, *fox_kn, *fox_w_out, *ret_w_in, *ret_gn, *ret_w_out;
  const float *peer_wq, *peer_sk, *peer_u, *peer_v;
  float* out;
  float* X; u16* H;
  u16 *WfinT, *WfoutT, *WrinT, *WroutT, *WpqT, *SKb, *Ub, *Vb;
  float *SV; int* SI;
  float *LFC, *LFR, *TT; unsigned long long* SSQ; int* QCTR;
  u16 *Qf, *Kf, *VtF, *OGf, *AO;
  u16 *Qr, *Kr, *KrT, *VrT, *Gr, *ST;
  float rope_rev[128];
};

typedef __attribute__((ext_vector_type(2))) float f2cv_t;
typedef __attribute__((ext_vector_type(2))) __bf16 bf2cv_t;
DEV uint32_t pack2(float a, float b) { f2cv_t v = {a, b}; bf2cv_t r = __builtin_convertvector(v, bf2cv_t); return __builtin_bit_cast(uint32_t, r); }
DEV u16 f2bf(float f) { return (u16)(pack2(f, 0.f) & 0xffffu); }
DEV float bf2f(u16 h) { return __uint_as_float(((uint32_t)h) << 16); }
DEV float bflo(uint32_t u) { return __uint_as_float(u << 16); }
DEV float bfhi(uint32_t u) { return __uint_as_float(u & 0xffff0000u); }

union V8 { bf16x8 v; uint32_t u[4]; u32x2 d[2]; u32x4 q; };

DEV f32x4 mfma(bf16x8 a, bf16x8 b, f32x4 c) { return __builtin_amdgcn_mfma_f32_16x16x32_bf16(a, b, c, 0, 0, 0); }

template <int CTRL> DEV float dppf(float v) {
  return __int_as_float(__builtin_amdgcn_update_dpp(0, __float_as_int(v), CTRL, 0xf, 0xf, false));
}
template <int CTRL> DEV uint32_t dppu(uint32_t v) {
  return (uint32_t)__builtin_amdgcn_update_dpp(0, (int)v, CTRL, 0xf, 0xf, false);
}
DEV float row16_sum(float v) {
  v += dppf<0xB1>(v); v += dppf<0x4E>(v); v += dppf<0x141>(v); v += dppf<0x140>(v);
  return v;
}
DEV uint32_t row16_maxu(uint32_t v) {
  v = max(v, dppu<0xB1>(v)); v = max(v, dppu<0x4E>(v)); v = max(v, dppu<0x141>(v)); v = max(v, dppu<0x140>(v));
  return v;
}
DEV float rdlane(float v, int l) { float r = __int_as_float(__builtin_amdgcn_readlane(__float_as_int(v), l)); asm volatile("" : "+v"(r)); return r; }
DEV float wave_sum(float v) {
  v = row16_sum(v);
  return rdlane(v, 0) + rdlane(v, 16) + rdlane(v, 32) + rdlane(v, 48);
}
DEV float wave_max(float v) {
  v = fmaxf(v, dppf<0xB1>(v)); v = fmaxf(v, dppf<0x4E>(v)); v = fmaxf(v, dppf<0x141>(v)); v = fmaxf(v, dppf<0x140>(v));
  return fmaxf(fmaxf(rdlane(v, 0), rdlane(v, 16)), fmaxf(rdlane(v, 32), rdlane(v, 48)));
}
DEV uint32_t wave_maxu(uint32_t v) {
  v = row16_maxu(v);
  uint32_t a = (uint32_t)__builtin_amdgcn_readlane((int)v, 0), b = (uint32_t)__builtin_amdgcn_readlane((int)v, 16);
  uint32_t c = (uint32_t)__builtin_amdgcn_readlane((int)v, 32), d = (uint32_t)__builtin_amdgcn_readlane((int)v, 48);
  return max(max(a, b), max(c, d));
}
DEV uint32_t f2key(float f) { uint32_t u = __float_as_uint(f); return (u & 0x80000000u) ? ~u : (u | 0x80000000u); }
DEV float key2f(uint32_t k) { uint32_t u = (k & 0x80000000u) ? (k & 0x7fffffffu) : ~k; return __uint_as_float(u); }

DEV float sigmoidf_(float x) { return 1.f / (1.f + __expf(-x)); }
DEV float logsigmoid_(float x) { return fminf(x, 0.f) - log1pf(expf(-fabsf(x))); }
DEV float gelu_(float x) { return 0.5f * x * (1.f + erff(x * 0.70710678118654752f)); }
DEV float ret_l2g(int h) { return log2f(1.f - exp2f(-5.f - (float)h)); }
DEV int otid() { int t = threadIdx.x; asm volatile("" : "+v"(t)); return t; }
DEV size_t tix(int rows, int h, int row, int pp) { return ((size_t)(h * 261 + (pp >> 6)) * rows + row) * 64 + (pp & 63); }
DEV int perm_dorig(int dp) { return ((dp >> 4) & 1) * 128 + (dp >> 5) * 16 + (dp & 15); }

DEV void norm_rows(const Params& p, const float* gain, bool from_input) {
  int tid_ = otid();
  int lane = tid_ & 63;
  int gw = (blockIdx.x * blockDim.x + tid_) >> 6, nw = (gridDim.x * blockDim.x) >> 6;
  for (int t = gw; t < TPAD; t += nw) {
    const float* src;
    if (from_input) {
      if (t < NMETA) src = p.meta + (size_t)t * DM;
      else if (t < LP) src = p.x_prompt + (size_t)(t - NMETA) * DM;
      else if (t < TTOK) src = p.x_sample + (size_t)(t - LP) * DM;
      else src = nullptr;
    } else src = p.X + (size_t)t * DM;
    f32x4 v[4];
    float ss = 0.f;
#pragma unroll
    for (int c = 0; c < 4; ++c) {
      if (src) v[c] = *(const f32x4*)(src + c * 256 + lane * 4); else v[c] = f32x4{0.f, 0.f, 0.f, 0.f};
      ss += v[c].x * v[c].x + v[c].y * v[c].y + v[c].z * v[c].z + v[c].w * v[c].w;
    }
    ss = wave_sum(ss);
    float rstd = rsqrtf(ss * (1.f / DM) + EPS);
#pragma unroll
    for (int c = 0; c < 4; ++c) {
      if (from_input) *(f32x4*)(p.X + (size_t)t * DM + c * 256 + lane * 4) = v[c];
      f32x4 g = *(const f32x4*)(gain + c * 256 + lane * 4);
      u32x2 o;
      o.x = pack2(v[c].x * rstd * g.x, v[c].y * rstd * g.y);
      o.y = pack2(v[c].z * rstd * g.z, v[c].w * rstd * g.w);
      *(u32x2*)(p.H + (size_t)t * DM + c * 256 + lane * 4) = o;
    }
  }
}

DEV void convert_bf16(const float* src, u16* dst, size_t n4) {
  size_t i = (size_t)blockIdx.x * blockDim.x + otid(), st = (size_t)gridDim.x * blockDim.x;
  for (; i < n4; i += st) {
    f32x4 v = ((const f32x4*)src)[i];
    u32x2 o; o.x = pack2(v.x, v.y); o.y = pack2(v.z, v.w);
    ((u32x2*)dst)[i] = o;
  }
}

DEV void xpose(const float* W, int K, int N, int Npad, u16* Wt, bool permq, char* smem) {
  u16* tile = (u16*)smem;
  int tid = otid();
  int ntn = Npad / 64, ntk = K / 64;
  for (int it = blockIdx.x; it < ntn * ntk; it += gridDim.x) {
    int n0 = (it / ntk) * 64, k0 = (it % ntk) * 64;
    int c = tid & 63, r0 = tid >> 6;
    int np = n0 + c;
    int src = np;
    if (permq && np < 2048) src = (np & ~255) + perm_dorig(np & 255);
    __syncthreads();
#pragma unroll
    for (int i = 0; i < 16; ++i) {
      int k = r0 + 4 * i;
      float v = (np < N) ? W[(size_t)(k0 + k) * N + src] : 0.f;
      tile[c * 72 + k] = f2bf(v);
    }
    __syncthreads();
    int nl = tid >> 2, kq = (tid & 3) * 16;
    u32x4 a = *(const u32x4*)(tile + nl * 72 + kq);
    u32x4 b = *(const u32x4*)(tile + nl * 72 + kq + 8);
    *(u32x4*)(Wt + (size_t)(n0 + nl) * K + k0 + kq) = a;
    *(u32x4*)(Wt + (size_t)(n0 + nl) * K + k0 + kq + 8) = b;
  }
}

typedef __attribute__((ext_vector_type(2))) float v2f_t;
constexpr float U_SCALE = 64.f, V_SCALE = 16.f;
DEV void convert_fp8(const float* src, uint32_t* dst, size_t n4, float scale) {
  size_t i = (size_t)blockIdx.x * blockDim.x + otid(), st = (size_t)gridDim.x * blockDim.x;
  for (; i < n4; i += st) {
    f32x4 v = ((const f32x4*)src)[i];
    int w = __builtin_amdgcn_cvt_pk_fp8_f32(v.x * scale, v.y * scale, 0, false);
    w = __builtin_amdgcn_cvt_pk_fp8_f32(v.z * scale, v.w * scale, w, true);
    dst[i] = (uint32_t)w;
  }
}
DEV void conv_tables(const Params& p, int layer) {
  convert_fp8(p.peer_u + (size_t)layer * NEXP * DM, (uint32_t*)p.Ub, (size_t)NEXP * DM / 4, U_SCALE);
  convert_fp8(p.peer_v + (size_t)layer * NEXP * DM, (uint32_t*)p.Vb, (size_t)NEXP * DM / 4, V_SCALE);
}

DEV void ph_prep(const Params& p, char* smem) {
  norm_rows(p, p.norm_mix, true);
  convert_bf16(p.peer_sk, p.SKb, (size_t)4 * 8 * 2 * 128 * 128 / 4);
  for (int j = 0; j < 2; ++j) {
    xpose(p.fox_w_in + (size_t)j * 1024 * 4112, 1024, 4112, 4224, p.WfinT + (size_t)j * 4224 * 1024, false, smem);
    xpose(p.fox_w_out + (size_t)j * 1024 * 1024, 1024, 1024, 1024, p.WfoutT + (size_t)j * 1024 * 1024, false, smem);
    xpose(p.ret_w_in + (size_t)j * 1024 * 6144, 1024, 6144, 6144, p.WrinT + (size_t)j * 6144 * 1024, true, smem);
    xpose(p.ret_w_out + (size_t)j * 2048 * 1024, 2048, 1024, 1024, p.WroutT + (size_t)j * 1024 * 2048, false, smem);
  }
  for (int l = 0; l < 4; ++l)
    xpose(p.peer_wq + (size_t)l * 1024 * 2048, 1024, 2048, 2048, p.WpqT + (size_t)l * 2048 * 1024, false, smem);
}

DEV void tile_mn(int it, int NT, int& mt, int& nt) {
  const int GM = 8;
  int g = it / (GM * NT), r = it - g * (GM * NT);
  int gm = min(GM, MTILES - g * GM);
  nt = r / gm; mt = g * GM + (r - nt * gm);
}

constexpr int LDK = 72;
template <bool SWAP>
DEV void gemm_tile(const u16* __restrict__ A, int lda, const u16* __restrict__ Bt, int ldb, int K,
                          int m0, int n0, char* smem, f32x4 (&acc)[4][4]) {
  u16* sA = (u16*)smem;
  u16* sB = sA + 128 * LDK;
  int tid = otid(), lane = tid & 63, wid = tid >> 6;
  int wr = wid >> 1, wc = wid & 1, fr = lane & 15, fq = lane >> 4;
#pragma unroll
  for (int m = 0; m < 4; ++m)
#pragma unroll
    for (int n = 0; n < 4; ++n) acc[m][n] = f32x4{0.f, 0.f, 0.f, 0.f};
  u32x4 ra[4], rb[4];
  const u16* Ap = A + (size_t)(m0 + (tid >> 3)) * lda + (tid & 7) * 8;
  const u16* Bp = Bt + (size_t)(n0 + (tid >> 3)) * ldb + (tid & 7) * 8;
#pragma unroll
  for (int i = 0; i < 4; ++i) {
    ra[i] = *(const u32x4*)(Ap + (size_t)(32 * i) * lda);
    rb[i] = *(const u32x4*)(Bp + (size_t)(32 * i) * ldb);
  }
  for (int k0 = 0; k0 < K; k0 += 64) {
    __syncthreads();
#pragma unroll
    for (int i = 0; i < 4; ++i) {
      *(u32x4*)(sA + ((tid >> 3) + 32 * i) * LDK + (tid & 7) * 8) = ra[i];
      *(u32x4*)(sB + ((tid >> 3) + 32 * i) * LDK + (tid & 7) * 8) = rb[i];
    }
    __syncthreads();
    if (k0 + 64 < K) {
#pragma unroll
      for (int i = 0; i < 4; ++i) {
        ra[i] = *(const u32x4*)(Ap + (size_t)(32 * i) * lda + k0 + 64);
        rb[i] = *(const u32x4*)(Bp + (size_t)(32 * i) * ldb + k0 + 64);
      }
    }
#pragma unroll
    for (int ks = 0; ks < 2; ++ks) {
      bf16x8 af[4], bfv[4];
#pragma unroll
      for (int m = 0; m < 4; ++m) af[m] = *(const bf16x8*)(sA + (wr * 64 + m * 16 + fr) * LDK + ks * 32 + fq * 8);
#pragma unroll
      for (int n = 0; n < 4; ++n) bfv[n] = *(const bf16x8*)(sB + (wc * 64 + n * 16 + fr) * LDK + ks * 32 + fq * 8);
#pragma unroll
      for (int m = 0; m < 4; ++m)
#pragma unroll
        for (int n = 0; n < 4; ++n) acc[m][n] = SWAP ? mfma(bfv[n], af[m], acc[m][n]) : mfma(af[m], bfv[n], acc[m][n]);
    }
  }
}

DEV void ph_f1(const Params& p, int jf, char* smem) {
  if (blockIdx.x == 0 && otid() == 0) p.QCTR[0] = 0;
  { unsigned int z_ = 0; asm volatile("" : "+v"(z_));
    for (int i = blockIdx.x * blockDim.x + otid(); i < TPAD; i += gridDim.x * blockDim.x) p.SSQ[i] = (unsigned long long)z_; }
  const u16* Wt = p.WfinT + (size_t)jf * 4224 * 1024;
  int tid = otid(), lane = tid & 63, wid = tid >> 6;
  int wr = wid >> 1, wc = wid & 1, fr = lane & 15, fq = lane >> 4;
  const int NT = 33;
  for (int it = blockIdx.x; it < MTILES * NT; it += gridDim.x) {
    int mt, nt; tile_mn(it, NT, mt, nt);
    int m0 = mt * 128;
    f32x4 acc[4][4];
    int type = nt >> 3;
    if (type == 2 || type == 4) gemm_tile<false>(p.H, DM, Wt, DM, DM, m0, nt * 128, smem, acc);
    else gemm_tile<true>(p.H, DM, Wt, DM, DM, m0, nt * 128, smem, acc);
    if (type <= 1) {
      int hh = (nt & 7) * 2 + wc;
      const float* gn = (type == 0 ? p.fox_qn : p.fox_kn) + jf * 64;
      const float gs = (type == 0) ? 0.125f * 1.44269504089f : 1.f;
      f32x4 g[4];
#pragma unroll
      for (int n = 0; n < 4; ++n) g[n] = *(const f32x4*)(gn + n * 16 + fq * 4) * gs;
#pragma unroll
      for (int m = 0; m < 4; ++m) {
        float ss = 0.f;
#pragma unroll
        for (int n = 0; n < 4; ++n)
#pragma unroll
          for (int j = 0; j < 4; ++j) ss += acc[m][n][j] * acc[m][n][j];
        ss += __shfl_xor(ss, 16); ss += __shfl_xor(ss, 32);
        float rstd = rsqrtf(ss * (1.f / 64.f) + EPS);
        int row = m0 + wr * 64 + m * 16 + fr;
#pragma unroll
        for (int n = 0; n < 4; ++n) {
          f32x4 v = acc[m][n] * rstd * g[n];
          int col = hh * 64 + n * 16 + fq * 4;
          u32x2 o; o.x = pack2(v.x, v.y); o.y = pack2(v.z, v.w);
          if (type == 0) *(u32x2*)(p.Qf + (size_t)row * DM + col) = o;
          else {
            *(u32x2*)(p.Kf + (size_t)row * DM + col) = o;
            if (row < LP) *(f32x4*)(p.out + O_FKP + ((size_t)jf * LP + row) * 1024 + col) = v;
            else if (row < TTOK) *(f32x4*)(p.out + O_FKS + ((size_t)jf * 128 + (row - LP)) * 1024 + col) = v;
          }
        }
      }
    } else if (type == 2) {
      int hh = (nt & 7) * 2 + wc;
#pragma unroll
      for (int m = 0; m < 4; ++m) {
        int rb = m0 + wr * 64 + m * 16 + fq * 4;
#pragma unroll
        for (int n = 0; n < 4; ++n) {
          int d = n * 16 + fr;
          u32x2 o; o.x = pack2(acc[m][n][0], acc[m][n][1]); o.y = pack2(acc[m][n][2], acc[m][n][3]);
          *(u32x2*)(p.VtF + (size_t)(hh * 64 + d) * TPAD + rb) = o;
#pragma unroll
          for (int j = 0; j < 4; ++j) {
            int row = rb + j; int col = hh * 64 + d;
            if (row < LP) p.out[O_FVP + ((size_t)jf * LP + row) * 1024 + col] = acc[m][n][j];
            else if (row < TTOK) p.out[O_FVS + ((size_t)jf * 128 + (row - LP)) * 1024 + col] = acc[m][n][j];
          }
        }
      }
    } else if (type == 3) {
#pragma unroll
      for (int m = 0; m < 4; ++m)
#pragma unroll
        for (int n = 0; n < 4; ++n) {
          int row = m0 + wr * 64 + m * 16 + fr;
          int col = (nt - 24) * 128 + wc * 64 + n * 16 + fq * 4;
          u32x2 o; o.x = pack2(acc[m][n][0], acc[m][n][1]); o.y = pack2(acc[m][n][2], acc[m][n][3]);
          *(u32x2*)(p.OGf + (size_t)row * DM + col) = o;
        }
    } else {
      float* lfs = (float*)smem;
      __syncthreads();
      if (wc == 0) {
        float bf = p.fox_b_f[jf * 16 + fr];
#pragma unroll
        for (int m = 0; m < 4; ++m)
#pragma unroll
          for (int j = 0; j < 4; ++j) {
            int rl = wr * 64 + m * 16 + fq * 4 + j;
            int row = m0 + rl;
            float lf = logsigmoid_(acc[m][0][j] + bf);
            lfs[rl * 16 + fr] = lf;
            p.LFR[(size_t)row * 16 + fr] = lf;
            if (row < LP) p.out[O_FLP + ((size_t)jf * LP + row) * 16 + fr] = lf;
            else if (row < TTOK) p.out[O_FLS + ((size_t)jf * 128 + (row - LP)) * 16 + fr] = lf;
          }
      }
      __syncthreads();
      if (tid < 16) {
        float run = 0.f;
        for (int r = 0; r < 128; ++r) {
          run += lfs[r * 16 + tid];
          p.LFC[(size_t)(m0 + r) * 16 + tid] = run;
        }
        p.TT[mt * 16 + tid] = run;
      }
    }
  }
}

template <bool MASK>
DEV void attn_tile(const u16* Kb, const u16* Vb, const float* cb, int key0, int q0, int fr, int fq,
                   const bf16x8 (&qf)[4][2], const float (&cq)[4], float (&lrow)[4], f32x4 (&o)[4][4]) {
  const bool diag = MASK;
#pragma unroll
  for (int pp = 0; pp < 2; ++pp) {
        V8 pfu[4];
#pragma unroll
        for (int kl = 0; kl < 2; ++kl) {
          f32x4 s1[4];
          f32x4 ck = *(const f32x4*)(cb + (2 * pp + kl) * 16 + fq * 4);
#pragma unroll
          for (int qi = 0; qi < 4; ++qi) s1[qi] = cq[qi] - ck;
#pragma unroll
          for (int ks = 0; ks < 2; ++ks) {
            bf16x8 a = *(const bf16x8*)(Kb + ((2 * pp + kl) * 16 + fr) * LDK + ks * 32 + fq * 8);
#pragma unroll
            for (int qi = 0; qi < 4; ++qi) s1[qi] = mfma(a, qf[qi][ks], s1[qi]);
          }
#pragma unroll
          for (int qi = 0; qi < 4; ++qi) {
            int q = q0 + qi * 16 + fr;
            float e[4];
#pragma unroll
            for (int j = 0; j < 4; ++j) {
              float v = s1[qi][j];
              if (diag && (key0 + (2 * pp + kl) * 16 + fq * 4 + j > q)) v = -INFINITY;
              e[j] = __builtin_amdgcn_exp2f(v);
            }
            lrow[qi] += (e[0] + e[1]) + (e[2] + e[3]);
            pfu[qi].u[kl * 2 + 0] = pack2(e[0], e[1]);
            pfu[qi].u[kl * 2 + 1] = pack2(e[2], e[3]);
          }
        }
        bf16x8 pf[4];
#pragma unroll
        for (int qi = 0; qi < 4; ++qi) pf[qi] = pfu[qi].v;
#pragma unroll
        for (int dt = 0; dt < 4; ++dt) {
          V8 a;
          a.d[0] = *(const u32x2*)(Vb + (dt * 16 + fr) * LDK + (2 * pp) * 16 + fq * 4);
          a.d[1] = *(const u32x2*)(Vb + (dt * 16 + fr) * LDK + (2 * pp + 1) * 16 + fq * 4);
#pragma unroll
          for (int qi = 0; qi < 4; ++qi) o[dt][qi] = mfma(a.v, pf[qi], o[dt][qi]);
        }
      }
}

DEV void f2_prompt(const Params& p, int qt, int h, char* smem) {
  u16* Ks = (u16*)smem;
  u16* Vs = Ks + 2 * 64 * LDK;
  float* cs = (float*)(Vs + 2 * 64 * LDK);
  float* off = cs + 128;
  float* tmp = off + 132;
  int tid = otid(), lane = tid & 63, wid = tid >> 6, fr = lane & 15, fq = lane >> 4;
  __syncthreads();
  if (tid < MTILES) tmp[tid] = p.TT[tid * 16 + h];
  __syncthreads();
  if (tid < MTILES) { float s = 0.f; for (int m = 0; m < tid; ++m) s += tmp[m]; off[tid] = s; }
  __syncthreads();
  int q0 = qt * 256 + wid * 64;
  bf16x8 qf[4][2];
  float cq[4], lrow[4];
  f32x4 o[4][4];
#pragma unroll
  for (int qi = 0; qi < 4; ++qi) {
    int q = q0 + qi * 16 + fr;
#pragma unroll
    for (int ks = 0; ks < 2; ++ks) qf[qi][ks] = *(const bf16x8*)(p.Qf + (size_t)q * DM + h * 64 + ks * 32 + fq * 8);
    cq[qi] = (p.LFC[(size_t)q * 16 + h] + off[q >> 7] - 12.f) * 1.44269504089f;
    lrow[qi] = 0.f;
#pragma unroll
    for (int dt = 0; dt < 4; ++dt) o[dt][qi] = f32x4{0.f, 0.f, 0.f, 0.f};
  }
  int nkt = 4 * (qt + 1);
  if (nkt > (LP + 63) / 64) nkt = (LP + 63) / 64;
  int* kst = (int*)(tmp + 132);
  if (tid == 0) {
    float cref = off[qt * 2];
    int m = 0;
    while (m < qt * 2 && cref - off[m + 1] < -45.f) ++m;
    kst[0] = m * 2;
  }
  __syncthreads();
  const int kt0 = kst[0];
  bool wave_valid = q0 < LP;
  u32x4 rk[2], rv[2]; float rc = 0.f;
  const int lrow_ = tid >> 2, lcol = (tid & 3) * 16;
  const u16* kfb = p.Kf + h * 64;
  const u16* vtb = p.VtF + (size_t)h * 64 * TPAD;
  const float* lcb = p.LFC + h;
  const unsigned kvo0 = (unsigned)(lrow_ * DM + lcol), kvo1 = kvo0 + 32u * DM;
  const unsigned vvo0 = (unsigned)(lrow_ * TPAD + lcol), vvo1 = vvo0 + 32u * TPAD;
#define GL(kt_) { int key0_ = (kt_) * 64; \
    const u16* kp_ = p.Kf + (size_t)(key0_ + lrow_) * DM + h * 64 + lcol; \
    const u16* vp_ = p.VtF + (size_t)(h * 64 + lrow_) * TPAD + key0_ + lcol; \
    rk[0] = *(const u32x4*)(kp_); rk[1] = *(const u32x4*)(kp_ + 8); \
    rv[0] = *(const u32x4*)(vp_); rv[1] = *(const u32x4*)(vp_ + 8); \
    if (tid < 64) rc = (p.LFC[(size_t)(key0_ + tid) * 16 + h] + off[(key0_ + tid) >> 7]) * 1.44269504089f; }
  GL(kt0);
  for (int kt = kt0; kt < nkt; ++kt) {
    int buf = kt & 1;
    u16* Kb = Ks + buf * 64 * LDK; u16* Vb = Vs + buf * 64 * LDK; float* cb = cs + buf * 64;
#pragma unroll
    for (int i = 0; i < 2; ++i) {
      *(u32x4*)(Kb + lrow_ * LDK + lcol + 8 * i) = rk[i];
      *(u32x4*)(Vb + lrow_ * LDK + lcol + 8 * i) = rv[i];
    }
    if (tid < 64) cb[tid] = rc;
    __syncthreads();
    if (kt + 1 < nkt) GL(kt + 1);
    int key0 = kt * 64;
    if (wave_valid && key0 <= q0 + 63) {
      if (key0 + 63 > q0) attn_tile<true>(Kb, Vb, cb, key0, q0, fr, fq, qf, cq, lrow, o);
      else attn_tile<false>(Kb, Vb, cb, key0, q0, fr, fq, qf, cq, lrow, o);
    }
  }
  int q0e = q0;
  asm volatile("" : "+v"(q0e));
#pragma unroll
  for (int qi = 0; qi < 4; ++qi) {
    float l = lrow[qi];
    l += __shfl_xor(l, 16); l += __shfl_xor(l, 32);
    float inv = 1.f / l;
    int q = q0e + qi * 16 + fr;
    if (q < LP) {
#pragma unroll
      for (int dt = 0; dt < 4; ++dt) {
        int d = dt * 16 + fq * 4;
        u32x2 og = *(const u32x2*)(p.OGf + (size_t)q * DM + h * 64 + d);
        u32x2 r;
        r.x = pack2(o[dt][qi][0] * inv * sigmoidf_(bflo(og.x)), o[dt][qi][1] * inv * sigmoidf_(bfhi(og.x)));
        r.y = pack2(o[dt][qi][2] * inv * sigmoidf_(bflo(og.y)), o[dt][qi][3] * inv * sigmoidf_(bfhi(og.y)));
        *(u32x2*)(p.AO + (size_t)q * DM + h * 64 + d) = r;
      }
    }
  }
}

DEV void f2_sample(const Params& p, int jf, int b, int h, int qh, char* smem) {
  constexpr int NK = PAST + 16;
  float* S = (float*)smem;
  float* qs = S + 8 * NK;
  float* cc = qs + 8 * 64;
  float* part = cc + NK;
  float* invl = part + 256;
  int tid = otid(), lane = tid & 63, wid = tid >> 6;
  __syncthreads();
  for (int e = tid; e < 512; e += 256) {
    int i = e >> 6, d = e & 63;
    qs[e] = bf2f(p.Qf[(size_t)(LP + b * 16 + qh * 8 + i) * DM + h * 64 + d]);
  }
  float lv[5]; float run = 0.f;
#pragma unroll
  for (int u = 0; u < 5; ++u) {
    int j = tid * 5 + u;
    float v = 0.f;
    if (j < PAST) v = p.cache_lf[(((size_t)jf * 8 + b) * PAST + j) * 16 + h];
    else if (j < NK) v = p.LFR[(size_t)(LP + b * 16 + (j - PAST)) * 16 + h];
    run += v; lv[u] = run;
  }
  part[tid] = run;
  __syncthreads();
  float base = 0.f;
  for (int m = 0; m < tid; ++m) base += part[m];
#pragma unroll
  for (int u = 0; u < 5; ++u) { int j = tid * 5 + u; if (j < NK) cc[j] = base + lv[u]; }
  __syncthreads();
  for (int j = tid; j < NK; j += 256) {
    const float* kp;
    if (j < PAST) kp = p.cache_k + ((((size_t)jf * 8 + b) * PAST + j) * 16 + h) * 64;
    else kp = p.out + O_FKS + (((size_t)jf * 128 + b * 16 + (j - PAST)) * 16 + h) * 64;
    f32x4 kv[16];
#pragma unroll
    for (int c = 0; c < 16; ++c) kv[c] = ((const f32x4*)kp)[c];
    float cj = cc[j];
#pragma unroll
    for (int i = 0; i < 8; ++i) {
      float a = 0.f;
#pragma unroll
      for (int c = 0; c < 16; ++c) {
        f32x4 qv = *(const f32x4*)(qs + i * 64 + c * 4);
        a += qv.x * kv[c].x + qv.y * kv[c].y + qv.z * kv[c].z + qv.w * kv[c].w;
      }
      int qi = qh * 8 + i;
      a = a * 0.69314718056f + (cc[PAST + qi] - cj);
      if (j > PAST + qi) a = -INFINITY;
      S[i * NK + j] = a;
    }
  }
  __syncthreads();
  for (int i = wid * 2; i < wid * 2 + 2; ++i) {
    float m = -INFINITY;
    for (int j = lane; j < NK; j += 64) m = fmaxf(m, S[i * NK + j]);
    m = wave_max(m);
    float l = 0.f;
    for (int j = lane; j < NK; j += 64) { float e = __expf(S[i * NK + j] - m); S[i * NK + j] = e; l += e; }
    l = wave_sum(l);
    if (lane == 0) invl[i] = 1.f / l;
  }
  __syncthreads();
  {
    int i = tid >> 5, dq = tid & 31;
    float o0 = 0.f, o1 = 0.f;
    const float* vb = p.cache_v + ((((size_t)jf * 8 + b) * PAST) * 16 + h) * 64 + dq * 2;
#pragma unroll 8
    for (int j = 0; j < PAST; ++j) {
      f32x2 v = *(const f32x2*)(vb + (size_t)j * 1024);
      float pj = S[i * NK + j];
      o0 += pj * v.x; o1 += pj * v.y;
    }
    const float* vn = p.out + O_FVS + (((size_t)jf * 128 + b * 16) * 16 + h) * 64 + dq * 2;
#pragma unroll
    for (int j = 0; j < 16; ++j) {
      f32x2 v = *(const f32x2*)(vn + (size_t)j * 1024);
      float pj = S[i * NK + PAST + j];
      o0 += pj * v.x; o1 += pj * v.y;
    }
    int row = LP + b * 16 + qh * 8 + i;
    float il = invl[i];
    uint32_t og = *(const uint32_t*)(p.OGf + (size_t)row * DM + h * 64 + dq * 2);
    *(uint32_t*)(p.AO + (size_t)row * DM + h * 64 + dq * 2) = pack2(o0 * il * sigmoidf_(bflo(og)), o1 * il * sigmoidf_(bfhi(og)));
  }
}

DEV void ph_f2(const Params& p, int jf, char* smem) {
  const int NP = 65 * 16, NI = NP + 256;
  {
    int gt = blockIdx.x * blockDim.x + otid(), gs = gridDim.x * blockDim.x;
    for (int i = gt; i < (TPAD - TTOK) * DM / 2; i += gs) ((uint32_t*)(p.AO + (size_t)TTOK * DM))[i] = 0u;
  }
  int* qslot = (int*)(smem + 53248 - 16);
  for (;;) {
    __syncthreads();
    if (otid() == 0) qslot[0] = atomicAdd(p.QCTR, 1);
    __syncthreads();
    int idx = qslot[0];
    if (idx >= NI) break;
    if (idx >= 256) { int pi = idx - 256; f2_prompt(p, 64 - pi / 16, pi % 16, smem); }
    else f2_sample(p, jf, idx >> 5, (idx >> 1) & 15, idx & 1, smem);
  }
  conv_tables(p, jf * 2);
}

DEV void ph_outproj(const Params& p, const u16* A, int K, const u16* Wt, const float* gffn, char* smem) {
  int tid = otid(), lane = tid & 63, wid = tid >> 6;
  int wr = wid >> 1, wc = wid & 1, fr = lane & 15, fq = lane >> 4;
  for (int it = blockIdx.x; it < MTILES * 8; it += gridDim.x) {
    int mt, nt; tile_mn(it, 8, mt, nt);
    f32x4 acc[4][4];
    gemm_tile<true>(A, K, Wt, K, K, mt * 128, nt * 128, smem, acc);
#pragma unroll
    for (int m = 0; m < 4; ++m) {
      int row = mt * 128 + wr * 64 + m * 16 + fr;
      float ss = 0.f;
#pragma unroll
      for (int n = 0; n < 4; ++n) {
        int col = nt * 128 + wc * 64 + n * 16 + fq * 4;
        f32x4* xp = (f32x4*)(p.X + (size_t)row * DM + col);
        f32x4 xn = *xp + acc[m][n];
        *xp = xn;
        f32x4 g = *(const f32x4*)(gffn + col);
        u32x2 o; o.x = pack2(xn.x * g.x, xn.y * g.y); o.y = pack2(xn.z * g.z, xn.w * g.w);
        *(u32x2*)(p.H + (size_t)row * DM + col) = o;
        ss += xn.x * xn.x + xn.y * xn.y + xn.z * xn.z + xn.w * xn.w;
      }
      ss += __shfl_xor(ss, 16); ss += __shfl_xor(ss, 32);
      if (fq == 0) atomicAdd(p.SSQ + row, (unsigned long long)(ss * 1048576.f + 0.5f));
    }
  }
}

DEV void ph_r1(const Params& p, int jr, char* smem) {
  const u16* Wt = p.WrinT + (size_t)jr * 6144 * 1024;
  int tid = otid(), lane = tid & 63, wid = tid >> 6;
  int wr = wid >> 1, wc = wid & 1, fr = lane & 15, fq = lane >> 4;
  {
    int gt = blockIdx.x * blockDim.x + tid, gs = gridDim.x * blockDim.x;
    for (int i = gt; i < LEAD * DM; i += gs) { p.Qr[i] = 0; p.Kr[i] = 0; }
    { unsigned int z_ = 0; asm volatile("" : "+v"(z_)); for (int i = gt; i < TPAD; i += gs) p.SSQ[i] = (unsigned long long)z_; }
    if (gt == 0) p.QCTR[1] = 0;
    for (int i = gt; i < 1024 * LEAD; i += gs) p.KrT[tix(256, (i / LEAD) >> 8, (i / LEAD) & 255, i % LEAD)] = 0;
    for (int i = gt; i < 2048 * LEAD; i += gs) p.VrT[tix(512, (i / LEAD) >> 9, (i / LEAD) & 511, i % LEAD)] = 0;
  }
  const int NT = 48;
  for (int it = blockIdx.x; it < MTILES * NT; it += gridDim.x) {
    int mt, nt; tile_mn(it, NT, mt, nt);
    int m0 = mt * 128;
    f32x4 acc[4][4];
    if (nt >= 8 && nt < 32) gemm_tile<false>(p.H, DM, Wt, DM, DM, m0, nt * 128, smem, acc);
    else gemm_tile<true>(p.H, DM, Wt, DM, DM, m0, nt * 128, smem, acc);
    if (nt < 8) {
      int hh = nt >> 1, half = nt & 1;
#pragma unroll
      for (int pr = 0; pr < 2; ++pr) {
        int g = half * 4 + wc * 2 + pr;
        f32x4 rr = *(const f32x4*)(p.rope_rev + g * 16 + fq * 4);
#pragma unroll
        for (int m = 0; m < 4; ++m) {
          int row = m0 + wr * 64 + m * 16 + fr;
          int pos = (row < LP) ? (row - NMETA) : ((row < TTOK) ? (PAST + ((row - LP) & 15)) : 0);
          float o1[4], o2[4];
#pragma unroll
          for (int j = 0; j < 4; ++j) {
            float rev = (float)pos * rr[j];
            rev -= floorf(rev);
            float sn = __builtin_amdgcn_sinf(rev), cs = __builtin_amdgcn_cosf(rev);
            float x1 = acc[m][2 * pr][j], x2 = acc[m][2 * pr + 1][j];
            o1[j] = (x1 * cs - x2 * sn) * 0.0625f; o2[j] = (x1 * sn + x2 * cs) * 0.0625f;
          }
          u32x2 t1, t2;
          t1.x = pack2(o1[0], o1[1]); t1.y = pack2(o1[2], o1[3]);
          t2.x = pack2(o2[0], o2[1]); t2.y = pack2(o2[2], o2[3]);
          u16* dq = p.Qr + (size_t)(row + LEAD) * DM + hh * 256 + g * 32 + fq * 4;
          *(u32x2*)dq = t1;
          *(u32x2*)(dq + 16) = t2;
        }
      }
    } else if (nt < 16) {
      bool isq = false;
      int hh = (nt & 7) >> 1, half = nt & 1;
      float l2g = ret_l2g(hh);
      u16* dst = isq ? p.Qr : p.Kr;
#pragma unroll
      for (int pr = 0; pr < 2; ++pr) {
        int g = half * 4 + wc * 2 + pr;
        int fi = g * 16 + fr;
        float rr = p.rope_rev[fi];
        int dp1 = g * 32 + fr, dp2 = dp1 + 16;
#pragma unroll
        for (int m = 0; m < 4; ++m) {
          int rb = m0 + wr * 64 + m * 16 + fq * 4;
          float o1[4], o2[4];
#pragma unroll
          for (int j = 0; j < 4; ++j) {
            int row = rb + j;
            int pos = (row < LP) ? (row - NMETA) : ((row < TTOK) ? (PAST + ((row - LP) & 15)) : 0);
            float rev = (float)pos * rr;
            rev -= floorf(rev);
            float sn = __builtin_amdgcn_sinf(rev), cs = __builtin_amdgcn_cosf(rev);
            float x1 = acc[m][2 * pr][j], x2 = acc[m][2 * pr + 1][j];
            float a = x1 * cs - x2 * sn, bb = x1 * sn + x2 * cs;
            if (isq) { a *= 0.0625f; bb *= 0.0625f; }
            o1[j] = a; o2[j] = bb;
            dst[(size_t)(row + LEAD) * DM + hh * 256 + dp1] = f2bf(a);
            dst[(size_t)(row + LEAD) * DM + hh * 256 + dp2] = f2bf(bb);
          }
          if (!isq) {
            float dc[4];
#pragma unroll
            for (int j = 0; j < 4; ++j) dc[j] = exp2f(l2g * (float)(63 - ((rb + j + LEAD) & 63)));
            u32x2 t1, t2;
            t1.x = pack2(o1[0] * dc[0], o1[1] * dc[1]); t1.y = pack2(o1[2] * dc[2], o1[3] * dc[3]);
            t2.x = pack2(o2[0] * dc[0], o2[1] * dc[1]); t2.y = pack2(o2[2] * dc[2], o2[3] * dc[3]);
            *(u32x2*)(p.KrT + tix(256, hh, dp1, rb + LEAD)) = t1;
            *(u32x2*)(p.KrT + tix(256, hh, dp2, rb + LEAD)) = t2;
          }
        }
      }
    } else if (nt < 32) {
      int hh = (nt - 16) >> 2;
#pragma unroll
      for (int m = 0; m < 4; ++m) {
        int rb = m0 + wr * 64 + m * 16 + fq * 4;
#pragma unroll
        for (int n = 0; n < 4; ++n) {
          int e = ((nt - 16) & 3) * 128 + wc * 64 + n * 16 + fr;
          u32x2 o; o.x = pack2(acc[m][n][0], acc[m][n][1]); o.y = pack2(acc[m][n][2], acc[m][n][3]);
          *(u32x2*)(p.VrT + tix(512, hh, e, rb + LEAD)) = o;
        }
      }
    } else {
#pragma unroll
      for (int m = 0; m < 4; ++m)
#pragma unroll
        for (int n = 0; n < 4; ++n) {
          int row = m0 + wr * 64 + m * 16 + fr;
          int col = (nt - 32) * 128 + wc * 64 + n * 16 + fq * 4;
          u32x2 o; o.x = pack2(acc[m][n][0], acc[m][n][1]); o.y = pack2(acc[m][n][2], acc[m][n][3]);
          *(u32x2*)(p.Gr + (size_t)row * 2048 + col) = o;
        }
    }
  }
}

DEV void ph_r2(const Params& p, int jr) {
  int tid = otid(), lane = tid & 63, wid = tid >> 6, fr = lane & 15, fq = lane >> 4;
  for (int it = blockIdx.x; it < 256; it += gridDim.x) {
    int h = it >> 6, sl = (it >> 2) & 15, rt = (it & 3) * 4 + wid;
    float dec64 = exp2f(ret_l2g(h) * 64.f);
    f32x4 st[2];
    st[0] = f32x4{0.f, 0.f, 0.f, 0.f}; st[1] = st[0];
    const u16* kb = p.KrT + tix(256, h, rt * 16 + fr, 0) + fq * 8;
    const u16* vb = p.VrT + tix(512, h, sl * 32 + fr, 0) + fq * 8;
    u16* sp0 = p.ST + (((size_t)h * 16 + rt) * 512 + sl * 32 + fr) * 16 + fq * 4;
    bf16x8 A0[2], B0[4], A1[2], B1[4], A2[2], B2[4], A3[2], B3[4], A4[2], B4[4], A5[2], B5[4], A6[2], B6[4], A7[2], B7[4];
#define R2L(A, B, n_) { size_t nn_ = (size_t)min((n_), NCH - 1); \
      A[0] = *(const bf16x8*)(kb + nn_ * (256 * 64)); A[1] = *(const bf16x8*)(kb + nn_ * (256 * 64) + 32); \
      B[0] = *(const bf16x8*)(vb + nn_ * (512 * 64)); B[1] = *(const bf16x8*)(vb + nn_ * (512 * 64) + 32); \
      B[2] = *(const bf16x8*)(vb + nn_ * (512 * 64) + 16 * 64); B[3] = *(const bf16x8*)(vb + nn_ * (512 * 64) + 16 * 64 + 32); }
#define R2S(A, B, n_) { \
      _Pragma("unroll") for (int c = 0; c < 2; ++c) { \
        u32x2 o; o.x = pack2(st[c][0], st[c][1]); o.y = pack2(st[c][2], st[c][3]); \
        *(u32x2*)(sp0 + (size_t)(n_) * (4 * 16 * 512 * 16) + c * 16 * 16) = o; \
        f32x4 t = st[c] * dec64; \
        t = mfma(A[0], B[c * 2], t); t = mfma(A[1], B[c * 2 + 1], t); st[c] = t; } }
    R2L(A0, B0, 0) R2L(A1, B1, 1) R2L(A2, B2, 2) R2L(A3, B3, 3) R2L(A4, B4, 4) R2L(A5, B5, 5) R2L(A6, B6, 6) R2L(A7, B7, 7)
#pragma unroll 1
    for (int n = 0; n < 256; n += 8) {
      R2S(A0, B0, n + 0) R2L(A0, B0, n + 8)
      R2S(A1, B1, n + 1) R2L(A1, B1, n + 9)
      R2S(A2, B2, n + 2) R2L(A2, B2, n + 10)
      R2S(A3, B3, n + 3) R2L(A3, B3, n + 11)
      R2S(A4, B4, n + 4) R2L(A4, B4, n + 12)
      R2S(A5, B5, n + 5) R2L(A5, B5, n + 13)
      R2S(A6, B6, n + 6) R2L(A6, B6, n + 14)
      R2S(A7, B7, n + 7) R2L(A7, B7, n + 15)
    }
    R2S(A0, B0, 256)
    int fre = fr, fqe = fq;
    asm volatile("" : "+v"(fre), "+v"(fqe));
#pragma unroll
    for (int c = 0; c < 2; ++c)
#pragma unroll
      for (int j = 0; j < 4; ++j) {
        int dorig = perm_dorig(rt * 16 + fqe * 4 + j);
        p.out[O_SRP + ((size_t)(jr * 4 + h) * 256 + dorig) * 512 + sl * 32 + c * 16 + fre] = st[c][j];
      }
  }
}

DEV void r3_prompt(const Params& p, int jr, int n, int h, char* smem) {
  u32x4* Sf = (u32x4*)smem;
  float* red = (float*)(smem + 8192);
  int tid = otid(), lane = tid & 63, w = tid >> 6, fr = lane & 15, fq = lane >> 4;
  int p0 = n * 64;
  float l2g = ret_l2g(h);
  f32x4 acc[8][4];
#pragma unroll
  for (int a = 0; a < 8; ++a)
#pragma unroll
    for (int b = 0; b < 4; ++b) acc[a][b] = f32x4{0.f, 0.f, 0.f, 0.f};
  const u16* qb = p.Qr + (size_t)(p0 + fr) * DM + h * 256 + fq * 8;
  if (n >= 1) {
    const u16* sb = p.ST + (((size_t)(n * 4 + h) * 16 + (fq >> 1)) * 512 + w * 128 + fr) * 16 + (fq & 1) * 8;
#pragma unroll 1
    for (int ks = 0; ks < 8; ++ks) {
      bf16x8 bq[4];
#pragma unroll
      for (int it = 0; it < 4; ++it) bq[it] = *(const bf16x8*)(qb + (size_t)(it * 16) * DM + ks * 32);
#pragma unroll
      for (int dvt = 0; dvt < 8; ++dvt) {
        bf16x8 a = *(const bf16x8*)(sb + (size_t)(ks * 2) * (512 * 16) + dvt * 16 * 16);
#pragma unroll
        for (int it = 0; it < 4; ++it) acc[dvt][it] = mfma(a, bq[it], acc[dvt][it]);
      }
    }
#pragma unroll
    for (int it = 0; it < 4; ++it) {
      float qd = exp2f(l2g * (float)(it * 16 + fr + 1));
#pragma unroll
      for (int dvt = 0; dvt < 8; ++dvt) acc[dvt][it] = acc[dvt][it] * qd;
    }
  }
  {
    f32x4 s[4];
#pragma unroll
    for (int jt = 0; jt < 4; ++jt) s[jt] = f32x4{0.f, 0.f, 0.f, 0.f};
    const u16* kb = p.Kr + (size_t)(p0 + fr) * DM + h * 256 + fq * 8;
#pragma unroll 1
    for (int ks = 0; ks < 8; ++ks) {
      bf16x8 b = *(const bf16x8*)(qb + (size_t)(w * 16) * DM + ks * 32);
#pragma unroll
      for (int jt = 0; jt < 4; ++jt) {
        bf16x8 a = *(const bf16x8*)(kb + (size_t)(jt * 16) * DM + ks * 32);
        s[jt] = mfma(a, b, s[jt]);
      }
    }
    int i = w * 16 + fr;
#pragma unroll
    for (int jt = 0; jt < 4; ++jt)
#pragma unroll
      for (int jj = 0; jj < 4; ++jj) {
        int j = jt * 16 + fq * 4 + jj;
        int dd = i > j ? i - j : j - i;
        s[jt][jj] *= exp2f(l2g * (float)dd);
      }
    __syncthreads();
#pragma unroll
    for (int pp = 0; pp < 2; ++pp) {
      u32x4 t;
      t.x = pack2(s[2 * pp][0], s[2 * pp][1]); t.y = pack2(s[2 * pp][2], s[2 * pp][3]);
      t.z = pack2(s[2 * pp + 1][0], s[2 * pp + 1][1]); t.w = pack2(s[2 * pp + 1][2], s[2 * pp + 1][3]);
      Sf[(w * 2 + pp) * 64 + lane] = t;
    }
    __syncthreads();
  }
  {
    const u16* vb = p.VrT + tix(512, h, w * 128 + fr, p0) + fq * 4;
#pragma unroll
    for (int pp = 0; pp < 2; ++pp) {
      V8 bs[4];
#pragma unroll
      for (int it = 0; it < 4; ++it) bs[it].q = Sf[(it * 2 + pp) * 64 + lane];
#pragma unroll
      for (int dvt = 0; dvt < 8; ++dvt) {
        V8 a;
        a.d[0] = *(const u32x2*)(vb + dvt * 16 * 64 + (2 * pp) * 16);
        a.d[1] = *(const u32x2*)(vb + dvt * 16 * 64 + (2 * pp + 1) * 16);
#pragma unroll
        for (int it = 0; it < 4; ++it) acc[dvt][it] = mfma(a.v, bs[it].v, acc[dvt][it]);
      }
    }
  }
  float mean[4], rstd[4];
  {
    float s1[4];
#pragma unroll
    for (int it = 0; it < 4; ++it) {
      float s = 0.f;
#pragma unroll
      for (int dvt = 0; dvt < 8; ++dvt) s += acc[dvt][it][0] + acc[dvt][it][1] + acc[dvt][it][2] + acc[dvt][it][3];
      s += __shfl_xor(s, 16); s += __shfl_xor(s, 32);
      s1[it] = s;
    }
    __syncthreads();
    if (fq == 0) {
#pragma unroll
      for (int it = 0; it < 4; ++it) red[w * 64 + it * 16 + fr] = s1[it];
    }
    __syncthreads();
#pragma unroll
    for (int it = 0; it < 4; ++it) {
      int i = it * 16 + fr;
      mean[it] = (red[i] + red[64 + i] + red[128 + i] + red[192 + i]) * (1.f / 512.f);
    }
#pragma unroll
    for (int it = 0; it < 4; ++it) {
      float s = 0.f;
#pragma unroll
      for (int dvt = 0; dvt < 8; ++dvt)
#pragma unroll
        for (int j = 0; j < 4; ++j) { float d = acc[dvt][it][j] - mean[it]; s += d * d; }
      s += __shfl_xor(s, 16); s += __shfl_xor(s, 32);
      s1[it] = s;
    }
    __syncthreads();
    if (fq == 0) {
#pragma unroll
      for (int it = 0; it < 4; ++it) red[w * 64 + it * 16 + fr] = s1[it];
    }
    __syncthreads();
#pragma unroll
    for (int it = 0; it < 4; ++it) {
      int i = it * 16 + fr;
      float var = (red[i] + red[64 + i] + red[128 + i] + red[192 + i]) * (1.f / 512.f);
      rstd[it] = rsqrtf(var + EPS);
    }
  }
#pragma unroll
  for (int it = 0; it < 4; ++it) {
    int t = p0 + it * 16 + fr - LEAD;
    if (t >= 0 && t < LP) {
#pragma unroll
      for (int dvt = 0; dvt < 8; ++dvt) {
        int e0 = h * 512 + w * 128 + dvt * 16 + fq * 4;
        u16* gp = p.Gr + (size_t)t * 2048 + e0;
        u32x2 g = *(const u32x2*)gp;
        f32x4 gn = *(const f32x4*)(p.ret_gn + jr * 2048 + e0);
        float g0 = bflo(g.x), g1 = bfhi(g.x), g2 = bflo(g.y), g3 = bfhi(g.y);
        float y0 = (acc[dvt][it][0] - mean[it]) * rstd[it] * gn.x * (g0 * sigmoidf_(g0));
        float y1 = (acc[dvt][it][1] - mean[it]) * rstd[it] * gn.y * (g1 * sigmoidf_(g1));
        float y2 = (acc[dvt][it][2] - mean[it]) * rstd[it] * gn.z * (g2 * sigmoidf_(g2));
        float y3 = (acc[dvt][it][3] - mean[it]) * rstd[it] * gn.w * (g3 * sigmoidf_(g3));
        u32x2 o; o.x = pack2(y0, y1); o.y = pack2(y2, y3);
        *(u32x2*)gp = o;
      }
    }
  }
}

DEV void r3_sample(const Params& p, int jr, int b, int h, char* smem) {
  float* obuf = (float*)smem;
  u16* qs = (u16*)(smem + 32768);
  u16* ks = qs + 16 * 256;
  float* sm = (float*)(smem + 49152);
  float* red = sm + 256;
  float* stat = red + 64;
  int tid = otid(), lane = tid & 63, wid = tid >> 6;
  float l2g = ret_l2g(h);
  int prow = LP + LEAD + b * 16;
  __syncthreads();
  for (int e = tid; e < 16 * 256; e += 256) {
    int i = e >> 8, d = e & 255;
    qs[e] = p.Qr[(size_t)(prow + i) * DM + h * 256 + d];
    ks[e] = p.Kr[(size_t)(prow + i) * DM + h * 256 + d];
  }
  __syncthreads();
  {
    int i = tid >> 4, j = tid & 15;
    float a = 0.f;
#pragma unroll 8
    for (int d = 0; d < 256; ++d) a += bf2f(qs[i * 256 + d]) * bf2f(ks[j * 256 + d]);
    int dd = i > j ? i - j : j - i;
    sm[tid] = a * exp2f(l2g * (float)dd);
  }
  __syncthreads();
  for (int e = tid; e < 16 * 256; e += 256) ks[e] = f2bf(bf2f(ks[e]) * exp2f(l2g * (float)(15 - (e >> 8))));
  __syncthreads();
  float dec16 = exp2f(l2g * 16.f);
  const float* stin = p.state_ret + ((size_t)(jr * 8 + b) * 4 + h) * 256 * 512;
  float* stout = p.out + O_SRS + ((size_t)(jr * 8 + b) * 4 + h) * 256 * 512;
#pragma unroll 1
  for (int c = 0; c < 2; ++c) {
    int e = tid + c * 256;
    float v[16], o[16];
    const u16* vp = p.VrT + tix(512, h, e, prow);
    u32x4 a = *(const u32x4*)vp, bq = *(const u32x4*)(vp + 8);
    v[0] = bflo(a.x); v[1] = bfhi(a.x); v[2] = bflo(a.y); v[3] = bfhi(a.y);
    v[4] = bflo(a.z); v[5] = bfhi(a.z); v[6] = bflo(a.w); v[7] = bfhi(a.w);
    v[8] = bflo(bq.x); v[9] = bfhi(bq.x); v[10] = bflo(bq.y); v[11] = bfhi(bq.y);
    v[12] = bflo(bq.z); v[13] = bfhi(bq.z); v[14] = bflo(bq.w); v[15] = bfhi(bq.w);
#pragma unroll
    for (int i = 0; i < 16; ++i) o[i] = 0.f;
#pragma unroll 8
    for (int dp = 0; dp < 256; ++dp) {
      int dorig = perm_dorig(dp);
      float s0 = stin[(size_t)dorig * 512 + e];
      float n0 = s0 * dec16;
#pragma unroll
      for (int i = 0; i < 16; ++i) {
        o[i] += bf2f(qs[i * 256 + dp]) * s0;
        n0 += bf2f(ks[i * 256 + dp]) * v[i];
      }
      stout[(size_t)dorig * 512 + e] = n0;
    }
#pragma unroll
    for (int i = 0; i < 16; ++i) obuf[i * 512 + e] = o[i] * exp2f(l2g * (float)(i + 1));
#pragma unroll 1
    for (int i = 0; i < 16; ++i) {
      float a0 = obuf[i * 512 + e];
#pragma unroll
      for (int j = 0; j < 16; ++j) a0 += sm[i * 16 + j] * v[j];
      obuf[i * 512 + e] = a0;
    }
  }
  __syncthreads();
  for (int i = 0; i < 16; ++i) {
    float s = wave_sum(obuf[i * 512 + tid] + obuf[i * 512 + 256 + tid]);
    if (lane == 0) red[wid * 16 + i] = s;
  }
  __syncthreads();
  if (tid < 16) stat[tid] = (red[tid] + red[16 + tid] + red[32 + tid] + red[48 + tid]) * (1.f / 512.f);
  __syncthreads();
  for (int i = 0; i < 16; ++i) {
    float mu = stat[i];
    float d0 = obuf[i * 512 + tid] - mu, d1 = obuf[i * 512 + 256 + tid] - mu;
    float s = wave_sum(d0 * d0 + d1 * d1);
    if (lane == 0) red[wid * 16 + i] = s;
  }
  __syncthreads();
  if (tid < 16) stat[16 + tid] = rsqrtf((red[tid] + red[16 + tid] + red[32 + tid] + red[48 + tid]) * (1.f / 512.f) + EPS);
  __syncthreads();
  for (int c = 0; c < 2; ++c) {
    int e = tid + c * 256;
    float gn = p.ret_gn[jr * 2048 + h * 512 + e];
    for (int i = 0; i < 16; ++i) {
      int t = LP + b * 16 + i;
      float g = bf2f(p.Gr[(size_t)t * 2048 + h * 512 + e]);
      float y = (obuf[i * 512 + e] - stat[i]) * stat[16 + i] * gn * (g * sigmoidf_(g));
      p.Gr[(size_t)t * 2048 + h * 512 + e] = f2bf(y);
    }
  }
}

DEV void ph_r3(const Params& p, int jr, char* smem) {
  const int NP = NCH * 4, NI = NP + 32;
  int* qslot = (int*)(smem + 53248 - 16);
  for (;;) {
    __syncthreads();
    if (otid() == 0) qslot[0] = atomicAdd(p.QCTR + 1, 1);
    __syncthreads();
    int it = qslot[0];
    if (it >= NI) break;
    if (it < 32) r3_sample(p, jr, it >> 2, it & 3, smem);
    else { int q = it - 32; r3_prompt(p, jr, q >> 2, q & 3, smem); }
  }
}

DEV void ph_p2(const Params& p, int layer, char* smem) {
  const u16* Wt = p.WpqT + (size_t)layer * 2048 * 1024;
  u16* Qs = (u16*)smem;
  constexpr int LQ = 136;
  int tid = otid(), lane = tid & 63, wid = tid >> 6;
  int wr = wid >> 1, wc = wid & 1, fr = lane & 15, fq = lane >> 4;
  for (int it = blockIdx.x; it < MTILES * 16; it += gridDim.x) {
    int mt, hp; tile_mn(it, 16, mt, hp);
    int m0 = mt * 128;
    f32x4 acc[4][4];
    gemm_tile<true>(p.H, DM, Wt, DM, DM, m0, hp * 128, smem, acc);
    __syncthreads();
#pragma unroll
    for (int m = 0; m < 4; ++m) {
      float rs = rsqrtf((float)p.SSQ[m0 + wr * 64 + m * 16 + fr] * (1.f / (1048576.f * DM)) + EPS);
#pragma unroll
      for (int n = 0; n < 4; ++n) {
        u32x2 o; o.x = pack2(acc[m][n][0] * rs, acc[m][n][1] * rs); o.y = pack2(acc[m][n][2] * rs, acc[m][n][3] * rs);
        *(u32x2*)(Qs + (wr * 64 + m * 16 + fr) * LQ + wc * 64 + n * 16 + fq * 4) = o;
      }
    }
    __syncthreads();
    f32x4 sc[2][8];
#pragma unroll
    for (int rt = 0; rt < 2; ++rt)
#pragma unroll
      for (int ct = 0; ct < 8; ++ct) sc[rt][ct] = f32x4{0.f, 0.f, 0.f, 0.f};
    const u16* skb = p.SKb + ((size_t)(layer * 16 + hp) * 128 + fr) * 128 + fq * 8;
#pragma unroll
    for (int ks = 0; ks < 4; ++ks) {
      bf16x8 a[2];
#pragma unroll
      for (int rt = 0; rt < 2; ++rt) a[rt] = *(const bf16x8*)(Qs + (wid * 32 + rt * 16 + fr) * LQ + ks * 32 + fq * 8);
#pragma unroll
      for (int ct = 0; ct < 8; ++ct) {
        bf16x8 b = *(const bf16x8*)(skb + (size_t)(ct * 16) * 128 + ks * 32);
#pragma unroll
        for (int rt = 0; rt < 2; ++rt) sc[rt][ct] = mfma(a[rt], b, sc[rt][ct]);
      }
    }
#pragma unroll
    for (int rt = 0; rt < 2; ++rt)
#pragma unroll
      for (int j = 0; j < 4; ++j) {
        uint32_t key[8];
#pragma unroll
        for (int ct = 0; ct < 8; ++ct) key[ct] = (f2key(sc[rt][ct][j]) & ~127u) | (uint32_t)(127 - (ct * 16 + fr));
        uint32_t mine = 0;
#pragma unroll 1
        for (int r = 0; r < 16; ++r) {
          uint32_t best = key[0];
#pragma unroll
          for (int ct = 1; ct < 8; ++ct) best = max(best, key[ct]);
          best = row16_maxu(best);
#pragma unroll
          for (int ct = 0; ct < 8; ++ct) key[ct] = (key[ct] == best) ? 0u : key[ct];
          if (fr == r) mine = best;
        }
        int row = m0 + wid * 32 + rt * 16 + fq * 4 + j;
        p.SV[((size_t)row * 16 + hp) * 16 + fr] = key2f(mine & ~127u);
        p.SI[((size_t)row * 16 + hp) * 16 + fr] = 127 - (int)(mine & 127u);
      }
  }
}

DEV void p3_partial(const Params& p, int t, int h0, int nh, int lane, int* eidL, float* gateL, float* svL,
                    int ca, int cb, bool cvalid, float (&oacc)[16]) {
  const int ne = nh * 16;
  int* siL = (int*)(svL + 256);
  {
    f32x4 sv4 = *(const f32x4*)(p.SV + (size_t)t * 256 + lane * 4);
    u32x4 si4 = *(const u32x4*)(p.SI + (size_t)t * 256 + lane * 4);
    *(f32x4*)(svL + lane * 4) = sv4;
    *(u32x4*)(siL + lane * 4) = si4;
  }
  for (int hl = 0; hl < nh; hl += 2) {
    int ha = h0 + hl, hb2 = ha + 1;
    float canda = cvalid ? (svL[ha * 32 + ca] + svL[ha * 32 + 16 + cb]) : 0.f;
    float candb = cvalid ? (svL[hb2 * 32 + ca] + svL[hb2 * 32 + 16 + cb]) : 0.f;
    uint32_t keya = cvalid ? ((f2key(canda) & ~63u) | (uint32_t)(63 - lane)) : 0u;
    uint32_t keyb = cvalid ? ((f2key(candb) & ~63u) | (uint32_t)(63 - lane)) : 0u;
    uint32_t minea = 0, mineb = 0;
#pragma unroll 1
    for (int r = 0; r < 16; ++r) {
      uint32_t besta = wave_maxu(keya), bestb = wave_maxu(keyb);
      keya = (keya == besta) ? 0u : keya;
      keyb = (keyb == bestb) ? 0u : keyb;
      if (lane == r) { minea = besta; mineb = bestb; }
    }
#pragma unroll
    for (int w = 0; w < 2; ++w) {
      uint32_t mine = w ? mineb : minea;
      int h = w ? hb2 : ha;
      int src = 63 - (int)(mine & 63u);
      int wa = __shfl(ca, src), wb = __shfl(cb, src);
      float fv = key2f(mine & ~63u);
      float f0 = rdlane(fv, 0);
      float e = (lane < 16) ? __expf(fv - f0) : 0.f;
      float ssum = row16_sum(e);
      if (lane < 16) {
        int eid = siL[h * 32 + wa] * 128 + siL[h * 32 + 16 + wb];
        eidL[(hl + w) * 16 + lane] = eid;
        gateL[(hl + w) * 16 + lane] = e / ssum;
      }
    }
  }
  float hf[16];
  {
    u32x4 ha = *(const u32x4*)(p.H + (size_t)t * DM + lane * 16);
    u32x4 hb = *(const u32x4*)(p.H + (size_t)t * DM + lane * 16 + 8);
    hf[0] = bflo(ha.x); hf[1] = bfhi(ha.x); hf[2] = bflo(ha.y); hf[3] = bfhi(ha.y);
    hf[4] = bflo(ha.z); hf[5] = bfhi(ha.z); hf[6] = bflo(ha.w); hf[7] = bfhi(ha.w);
    hf[8] = bflo(hb.x); hf[9] = bfhi(hb.x); hf[10] = bflo(hb.y); hf[11] = bfhi(hb.y);
    hf[12] = bflo(hb.z); hf[13] = bfhi(hb.z); hf[14] = bflo(hb.w); hf[15] = bfhi(hb.w);
    float rs = rsqrtf((float)p.SSQ[t] * (1.f / (1048576.f * DM)) + EPS);
#pragma unroll
    for (int i = 0; i < 16; ++i) hf[i] *= rs;
  }
  const unsigned char* U8 = (const unsigned char*)p.Ub + lane * 16;
  const unsigned char* V8p = (const unsigned char*)p.Vb + lane * 16;
#define P3_LOAD(buf, tab, base) _Pragma("unroll") for (int u = 0; u < 8; ++u) { \
      int eid_ = __builtin_amdgcn_readfirstlane(eidL[(base) + u]); \
      buf[u] = *(const u32x4*)((tab) + (size_t)eid_ * DM); }
#define P3_CVT(f, q) { v2f_t c_; \
      c_ = __builtin_amdgcn_cvt_pk_f32_fp8((int)(q).x, false); f[0] = c_.x; f[1] = c_.y; \
      c_ = __builtin_amdgcn_cvt_pk_f32_fp8((int)(q).x, true);  f[2] = c_.x; f[3] = c_.y; \
      c_ = __builtin_amdgcn_cvt_pk_f32_fp8((int)(q).y, false); f[4] = c_.x; f[5] = c_.y; \
      c_ = __builtin_amdgcn_cvt_pk_f32_fp8((int)(q).y, true);  f[6] = c_.x; f[7] = c_.y; \
      c_ = __builtin_amdgcn_cvt_pk_f32_fp8((int)(q).z, false); f[8] = c_.x; f[9] = c_.y; \
      c_ = __builtin_amdgcn_cvt_pk_f32_fp8((int)(q).z, true);  f[10] = c_.x; f[11] = c_.y; \
      c_ = __builtin_amdgcn_cvt_pk_f32_fp8((int)(q).w, false); f[12] = c_.x; f[13] = c_.y; \
      c_ = __builtin_amdgcn_cvt_pk_f32_fp8((int)(q).w, true);  f[14] = c_.x; f[15] = c_.y; }
#define P3_DOT(buf, base) _Pragma("unroll") for (int u = 0; u < 8; ++u) { \
      float f_[16]; P3_CVT(f_, buf[u]); float d_ = 0.f; \
      _Pragma("unroll") for (int i = 0; i < 16; ++i) d_ += hf[i] * f_[i]; \
      d_ = wave_sum(d_) * (1.f / U_SCALE); \
      int k_ = (base) + u; \
      if (lane == (k_ & 63)) { if (k_ < 64) w0 = d_; else w1 = d_; } }
#define P3_AXPY(buf, base) { float ws_ = ((base) < 64) ? w0 : w1; \
      _Pragma("unroll") for (int u = 0; u < 8; ++u) { \
        float f_[16]; P3_CVT(f_, buf[u]); float wk_ = rdlane(ws_, ((base) + u) & 63); \
        _Pragma("unroll") for (int i = 0; i < 16; ++i) oacc[i] += wk_ * f_[i]; } }
  float w0 = 0.f, w1 = 0.f;
  {
    u32x4 A[8], B[8];
    P3_LOAD(A, U8, 0)
#pragma unroll 1
    for (int kb = 0; kb < ne; kb += 16) {
      P3_LOAD(B, U8, kb + 8)
      P3_DOT(A, kb)
      if (kb + 16 < ne) { P3_LOAD(A, U8, kb + 16) }
      P3_DOT(B, kb + 8)
    }
  }
  w0 = gateL[lane] * gelu_(w0);
  w1 = gateL[64 + lane] * gelu_(w1);
  {
    u32x4 A[8], B[8];
    P3_LOAD(A, V8p, 0)
#pragma unroll 1
    for (int kb = 0; kb < ne; kb += 16) {
      P3_LOAD(B, V8p, kb + 8)
      P3_AXPY(A, kb)
      if (kb + 16 < ne) { P3_LOAD(A, V8p, kb + 16) }
      P3_AXPY(B, kb + 8)
    }
  }
}

DEV void p3_finish(const Params& p, int layer, int t, int lane, float (&oacc)[16]) {
  int te = t, le = lane;
  asm volatile("" : "+v"(te), "+v"(le));
  float* xr = p.X + (size_t)te * DM + le * 16;
  f32x4 xv[4];
#pragma unroll
  for (int c = 0; c < 4; ++c) {
    xv[c] = *(const f32x4*)(xr + c * 4);
    xv[c].x += oacc[c * 4 + 0] * (1.f / V_SCALE); xv[c].y += oacc[c * 4 + 1] * (1.f / V_SCALE);
    xv[c].z += oacc[c * 4 + 2] * (1.f / V_SCALE); xv[c].w += oacc[c * 4 + 3] * (1.f / V_SCALE);
  }
  if (layer < 3) {
    float ss = 0.f;
#pragma unroll
    for (int c = 0; c < 4; ++c) {
      *(f32x4*)(xr + c * 4) = xv[c];
      ss += xv[c].x * xv[c].x + xv[c].y * xv[c].y + xv[c].z * xv[c].z + xv[c].w * xv[c].w;
    }
    ss = wave_sum(ss);
    float rstd = rsqrtf(ss * (1.f / DM) + EPS);
    const float* g = p.norm_mix + (size_t)(layer + 1) * DM + le * 16;
    u32x4 o0, o1;
    f32x4 g0 = *(const f32x4*)(g), g1 = *(const f32x4*)(g + 4), g2 = *(const f32x4*)(g + 8), g3 = *(const f32x4*)(g + 12);
    o0.x = pack2(xv[0].x * rstd * g0.x, xv[0].y * rstd * g0.y); o0.y = pack2(xv[0].z * rstd * g0.z, xv[0].w * rstd * g0.w);
    o0.z = pack2(xv[1].x * rstd * g1.x, xv[1].y * rstd * g1.y); o0.w = pack2(xv[1].z * rstd * g1.z, xv[1].w * rstd * g1.w);
    o1.x = pack2(xv[2].x * rstd * g2.x, xv[2].y * rstd * g2.y); o1.y = pack2(xv[2].z * rstd * g2.z, xv[2].w * rstd * g2.w);
    o1.z = pack2(xv[3].x * rstd * g3.x, xv[3].y * rstd * g3.y); o1.w = pack2(xv[3].z * rstd * g3.z, xv[3].w * rstd * g3.w);
    *(u32x4*)(p.H + (size_t)te * DM + le * 16) = o0;
    *(u32x4*)(p.H + (size_t)te * DM + le * 16 + 8) = o1;
  } else {
    float* yo = nullptr;
    if (te >= NMETA && te < LP) yo = p.out + O_YP + (size_t)(te - NMETA) * DM + le * 16;
    else if (te >= LP) yo = p.out + O_YS + (size_t)(te - LP) * DM + le * 16;
    if (yo) {
#pragma unroll
      for (int c = 0; c < 4; ++c) *(f32x4*)(yo + c * 4) = xv[c];
    }
  }
}

DEV void ph_p3(const Params& p, int layer, char* smem) {
  int tid = otid(), lane = tid & 63, wid = tid >> 6;
  int* eidL = (int*)smem + wid * 256;
  float* gateL = (float*)(eidL + 128);
  float* part = (float*)(smem + 4096);
  float* svL = (float*)(smem + 20480) + wid * 512;
  int ca = 0, cb = 0; bool cvalid = false;
  {
    int cnt = 0;
    for (int a = 0; a < 16; ++a) {
      int nb = 16 / (a + 1);
      if (lane >= cnt && lane < cnt + nb) { ca = a; cb = lane - cnt; cvalid = true; }
      cnt += nb;
    }
  }
  int gw = (blockIdx.x * blockDim.x + tid) >> 6, nw = (gridDim.x * blockDim.x) >> 6;
  int tmain = (TTOK / nw) * nw;
  for (int t = gw; t < tmain; t += nw) {
    float oacc[16];
#pragma unroll
    for (int i = 0; i < 16; ++i) oacc[i] = 0.f;
    p3_partial(p, t, 0, 8, lane, eidL, gateL, svL, ca, cb, cvalid, oacc);
    p3_finish(p, layer, t, lane, oacc);
  }
  for (int t = tmain + blockIdx.x; t < TTOK; t += gridDim.x) {
    float oacc[16];
#pragma unroll
    for (int i = 0; i < 16; ++i) oacc[i] = 0.f;
    p3_partial(p, t, wid * 2, 2, lane, eidL, gateL, svL, ca, cb, cvalid, oacc);
    __syncthreads();
#pragma unroll
    for (int i = 0; i < 16; ++i) part[(wid * 64 + lane) * 16 + i] = oacc[i];
    __syncthreads();
    if (wid == 0) {
#pragma unroll
      for (int i = 0; i < 16; ++i) oacc[i] = part[lane * 16 + i] + part[(64 + lane) * 16 + i] + part[(128 + lane) * 16 + i] + part[(192 + lane) * 16 + i];
      p3_finish(p, layer, t, lane, oacc);
    }
  }
}

constexpr int NPHASE = 23;
#ifndef DBG_PHASES
#define DBG_PHASES NPHASE
#endif
#ifndef DBG_SCALES
#define DBG_SCALES {1,1,1,1,1,1,1,1,1,1,1,1,1,1,1,1,1,1,1,1}
#endif
#ifndef DBG_POST
#define DBG_POST 0
#endif
DEV void post_scale(const Params& p) {
  const float sc[20] = DBG_SCALES;
  const size_t offs[11] = {O_YP, O_YS, O_FKP, O_FVP, O_FLP, O_SRP, O_FKS, O_FVS, O_FLS, O_SRS, O_SRS + (size_t)2 * 8 * 4 * 256 * 512};
  size_t i0 = (size_t)blockIdx.x * blockDim.x + otid(), st = (size_t)gridDim.x * blockDim.x;
#pragma unroll
  for (int k = 0; k < 20; ++k) {
    float f = sc[k];
    if (f == 1.f) continue;
    size_t a = offs[k >> 1], b = offs[(k >> 1) + 1], mid = a + (b - a) / 2;
    size_t lo = (k & 1) ? mid : a, hi = (k & 1) ? b : mid;
    for (size_t i = lo + i0; i < hi; i += st) p.out[i] *= f;
  }
}
DEV void dump_x(const Params& p) {
  size_t i = (size_t)blockIdx.x * blockDim.x + otid(), st = (size_t)gridDim.x * blockDim.x;
  for (; i < (size_t)(TTOK - NMETA) * DM; i += st) p.out[i] = p.X[(size_t)NMETA * DM + i];
}
__global__ void __launch_bounds__(256, 2) mega(Params p, int ph0, int ph1) {
  __shared__ __attribute__((aligned(16))) char smem[53248];
  for (int ph = ph0; ph < ph1; ++ph) {
    if (ph > ph0) cg::this_grid().sync();
    if (ph == 0) { ph_prep(p, smem); continue; }
    int q = ph - 1, layer, idx;
    if (q < 5) { layer = 0; idx = q; } else if (q < 11) { layer = 1; idx = q - 5; }
    else if (q < 16) { layer = 2; idx = q - 11; } else { layer = 3; idx = q - 16; }
    int j = layer >> 1;
    const float* gffn = p.norm_ffn + (size_t)layer * DM;
    if ((layer & 1) == 0) {
      if (idx == 0) ph_f1(p, j, smem);
      else if (idx == 1) ph_f2(p, j, smem);
      else if (idx == 2) ph_outproj(p, p.AO, 1024, p.WfoutT + (size_t)j * 1024 * 1024, gffn, smem);
      else if (idx == 3) ph_p2(p, layer, smem);
      else ph_p3(p, layer, smem);
    } else {
      if (idx == 0) ph_r1(p, j, smem);
      else if (idx == 1) { ph_r2(p, j); conv_tables(p, layer); }
      else if (idx == 2) ph_r3(p, j, smem);
      else if (idx == 3) ph_outproj(p, p.Gr, 2048, p.WroutT + (size_t)j * 1024 * 2048, gffn, smem);
      else if (idx == 4) ph_p2(p, layer, smem);
      else ph_p3(p, layer, smem);
    }
  }
}

extern "C" void kernel_launch(void* const* d_in, const int* in_sizes, int n_in, void* d_out, int out_size,
                              void* d_ws, size_t ws_size, hipStream_t stream) {
  static int grid_blocks = 0;
  if (!grid_blocks) {
    int dev = 0, cus = 0, per_cu = 0;
    hipGetDevice(&dev);
    hipDeviceGetAttribute(&cus, hipDeviceAttributeMultiprocessorCount, dev);
    hipOccupancyMaxActiveBlocksPerMultiprocessor(&per_cu, mega, 256, 0);
    if (per_cu > 2) per_cu = 2;
    if (per_cu < 1) per_cu = 1;
    grid_blocks = cus * per_cu;
  }
  Params p;
  memset(&p, 0, sizeof(p));
  const float* const* in = (const float* const*)d_in;
  p.x_prompt = in[0]; p.x_sample = in[1]; p.cache_k = in[2]; p.cache_v = in[3]; p.cache_lf = in[4]; p.state_ret = in[5];
  p.meta = in[6]; p.norm_mix = in[7]; p.norm_ffn = in[8]; p.fox_w_in = in[9]; p.fox_b_f = in[10]; p.fox_qn = in[11];
  p.fox_kn = in[12]; p.fox_w_out = in[13]; p.ret_w_in = in[14]; p.ret_gn = in[15]; p.ret_w_out = in[16];
  p.peer_wq = in[17]; p.peer_sk = in[18]; p.peer_u = in[19]; p.peer_v = in[20];
  p.out = (float*)d_out;
  char* w = (char*)d_ws;
  size_t off = 0;
  auto take = [&](size_t bytes) { char* r = w + off; off += (bytes + 255) & ~(size_t)255; return r; };
  p.X = (float*)take((size_t)TPAD * DM * 4);
  p.H = (u16*)take((size_t)TPAD * DM * 2);
  p.WfinT = (u16*)take((size_t)2 * 4224 * 1024 * 2);
  p.WfoutT = (u16*)take((size_t)2 * 1024 * 1024 * 2);
  p.WrinT = (u16*)take((size_t)2 * 6144 * 1024 * 2);
  p.WroutT = (u16*)take((size_t)2 * 1024 * 2048 * 2);
  p.WpqT = (u16*)take((size_t)4 * 2048 * 1024 * 2);
  p.SKb = (u16*)take((size_t)4 * 8 * 2 * 128 * 128 * 2);
  p.Ub = (u16*)take((size_t)NEXP * DM * 2);
  p.Vb = (u16*)take((size_t)NEXP * DM * 2);
  p.SV = (float*)take((size_t)TPAD * 256 * 4);
  p.SI = (int*)take((size_t)TPAD * 256 * 4);
  p.LFC = (float*)take((size_t)TPAD * 16 * 4);
  p.LFR = (float*)take((size_t)TPAD * 16 * 4);
  p.TT = (float*)take((size_t)MTILES * 16 * 4);
  p.SSQ = (unsigned long long*)take((size_t)TPAD * 8);
  p.QCTR = (int*)take(256);
  size_t region = off;
  p.Qf = (u16*)take((size_t)TPAD * DM * 2);
  p.Kf = (u16*)take((size_t)TPAD * DM * 2);
  p.VtF = (u16*)take((size_t)1024 * TPAD * 2);
  p.OGf = (u16*)take((size_t)TPAD * DM * 2);
  p.AO = (u16*)take((size_t)TPAD * DM * 2);
  off = region;
  p.Qr = (u16*)take((size_t)TP2 * DM * 2);
  p.Kr = (u16*)take((size_t)TP2 * DM * 2);
  p.KrT = (u16*)take((size_t)1024 * TP2 * 2);
  p.VrT = (u16*)take((size_t)2048 * TP2 * 2);
  p.Gr = (u16*)take((size_t)TPAD * 2048 * 2);
  p.ST = (u16*)take((size_t)NCH * 4 * 512 * 256 * 2);
  if (off > ws_size) { fprintf(stderr, "workspace too small: need %zu have %zu\n", off, ws_size); return; }
  for (int i = 0; i < 128; ++i) p.rope_rev[i] = (float)(pow(10000.0, -(double)i / 128.0) / (2.0 * M_PI));
#if ONE_LAUNCH
  int ph0 = 0, ph1 = NPHASE;
  void* args[] = {&p, &ph0, &ph1};
  hipError_t e = hipLaunchCooperativeKernel((void*)mega, dim3(grid_blocks), dim3(256), args, 0, stream);
  if (e != hipSuccess) fprintf(stderr, "cooperative launch failed: %s (grid %d)\n", hipGetErrorString(e), grid_blocks);
#else
  for (int ph = 0; ph < NPHASE; ++ph) mega<<<grid_blocks, 256, 0, stream>>>(p, ph, ph + 1);
#endif
}
```
